# Optimizing an MI355X kernel written in HIP

```python
import math
import jax, jax.numpy as jnp
from jax import lax
import numpy as np

D_MODEL = 1024
BATCH = 2
SEQ = 16384
DEPTH = 4

GRID_W = 64
CTX_LEN = 256
N_MIXERS = 4
MOD_CHUNKS = 6
RMS_EPS = 1e-6
ROPE_THETA = 10000.0
Q_BLOCK = 128

POOL_WINDOWS = (2, 4, 8, 16)
POOL_GROUP = D_MODEL // len(POOL_WINDOWS)
GQA_HEAD_DIM = 128
GQA_Q_HEADS = D_MODEL // GQA_HEAD_DIM
GQA_KV_HEADS = 2
GQA_GROUP = GQA_Q_HEADS // GQA_KV_HEADS
CONV_WIDTH = 3
DIFF_HEAD_DIM = 64
DIFF_HEADS = D_MODEL // (2 * DIFF_HEAD_DIM)
N_EXPERTS = 32
TOP_K = 4
D_FF = D_MODEL
SWIGLU_LIMIT = 7.0
SWIGLU_ALPHA = 1.702
EXPERT_BLOCK = 512

kernel_name = "hybrid_interleaved_dit_block"


def rmsnorm(x, g):
    xf = x.astype(jnp.float32)
    xf = xf * lax.rsqrt(jnp.mean(xf * xf, axis=-1, keepdims=True) + RMS_EPS)
    return xf.astype(x.dtype) * g


def axial_rope_tables(row, col, dim):
    n = dim // 4
    freqs = ROPE_THETA ** (-jnp.arange(n, dtype=jnp.float32) / n)
    ang = jnp.concatenate([row[:, None] * freqs, col[:, None] * freqs], axis=-1)
    return jnp.cos(ang), jnp.sin(ang)


def apply_rope(x, cos, sin):
    half = x.shape[-1] // 2
    x1, x2 = x[..., :half], x[..., half:]
    cos = cos.astype(x.dtype)
    sin = sin.astype(x.dtype)
    return jnp.concatenate([x1 * cos - x2 * sin, x2 * cos + x1 * sin], axis=-1)


def sweep_query_blocks(fn, *qs):
    L = qs[0].shape[-2]
    nb = L // Q_BLOCK

    def split(q):
        qb = q.reshape(q.shape[:-2] + (nb, Q_BLOCK, q.shape[-1]))
        return jnp.moveaxis(qb, -3, 0)

    out = lax.map(lambda blk: fn(*blk), tuple(split(q) for q in qs))
    out = jnp.moveaxis(out, 0, -3)
    return out.reshape(out.shape[:-3] + (L, out.shape[-1]))


def pool_seq(h, w_pool, scale):
    b, l, _ = h.shape
    hf = h.astype(jnp.float32)
    cs = jnp.pad(jnp.cumsum(hf, axis=1), ((0, 0), (1, 0), (0, 0)))
    t = jnp.arange(l)
    parts = []
    for g, w in enumerate(POOL_WINDOWS):
        lo = jnp.clip(t - w // 2, 0, l)
        hi = jnp.clip(t + (w - w // 2), 0, l)
        cg = cs[..., g * POOL_GROUP:(g + 1) * POOL_GROUP]
        mean = (cg[:, hi] - cg[:, lo]) / (hi - lo).astype(jnp.float32)[:, None]
        parts.append(mean - hf[..., g * POOL_GROUP:(g + 1) * POOL_GROUP])
    d = jnp.stack(parts, axis=2).astype(h.dtype)
    y = jnp.einsum('blgc,gcd->blgd', d, w_pool).reshape(b, l, D_MODEL)
    return y * scale


def pool_mixer(h_ctx, h_lat, w_pool, scale, need_ctx):
    y_ctx = pool_seq(h_ctx, w_pool, scale) if need_ctx else None
    return y_ctx, pool_seq(h_lat, w_pool, scale)


def gqa_attend(q, k, v):
    s = jnp.einsum('bhgqd,bhkd->bhgqk', q, k)
    p = jax.nn.softmax(s.astype(jnp.float32) * GQA_HEAD_DIM ** -0.5, axis=-1)
    return jnp.einsum('bhgqk,bhkd->bhgqd', p.astype(v.dtype), v)


def gqa_mixer(h_ctx, h_lat, w_qkv, w_o, q_gain, k_gain, cos, sin, need_ctx):
    def project(h):
        b, l, _ = h.shape
        q, k, v = jnp.split(h @ w_qkv, [GQA_Q_HEADS * GQA_HEAD_DIM,
                                        (GQA_Q_HEADS + GQA_KV_HEADS) * GQA_HEAD_DIM], axis=-1)
        q = q.reshape(b, l, GQA_KV_HEADS, GQA_GROUP, GQA_HEAD_DIM).transpose(0, 2, 3, 1, 4)
        k = k.reshape(b, l, GQA_KV_HEADS, GQA_HEAD_DIM).transpose(0, 2, 1, 3)
        v = v.reshape(b, l, GQA_KV_HEADS, GQA_HEAD_DIM).transpose(0, 2, 1, 3)
        return rmsnorm(q, q_gain), rmsnorm(k, k_gain), v

    def merge(o):
        b, _, _, l, _ = o.shape
        return o.transpose(0, 3, 1, 2, 4).reshape(b, l, GQA_Q_HEADS * GQA_HEAD_DIM) @ w_o

    q_c, k_c, v_c = project(h_ctx)
    q_l, k_l, v_l = project(h_lat)
    q_l = apply_rope(q_l, cos, sin)
    k_l = apply_rope(k_l, cos, sin)
    k_all = jnp.concatenate([k_c, k_l], axis=2)
    v_all = jnp.concatenate([v_c, v_l], axis=2)
    o_lat = sweep_query_blocks(lambda qb: gqa_attend(qb, k_all, v_all), q_l)
    y_ctx = merge(gqa_attend(q_c, k_c, v_c)) if need_ctx else None
    return y_ctx, merge(o_lat)


def depthwise_conv3(u, w):
    return lax.conv_general_dilated(u, w[:, None, :], window_strides=(1,),
                                    padding=((CONV_WIDTH // 2, CONV_WIDTH // 2),),
                                    dimension_numbers=('NWC', 'WIO', 'NWC'),
                                    feature_group_count=u.shape[-1])


def shortconv_seq(h, w_in, w_dw, w_out):
    gate_b, gate_c, xv = jnp.split(h @ w_in, 3, axis=-1)
    return (gate_b * depthwise_conv3(gate_c * xv, w_dw)) @ w_out


def shortconv_mixer(h_ctx, h_lat, w_in, w_dw, w_out, need_ctx):
    y_ctx = shortconv_seq(h_ctx, w_in, w_dw, w_out) if need_ctx else None
    return y_ctx, shortconv_seq(h_lat, w_in, w_dw, w_out)


def diff_attend(q1, q2, k1, k2, v, lam):
    scale = DIFF_HEAD_DIM ** -0.5
    p1 = jax.nn.softmax(jnp.einsum('bhqd,bhkd->bhqk', q1, k1).astype(jnp.float32) * scale, axis=-1)
    p2 = jax.nn.softmax(jnp.einsum('bhqd,bhkd->bhqk', q2, k2).astype(jnp.float32) * scale, axis=-1)
    return jnp.einsum('bhqk,bhkd->bhqd', (p1 - lam * p2).astype(v.dtype), v)


def diff_mixer(h_ctx, h_lat, w_qkv, w_o, lam_vecs, subln_gain, lam_init, cos, sin, need_ctx):
    lv = lam_vecs.astype(jnp.float32)
    lam = jnp.exp(jnp.sum(lv[0] * lv[1])) - jnp.exp(jnp.sum(lv[2] * lv[3])) + lam_init

    def project(h):
        b, l, _ = h.shape
        q, k, v = jnp.split(h @ w_qkv, 3, axis=-1)
        q = q.reshape(b, l, DIFF_HEADS, 2, DIFF_HEAD_DIM).transpose(3, 0, 2, 1, 4)
        k = k.reshape(b, l, DIFF_HEADS, 2, DIFF_HEAD_DIM).transpose(3, 0, 2, 1, 4)
        v = v.reshape(b, l, DIFF_HEADS, 2 * DIFF_HEAD_DIM).transpose(0, 2, 1, 3)
        return q[0], q[1], k[0], k[1], v

    def merge(o):
        b, _, l, _ = o.shape
        o = rmsnorm(o, subln_gain) * (1.0 - lam_init)
        return o.transpose(0, 2, 1, 3).reshape(b, l, D_MODEL) @ w_o

    q1_c, q2_c, k1_c, k2_c, v_c = project(h_ctx)
    q1_l, q2_l, k1_l, k2_l, v_l = project(h_lat)
    q1_l, q2_l = apply_rope(q1_l, cos, sin), apply_rope(q2_l, cos, sin)
    k1_l, k2_l = apply_rope(k1_l, cos, sin), apply_rope(k2_l, cos, sin)
    k1_all = jnp.concatenate([k1_c, k1_l], axis=2)
    k2_all = jnp.concatenate([k2_c, k2_l], axis=2)
    v_all = jnp.concatenate([v_c, v_l], axis=2)
    o_lat = sweep_query_blocks(lambda a, b_: diff_attend(a, b_, k1_all, k2_all, v_all, lam), q1_l, q2_l)
    y_ctx = merge(diff_attend(q1_c, q2_c, k1_c, k2_c, v_c, lam)) if need_ctx else None
    return y_ctx, merge(o_lat)


def moe_ffn(h, w_router, b_router, w1, b1, w2, b2):
    T, D = h.shape
    logits = (h @ w_router).astype(jnp.float32) + b_router.astype(jnp.float32)
    top_val, top_idx = lax.top_k(logits, TOP_K)
    gates = jax.nn.softmax(top_val, axis=-1)
    n = T * TOP_K
    flat_e = top_idx.reshape(-1)
    flat_tok = jnp.arange(n, dtype=jnp.int32) // TOP_K
    order = jnp.argsort(flat_e)
    se, st, sg = flat_e[order], flat_tok[order], gates.reshape(-1)[order]
    counts = jnp.zeros((N_EXPERTS,), jnp.int32).at[flat_e].add(1)
    padded = (counts + EXPERT_BLOCK - 1) // EXPERT_BLOCK * EXPERT_BLOCK
    start = jnp.cumsum(counts) - counts
    pend = jnp.cumsum(padded)
    pstart = pend - padded
    dest = pstart[se] + (jnp.arange(n, dtype=jnp.int32) - start[se])
    n_blocks = -(-n // EXPERT_BLOCK) + N_EXPERTS
    n_pad = n_blocks * EXPERT_BLOCK
    row_tok = jnp.zeros((n_pad,), jnp.int32).at[dest].set(st)
    row_gate = jnp.zeros((n_pad,), jnp.float32).at[dest].set(sg)
    block_e = jnp.minimum(
        jnp.searchsorted(pend, jnp.arange(n_blocks, dtype=jnp.int32) * EXPERT_BLOCK, side='right'),
        N_EXPERTS - 1)

    def expert_block(args):
        tok, e = args
        gu = h[tok] @ w1[e] + b1[e]
        g = jnp.minimum(gu[:, :D_FF], SWIGLU_LIMIT)
        u = jnp.clip(gu[:, D_FF:], -SWIGLU_LIMIT, SWIGLU_LIMIT)
        act = g * jax.nn.sigmoid(SWIGLU_ALPHA * g) * (u + 1.0)
        return act @ w2[e] + b2[e]

    out = lax.map(expert_block, (row_tok.reshape(n_blocks, EXPERT_BLOCK), block_e))
    out = out.reshape(n_pad, D) * row_gate[:, None].astype(h.dtype)
    return jnp.zeros_like(h).at[row_tok].add(out)


def setup_inputs(seed: int = 0) -> dict:
    key = jax.random.key(seed)
    keys = list(jax.random.split(key, 32))

    def nrm(shape, scale):
        return scale * jax.random.normal(keys.pop(), shape, jnp.float32)

    def gain(shape):
        return 1.0 + nrm(shape, 0.1)

    n_a, n_b, n_c, n_d = (len(range(m, DEPTH, N_MIXERS)) for m in range(N_MIXERS))
    D = D_MODEL
    s = D ** -0.5
    return {
        "x": nrm((BATCH, SEQ, D), 1.0),
        "c": nrm((BATCH, D), 1.0),
        "ctx": nrm((BATCH, CTX_LEN, D), 1.0),
        "c_ctx": nrm((D,), 1.0),
        "mod_w": nrm((DEPTH, D, MOD_CHUNKS * D), 0.3 * s),
        "mod_b": nrm((DEPTH, MOD_CHUNKS * D), 0.02),
        "norm_g": gain((DEPTH, 4, D)),
        "pool_w": nrm((n_a, len(POOL_WINDOWS), POOL_GROUP, POOL_GROUP), POOL_GROUP ** -0.5),
        "pool_scale": gain((n_a, D)),
        "gqa_w_qkv": nrm((n_b, D, (GQA_Q_HEADS + 2 * GQA_KV_HEADS) * GQA_HEAD_DIM), s),
        "gqa_w_o": nrm((n_b, GQA_Q_HEADS * GQA_HEAD_DIM, D), (GQA_Q_HEADS * GQA_HEAD_DIM) ** -0.5),
        "gqa_q_gain": gain((n_b, GQA_HEAD_DIM)),
        "gqa_k_gain": gain((n_b, GQA_HEAD_DIM)),
        "conv_w_in": nrm((n_c, D, 3 * D), s),
        "conv_w_dw": nrm((n_c, CONV_WIDTH, D), CONV_WIDTH ** -0.5),
        "conv_w_out": nrm((n_c, D, D), s),
        "diff_w_qkv": nrm((n_d, D, 3 * D), s),
        "diff_w_o": nrm((n_d, D, D), s),
        "diff_lambda": nrm((n_d, 4, DIFF_HEAD_DIM), 0.1),
        "diff_subln_gain": gain((n_d, 2 * DIFF_HEAD_DIM)),
        "router_w": nrm((DEPTH, D, N_EXPERTS), s),
        "router_b": nrm((DEPTH, N_EXPERTS), 0.01),
        "moe_w1": nrm((DEPTH, N_EXPERTS, D, 2 * D_FF), s),
        "moe_b1": nrm((DEPTH, N_EXPERTS, 2 * D_FF), 0.02),
        "moe_w2": nrm((DEPTH, N_EXPERTS, D_FF, D), D_FF ** -0.5),
        "moe_b2": nrm((DEPTH, N_EXPERTS, D), 0.02),
    }


def reference(x, c, ctx, c_ctx, mod_w, mod_b, norm_g, pool_w, pool_scale,
              gqa_w_qkv, gqa_w_o, gqa_q_gain, gqa_k_gain,
              conv_w_in, conv_w_dw, conv_w_out,
              diff_w_qkv, diff_w_o, diff_lambda, diff_subln_gain,
              router_w, router_b, moe_w1, moe_b1, moe_w2, moe_b2):
    b, L, D = x.shape
    n_ctx = ctx.shape[1]
    rows = L // GRID_W
    row = jnp.broadcast_to(jnp.arange(rows, dtype=jnp.float32)[:, None], (rows, GRID_W)).reshape(-1)
    col = jnp.broadcast_to(jnp.arange(GRID_W, dtype=jnp.float32)[None, :], (rows, GRID_W)).reshape(-1)
    cos_b, sin_b = axial_rope_tables(row, col, GQA_HEAD_DIM)
    cos_d, sin_d = axial_rope_tables(row, col, DIFF_HEAD_DIM)
    silu_c = jax.nn.silu(c)
    silu_cc = jax.nn.silu(c_ctx)

    for i in range(DEPTH):
        m, j = i % N_MIXERS, i // N_MIXERS
        need_ctx = i < DEPTH - 1
        mod_l = jnp.split((silu_c @ mod_w[i] + mod_b[i])[:, None, :], MOD_CHUNKS, axis=-1)
        mod_c = jnp.split(silu_cc @ mod_w[i] + mod_b[i], MOD_CHUNKS, axis=-1)

        h_l = rmsnorm(x, norm_g[i, 0]) * (1.0 + mod_l[1]) + mod_l[0]
        h_c = rmsnorm(ctx, norm_g[i, 0]) * (1.0 + mod_c[1]) + mod_c[0]
        if m == 0:
            y_c, y_l = pool_mixer(h_c, h_l, pool_w[j], pool_scale[j], need_ctx)
        elif m == 1:
            y_c, y_l = gqa_mixer(h_c, h_l, gqa_w_qkv[j], gqa_w_o[j], gqa_q_gain[j], gqa_k_gain[j],
                                 cos_b, sin_b, need_ctx)
        elif m == 2:
            y_c, y_l = shortconv_mixer(h_c, h_l, conv_w_in[j], conv_w_dw[j], conv_w_out[j], need_ctx)
        else:
            lam_init = 0.8 - 0.6 * math.exp(-0.3 * i)
            y_c, y_l = diff_mixer(h_c, h_l, diff_w_qkv[j], diff_w_o[j], diff_lambda[j],
                                  diff_subln_gain[j], lam_init, cos_d, sin_d, need_ctx)
        x = x + mod_l[2] * rmsnorm(y_l, norm_g[i, 1])

        h_l = rmsnorm(x, norm_g[i, 2]) * (1.0 + mod_l[4]) + mod_l[3]
        if need_ctx:
            ctx = ctx + mod_c[2] * rmsnorm(y_c, norm_g[i, 1])
            h_c = rmsnorm(ctx, norm_g[i, 2]) * (1.0 + mod_c[4]) + mod_c[3]
            h_all = jnp.concatenate([h_c, h_l], axis=1)
        else:
            h_all = h_l
        y_all = moe_ffn(h_all.reshape(-1, D), router_w[i], router_b[i],
                        moe_w1[i], moe_b1[i], moe_w2[i], moe_b2[i]).reshape(h_all.shape)
        x = x + mod_l[5] * rmsnorm(y_all[:, h_all.shape[1] - L:], norm_g[i, 3])
        if need_ctx:
            ctx = ctx + mod_c[5] * rmsnorm(y_all[:, :n_ctx], norm_g[i, 3])
    return x
```

```cpp
#include <hip/hip_runtime.h>
#include <cstdio>
#include <cstdint>

#define GAS __attribute__((address_space(1)))
#define LAS __attribute__((address_space(3)))

constexpr int D = 1024, NB = 2, SEQ = 16384, NCTX = 256, SB = SEQ + NCTX  , T = NB * SB  ;
constexpr int NE = 32, TOPK = 4, DFF = 1024;
constexpr int MAXTILES = T * TOPK / 256 + NE;
constexpr int CROWS = MAXTILES * 256;
constexpr float RMS_EPS = 1e-6f;
constexpr float LAM_INIT = 0.55605818f;
constexpr float LOG2_THETA = 13.287712379549449f;
constexpr float INV_2PI = 0.15915494309189535f;
constexpr float OS_GQA = 32.f, OS_DIFF = 16.f, OS_CONV = 4.f;

enum { I_X = 0, I_C, I_CTX, I_CCTX, I_MODW, I_MODB, I_NORMG, I_POOLW, I_POOLS, I_GQKV, I_GO, I_GQG, I_GKG, I_CIN, I_CDW, I_COUT, I_DQKV, I_DO, I_DLAM, I_DSUB,
       I_RW, I_RB, I_W1, I_B1, I_W2, I_B2, N_IN };

constexpr size_t MiB = 1u << 20;
constexpr size_t WS_CTL = 0, CTL_ZERO_BYTES = 1 * MiB;
constexpr size_t WS_MOD = 1 * MiB;
constexpr size_t WS_POOLW = 2 * MiB;
constexpr size_t WS_GQKV = 3 * MiB;
constexpr size_t WS_GO = 6 * MiB;
constexpr size_t WS_CIN = 8 * MiB;
constexpr size_t WS_COUT = 14 * MiB;
constexpr size_t WS_DQKV = 16 * MiB;
constexpr size_t WS_DO = 22 * MiB;
constexpr size_t WS_GATE = 24 * MiB;
constexpr size_t WS_B1H = 25 * MiB;
constexpr size_t WS_B2H = WS_B1H + 512 * 1024;
constexpr size_t WS_LIST = 26 * MiB;
constexpr size_t WS_W1T = 32 * MiB;
constexpr size_t WS_W2T = WS_W1T + 512 * MiB;
constexpr size_t WS_X = WS_W2T + 256 * MiB;
constexpr size_t WS_H = WS_X + 130 * MiB;
constexpr size_t WS_G = WS_H + 65 * MiB;
constexpr size_t WS_O = WS_G + 195 * MiB;
constexpr size_t WS_OA = WS_O + 65 * MiB;
constexpr size_t WS_OB = WS_OA + 65 * MiB;
constexpr size_t WS_Y = WS_OB + 65 * MiB;
constexpr size_t WS_HS = WS_Y + 65 * MiB;
constexpr size_t WS_ACT = WS_HS + 276 * MiB;
constexpr size_t WS_SLOT = WS_ACT + 276 * MiB;
constexpr size_t WS_Q8 = WS_SLOT + 260 * MiB;
constexpr size_t WS_K8 = WS_Q8 + 33 * MiB;
constexpr size_t WS_VT8 = WS_K8 + 33 * MiB;
constexpr size_t WS_END = WS_VT8 + 33 * MiB;
static_assert((size_t)T * 1024 <= 33 * MiB && (size_t)NB * 8 * 128 * SB <= 33 * MiB, "ws map fp8");
static_assert((size_t)T * D * 4 <= 130 * MiB && (size_t)T * D * 2 <= 65 * MiB && (size_t)T * 3072 * 2 <= 195 * MiB && (size_t)CROWS * D * 2 <= 276 * MiB && (size_t)T * 4 * D * 2 <= 260 * MiB, "ws map");
static_assert((size_t)NE * T * 4 <= 6 * MiB && (size_t)CROWS * 4 <= 1 * MiB && (size_t)T * 4 * 4 <= 1 * MiB && 4 * 3 * 6144 * 4 <= 1 * MiB, "ws map small");
constexpr int CW_CNT = 64;
constexpr int CW_BAR = 4096;

constexpr int RING_BYTES = 131072;
constexpr int LC_MISC = RING_BYTES;
constexpr int LC_CNT = LC_MISC + 64;
constexpr int LC_TBASE = LC_CNT + 128;
constexpr int LC_LCNT = LC_TBASE + 192;
constexpr int LC_GBASE = LC_LCNT + 128;
constexpr int LC_TILEE = LC_GBASE + 128;
constexpr int LC_TOK16 = LC_TILEE + MAXTILES * 4;
constexpr int MAXU = 26;
constexpr int LDS_BYTES = 147456;
static_assert(LC_TOK16 % 16 == 0 && LC_TOK16 + MAXU * 512 <= LDS_BYTES, "LDS map");

typedef unsigned short bf16_t;
typedef float f32x4 __attribute__((ext_vector_type(4)));
typedef float f32x2 __attribute__((ext_vector_type(2)));
typedef unsigned u32x2 __attribute__((ext_vector_type(2)));
typedef unsigned u32x4 __attribute__((ext_vector_type(4)));

__device__ __forceinline__ unsigned pkbf(float lo, float hi) { unsigned r; asm("v_cvt_pk_bf16_f32 %0, %1, %2" : "=v"(r) : "v"(lo), "v"(hi)); return r; }
__device__ __forceinline__ float bflo(unsigned w) { return __uint_as_float(w << 16); }
__device__ __forceinline__ float bfhi(unsigned w) { return __uint_as_float(w & 0xffff0000u); }
__device__ __forceinline__ float wave_sum(float v) {
#pragma unroll
    for (int o = 1; o < 64; o <<= 1) v += __shfl_xor(v, o);
    return v;
}
#define LDS_WAIT() asm volatile("s_waitcnt lgkmcnt(0)" ::: "memory")
#define VM_WAIT() asm volatile("s_waitcnt vmcnt(0)" ::: "memory")

namespace pg8 {
#define PG8_LAS __attribute__((address_space(3)))
typedef unsigned short bf16_t;
typedef short bf16x8 __attribute__((ext_vector_type(8)));
typedef float f32x4 __attribute__((ext_vector_type(4)));
typedef unsigned u32x4 __attribute__((ext_vector_type(4)));
typedef int i32x4 __attribute__((ext_vector_type(4)));
typedef int i32x8 __attribute__((ext_vector_type(8)));
typedef unsigned u32x2 __attribute__((ext_vector_type(2)));
constexpr int BM = 256, BK = 64, HALF = 128, HTB = HALF * BK * 2  , STAGE_BYTES = 8 * HTB, NXCD = 8, WGM = 8;

__host__ __device__ __forceinline__ int lds_byte(int r, int c) { const int st = (r >> 4) * 2 + (c >> 5), rr = r & 15, cc = c & 31, ob = rr * 64 + cc * 2; return st * 1024 + (ob ^ (((ob >> 9) & 1) << 5)); }
__host__ __device__ __forceinline__ void stage_rc(int b, int& R, int& C) { const int st = b / 1024, sb = b % 1024, swz = sb ^ (((sb >> 9) & 1) << 5); R = (st >> 1) * 16 + swz / 64; C = (st & 1) * 32 + (swz % 64) / 2; }
__host__ __device__ __forceinline__ int perm32(int rho) { const int n = rho >> 4, i = rho & 15; return 8 * (i >> 2) + 4 * n + (i & 3); }

struct Unit { int pm, pn; };
struct Gemm { const bf16_t* A; const bf16_t* Bt; int M, N, K; };

struct StaticOrder {
    int nM, nN, nwg, G, c;
    __host__ __device__ void init(int M, int N, int G_, int c_) { nM = M / BM; nN = N / BM; nwg = nM * nN; G = G_; c = c_; }
    __host__ __device__ bool next(int i, Unit& u) const {
        const long L = (long)i * G + c; if (L >= nwg) return false;
        int wgid = (int)L; { const int q = nwg / NXCD, r = nwg % NXCD, xcd = wgid % NXCD, off = wgid / NXCD; wgid = (xcd < r ? xcd * (q + 1) : r * (q + 1) + (xcd - r) * q) + off; }
        const int nig = WGM * nN, gid = wgid / nig, fm = gid * WGM, gsz = (nM - fm) < WGM ? (nM - fm) : WGM;
        u.pm = fm + ((wgid % nig) % gsz); u.pn = (wgid % nig) / gsz; return true;
    }
    __device__ __forceinline__ void a_ready(const Unit&) const {}
    __device__ __forceinline__ void done(const Unit&) const {}
};


struct PoolOrder {
    int G, c;
    __device__ __forceinline__ bool next(int i, Unit& u) const { const int L = i * G + c; if (L >= 4 * 130) return false; const int g = L & 3, pm = L >> 2; u.pm = g * 130 + pm; u.pn = g; return true; }
    __device__ __forceinline__ void a_ready(const Unit&) const {}
    __device__ __forceinline__ void done(const Unit&) const {}
};
struct LatentOrder {
    StaticOrder S;
    __device__ void init(int N, int G_, int c_) { S.init(NB * SEQ, N, G_, c_); }
    __device__ bool next(int i, Unit& u) const { if (!S.next(i, u)) return false; u.pm += (u.pm >= SEQ / 256) ? 2 : 1; return true; }
    __device__ __forceinline__ void a_ready(const Unit&) const {}
    __device__ __forceinline__ void done(const Unit&) const {}
};
struct MoeOrder {
    const PG8_LAS int* tile_e; int lim, nN, G, c;
    __device__ __forceinline__ bool next(int i, Unit& u) const { const int L = i * G + c; if (L >= lim) return false; const int pm = L / nN, pl = L - pm * nN; u.pm = pm; u.pn = tile_e[pm] * nN + pl; return true; }
    __device__ __forceinline__ void a_ready(const Unit&) const {}
    __device__ __forceinline__ void done(const Unit&) const {}
};

__device__ __forceinline__ unsigned cvt_pk_bf16(float lo, float hi) { unsigned r; asm volatile("v_cvt_pk_bf16_f32 %0, %1, %2" : "=v"(r) : "v"(lo), "v"(hi)); return r; }

template <bool POOL> struct EpiPlainT {
    static constexpr bool PERM = true, AFTER_DRAIN = false, HAS_PRE = false; struct Pre {};
    bf16_t* O; int ldc;
    __device__ __forceinline__ void operator()(const f32x4 (&acc)[2][2][4][2], const Unit& u, int wr, int wc, int fr, int fq) const {
        const int rt = POOL ? (u.pm - 130 * u.pn) : u.pm;
        const int row0 = rt * BM + wr * 64 + fr, col0 = u.pn * BM + wc * 32 + 8 * fq;
#pragma unroll
        for (int ai = 0; ai < 2; ++ai)
#pragma unroll
            for (int m = 0; m < 4; ++m) { bf16_t* rowp = O + (size_t)(row0 + ai * HALF + m * 16) * ldc + col0;
#pragma unroll
                for (int bj = 0; bj < 2; ++bj) { const f32x4 v0 = acc[ai][bj][m][0], v1 = acc[ai][bj][m][1];
                    u32x4 w; w.x = cvt_pk_bf16(v0[0], v0[1]); w.y = cvt_pk_bf16(v0[2], v0[3]); w.z = cvt_pk_bf16(v1[0], v1[1]); w.w = cvt_pk_bf16(v1[2], v1[3]);
                    *(u32x4*)(rowp + bj * HALF) = w; } }
    }
};
struct EpiScaled {
    static constexpr bool PERM = true, AFTER_DRAIN = false, HAS_PRE = false; struct Pre {};
    bf16_t* O; int ldc; float asc;
    __device__ __forceinline__ void operator()(const f32x4 (&acc)[2][2][4][2], const Unit& u, int wr, int wc, int fr, int fq) const {
        const int row0 = u.pm * BM + wr * 64 + fr, col0 = u.pn * BM + wc * 32 + 8 * fq;
#pragma unroll
        for (int ai = 0; ai < 2; ++ai)
#pragma unroll
            for (int m = 0; m < 4; ++m) { bf16_t* rowp = O + (size_t)(row0 + ai * HALF + m * 16) * ldc + col0;
#pragma unroll
                for (int bj = 0; bj < 2; ++bj) { const f32x4 v0 = acc[ai][bj][m][0] * asc, v1 = acc[ai][bj][m][1] * asc;
                    u32x4 w; w.x = cvt_pk_bf16(v0[0], v0[1]); w.y = cvt_pk_bf16(v0[2], v0[3]); w.z = cvt_pk_bf16(v1[0], v1[1]); w.w = cvt_pk_bf16(v1[2], v1[3]);
                    *(u32x4*)(rowp + bj * HALF) = w; } }
    }
};
typedef EpiPlainT<false> EpiPlain;
typedef EpiPlainT<true> EpiPool;
template <int CHEAP> struct EpiSwiGLUT {
    static constexpr bool PERM = true, AFTER_DRAIN = false;
    unsigned char* ACT; const bf16_t* b1h; float asc;
    static constexpr bool HAS_PRE = true; struct Pre { u32x4 bg, bu; };
    __device__ __forceinline__ void pre(const Unit& u, int wc, int fq, Pre& p) const {
        const int e = u.pn >> 3, pl = u.pn & 7, oc0 = pl * 128 + wc * 32 + 8 * fq;
        const bf16_t* a = b1h + e * 2048 + oc0;
        asm volatile("global_load_dwordx4 %0, %1, off" : "=v"(p.bg) : "v"(a) : "memory");
        asm volatile("global_load_dwordx4 %0, %1, off offset:2048" : "=v"(p.bu) : "v"(a) : "memory");
    }
    __device__ __forceinline__ void operator()(const f32x4 (&acc)[2][2][4][2], const Unit& u, int wr, int wc, int fr, int fq, const Pre& p) const {
        if constexpr (CHEAP == 2) return;
        const int pl = u.pn & 7;
        const int row0 = u.pm * BM + wr * 64 + fr, oc0 = pl * 128 + wc * 32 + 8 * fq;
        f32x4 bg[2], bu[2];
#pragma unroll
        for (int n = 0; n < 2; ++n) { bg[n] = (f32x4){__uint_as_float(p.bg[2 * n] << 16), __uint_as_float(p.bg[2 * n] & 0xffff0000u), __uint_as_float(p.bg[2 * n + 1] << 16), __uint_as_float(p.bg[2 * n + 1] & 0xffff0000u)};
            bu[n] = (f32x4){__uint_as_float(p.bu[2 * n] << 16), __uint_as_float(p.bu[2 * n] & 0xffff0000u), __uint_as_float(p.bu[2 * n + 1] << 16), __uint_as_float(p.bu[2 * n + 1] & 0xffff0000u)} + 1.0f; }
#pragma unroll
        for (int ai = 0; ai < 2; ++ai)
#pragma unroll
            for (int mp = 0; mp < 2; ++mp) {
                unsigned w[2][2];
#pragma unroll
                for (int mm = 0; mm < 2; ++mm) { const int m = 2 * mp + mm; float o[8];
#pragma unroll
                    for (int n = 0; n < 2; ++n) { const f32x4 gv = acc[ai][0][m][n] * asc + bg[n], uv = acc[ai][1][m][n] * asc + bu[n];
#pragma unroll
                        for (int j = 0; j < 4; ++j) { const float g = fminf(gv[j], 7.0f), uu = fminf(fmaxf(uv[j], -6.0f), 8.0f);
                            const float sg = (CHEAP != 0) ? 0.5f : __builtin_amdgcn_rcpf(1.0f + __builtin_amdgcn_exp2f(g * (-1.702f * 1.4426950408889634f)));
                            o[4 * n + j] = g * sg * uu; } }
                    int w0 = 0, w1 = 0; w0 = __builtin_amdgcn_cvt_pk_fp8_f32(o[0], o[1], w0, false); w0 = __builtin_amdgcn_cvt_pk_fp8_f32(o[2], o[3], w0, true);
                    w1 = __builtin_amdgcn_cvt_pk_fp8_f32(o[4], o[5], w1, false); w1 = __builtin_amdgcn_cvt_pk_fp8_f32(o[6], o[7], w1, true);
                    w[mm][0] = (unsigned)w0; w[mm][1] = (unsigned)w1; }
                const auto lo = __builtin_amdgcn_permlane16_swap(w[0][0], w[1][0], false, false), hi2 = __builtin_amdgcn_permlane16_swap(w[0][1], w[1][1], false, false);
                const int m = 2 * mp + (fq & 1);
                *(u32x4*)(ACT + (size_t)(row0 + ai * HALF + m * 16) * 1024 + (oc0 & ~15)) = (u32x4){lo[0], hi2[0], lo[1], hi2[1]}; }
    }
};
typedef EpiSwiGLUT<0> EpiSwiGLU;
struct EpiScatter {
    static constexpr bool PERM = true, AFTER_DRAIN = false;
    unsigned char* SLOT; const PG8_LAS int* slot_tab; int G, c; const bf16_t* b2h; float asc; int seq;
    static constexpr bool HAS_PRE = true; struct Pre { u32x4 bv[2]; };
    __device__ __forceinline__ void pre(const Unit& u, int wc, int fq, Pre& p) const {
        const int e = u.pn >> 2, pl = u.pn & 3, col0 = pl * BM + wc * 32 + 8 * fq;
        const bf16_t* a = b2h + e * 1024 + col0;
        asm volatile("global_load_dwordx4 %0, %1, off" : "=v"(p.bv[0]) : "v"(a) : "memory");
        asm volatile("global_load_dwordx4 %0, %1, off offset:256" : "=v"(p.bv[1]) : "v"(a) : "memory");
    }
    __device__ __forceinline__ void operator()(const f32x4 (&acc)[2][2][4][2], const Unit& u, int wr, int wc, int fr, int fq, const Pre& p) const {
        const int pl = u.pn & 3, ui = (u.pm * 4 + pl - c) / G;
        const int col0 = pl * BM + wc * 32 + 8 * fq;
        f32x4 bv[2][2];
#pragma unroll
        for (int bj = 0; bj < 2; ++bj)
#pragma unroll
            for (int n = 0; n < 2; ++n) bv[bj][n] = (f32x4){__uint_as_float(p.bv[bj][2 * n] << 16), __uint_as_float(p.bv[bj][2 * n] & 0xffff0000u), __uint_as_float(p.bv[bj][2 * n + 1] << 16), __uint_as_float(p.bv[bj][2 * n + 1] & 0xffff0000u)};
#pragma unroll
        for (int ai = 0; ai < 2; ++ai)
#pragma unroll
            for (int mp = 0; mp < 2; ++mp) {
                const int m = 2 * mp + (fq & 1), rit = wr * 64 + fr + ai * HALF + m * 16;
                const int slot = seq ? (u.pm * BM + rit) : slot_tab[ui * BM + rit];
#pragma unroll
                for (int bj = 0; bj < 2; ++bj) { unsigned w[2][2];
#pragma unroll
                    for (int mm = 0; mm < 2; ++mm) { const f32x4 v0 = acc[ai][bj][2 * mp + mm][0] * asc + bv[bj][0], v1 = acc[ai][bj][2 * mp + mm][1] * asc + bv[bj][1];
                        int w0 = 0, w1 = 0; w0 = __builtin_amdgcn_cvt_pk_fp8_f32(v0[0], v0[1], w0, false); w0 = __builtin_amdgcn_cvt_pk_fp8_f32(v0[2], v0[3], w0, true);
                        w1 = __builtin_amdgcn_cvt_pk_fp8_f32(v1[0], v1[1], w1, false); w1 = __builtin_amdgcn_cvt_pk_fp8_f32(v1[2], v1[3], w1, true);
                        w[mm][0] = (unsigned)w0; w[mm][1] = (unsigned)w1; }
                    const auto lo = __builtin_amdgcn_permlane16_swap(w[0][0], w[1][0], false, false), hi2 = __builtin_amdgcn_permlane16_swap(w[0][1], w[1][1], false, false);
                    if (slot >= 0 && seq != 2) *(u32x4*)(SLOT + (size_t)slot * 1024 + (col0 & ~15) + bj * HALF) = (u32x4){lo[0], hi2[0], lo[1], hi2[1]}; }
            }
    }
};

template <class Epi, class Sched, bool ALIGN_EPI = false, bool SP2 = false, int ES = 2, bool GATHER = false, int PRB = 0>
__device__ __forceinline__ void gemm_phase(PG8_LAS unsigned char* lds, const Gemm g, const Sched& S, const Epi& E, const PG8_LAS unsigned short* tok16 = nullptr) {
    static_assert(SP2 || !GATHER, "GATHER is implemented for the SP2 loop");
    int tid_ = threadIdx.x; asm volatile("" : "+v"(tid_));
    const int tid = tid_, wid = __builtin_amdgcn_readfirstlane(tid >> 6), lane = tid & 63, wr = wid >> 2, wc = wid & 3, fr = lane & 15, fq = lane >> 4;
    const int K = g.K, nt = K * ES / (BK * 2);
    unsigned voffA[2], voffB[2]; int rowA[2]; unsigned colA[2];
#pragma unroll
    for (int i = 0; i < 2; ++i) { int R, C; stage_rc(tid * 16 + i * 8192, R, C); const int Rb = Epi::PERM ? ((R & ~31) + perm32(R & 31)) : R;
        voffA[i] = (unsigned)(R * K * ES + C * 2); voffB[i] = (unsigned)(Rb * K * ES + C * 2); rowA[i] = R; colA[i] = (unsigned)(C * 2); }
    const size_t kstep = (size_t)(BK * 2);
    const size_t hstep = (size_t)HALF * K * ES;
    const size_t hstepA = GATHER ? 0 : hstep;
    const size_t tstep = 2 * hstep;
    const unsigned ldsw = (unsigned)wid * 1024u;
    const int aoff = lds_byte(wr * 64 + fr, fq * 8), boff = lds_byte(wc * 32 + fr, fq * 8);
#define PG8_SA(b, h) (((b) * 2 + (h)) * HTB)
#define PG8_SB(b, h) ((4 + (b) * 2 + (h)) * HTB)
#define PG8_STAGE(bufoff, gbase, voff) do { _Pragma("unroll") for (int _i = 0; _i < 2; ++_i) \
        __builtin_amdgcn_global_load_lds((const unsigned*)((const char*)(gbase) + (voff)[_i]), (PG8_LAS unsigned*)(lds + (bufoff) + ldsw + _i * 8192), 16, 0, 0); } while (0)
#define PG8_GOFF(dst, ui_) do { _Pragma("unroll") for (int _h = 0; _h < 2; ++_h) _Pragma("unroll") for (int _i = 0; _i < 2; ++_i) dst[_h][_i] = (unsigned)tok16[(ui_) * 256 + _h * HALF + rowA[_i]] * (unsigned)(K * ES) + colA[_i]; } while (0)
#define PG8_STAGE_A(bufoff, gbase, h, usenext) do { if constexpr (GATHER) { _Pragma("unroll") for (int _i = 0; _i < 2; ++_i) { const unsigned vo_ = (usenext) ? goffN[h][_i] : goffC[h][_i]; \
        __builtin_amdgcn_global_load_lds((const unsigned*)((const char*)(gbase) + vo_), (PG8_LAS unsigned*)(lds + (bufoff) + ldsw + _i * 8192), 16, 0, 0); } } else PG8_STAGE(bufoff, gbase, voffA); } while (0)
#define PG8_LDA(dst, b, h) do { _Pragma("unroll") for (int m = 0; m < 4; ++m) _Pragma("unroll") for (int k = 0; k < 2; ++k) dst[m][k] = *(const PG8_LAS bf16x8*)(lds + PG8_SA(b, h) + aoff + m * 2048 + k * 1024); } while (0)
#define PG8_LDB(dst, b, h) do { _Pragma("unroll") for (int n = 0; n < 2; ++n) _Pragma("unroll") for (int k = 0; k < 2; ++k) dst[n][k] = *(const PG8_LAS bf16x8*)(lds + PG8_SB(b, h) + boff + n * 2048 + k * 1024); } while (0)
#define PG8_CAT8(lo, hi) __builtin_shufflevector(__builtin_bit_cast(i32x4, lo), __builtin_bit_cast(i32x4, hi), 0, 1, 2, 3, 4, 5, 6, 7)
#define PG8_MFMA8(accv, bv, av) asm volatile("v_mfma_scale_f32_16x16x128_f8f6f4 %0, %1, %2, %0, %3, %3 op_sel_hi:[0,0,0]" : "+v"(accv) : "v"(bv), "v"(av), "v"(sc1))
#define PG8_MMA(ai, bj, At, Bt) do { if constexpr (PRB == 1) break; __builtin_amdgcn_s_setprio(1); if constexpr (ES == 2) { _Pragma("unroll") for (int m = 0; m < 4; ++m) _Pragma("unroll") for (int n = 0; n < 2; ++n) _Pragma("unroll") for (int k = 0; k < 2; ++k) \
        acc[ai][bj][m][n] = __builtin_amdgcn_mfma_f32_16x16x32_bf16(Bt[n][k], At[m][k], acc[ai][bj][m][n], 0, 0, 0); } else { _Pragma("unroll") for (int m = 0; m < 4; ++m) _Pragma("unroll") for (int n = 0; n < 2; ++n) { \
        const i32x8 b8_ = PG8_CAT8(Bt[n][0], Bt[n][1]), a8_ = PG8_CAT8(At[m][0], At[m][1]); PG8_MFMA8(acc[ai][bj][m][n], b8_, a8_); } } __builtin_amdgcn_s_setprio(0); } while (0)
#define PG8_WAIT_V(n) asm volatile("s_waitcnt vmcnt(" #n ")" ::: "memory")
#define PG8_WAIT_L(n) asm volatile("s_waitcnt lgkmcnt(" #n ")" ::: "memory")
#define PG8_BAR __builtin_amdgcn_s_barrier()
#define PG8_SCHED __builtin_amdgcn_sched_barrier(0)
    Unit cur, nxt; int ui = 0; typename Epi::Pre epre;
    if (!S.next(0, cur)) return;
    int sc1 = 0x7f7f7f7f; asm volatile("" : "+v"(sc1));
    f32x4 acc[2][2][4][2];
#pragma unroll
    for (int a = 0; a < 2; ++a)
#pragma unroll
        for (int b = 0; b < 2; ++b)
#pragma unroll
            for (int m = 0; m < 4; ++m)
#pragma unroll
                for (int n = 0; n < 2; ++n) acc[a][b][m][n] = (f32x4){0.f, 0.f, 0.f, 0.f};
    bf16x8 At[4][2], B0[2][2], B1[2][2];
    const char* cA = (const char*)g.A + (GATHER ? (size_t)0 : (size_t)cur.pm * tstep); const char* cB = (const char*)g.Bt + (size_t)cur.pn * tstep;
    unsigned goffC[2][2] = {{0u, 0u}, {0u, 0u}}, goffN[2][2] = {{0u, 0u}, {0u, 0u}};
    if constexpr (GATHER) PG8_GOFF(goffC, 0);
    S.a_ready(cur);
    if constexpr (SP2) {
        PG8_STAGE(PG8_SB(0, 0), cB, voffB); PG8_STAGE(PG8_SB(0, 1), cB + hstep, voffB); PG8_STAGE_A(PG8_SA(0, 0), cA, 0, false); PG8_STAGE_A(PG8_SA(0, 1), cA + hstepA, 1, false);
        if (wr == 1) PG8_BAR;
        PG8_WAIT_V(2); PG8_BAR;
        PG8_STAGE(PG8_SB(1, 0), cB + kstep, voffB); PG8_STAGE_A(PG8_SA(1, 0), cA + kstep, 0, false); PG8_STAGE(PG8_SB(1, 1), cB + hstep + kstep, voffB);
        PG8_WAIT_V(6); PG8_BAR;
    } else {
        PG8_STAGE(PG8_SB(0, 0), cB, voffB); PG8_STAGE(PG8_SA(0, 0), cA, voffA); PG8_STAGE(PG8_SB(0, 1), cB + hstep, voffB); PG8_STAGE(PG8_SA(0, 1), cA + hstep, voffA);
        if (wr == 1) PG8_BAR;
        PG8_WAIT_V(4); PG8_BAR;
        PG8_STAGE(PG8_SB(1, 0), cB + kstep, voffB); PG8_STAGE(PG8_SA(1, 0), cA + kstep, voffA); PG8_STAGE(PG8_SB(1, 1), cB + hstep + kstep, voffB);
        PG8_WAIT_V(6); PG8_BAR;
    }
    for (;;) {
        const bool has_next = S.next(ui + 1, nxt);
        const char* nA = (has_next && !GATHER) ? (const char*)g.A + (size_t)nxt.pm * tstep : cA;
        const char* nB = has_next ? (const char*)g.Bt + (size_t)nxt.pn * tstep : cB;
        for (int t = 0; t < nt; t += 2) {
            const bool last = (t == nt - 2);
            const char* a1 = cA + (size_t)(t + 1) * kstep;
            const char* a2 = last ? nA : cA + (size_t)(t + 2) * kstep; const char* b2 = last ? nB : cB + (size_t)(t + 2) * kstep;
            const char* a3 = a2 + kstep; const char* b3 = b2 + kstep;
            if (last && has_next) S.a_ready(nxt);
            if constexpr (Epi::HAS_PRE) { if (last) E.pre(cur, wc, fq, epre); }
            if constexpr (GATHER) { if (last) { if (has_next) PG8_GOFF(goffN, ui + 1); else { _Pragma("unroll") for (int _h = 0; _h < 2; ++_h) _Pragma("unroll") for (int _i = 0; _i < 2; ++_i) goffN[_h][_i] = goffC[_h][_i]; } } }
            if constexpr (SP2) {
            PG8_LDB(B0, 0, 0); PG8_LDB(B1, 0, 1); PG8_SCHED; PG8_LDA(At, 0, 0); PG8_STAGE_A(PG8_SA(1, 1), a1 + hstepA, 1, false);
            PG8_WAIT_V(8); PG8_WAIT_L(0); PG8_BAR; PG8_MMA(0, 0, At, B0); PG8_MMA(0, 1, At, B1); PG8_BAR; PG8_SCHED;
            PG8_LDA(At, 0, 1); PG8_STAGE(PG8_SB(0, 0), b2, voffB); PG8_STAGE(PG8_SB(0, 1), b2 + hstep, voffB); PG8_STAGE_A(PG8_SA(0, 0), a2, 0, last);
            PG8_WAIT_V(8); PG8_WAIT_L(0); PG8_BAR; PG8_MMA(1, 0, At, B0); PG8_MMA(1, 1, At, B1); PG8_BAR; PG8_SCHED;
            PG8_LDB(B0, 1, 0); PG8_LDB(B1, 1, 1); PG8_SCHED; PG8_LDA(At, 1, 0); PG8_STAGE_A(PG8_SA(0, 1), a2 + hstepA, 1, last);
            PG8_WAIT_V(8); PG8_WAIT_L(0); PG8_BAR; PG8_MMA(0, 0, At, B0); PG8_MMA(0, 1, At, B1); PG8_BAR; PG8_SCHED;
            PG8_LDA(At, 1, 1); PG8_STAGE(PG8_SB(1, 0), b3, voffB); PG8_STAGE(PG8_SB(1, 1), b3 + hstep, voffB); PG8_STAGE_A(PG8_SA(1, 0), a3, 0, last);
            PG8_WAIT_V(8); PG8_WAIT_L(0); PG8_BAR; PG8_MMA(1, 0, At, B0); PG8_MMA(1, 1, At, B1); PG8_BAR; PG8_SCHED;
            } else {
            PG8_LDB(B0, 0, 0); PG8_SCHED; PG8_LDA(At, 0, 0); PG8_STAGE(PG8_SA(1, 1), a1 + hstep, voffA);
            PG8_WAIT_L(8); PG8_BAR; PG8_WAIT_L(0); PG8_MMA(0, 0, At, B0); PG8_BAR; PG8_SCHED;
            PG8_LDB(B1, 0, 1); PG8_STAGE(PG8_SB(0, 0), b2, voffB);
            PG8_BAR; PG8_WAIT_L(0); PG8_MMA(0, 1, At, B1); PG8_BAR;
            PG8_LDA(At, 0, 1); PG8_STAGE(PG8_SA(0, 0), a2, voffA);
            PG8_BAR; PG8_WAIT_L(0); PG8_MMA(1, 0, At, B0); PG8_BAR; PG8_SCHED;
            PG8_STAGE(PG8_SB(0, 1), b2 + hstep, voffB);
            PG8_WAIT_V(6); PG8_BAR; PG8_MMA(1, 1, At, B1); PG8_BAR;
            PG8_LDB(B0, 1, 0); PG8_SCHED; PG8_LDA(At, 1, 0); PG8_STAGE(PG8_SA(0, 1), a2 + hstep, voffA);
            PG8_WAIT_L(8); PG8_BAR; PG8_WAIT_L(0); PG8_MMA(0, 0, At, B0); PG8_BAR; PG8_SCHED;
            PG8_LDB(B1, 1, 1); PG8_STAGE(PG8_SB(1, 0), b3, voffB);
            PG8_BAR; PG8_WAIT_L(0); PG8_MMA(0, 1, At, B1); PG8_BAR;
            PG8_LDA(At, 1, 1); PG8_STAGE(PG8_SA(1, 0), a3, voffA);
            PG8_BAR; PG8_WAIT_L(0); PG8_MMA(1, 0, At, B0); PG8_BAR; PG8_SCHED;
            PG8_STAGE(PG8_SB(1, 1), b3 + hstep, voffB);
            PG8_WAIT_V(6); PG8_BAR; PG8_MMA(1, 1, At, B1); PG8_BAR;
            }
        }
        if constexpr (ES == 1) { PG8_SCHED; asm volatile("s_nop 15\n\ts_nop 15" ::: "memory"); PG8_SCHED; }
        if constexpr (ALIGN_EPI) { if (wr == 0) PG8_BAR; }
        if constexpr (!Epi::AFTER_DRAIN) { if constexpr (Epi::HAS_PRE) E(acc, cur, wr, wc, fr, fq, epre); else E(acc, cur, wr, wc, fr, fq); S.done(cur); }
        if (!has_next) break;
#pragma unroll
        for (int a = 0; a < 2; ++a)
#pragma unroll
            for (int b = 0; b < 2; ++b)
#pragma unroll
                for (int m = 0; m < 4; ++m)
#pragma unroll
                    for (int n = 0; n < 2; ++n) acc[a][b][m][n] = (f32x4){0.f, 0.f, 0.f, 0.f};
        cur = nxt; cA = nA; cB = nB; ++ui;
        if constexpr (GATHER) { _Pragma("unroll") for (int _h = 0; _h < 2; ++_h) _Pragma("unroll") for (int _i = 0; _i < 2; ++_i) goffC[_h][_i] = goffN[_h][_i]; }
        if constexpr (ALIGN_EPI) { if (wr == 1) PG8_BAR; }
    }
    PG8_WAIT_V(0);
    if constexpr (!ALIGN_EPI) { if (wr == 0) PG8_BAR; }
    PG8_BAR;
    if constexpr (Epi::AFTER_DRAIN) { E.fused(acc, cur, wr, wc, fr, fq, lds, wid, lane); S.done(cur); }
#undef PG8_SA
#undef PG8_SB
#undef PG8_STAGE
#undef PG8_STAGE_A
#undef PG8_GOFF
#undef PG8_LDA
#undef PG8_LDB
#undef PG8_MMA
#undef PG8_CAT8
#undef PG8_MFMA8
#undef PG8_WAIT_V
#undef PG8_WAIT_L
#undef PG8_BAR
#undef PG8_SCHED
}
}

namespace att {
using f32x16 = __attribute__((ext_vector_type(16))) float;
__device__ __forceinline__ int crow(int r, int hi) { return (r & 3) + 8 * (r >> 2) + 4 * hi; }
__device__ __forceinline__ unsigned cvtpk(float lo, float hi) { unsigned r; asm volatile("v_cvt_pk_bf16_f32 %0, %1, %2" : "=v"(r) : "v"(lo), "v"(hi)); return r; }
}

namespace att8 {
using att::f32x16; using att::crow;
typedef int i32x4 __attribute__((ext_vector_type(4)));
typedef int i32x8 __attribute__((ext_vector_type(8)));
constexpr int NW = 8, QBLK = 32, KVBLK = 64;
#define SBAR() __builtin_amdgcn_sched_barrier(0)
template <int OFF> __device__ __forceinline__ i32x4 rd128(int a) { i32x4 r; asm volatile("ds_read_b128 %0, %1 offset:%2" : "=&v"(r) : "v"(a), "i"(OFF) : "memory"); return r; }
__device__ __forceinline__ i32x8 cat8(i32x4 lo, i32x4 hi) { return __builtin_shufflevector(lo, hi, 0, 1, 2, 3, 4, 5, 6, 7); }
__device__ __forceinline__ float mx3(float a, float b, float c) { float r; asm("v_max3_f32 %0, %1, %2, %3" : "=v"(r) : "v"(a), "v"(b), "v"(c)); return r; }
constexpr float CSC = 1.f / 65536.f;
template <bool FIRST>
__device__ __forceinline__ void softmax8(f32x16& p0, f32x16& p1, float& M_run, float& alpha, i32x8& pf) {
  constexpr float CTHR = (56.f + 8.f * (5.f * 1.4426950408889634f)) * CSC;
  float a0 = mx3(p0[0], p0[1], p0[2]), a1 = mx3(p0[8], p0[9], p0[10]), a2 = mx3(p1[0], p1[1], p1[2]), a3 = mx3(p1[8], p1[9], p1[10]);
  a0 = mx3(a0, p0[3], p0[4]); a1 = mx3(a1, p0[11], p0[12]); a2 = mx3(a2, p1[3], p1[4]); a3 = mx3(a3, p1[11], p1[12]);
  a0 = mx3(a0, p0[5], p0[6]); a1 = mx3(a1, p0[13], p0[14]); a2 = mx3(a2, p1[5], p1[6]); a3 = mx3(a3, p1[13], p1[14]);
  a0 = mx3(a0, p0[7], a1); a2 = mx3(a2, p1[7], a3);
  float cmax = mx3(a0, p0[15], a2); cmax = mx3(cmax, p1[15], cmax);
  { auto rr = __builtin_amdgcn_permlane32_swap(__float_as_uint(cmax), __float_as_uint(cmax), false, false); cmax = mx3(__uint_as_float(rr[0]), __uint_as_float(rr[1]), __uint_as_float(rr[1])); }
  alpha = 1.f;
  if (FIRST || !__builtin_expect(__all(cmax <= CTHR), 1)) {
    const float tmax = (cmax * 65536.f - 56.f) * 0.125f, d = FIRST ? tmax : fmaxf(tmax, 0.f), d8 = 8.f * d * CSC;
    alpha = __builtin_amdgcn_exp2f(-d); M_run += d;
#pragma unroll
    for (int r = 0; r < 16; ++r) { p0[r] -= d8; p1[r] -= d8; }
  }
  typedef unsigned short us2 __attribute__((ext_vector_type(2)));
#pragma unroll
  for (int w = 0; w < 4; ++w) { const unsigned A = __builtin_bit_cast(unsigned, __builtin_amdgcn_cvt_pknorm_u16(p0[4 * w], p0[4 * w + 1])), B = __builtin_bit_cast(unsigned, __builtin_amdgcn_cvt_pknorm_u16(p0[4 * w + 2], p0[4 * w + 3]));
    pf[w] = (int)__builtin_amdgcn_perm(B, A, 0x06040200u); }
#pragma unroll
  for (int w = 0; w < 4; ++w) { const unsigned A = __builtin_bit_cast(unsigned, __builtin_amdgcn_cvt_pknorm_u16(p1[4 * w], p1[4 * w + 1])), B = __builtin_bit_cast(unsigned, __builtin_amdgcn_cvt_pknorm_u16(p1[4 * w + 2], p1[4 * w + 3]));
    pf[4 + w] = (int)__builtin_amdgcn_perm(B, A, 0x06040200u); }
}

template <int DQK, int LDQ, int LDK, int LDO, bool DIFF, int PROBE = 0>
__device__ __forceinline__ void attn_body8(const unsigned char* __restrict__ Qb, const unsigned char* __restrict__ Kh, const unsigned char* __restrict__ VT, unsigned char* __restrict__ Ob, int seq, char* lds,
                                           int dmode, float lam, const float* __restrict__ subg) {
  constexpr int SHM_V = 128 * 64, SHM_K = 64 * DQK, SLOT = SHM_V + SHM_K, NS = DQK / 64;
  int tid_ = threadIdx.x; asm volatile("" : "+v"(tid_));
  const int tid = tid_, wid = __builtin_amdgcn_readfirstlane(tid >> 6), lane = tid & 63, r32 = lane & 31, hi = lane >> 5, half = wid >> 2;
  constexpr int RD = 4;
  float* ws = (float*)(lds + RD * SLOT) + wid * 64; float* al_l = ws + 32;
  int sc1 = 0x7f7f7f7f; asm volatile("" : "+v"(sc1));
  int scq = 0x6f6f6f6f; asm volatile("" : "+v"(scq));
  float M_run = 0.f; asm volatile("" : "+v"(M_run));
  f32x16 o[4] = {};
  typedef float f32x4_ __attribute__((ext_vector_type(4)));
  f32x4_ osum = {0.f, 0.f, 0.f, 0.f};
  i32x8 sel8;
  { const int onv = (((lane & 15) == 0 && ((lane >> 4) & 1) == 0) || ((lane & 15) == 1 && ((lane >> 4) & 1) == 1)) ? 0x38383838 : 0;
#pragma unroll
    for (int i = 0; i < 8; ++i) { int t_; asm volatile("v_mov_b32 %0, %1" : "=v"(t_) : "v"(onv)); sel8[i] = t_; } }
#define MFMA16S(acc4, a8, b8) asm volatile("v_mfma_scale_f32_16x16x128_f8f6f4 %0, %1, %2, %0, %3, %3 op_sel_hi:[0,0,0]" : "+v"(acc4) : "v"(a8), "v"(b8), "v"(sc1))
  i32x8 qf[NS];
  { const unsigned char* Qw = Qb + (long)(wid * QBLK + r32) * LDQ + hi * 32;
#pragma unroll
    for (int s = 0; s < NS; ++s) qf[s] = cat8(*reinterpret_cast<const i32x4*>(Qw + s * 64), *reinterpret_cast<const i32x4*>(Qw + s * 64 + 16)); }
  const int vrow = 16 * wid + (lane >> 2), vpc = lane & 3;
  const int krow = 8 * wid + ((DQK == 128) ? (lane >> 3) : ((lane >> 2) & 7)), kpc = (DQK == 128) ? (lane & 7) : (lane & 3);
  const unsigned char* vsrc = VT + (long)vrow * SB + ((vpc ^ ((vrow >> 2) & 3)) << 4);
  const unsigned char* ksrc = Kh + (long)krow * LDK + ((DQK == 128) ? ((kpc ^ ((krow >> 1) & 7)) << 4) : ((kpc ^ ((krow >> 2) & 3)) << 4));
  const bool kact = (DQK == 128) || (lane < 32);
  const unsigned ldv = (unsigned)__builtin_amdgcn_readfirstlane((int)(uintptr_t)lds + wid * 1024), ldk = (unsigned)__builtin_amdgcn_readfirstlane((int)(uintptr_t)lds + SHM_V + wid * (DQK == 128 ? 1024 : 512));
#define GLDS16(gsrc, ldst) do { unsigned keep_; asm volatile("s_mov_b32 %0, m0\n\ts_mov_b32 m0, %2\n\ts_nop 0\n\tglobal_load_lds_dwordx4 %1, off\n\ts_mov_b32 m0, %0" : "=&s"(keep_) : "v"(gsrc), "s"(ldst) : "memory"); } while (0)
#define SDMA8(t_, sl_) do { GLDS16(vsrc + (t_) * KVBLK, ldv + (unsigned)((sl_) * SLOT)); if (kact) GLDS16(ksrc + (long)((t_) * KVBLK) * LDK, ldk + (unsigned)((sl_) * SLOT)); } while (0)
#define VMWAIT8(n) asm volatile("s_waitcnt vmcnt(" #n ")" ::: "memory")
#define BARL8() do { SBAR(); asm volatile("s_waitcnt lgkmcnt(0)\n\ts_barrier" ::: "memory"); SBAR(); } while (0)
#define LWAIT8(n) do { asm volatile("s_waitcnt lgkmcnt(" #n ")" ::: "memory"); SBAR(); } while (0)
#define RESC8(a) do { if (__any((a) < 1.f)) { if (hi == 0) al_l[r32] = (a); asm volatile("s_waitcnt lgkmcnt(0)" ::: "memory"); \
    _Pragma("unroll") for (int g = 0; g < 4; ++g) { const f32x4 a4_ = *(const f32x4*)(al_l + 8 * g + 4 * hi);      \
      _Pragma("unroll") for (int i = 0; i < 4; ++i) { _Pragma("unroll") for (int d = 0; d < 4; ++d) o[d][4 * g + i] *= a4_[i]; } SBAR(); } \
    { const f32x4 a4_ = *(const f32x4*)(al_l + (lane & 1) * 16 + 4 * (lane >> 4)); _Pragma("unroll") for (int i = 0; i < 4; ++i) osum[i] *= a4_[i]; }     \
    CIN_SET8(); } } while (0)
#define MFMA8(acc, a8, b8) asm volatile("v_mfma_scale_f32_32x32x64_f8f6f4 %0, %1, %2, %0, %3, %3 op_sel_hi:[0,0,0]" : "+v"(acc) : "v"(a8), "v"(b8), "v"(sc1))
#define MFMA8QC(acc, a8, b8, cin_) asm volatile("v_mfma_scale_f32_32x32x64_f8f6f4 %0, %1, %2, %3, %4, %5 op_sel_hi:[0,0,0]" : "=&v"(acc) : "v"(a8), "v"(b8), "v"(cin_), "v"(scq), "v"(sc1))
#define MFMA8Q(acc, a8, b8) asm volatile("v_mfma_scale_f32_32x32x64_f8f6f4 %0, %1, %2, %0, %3, %4 op_sel_hi:[0,0,0]" : "+v"(acc) : "v"(a8), "v"(b8), "v"(scq), "v"(sc1))
  const int lb = (int)(uintptr_t)lds;
  const int va0 = lb + r32 * 64 + (((2 * hi) ^ ((r32 >> 2) & 3)) << 4), va1 = lb + r32 * 64 + (((2 * hi + 1) ^ ((r32 >> 2) & 3)) << 4);
  const int kz = (DQK == 128) ? ((r32 >> 1) & 7) : ((r32 >> 2) & 3), krb = lb + SHM_V + r32 * DQK;
  const int ka00 = krb + (((2 * hi) ^ kz) << 4), ka01 = krb + (((2 * hi + 1) ^ kz) << 4), ka10 = krb + (((4 + 2 * hi) ^ kz) << 4), ka11 = krb + (((5 + 2 * hi) ^ kz) << 4);
#define KREAD8(so) do { k00 = rd128<0>(ka00 + (so)); k01 = rd128<0>(ka01 + (so)); k10 = rd128<32 * DQK>(ka00 + (so)); k11 = rd128<32 * DQK>(ka01 + (so)); \
    if constexpr (NS == 2) { k20 = rd128<0>(ka10 + (so)); k21 = rd128<0>(ka11 + (so)); k30 = rd128<32 * DQK>(ka10 + (so)); k31 = rd128<32 * DQK>(ka11 + (so)); } } while (0)
#define KREAD8C(SO) do { k00 = rd128<(SO)>(ka00); k01 = rd128<(SO)>(ka01); k10 = rd128<(SO) + 32 * DQK>(ka00); k11 = rd128<(SO) + 32 * DQK>(ka01); \
    if constexpr (NS == 2) { k20 = rd128<(SO)>(ka10); k21 = rd128<(SO)>(ka11); k30 = rd128<(SO) + 32 * DQK>(ka10); k31 = rd128<(SO) + 32 * DQK>(ka11); } } while (0)
#define VREAD8AC(SO) do { v00 = rd128<(SO)>(va0); v01 = rd128<(SO)>(va1); v10 = rd128<(SO) + 2048>(va0); v11 = rd128<(SO) + 2048>(va1); } while (0)
#define VREAD8BC(SO) do { if constexpr (NS == 2) { k00 = rd128<(SO) + 4096>(va0); k01 = rd128<(SO) + 4096>(va1); k10 = rd128<(SO) + 6144>(va0); k11 = rd128<(SO) + 6144>(va1); } \
    else { k20 = rd128<(SO) + 4096>(va0); k21 = rd128<(SO) + 4096>(va1); k30 = rd128<(SO) + 6144>(va0); k31 = rd128<(SO) + 6144>(va1); } } while (0)
#define VREAD8A(so) do { v00 = rd128<0>(va0 + (so)); v01 = rd128<0>(va1 + (so)); v10 = rd128<2048>(va0 + (so)); v11 = rd128<2048>(va1 + (so)); } while (0)
#define VREAD8B(so) do { if constexpr (NS == 2) { k00 = rd128<4096>(va0 + (so)); k01 = rd128<4096>(va1 + (so)); k10 = rd128<6144>(va0 + (so)); k11 = rd128<6144>(va1 + (so)); } \
    else { k20 = rd128<4096>(va0 + (so)); k21 = rd128<4096>(va1 + (so)); k30 = rd128<6144>(va0 + (so)); k31 = rd128<6144>(va1 + (so)); } } while (0)
#define QK8(NV) do { if constexpr (NS == 2) { LWAIT8_(NV + 6); MFMA8QC(p0, cat8(k00, k01), qf[0], cin); LWAIT8_(NV + 4); MFMA8QC(p1, cat8(k10, k11), qf[0], cin); LWAIT8_(NV + 2); MFMA8Q(p0, cat8(k20, k21), qf[NS - 1]); LWAIT8_(NV); MFMA8Q(p1, cat8(k30, k31), qf[NS - 1]); } \
    else { LWAIT8_(NV + 2); MFMA8QC(p0, cat8(k00, k01), qf[0], cin); LWAIT8_(NV); MFMA8QC(p1, cat8(k10, k11), qf[0], cin); } } while (0)
#define LWAIT8_(n) do { asm volatile("s_waitcnt lgkmcnt(%0)" :: "n"(n) : "memory"); SBAR(); } while (0)
#define PV8() do { MFMA16S(osum, pf, sel8); LWAIT8(6); MFMA8(o[0], pf, cat8(v00, v01)); LWAIT8(4); MFMA8(o[1], pf, cat8(v10, v11)); \
    if constexpr (NS == 2) { LWAIT8(2); MFMA8(o[2], pf, cat8(k00, k01)); LWAIT8(0); MFMA8(o[3], pf, cat8(k10, k11)); } else { LWAIT8(2); MFMA8(o[2], pf, cat8(k20, k21)); LWAIT8(0); MFMA8(o[3], pf, cat8(k30, k31)); } } while (0)
  f32x16 p0, p1; float al; i32x8 pf; const int NT = seq / KVBLK;
  f32x16 cin;
#define CIN_SET8() do { const float nm_ = (56.f - 8.f * M_run) * CSC; _Pragma("unroll") for (int r = 0; r < 16; ++r) cin[r] = nm_; asm volatile("" : "+v"(cin)); SBAR(); } while (0)
  i32x4 k00, k01, k10, k11, k20, k21, k30, k31, v00, v01, v10, v11;
#define ACC_INIT8() do { const float nm = (56.f - 8.f * M_run) * CSC; typedef float f2_ __attribute__((ext_vector_type(2))); f2_ n2 = {nm, nm}; asm volatile("" : "+v"(n2)); \
      f2_ q_[16]; _Pragma("unroll") for (int i = 0; i < 16; ++i) asm volatile("v_mov_b64 %0, %1" : "=v"(q_[i]) : "v"(n2)); \
      typedef float f4_ __attribute__((ext_vector_type(4))); typedef float f8_ __attribute__((ext_vector_type(8))); \
      { const f4_ a = __builtin_shufflevector(q_[0], q_[1], 0, 1, 2, 3), b = __builtin_shufflevector(q_[2], q_[3], 0, 1, 2, 3), c = __builtin_shufflevector(q_[4], q_[5], 0, 1, 2, 3), d = __builtin_shufflevector(q_[6], q_[7], 0, 1, 2, 3); \
        const f8_ ab = __builtin_shufflevector(a, b, 0, 1, 2, 3, 4, 5, 6, 7), cd = __builtin_shufflevector(c, d, 0, 1, 2, 3, 4, 5, 6, 7); p0 = __builtin_shufflevector(ab, cd, 0, 1, 2, 3, 4, 5, 6, 7, 8, 9, 10, 11, 12, 13, 14, 15); } \
      { const f4_ a = __builtin_shufflevector(q_[8], q_[9], 0, 1, 2, 3), b = __builtin_shufflevector(q_[10], q_[11], 0, 1, 2, 3), c = __builtin_shufflevector(q_[12], q_[13], 0, 1, 2, 3), d = __builtin_shufflevector(q_[14], q_[15], 0, 1, 2, 3); \
        const f8_ ab = __builtin_shufflevector(a, b, 0, 1, 2, 3, 4, 5, 6, 7), cd = __builtin_shufflevector(c, d, 0, 1, 2, 3, 4, 5, 6, 7); p1 = __builtin_shufflevector(ab, cd, 0, 1, 2, 3, 4, 5, 6, 7, 8, 9, 10, 11, 12, 13, 14, 15); } \
      asm volatile("" : "+v"(p0), "+v"(p1)); SBAR(); } while (0)
  SDMA8(0, 0); SDMA8(1, 1); SDMA8(2, 2); if (half) SDMA8(3, 3);
  VMWAIT8(0); BARL8();
  CIN_SET8();
  KREAD8(0); QK8(0);
  SBAR(); asm volatile("s_nop 15\n\ts_nop 15\n\ts_nop 15\n\ts_nop 15\n\ts_nop 15\n\ts_nop 15" ::: "memory"); SBAR();
  softmax8<true>(p0, p1, M_run, al, pf);
  CIN_SET8();
  if (half) BARL8();
  int sw = (3 + half) & 3;
#define MSEG8(KO, VO) do { \
    if constexpr (NS == 2) { \
      k00 = rd128<(KO)>(ka00); k01 = rd128<(KO)>(ka01); k10 = rd128<(KO) + 32 * DQK>(ka00); k11 = rd128<(KO) + 32 * DQK>(ka01); k20 = rd128<(KO)>(ka10); k21 = rd128<(KO)>(ka11); \
      LWAIT8(4); MFMA8QC(p0, cat8(k00, k01), qf[0], cin); k30 = rd128<(KO) + 32 * DQK>(ka10); k31 = rd128<(KO) + 32 * DQK>(ka11); \
      LWAIT8(4); MFMA8QC(p1, cat8(k10, k11), qf[0], cin); v00 = rd128<(VO)>(va0); v01 = rd128<(VO)>(va1); \
      LWAIT8(4); MFMA8Q(p0, cat8(k20, k21), qf[NS - 1]); v10 = rd128<(VO) + 2048>(va0); v11 = rd128<(VO) + 2048>(va1); \
      LWAIT8(4); MFMA8Q(p1, cat8(k30, k31), qf[NS - 1]); k00 = rd128<(VO) + 4096>(va0); k01 = rd128<(VO) + 4096>(va1); \
      MFMA16S(osum, pf, sel8); k10 = rd128<(VO) + 6144>(va0); k11 = rd128<(VO) + 6144>(va1); \
      LWAIT8(6); MFMA8(o[0], pf, cat8(v00, v01)); LWAIT8(4); MFMA8(o[1], pf, cat8(v10, v11)); LWAIT8(2); MFMA8(o[2], pf, cat8(k00, k01)); LWAIT8(0); MFMA8(o[3], pf, cat8(k10, k11)); \
    } else { \
      k00 = rd128<(KO)>(ka00); k01 = rd128<(KO)>(ka01); k10 = rd128<(KO) + 32 * DQK>(ka00); k11 = rd128<(KO) + 32 * DQK>(ka01); v00 = rd128<(VO)>(va0); v01 = rd128<(VO)>(va1); \
      LWAIT8(4); MFMA8QC(p0, cat8(k00, k01), qf[0], cin); v10 = rd128<(VO) + 2048>(va0); v11 = rd128<(VO) + 2048>(va1); \
      LWAIT8(4); MFMA8QC(p1, cat8(k10, k11), qf[0], cin); k20 = rd128<(VO) + 4096>(va0); k21 = rd128<(VO) + 4096>(va1); \
      MFMA16S(osum, pf, sel8); k30 = rd128<(VO) + 6144>(va0); k31 = rd128<(VO) + 6144>(va1); \
      LWAIT8(6); MFMA8(o[0], pf, cat8(v00, v01)); LWAIT8(4); MFMA8(o[1], pf, cat8(v10, v11)); LWAIT8(2); MFMA8(o[2], pf, cat8(k20, k21)); LWAIT8(0); MFMA8(o[3], pf, cat8(k30, k31)); } } while (0)
#define STEP8(KS, VS, jj) do { \
    __builtin_amdgcn_s_setprio(2); MSEG8((KS) * SLOT, (VS) * SLOT); __builtin_amdgcn_s_setprio(0); \
    BARL8(); \
    softmax8<false>(p0, p1, M_run, al, pf); RESC8(al); \
    { const int t = (jj) + 3 + half; if (t < NT) { SDMA8(t, sw); VMWAIT8(2); } else VMWAIT8(0); } \
    BARL8(); \
    sw = (sw + 1) & 3; } while (0)
  int j = 0;
  for (; j + 4 < NT; j += 4) { STEP8(1, 0, j); STEP8(2, 1, j + 1); STEP8(3, 2, j + 2); STEP8(0, 3, j + 3); }
  if (j + 1 < NT) { STEP8(1, 0, j); ++j; }
  if (j + 1 < NT) { STEP8(2, 1, j); ++j; }
  if (j + 1 < NT) { STEP8(3, 2, j); ++j; }
  const int sv = j & 3;
#undef STEP8
#undef MSEG8
#undef ACC_INIT8
#undef CIN_SET8
  VREAD8A(sv * SLOT); VREAD8B(sv * SLOT); PV8();
  SBAR(); asm volatile("s_nop 15\n\ts_nop 15\n\ts_nop 15\n\ts_nop 15\n\ts_nop 15\n\ts_nop 15" ::: "memory"); SBAR();
  if (!half) BARL8();
  float rli[16];
  { if ((lane & 15) < 2) *(f32x4*)(al_l + (lane & 15) * 16 + 4 * (lane >> 4)) = (f32x4){osum[0], osum[1], osum[2], osum[3]};
    asm volatile("s_waitcnt lgkmcnt(0)" ::: "memory");
#pragma unroll
    for (int g = 0; g < 4; ++g) { const f32x4 a4 = *(const f32x4*)(al_l + 8 * g + 4 * hi);
#pragma unroll
      for (int i = 0; i < 4; ++i) rli[4 * g + i] = __builtin_amdgcn_rcpf(a4[i]); } }
  unsigned char* Ow = Ob + (long)(wid * QBLK) * LDO;
  if constexpr (!DIFF) {
#pragma unroll
    for (int r = 0; r < 16; ++r) { int orow = crow(r, hi);
#pragma unroll
      for (int d0 = 0; d0 < 4; ++d0) { const float v_ = o[d0][r] * (rli[r] * OS_GQA); Ow[(long)orow * LDO + d0 * 32 + r32] = (unsigned char)__builtin_amdgcn_cvt_pk_fp8_f32(v_, v_, 0, false); } }
  } else {
    char* stash = lds + RD * SLOT + 2048 + wid * 8192 + lane * 16;
    if (dmode == 0) {
#pragma unroll
      for (int q = 0; q < 8; ++q) { const int d0 = q >> 1, r0 = (q & 1) * 8; i32x4 w;
#pragma unroll
        for (int i = 0; i < 4; ++i) w[i] = (int)att::cvtpk(o[d0][r0 + 2 * i] * rli[r0 + 2 * i], o[d0][r0 + 2 * i + 1] * rli[r0 + 2 * i + 1]);
        *(i32x4*)(stash + q * 1024) = w; }
    } else {
      float ss[16];
#pragma unroll
      for (int r = 0; r < 16; ++r) ss[r] = 0.f;
#pragma unroll
      for (int q = 0; q < 8; ++q) { const int d0 = q >> 1, r0 = (q & 1) * 8; const i32x4 w = *(const i32x4*)(stash + q * 1024);
#pragma unroll
        for (int i = 0; i < 4; ++i) { const int r = r0 + 2 * i;
          const float a = bflo((unsigned)w[i]) - lam * (o[d0][r] * rli[r]), b = bfhi((unsigned)w[i]) - lam * (o[d0][r + 1] * rli[r + 1]);
          o[d0][r] = a; o[d0][r + 1] = b; ss[r] += a * a; ss[r + 1] += b * b; } }
      float sg[4];
#pragma unroll
      for (int d0 = 0; d0 < 4; ++d0) sg[d0] = subg[d0 * 32 + r32] * ((1.f - LAM_INIT) * OS_DIFF);
#pragma unroll
      for (int r = 0; r < 16; ++r) { float s = ss[r];
#pragma unroll
        for (int x = 1; x < 32; x <<= 1) s += __shfl_xor(s, x);
        const float rs = rsqrtf(s * (1.f / 128.f) + RMS_EPS); const int orow = crow(r, hi);
#pragma unroll
        for (int d0 = 0; d0 < 4; ++d0) { const float v_ = o[d0][r] * rs * sg[d0]; Ow[(long)orow * LDO + d0 * 32 + r32] = (unsigned char)__builtin_amdgcn_cvt_pk_fp8_f32(v_, v_, 0, false); } }
    }
  }
  BARL8();
#undef GLDS16
#undef SDMA8
#undef VMWAIT8
#undef BARL8
#undef LWAIT8
#undef LWAIT8_
#undef RESC8
#undef MFMA8
#undef MFMA8Q
#undef MFMA16S
#undef KREAD8
#undef VREAD8A
#undef VREAD8B
#undef KREAD8C
#undef VREAD8AC
#undef VREAD8BC
#undef QK8
#undef PV8
}
#undef SBAR
}
#define XB_TMO      128
#define XB_XCNT(j)  (256  + 64 * (j))
#define XB_XSUB(j)  (1280 + 64 * (j))
#define XB_XGEN(j)  (2304 + 64 * (j))
#define XB_TOP      3328
#define XB_TOPGEN   3392
#define XCD_BAR_WORDS 3456
#define XB_SPIN_CAP (1u << 18)

__device__ __forceinline__ unsigned xb_ld(unsigned* p)              { return __hip_atomic_load(p, __ATOMIC_RELAXED, __HIP_MEMORY_SCOPE_AGENT); }
__device__ __forceinline__ unsigned xb_add(unsigned* p, unsigned v) { return __hip_atomic_fetch_add(p, v, __ATOMIC_RELAXED, __HIP_MEMORY_SCOPE_AGENT); }
__device__ __forceinline__ unsigned xb_xcc_id() { return (unsigned)__builtin_amdgcn_s_getreg((3 << 11) | 20) & 0xFu; }
#define XB_SPIN(cond, bar) do { unsigned _sp = 0; while (cond) { __builtin_amdgcn_s_sleep(1); \
    if ((++_sp & 255u) == 0u) { if (xb_ld(&(bar)[XB_TMO])) break; if (_sp > XB_SPIN_CAP) { atomicAdd(&(bar)[XB_TMO], 1u); break; } } } } while (0)

struct XcdBarrier {
    unsigned* bar; unsigned x;
    volatile LAS unsigned* st;
};

__device__ __forceinline__ XcdBarrier xcd_barrier_post(unsigned* bar, volatile LAS unsigned* st) {
    XcdBarrier b; b.bar = bar; b.x = xb_xcc_id(); b.st = st;
    if (threadIdx.x == 0) (void)xb_add(&bar[XB_XCNT(b.x)], 1u);
    return b;
}
__device__ __forceinline__ void xcd_barrier_complete(unsigned* bar, unsigned x, unsigned& nloc, unsigned& nx) {
    const unsigned G = gridDim.x * gridDim.y * gridDim.z;
    unsigned sum, cnt, mine, sp = 0u;
    for (;;) {
        sum = 0u; cnt = 0u; mine = 0u;
#pragma unroll
        for (unsigned j = 0; j < 16; ++j) { const unsigned c = xb_ld(&bar[XB_XCNT(j)]); sum += c; cnt += (c > 0u) ? 1u : 0u; mine = (j == x) ? c : mine; }
        if (sum == G) break;
        __builtin_amdgcn_s_sleep(1);
        if ((++sp & 255u) == 0u) { if (xb_ld(&bar[XB_TMO])) break; if (sp > XB_SPIN_CAP) { atomicAdd(&bar[XB_TMO], 1u); break; } }
    }
    nloc = mine > 0u ? mine : 1u; nx = cnt > 0u ? cnt : 1u;
}

__device__ __forceinline__ void xcd_barrier(const XcdBarrier& b) {
    asm volatile("s_waitcnt vmcnt(0)" ::: "memory");
    __syncthreads();
    if (threadIdx.x == 0) {
        unsigned* bar = b.bar;
        __builtin_amdgcn_s_waitcnt(0);
        unsigned nloc = b.st[0], nx = b.st[1];
        if (nloc == 0u) { xcd_barrier_complete(bar, b.x, nloc, nx); b.st[0] = nloc; b.st[1] = nx; }
        const unsigned old = xb_add(&bar[XB_XSUB(b.x)], 1u);
        const unsigned gen = old / nloc;
        if (old + 1u == (gen + 1u) * nloc) {
            __builtin_amdgcn_fence(__ATOMIC_RELEASE, "agent");
            asm volatile("s_waitcnt vmcnt(0)" ::: "memory");
            const unsigned og = xb_add(&bar[XB_TOP], 1u);
            const unsigned tg = og / nx;
            if (og + 1u == (tg + 1u) * nx) xb_add(&bar[XB_TOPGEN], 1u);
            else XB_SPIN(xb_ld(&bar[XB_TOPGEN]) == tg, bar);
            __builtin_amdgcn_fence(__ATOMIC_ACQUIRE, "agent");
            xb_add(&bar[XB_XGEN(b.x)], 1u);
            asm volatile("s_waitcnt vmcnt(0)" ::: "memory");
        } else {
            XB_SPIN(xb_ld(&bar[XB_XGEN(b.x)]) == gen, bar);
            __builtin_amdgcn_fence(__ATOMIC_ACQUIRE, "agent");
            asm volatile("s_waitcnt vmcnt(0)" ::: "memory");
        }
    }
    __syncthreads();
}

constexpr int NWAVES = 8;
constexpr int N_PHASES = 36;
#ifndef MK_STOP
#define MK_STOP N_PHASES
#endif
#ifndef ATT_SDEPTH
#define ATT_SDEPTH 1
#endif
#ifndef G1_PROBE
#define G1_PROBE 0
#endif
#ifndef ATT_PROBE
#define ATT_PROBE 0
#endif
#ifndef REP_MASK
#define REP_MASK 0
#endif
constexpr size_t WS_JUNK = WS_END - WS_GATE;
constexpr float W8_SCALE = 32.f;
constexpr float QSCALE128 = 8.f * 0.088388347648318440f * 1.4426950408889634f, QSCALE64 = 8.f * 0.125f * 1.4426950408889634f;
#ifndef SM_MASK
#define SM_MASK 127
#endif
#ifndef PRO_PARTS
#define PRO_PARTS 15
#endif
#ifndef MK_MULTI
#define MK_MULTI 0
#endif

struct Args { const float* in[N_IN]; float* out; unsigned char* ws; int ph_lo, ph_hi, dump, pad; };
static_assert(sizeof(Args) == N_IN * 8 + 8 + 8 + 16, "Args has no padding");
typedef const __attribute__((address_space(4))) Args* KArgs;
struct Frame {
    LAS unsigned char* lds;
    char* ldsg;
    int tid, lane, wave, vcu, G, gw, NGW;
    KArgs kp;
    __device__ __forceinline__ const float* in(int i) const { return kp->in[i]; }
    __device__ __forceinline__ float* out() const { return kp->out; }
    __device__ __forceinline__ unsigned char* ws() const { return kp->ws; }
    __device__ __forceinline__ unsigned* ctl() const { return (unsigned*)(kp->ws + WS_CTL); }
};
__device__ __forceinline__ bool refresh(Frame& F) { int t = threadIdx.x; asm volatile("" : "+v"(t)); F.tid = t; F.lane = t & 63; KArgs k = (KArgs)__builtin_amdgcn_kernarg_segment_ptr(); asm volatile("" : "+s"(k)); F.kp = k; return true; }
__device__ __forceinline__ const float* input_row(const Frame& F, int row) {
    const int b = row >= SB ? 1 : 0, w = row - b * SB;
    return (w < NCTX) ? F.in(I_CTX) + ((size_t)(b * NCTX + w)) * D : F.in(I_X) + ((size_t)(b * SEQ + (w - NCTX))) * D;
}
__device__ __forceinline__ int stream_of(int row) { const int b = row >= SB ? 1 : 0, w = row - b * SB; return (w < NCTX) ? 2 : b; }
__device__ __forceinline__ const float* modp(const Frame& F, int layer, int s, int chunk) { return (const float*)(F.ws() + WS_MOD) + ((size_t)(layer * 3 + s) * 6 + chunk) * D; }
__device__ __forceinline__ const float* normg(const Frame& F, int layer, int k) { return F.in(I_NORMG) + (size_t)(layer * 4 + k) * D; }

__device__ __forceinline__ void ld_row_f32(const float* p, int lane, f32x4 (&v)[4]) {
#pragma unroll
    for (int j = 0; j < 4; ++j) v[j] = *(const f32x4*)(p + 256 * j + 4 * lane);
}
__device__ __forceinline__ void st_row_f32(float* p, int lane, const f32x4 (&v)[4]) {
#pragma unroll
    for (int j = 0; j < 4; ++j) *(f32x4*)(p + 256 * j + 4 * lane) = v[j];
}
__device__ __forceinline__ void ld_row_bf16(const bf16_t* p, int lane, f32x4 (&v)[4]) {
#pragma unroll
    for (int j = 0; j < 4; ++j) { const u32x2 w = *(const u32x2*)(p + 256 * j + 4 * lane); v[j] = (f32x4){bflo(w.x), bfhi(w.x), bflo(w.y), bfhi(w.y)}; }
}
__device__ __forceinline__ void ld_row_fp8(const unsigned char* p, int lane, f32x4 (&v)[4]) {
#pragma unroll
    for (int j = 0; j < 4; ++j) { const int w = *(const int*)(p + 256 * j + 4 * lane);
        v[j] = (f32x4){__builtin_amdgcn_cvt_f32_fp8(w, 0), __builtin_amdgcn_cvt_f32_fp8(w, 1), __builtin_amdgcn_cvt_f32_fp8(w, 2), __builtin_amdgcn_cvt_f32_fp8(w, 3)}; }
}
__device__ __forceinline__ void st_row_bf16(bf16_t* p, int lane, const f32x4 (&v)[4]) {
#pragma unroll
    for (int j = 0; j < 4; ++j) { u32x2 w; w.x = pkbf(v[j].x, v[j].y); w.y = pkbf(v[j].z, v[j].w); *(u32x2*)(p + 256 * j + 4 * lane) = w; }
}
__device__ __forceinline__ float row_ss(const f32x4 (&v)[4]) {
    float s = 0.f;
#pragma unroll
    for (int j = 0; j < 4; ++j) s += (v[j].x * v[j].x + v[j].y * v[j].y) + (v[j].z * v[j].z + v[j].w * v[j].w);
    return wave_sum(s);
}
__device__ __forceinline__ void modnorm(const f32x4 (&v)[4], const float* g, const float* m1, const float* m0, int lane, f32x4 (&h)[4]) {
    const float r = rsqrtf(row_ss(v) * (1.f / D) + RMS_EPS);
#pragma unroll
    for (int j = 0; j < 4; ++j) { const f32x4 gv = *(const f32x4*)(g + 256 * j + 4 * lane), a = *(const f32x4*)(m1 + 256 * j + 4 * lane), b = *(const f32x4*)(m0 + 256 * j + 4 * lane);
        h[j] = (v[j] * r) * gv * (a + 1.f) + b; }
}

__device__ __forceinline__ void tr_item(const float* W, int K, int N, bf16_t* WT, int k0, int n0, int dst_row0, LAS float* scr, int lane, const float* colscale = nullptr) {
    float tmp[32]; const float csv = colscale ? colscale[lane & 31] : 1.f;
#pragma unroll
    for (int i = 0; i < 32; ++i) { const int kk = 2 * i + (lane >> 5); tmp[i] = W[(size_t)(k0 + kk) * N + n0 + (lane & 31)]; }
#pragma unroll
    for (int i = 0; i < 32; ++i) { const int kk = 2 * i + (lane >> 5); scr[kk * 33 + (lane & 31)] = tmp[i] * csv; }
    LDS_WAIT(); asm volatile("" ::: "memory");
    const int c = lane & 7;
#pragma unroll
    for (int j = 0; j < 4; ++j) { const int n = (lane >> 3) + 8 * j; const LAS float* s = scr + (8 * c) * 33 + n;
        u32x4 o; o.x = pkbf(s[0 * 33], s[1 * 33]); o.y = pkbf(s[2 * 33], s[3 * 33]); o.z = pkbf(s[4 * 33], s[5 * 33]); o.w = pkbf(s[6 * 33], s[7 * 33]);
        *(u32x4*)(WT + (size_t)(dst_row0 + n) * K + k0 + 8 * c) = o; }
    LDS_WAIT(); asm volatile("" ::: "memory");
}
__device__ __forceinline__ void tr_item8(const float* W, int K, int N, unsigned char* WT, int k0, int n0, int dst_row0, LAS float* scr, int lane, float wscale) {
    float tmp[32];
#pragma unroll
    for (int i = 0; i < 32; ++i) { const int kk = 2 * i + (lane >> 5); tmp[i] = W[(size_t)(k0 + kk) * N + n0 + (lane & 31)]; }
#pragma unroll
    for (int i = 0; i < 32; ++i) { const int kk = 2 * i + (lane >> 5); scr[kk * 33 + (lane & 31)] = tmp[i] * wscale; }
    LDS_WAIT(); asm volatile("" ::: "memory");
    const int c = lane & 7;
#pragma unroll
    for (int j = 0; j < 4; ++j) { const int n = (lane >> 3) + 8 * j; const LAS float* s = scr + (8 * c) * 33 + n;
        int w0 = 0, w1 = 0; w0 = __builtin_amdgcn_cvt_pk_fp8_f32(s[0 * 33], s[1 * 33], w0, false); w0 = __builtin_amdgcn_cvt_pk_fp8_f32(s[2 * 33], s[3 * 33], w0, true);
        w1 = __builtin_amdgcn_cvt_pk_fp8_f32(s[4 * 33], s[5 * 33], w1, false); w1 = __builtin_amdgcn_cvt_pk_fp8_f32(s[6 * 33], s[7 * 33], w1, true);
        *(u32x2*)(WT + (size_t)(dst_row0 + n) * K + k0 + 8 * c) = (u32x2){(unsigned)w0, (unsigned)w1}; }
    LDS_WAIT(); asm volatile("" ::: "memory");
}
__device__ __forceinline__ void tr_plain(const float* W, int K, int N, bf16_t* WT, int row_off, LAS float* scr, int item, int lane, const float* colscale = nullptr) {
    const int nblk = N / 32, kb = item / nblk, nb = item - kb * nblk;
    tr_item(W, K, N, WT, 64 * kb, 32 * nb, row_off + 32 * nb, scr, lane, colscale ? colscale + 32 * nb : nullptr);
}
__device__ __forceinline__ void tr_plain8(const float* W, int K, int N, unsigned char* WT, LAS float* scr, int item, int lane) {
    const int nblk = N / 32, kb = item / nblk, nb = item - kb * nblk;
    tr_item8(W, K, N, WT, 64 * kb, 32 * nb, 32 * nb, scr, lane, W8_SCALE);
}
__device__ __forceinline__ void p0_prologue(Frame& F) {
    {
        LAS float* sv = (LAS float*)(F.lds);
        LAS float* red = (LAS float*)(F.lds + 16384);
        if ((PRO_PARTS & 1) && F.vcu < 192) {
            for (int i = F.tid; i < 3 * D; i += 512) { const int s = i >> 10, k = i & 1023; const float c = (s < 2) ? F.in(I_C)[s * D + k] : F.in(I_CCTX)[k]; sv[i] = c / (1.f + __expf(-c)); }
            __syncthreads();
            for (int task = F.vcu; task < 192; task += F.G) {
                const int layer = task / 48, n0 = (task % 48) * 128;
                const int tx = F.tid & 31, ty = F.tid >> 5;
                const float* wp = F.in(I_MODW) + ((size_t)layer * D + ty * 64) * 6144 + n0 + 4 * tx;
                f32x4 a0 = {0, 0, 0, 0}, a1 = a0, a2 = a0;
#pragma unroll 8
                for (int k = 0; k < 64; ++k) { const f32x4 w = *(const f32x4*)(wp + (size_t)k * 6144); const int kk = ty * 64 + k;
                    a0 += w * sv[kk]; a1 += w * sv[D + kk]; a2 += w * sv[2 * D + kk]; }
                *(LAS f32x4*)(red + (ty * 3 + 0) * 128 + 4 * tx) = a0; *(LAS f32x4*)(red + (ty * 3 + 1) * 128 + 4 * tx) = a1; *(LAS f32x4*)(red + (ty * 3 + 2) * 128 + 4 * tx) = a2;
                __syncthreads();
                if (F.tid < 384) { const int s = F.tid >> 7, n = F.tid & 127; float acc = F.in(I_MODB)[layer * 6144 + n0 + n];
#pragma unroll
                    for (int y = 0; y < 16; ++y) acc += red[(y * 3 + s) * 128 + n];
                    ((float*)(F.ws() + WS_MOD))[((size_t)(layer * 3 + s)) * 6144 + n0 + n] = acc; }
                __syncthreads();
            }
        }
        __syncthreads();
    }
    { bf16_t* b1h = (bf16_t*)(F.ws() + WS_B1H); bf16_t* b2h = (bf16_t*)(F.ws() + WS_B2H); const float* b1 = F.in(I_B1); const float* b2 = F.in(I_B2);
      const int gt = F.vcu * (NWAVES * 64) + F.tid, ngt = F.G * NWAVES * 64;
      for (int i = gt; i < 4 * NE * 2048 / 2; i += ngt) ((unsigned*)b1h)[i] = pkbf(b1[2 * i], b1[2 * i + 1]);
      for (int i = gt; i < 4 * NE * 1024 / 2; i += ngt) ((unsigned*)b2h)[i] = pkbf(b2[2 * i], b2[2 * i + 1]); }
    LAS float* scr = (LAS float*)(F.lds + F.wave * 16384);
    if (PRO_PARTS & 2) {
        constexpr int I_POOL = 4 * (256 / 64) * (256 / 32);
        constexpr int I_GQ = 16 * 48, I_SQ = 16 * 32, I_W3 = 16 * 96;
        constexpr int NSMALL = I_POOL + I_GQ + I_SQ + I_W3 + I_SQ + I_W3 + I_SQ;
        for (int it = F.gw; it < NSMALL; it += F.NGW) {
            int r = it;
            if (r < I_POOL) { if (!(SM_MASK & 1)) continue; const int g = r >> 5; tr_plain(F.in(I_POOLW) + (size_t)g * 65536, 256, 256, (bf16_t*)(F.ws() + WS_POOLW), g * 256, scr, r & 31, F.lane, F.in(I_POOLS) + g * 256); continue; } r -= I_POOL;
            if (r < I_GQ) { if (!(SM_MASK & 2)) continue; tr_plain8(F.in(I_GQKV), D, 1536, F.ws() + WS_GQKV, scr, r, F.lane); continue; } r -= I_GQ;
            if (r < I_SQ) { if (!(SM_MASK & 4)) continue; tr_plain8(F.in(I_GO), D, D, F.ws() + WS_GO, scr, r, F.lane); continue; } r -= I_SQ;
            if (r < I_W3) { if (!(SM_MASK & 8)) continue; tr_plain8(F.in(I_CIN), D, 3072, F.ws() + WS_CIN, scr, r, F.lane); continue; } r -= I_W3;
            if (r < I_SQ) { if (!(SM_MASK & 16)) continue; tr_plain8(F.in(I_COUT), D, D, F.ws() + WS_COUT, scr, r, F.lane); continue; } r -= I_SQ;
            if (r < I_W3) { if (!(SM_MASK & 32)) continue; tr_plain8(F.in(I_DQKV), D, 3072, F.ws() + WS_DQKV, scr, r, F.lane); continue; } r -= I_W3;
            if (!(SM_MASK & 64)) continue; tr_plain8(F.in(I_DO), D, D, F.ws() + WS_DO, scr, r, F.lane);
        }
    }
    if (PRO_PARTS & 12) {
        constexpr int NI1 = 128 * 1024, NIT = NI1 + 128 * 512;
        float cur[32], nxt[32];
#define XW_DECODE(it_) const bool w1_ = (it_) < NI1; const int r2_ = w1_ ? (it_) : (it_) - NI1; const int mat_ = w1_ ? (r2_ >> 10) : (r2_ >> 9), rr_ = w1_ ? (r2_ & 1023) : (r2_ & 511), kb_ = w1_ ? (rr_ >> 7) : (rr_ >> 6), n0_ = 16 * (w1_ ? (rr_ & 127) : (rr_ & 63)), N_ = w1_ ? 2048 : 1024; \
        const float* W_ = w1_ ? F.in(I_W1) + (size_t)mat_ * D * 2048 : F.in(I_W2) + (size_t)mat_ * D * D;
#define XW_LOAD(it_, buf) do { XW_DECODE(it_) _Pragma("unroll") for (int i = 0; i < 32; ++i) { const int kk = 4 * i + (F.lane >> 4); buf[i] = W_[(size_t)(128 * kb_ + kk) * N_ + n0_ + (F.lane & 15)]; } } while (0)
        int it = F.gw;
        if (it < NIT) XW_LOAD(it, cur);
        for (; it < NIT; it += F.NGW) {
            const int itn = it + F.NGW;
            if (itn < NIT) XW_LOAD(itn, nxt);
            XW_DECODE(it)
            const int drow = w1_ ? (mat_ * 2048 + ((n0_ & 1023) >> 7) * 256 + (n0_ >> 10) * 128 + (n0_ & 127)) : (mat_ * 1024 + n0_);
            unsigned char* WT = F.ws() + (w1_ ? WS_W1T : WS_W2T);
#pragma unroll
            for (int i = 0; i < 32; ++i) { const int kk = 4 * i + (F.lane >> 4); scr[kk * 17 + (F.lane & 15)] = cur[i] * W8_SCALE; }
            LDS_WAIT(); asm volatile("" ::: "memory");
            { const int n = F.lane >> 2, c = F.lane & 3; const LAS float* s = scr + (32 * c) * 17 + n; unsigned o8[8];
#pragma unroll
              for (int q = 0; q < 8; ++q) { int w0 = 0; w0 = __builtin_amdgcn_cvt_pk_fp8_f32(s[(4 * q) * 17], s[(4 * q + 1) * 17], w0, false); w0 = __builtin_amdgcn_cvt_pk_fp8_f32(s[(4 * q + 2) * 17], s[(4 * q + 3) * 17], w0, true); o8[q] = (unsigned)w0; }
              unsigned char* d = WT + (size_t)(drow + n) * D + 128 * kb_ + 32 * c;
              *(u32x4*)d = (u32x4){o8[0], o8[1], o8[2], o8[3]}; *(u32x4*)(d + 16) = (u32x4){o8[4], o8[5], o8[6], o8[7]}; }
            LDS_WAIT(); asm volatile("" ::: "memory");
#pragma unroll
            for (int i = 0; i < 32; ++i) cur[i] = nxt[i];
        }
#undef XW_DECODE
#undef XW_LOAD
    }
    __syncthreads();
}

template <bool DRY> __device__ __forceinline__ void p_hpass0(Frame& F) {
    bf16_t* H = (bf16_t*)(F.ws() + WS_H + (DRY ? WS_JUNK : 0));
    int cs = -1; f32x4 pg[4], p0v[4];
    for (int rr = F.gw; rr < T; rr += 2 * F.NGW) {
        const int r0 = rr, r1 = min(rr + F.NGW, T - 1);
        f32x4 v0[4], v1[4], h[4]; ld_row_f32(input_row(F, r0), F.lane, v0); ld_row_f32(input_row(F, r1), F.lane, v1);
#define HP_ROW(v_, r_) do { const int s = stream_of(r_); if (s != cs) { cs = s; const float* gn = normg(F, 0, 0); const float* m1n = modp(F, 0, s, 1); const float* m0n = modp(F, 0, s, 0); \
            _Pragma("unroll") for (int j = 0; j < 4; ++j) { const int o = 256 * j + 4 * F.lane; pg[j] = *(const f32x4*)(gn + o) * (*(const f32x4*)(m1n + o) + 1.f); p0v[j] = *(const f32x4*)(m0n + o); } } \
          const float rx = rsqrtf(row_ss(v_) * (1.f / D) + RMS_EPS); _Pragma("unroll") for (int j = 0; j < 4; ++j) h[j] = (v_[j] * rx) * pg[j] + p0v[j]; st_row_bf16(H + (size_t)(r_) * D, F.lane, h); } while (0)
        HP_ROW(v0, r0); HP_ROW(v1, r1);
#undef HP_ROW
    }
}
template <bool DRY> __device__ __forceinline__ void p_poolprep(Frame& F) {
    const bf16_t* H = (const bf16_t*)(F.ws() + WS_H); bf16_t* Dp = (bf16_t*)(F.ws() + WS_O + (DRY ? WS_JUNK : 0));
    for (int row = F.gw; row < T; row += F.NGW) {
        const int b = row >= SB ? 1 : 0, w = row - b * SB;
        const int s0 = (w < NCTX) ? b * SB : b * SB + NCTX, s1 = (w < NCTX) ? b * SB + NCTX : (b + 1) * SB;
#pragma unroll
        for (int j = 0; j < 4; ++j) {
            constexpr int dummy = 0; (void)dummy;
            const int half = 1 << j;
            const int lo = max(row - half, s0), hi = min(row + half, s1);
            u32x2 q[16];
#pragma unroll
            for (int i = 0; i < 2 * half; ++i) { const int rr = row - half + i; const int rc = (rr >= lo && rr < hi) ? rr : row; q[i] = *(const u32x2*)(H + (size_t)rc * D + 256 * j + 4 * F.lane); }
            const u32x2 qs = *(const u32x2*)(H + (size_t)row * D + 256 * j + 4 * F.lane);
            f32x4 acc = {0, 0, 0, 0};
#pragma unroll
            for (int i = 0; i < 2 * half; ++i) { const int rr = row - half + i; const float wgt = (rr >= lo && rr < hi) ? 1.f : 0.f; acc += (f32x4){bflo(q[i].x), bfhi(q[i].x), bflo(q[i].y), bfhi(q[i].y)} * wgt; }
            const f32x4 self = {bflo(qs.x), bfhi(qs.x), bflo(qs.y), bfhi(qs.y)};
            const f32x4 d = acc * (1.f / (float)(hi - lo)) - self;
            u32x2 o; o.x = pkbf(d.x, d.y); o.y = pkbf(d.z, d.w);
            *(u32x2*)(Dp + ((size_t)j * T + row) * 256 + 4 * F.lane) = o;
        }
    }
}

template <int L>
__device__ __forceinline__ void p_moe_a(Frame& F, const bool DRY) {
    const bf16_t* Y = (const bf16_t*)(F.ws() + WS_Y); const bf16_t* X = (const bf16_t*)(F.ws() + WS_X); bf16_t* Xo = (bf16_t*)(F.ws() + WS_X + (DRY ? WS_JUNK : 0)); unsigned char* H8 = F.ws() + WS_H + (DRY ? WS_JUNK : 0);
    float* gate = (float*)(F.ws() + WS_GATE + (DRY ? WS_JUNK : 0)); int* list = (int*)(F.ws() + WS_LIST);
    LAS float* hbuf = (LAS float*)(F.lds);
    LAS float* part = (LAS float*)(F.lds + 65536);
    LAS int* sel = (LAS int*)(F.lds + 83968);
    LAS int* lcnt = (LAS int*)(F.lds + LC_LCNT); LAS int* gbase = (LAS int*)(F.lds + LC_GBASE);
    const float* g1 = normg(F, L, 1); const float* g2 = normg(F, L, 2);
    const float* rw = F.in(I_RW) + (size_t)L * D * NE; const float* rb = F.in(I_RB) + L * NE;
    const int e = F.lane & 31, kh = F.lane >> 5;
    typedef short rbf16x8 __attribute__((ext_vector_type(8)));
    rbf16x8 wh[4][2], wl[4][2];
#pragma unroll
    for (int s = 0; s < 4; ++s)
#pragma unroll
        for (int n = 0; n < 2; ++n) { unsigned hw[4], lw[4];
#pragma unroll
            for (int q = 0; q < 4; ++q) { const int k = 128 * F.wave + 32 * s + 8 * (F.lane >> 4) + 2 * q; const float w0 = rw[(size_t)k * NE + 16 * n + (F.lane & 15)], w1 = rw[(size_t)(k + 1) * NE + 16 * n + (F.lane & 15)];
                hw[q] = pkbf(w0, w1); lw[q] = pkbf(w0 - bflo(hw[q]), w1 - bfhi(hw[q])); }
            const u32x4 hv = {hw[0], hw[1], hw[2], hw[3]}, lv = {lw[0], lw[1], lw[2], lw[3]}; wh[s][n] = __builtin_bit_cast(rbf16x8, hv); wl[s][n] = __builtin_bit_cast(rbf16x8, lv); }
    const float bias = rb[e];
    if (F.tid < 32) lcnt[F.tid] = 0;
    __syncthreads();
    constexpr int NRA = (L == 3) ? NB * SEQ : T;
#define MA_ROW(n_) ((L == 3) ? (((n_) >> 14) * SB + NCTX + ((n_) & (SEQ - 1))) : (n_))
    const int chunk = (NRA + F.G - 1) / F.G, tok0 = min(NRA, (int)blockIdx.x * chunk), tok1 = min(NRA, tok0 + chunk);
    int cs = -1; f32x4 qm[4], qg[4], q0v[4];
    f32x4 y[2][4], x[2][4];
#define MA_LOAD(base_) do { _Pragma("unroll") for (int tt = 0; tt < 2; ++tt) { const int tok_ = (base_) + F.wave * 2 + tt; if (tok_ < tok1) { \
        const int row_ = MA_ROW(tok_); ld_row_bf16(Y + (size_t)row_ * D, F.lane, y[tt]); if constexpr (L == 0) ld_row_f32(input_row(F, row_), F.lane, x[tt]); else ld_row_bf16(X + (size_t)row_ * D, F.lane, x[tt]); } } } while (0)
    MA_LOAD(tok0);
    for (int base = tok0; base < tok1; base += 16) {
#pragma unroll
        for (int tt = 0; tt < 2; ++tt) {
            const int tl = F.wave * 2 + tt, tok = base + tl;
            if (tok < tok1) {
                const int row = MA_ROW(tok), s = stream_of(row);
                f32x4 h[4];
                if (s != cs) { cs = s; const float* m2 = modp(F, L, s, 2); const float* m4 = modp(F, L, s, 4); const float* m3 = modp(F, L, s, 3);
#pragma unroll
                    for (int j = 0; j < 4; ++j) { const int o = 256 * j + 4 * F.lane; qm[j] = *(const f32x4*)(m2 + o) * *(const f32x4*)(g1 + o); qg[j] = *(const f32x4*)(g2 + o) * (*(const f32x4*)(m4 + o) + 1.f); q0v[j] = *(const f32x4*)(m3 + o); } }
                const float ry = rsqrtf(row_ss(y[tt]) * (1.f / D) + RMS_EPS);
#pragma unroll
                for (int j = 0; j < 4; ++j) x[tt][j] = x[tt][j] + qm[j] * (y[tt][j] * ry);
                st_row_bf16(Xo + (size_t)row * D, F.lane, x[tt]);
                { const float rx = rsqrtf(row_ss(x[tt]) * (1.f / D) + RMS_EPS);
#pragma unroll
                  for (int j = 0; j < 4; ++j) h[j] = (x[tt][j] * rx) * qg[j] + q0v[j]; }
#pragma unroll
                for (int j = 0; j < 4; ++j) { int w = 0; w = __builtin_amdgcn_cvt_pk_fp8_f32(h[j].x, h[j].y, w, false); w = __builtin_amdgcn_cvt_pk_fp8_f32(h[j].z, h[j].w, w, true); *(int*)(H8 + (size_t)row * D + 256 * j + 4 * F.lane) = w; }
#pragma unroll
                for (int j = 0; j < 4; ++j) *(LAS f32x4*)(hbuf + tl * D + 256 * j + 4 * F.lane) = h[j];
            }
        }
        __syncthreads();
        if (base + 16 < tok1) MA_LOAD(base + 16);
        {
            f32x4 lg0 = {0.f, 0.f, 0.f, 0.f}, lg1 = {0.f, 0.f, 0.f, 0.f};
#pragma unroll
            for (int s = 0; s < 4; ++s) {
                const LAS float* hp = hbuf + (F.lane & 15) * D + 128 * F.wave + 32 * s + 8 * (F.lane >> 4);
                const f32x4 x0 = *(const LAS f32x4*)hp, x1 = *(const LAS f32x4*)(hp + 4);
                const unsigned h0 = pkbf(x0.x, x0.y), h1 = pkbf(x0.z, x0.w), h2 = pkbf(x1.x, x1.y), h3 = pkbf(x1.z, x1.w);
                const unsigned l0 = pkbf(x0.x - bflo(h0), x0.y - bfhi(h0)), l1 = pkbf(x0.z - bflo(h1), x0.w - bfhi(h1)), l2 = pkbf(x1.x - bflo(h2), x1.y - bfhi(h2)), l3 = pkbf(x1.z - bflo(h3), x1.w - bfhi(h3));
                const u32x4 hv = {h0, h1, h2, h3}, lv = {l0, l1, l2, l3};
                const rbf16x8 ah = __builtin_bit_cast(rbf16x8, hv), al = __builtin_bit_cast(rbf16x8, lv);
                lg0 = __builtin_amdgcn_mfma_f32_16x16x32_bf16(ah, wh[s][0], lg0, 0, 0, 0); lg1 = __builtin_amdgcn_mfma_f32_16x16x32_bf16(ah, wh[s][1], lg1, 0, 0, 0);
                lg0 = __builtin_amdgcn_mfma_f32_16x16x32_bf16(ah, wl[s][0], lg0, 0, 0, 0); lg1 = __builtin_amdgcn_mfma_f32_16x16x32_bf16(ah, wl[s][1], lg1, 0, 0, 0);
                lg0 = __builtin_amdgcn_mfma_f32_16x16x32_bf16(al, wh[s][0], lg0, 0, 0, 0); lg1 = __builtin_amdgcn_mfma_f32_16x16x32_bf16(al, wh[s][1], lg1, 0, 0, 0);
            }
#pragma unroll
            for (int r = 0; r < 4; ++r) { const int tl = 4 * (F.lane >> 4) + r; part[(F.wave * 16 + tl) * 32 + (F.lane & 15)] = lg0[r]; part[(F.wave * 16 + tl) * 32 + 16 + (F.lane & 15)] = lg1[r]; }
        }
        __syncthreads();
        {
            const int tl = F.wave * 2 + kh, tok = base + tl;
            float v = bias;
#pragma unroll
            for (int w = 0; w < 8; ++w) v += part[(w * 16 + tl) * 32 + e];
            float tv[4]; int ti[4];
#pragma unroll
            for (int k = 0; k < 4; ++k) {
                float cv = v; int ci = e;
#pragma unroll
                for (int o = 1; o < 32; o <<= 1) { const float ov = __shfl_xor(cv, o); const int oi = __shfl_xor(ci, o); if (ov > cv || (ov == cv && oi < ci)) { cv = ov; ci = oi; } }
                tv[k] = cv; ti[k] = ci; if (e == ci) v = -3.0e38f;
            }
            if (tok < tok1) {
                const float e1 = __expf(tv[1] - tv[0]), e2 = __expf(tv[2] - tv[0]), e3 = __expf(tv[3] - tv[0]); const float inv = 1.f / (1.f + e1 + e2 + e3);
                if (e == 0) *(f32x4*)(gate + (size_t)MA_ROW(tok) * 4) = (f32x4){inv, e1 * inv, e2 * inv, e3 * inv};
                if (!DRY && e < 4) { const int ex = (e == 0) ? ti[0] : (e == 1) ? ti[1] : (e == 2) ? ti[2] : ti[3];
                    const int rank = __hip_atomic_fetch_add(lcnt + ex, 1, __ATOMIC_RELAXED, __HIP_MEMORY_SCOPE_WORKGROUP); sel[(tok - tok0) * 4 + e] = ex | (rank << 8); }
            }
        }
    }
#undef MA_LOAD
    __syncthreads();
    if (DRY) return;
    if (F.tid < 32) gbase[F.tid] = (int)__hip_atomic_fetch_add(F.ctl() + CW_CNT + L * 32 + F.tid, (unsigned)lcnt[F.tid], __ATOMIC_RELAXED, __HIP_MEMORY_SCOPE_AGENT);
    __syncthreads();
    for (int i = F.tid; i < (tok1 - tok0) * 4; i += 512) { const int v = sel[i], ee = v & 255, rank = v >> 8; list[(size_t)ee * T + gbase[ee] + rank] = MA_ROW(tok0 + (i >> 2)) * 4 + (i & 3); }
    __syncthreads();
#undef MA_ROW
}
template <int L>
__device__ __forceinline__ int moe_setup(Frame& F) {
    LAS int* cnt = (LAS int*)(F.lds + LC_CNT); LAS int* tbase = (LAS int*)(F.lds + LC_TBASE); LAS int* tile_e = (LAS int*)(F.lds + LC_TILEE);
    __syncthreads();
    if (F.tid < 64) {
        const int c = (F.lane < 32) ? (int)__hip_atomic_load(F.ctl() + CW_CNT + L * 32 + F.lane, __ATOMIC_RELAXED, __HIP_MEMORY_SCOPE_AGENT) : 0;
        const int nt = (c + 255) >> 8;
        int incl = nt;
#pragma unroll
        for (int o = 1; o < 32; o <<= 1) { const int t = __shfl_up(incl, o); if (F.lane >= o) incl += t; }
        const int excl = incl - nt;
        if (F.lane < 32) { cnt[F.lane] = c; tbase[F.lane] = excl; for (int t = 0; t < nt; ++t) tile_e[excl + t] = F.lane; }
        if (F.lane == 31) tbase[32] = incl;
    }
    __syncthreads();
    return tbase[32];
}
template <int L, bool DRY>
__device__ __forceinline__ void p_moe_b(Frame& F) {
    const unsigned char* SLOT = F.ws() + WS_SLOT; const bf16_t* X = (const bf16_t*)(F.ws() + WS_X); bf16_t* Xo = (bf16_t*)(F.ws() + WS_X + (DRY ? WS_JUNK : 0)); unsigned char* H8 = F.ws() + WS_H + (DRY ? WS_JUNK : 0); const float* gate = (const float*)(F.ws() + WS_GATE);
    const float* g3 = normg(F, L, 3);
    constexpr int NR = (L == 3) ? NB * SEQ : T;
    int sl[4][4], sn[4][4]; f32x4 xc[4], xn[4], gc, gn;
#define MB_ROW(n_) ((L == 3) ? (((n_) >> 14) * SB + NCTX + ((n_) & (SEQ - 1))) : (n_))
#define MB_LOAD(n_, S_, X_, G_) do { const int r_ = MB_ROW(n_); G_ = *(const f32x4*)(gate + (size_t)r_ * 4); \
        _Pragma("unroll") for (int k = 0; k < 4; ++k) _Pragma("unroll") for (int j = 0; j < 4; ++j) S_[k][j] = *(const int*)(SLOT + ((size_t)r_ * 4 + k) * D + 256 * j + 4 * F.lane); \
        ld_row_bf16(X + (size_t)r_ * D, F.lane, X_); } while (0)
    int cs = -1; f32x4 pm[4], pg[4], p0v[4];
    int n = F.gw;
    if (n < NR) MB_LOAD(n, sl, xc, gc);
    for (; n < NR; n += F.NGW) {
        const int nn = n + F.NGW;
        if (nn < NR) MB_LOAD(nn, sn, xn, gn);
        const int row = MB_ROW(n), b = row >= SB ? 1 : 0, w = row - b * SB, s = (w < NCTX) ? 2 : b;
        f32x4 y[4], x[4];
#pragma unroll
        for (int j = 0; j < 4; ++j) { y[j] = (f32x4){0, 0, 0, 0}; x[j] = xc[j];
#pragma unroll
            for (int k = 0; k < 4; ++k) { const int q = sl[k][j]; y[j] += (f32x4){__builtin_amdgcn_cvt_f32_fp8(q, 0), __builtin_amdgcn_cvt_f32_fp8(q, 1), __builtin_amdgcn_cvt_f32_fp8(q, 2), __builtin_amdgcn_cvt_f32_fp8(q, 3)} * gc[k]; } }
        if (s != cs) { cs = s; constexpr int LN_ = (L < 3) ? L + 1 : 3; const float* m5 = modp(F, L, s, 5); const float* gn = normg(F, LN_, 0); const float* m1n = modp(F, LN_, s, 1); const float* m0n = modp(F, LN_, s, 0);
#pragma unroll
            for (int j = 0; j < 4; ++j) { const int o = 256 * j + 4 * F.lane; pm[j] = *(const f32x4*)(m5 + o) * *(const f32x4*)(g3 + o); pg[j] = *(const f32x4*)(gn + o) * (*(const f32x4*)(m1n + o) + 1.f); p0v[j] = *(const f32x4*)(m0n + o); } }
        const float ry = rsqrtf(row_ss(y) * (1.f / D) + RMS_EPS);
#pragma unroll
        for (int j = 0; j < 4; ++j) x[j] = x[j] + pm[j] * (y[j] * ry);
        if (L == 3) { st_row_f32((DRY ? (float*)Xo : F.out()) + ((size_t)(b * SEQ + (w - NCTX))) * D, F.lane, x); }
        else {
            st_row_bf16(Xo + (size_t)row * D, F.lane, x);
            f32x4 h[4]; const float rx = rsqrtf(row_ss(x) * (1.f / D) + RMS_EPS);
#pragma unroll
            for (int j = 0; j < 4; ++j) h[j] = (x[j] * rx) * pg[j] + p0v[j];
#pragma unroll
            for (int j = 0; j < 4; ++j) { int w8 = 0; w8 = __builtin_amdgcn_cvt_pk_fp8_f32(h[j].x, h[j].y, w8, false); w8 = __builtin_amdgcn_cvt_pk_fp8_f32(h[j].z, h[j].w, w8, true); *(int*)(H8 + (size_t)row * D + 256 * j + 4 * F.lane) = w8; }
        }
#pragma unroll
        for (int k = 0; k < 4; ++k)
#pragma unroll
            for (int j = 0; j < 4; ++j) sl[k][j] = sn[k][j];
#pragma unroll
        for (int j = 0; j < 4; ++j) xc[j] = xn[j];
        gc = gn;
    }
#undef MB_ROW
#undef MB_LOAD
}
template <int LDG, int VCOL0, int NH>
__device__ __forceinline__ void vt_prep(Frame& F, const bf16_t* G, unsigned char* VT8) {
    LAS unsigned char* scr = F.lds + F.wave * 4096;
    constexpr int NTI = SB / 64;
    const int dvl = F.lane >> 1, hf = F.lane & 1;
    for (int it = F.gw; it < NB * NH * NTI; it += F.NGW) {
        const int tile = it % NTI, bh = it / NTI, b = bh / NH, hd = bh - b * NH;
        const bf16_t* src = G + (size_t)(b * SB + tile * 64 + F.lane) * LDG + VCOL0 + hd * 128;
        unsigned char* dst = VT8 + (size_t)(bh * 128) * SB + tile * 64 + hf * 32;
#pragma unroll 1
        for (int c = 0; c < 4; ++c) {
            u32x4 a[4];
#pragma unroll
            for (int i = 0; i < 4; ++i) a[i] = *(const u32x4*)(src + c * 32 + i * 8);
#pragma unroll
            for (int i = 0; i < 4; ++i) {
                int w0 = 0, w1 = 0;
                w0 = __builtin_amdgcn_cvt_pk_fp8_f32(bflo(a[i].x), bfhi(a[i].x), w0, false); w0 = __builtin_amdgcn_cvt_pk_fp8_f32(bflo(a[i].y), bfhi(a[i].y), w0, true);
                w1 = __builtin_amdgcn_cvt_pk_fp8_f32(bflo(a[i].z), bfhi(a[i].z), w1, false); w1 = __builtin_amdgcn_cvt_pk_fp8_f32(bflo(a[i].w), bfhi(a[i].w), w1, true);
                *(LAS int*)(scr + F.lane * 36 + 8 * i) = w0; *(LAS int*)(scr + F.lane * 36 + 8 * i + 4) = w1;
            }
            LDS_WAIT(); asm volatile("" ::: "memory");
            unsigned o8[8];
#pragma unroll
            for (int q = 0; q < 8; ++q) { const int kb = 32 * (q >> 2) + 8 * (q & 3) + 4 * hf; const LAS unsigned char* p = scr + kb * 36 + dvl;
                o8[q] = (unsigned)p[0] | ((unsigned)p[36] << 8) | ((unsigned)p[72] << 16) | ((unsigned)p[108] << 24); }
            unsigned char* d = dst + (size_t)(c * 32 + dvl) * SB;
            *(u32x4*)d = (u32x4){o8[0], o8[1], o8[2], o8[3]}; *(u32x4*)(d + 16) = (u32x4){o8[4], o8[5], o8[6], o8[7]};
            LDS_WAIT(); asm volatile("" ::: "memory");
        }
    }
}
template <bool DRY> __device__ __forceinline__ void p_gqa_prep(Frame& F) {
    const bf16_t* G = (const bf16_t*)(F.ws() + WS_G); unsigned char* Q8 = F.ws() + WS_Q8; unsigned char* K8 = F.ws() + WS_K8; const float* qg = F.in(I_GQG); const float* kg = F.in(I_GKG);
    const int hi = F.lane >> 5, jl = (F.lane & 31) * 2, c0 = hi * 64 + jl;
    const float f0 = __builtin_amdgcn_exp2f(-(float)(jl & 31) * (LOG2_THETA / 32.f)), f1 = __builtin_amdgcn_exp2f(-(float)((jl + 1) & 31) * (LOG2_THETA / 32.f));
    const float qg0 = qg[c0], qg1 = qg[c0 + 1], kg0 = kg[c0], kg1 = kg[c0 + 1];
    for (int rr = F.gw; rr < T; rr += 2 * F.NGW) {
        unsigned qw[2][10];
#pragma unroll
        for (int u = 0; u < 2; ++u) { const int row = min(rr + u * F.NGW, T - 1); const bf16_t* gr = G + (size_t)row * 1536 + c0;
#pragma unroll
            for (int h = 0; h < 10; ++h) qw[u][h] = *(const unsigned*)(gr + h * 128); }
#pragma unroll
        for (int u = 0; u < 2; ++u) {
            const int row = min(rr + u * F.NGW, T - 1);
            const int b = row >= SB ? 1 : 0, w = row - b * SB; const bool lat = w >= NCTX; const int t = w - NCTX;
            const float pos = lat ? ((jl < 32) ? (float)(t >> 6) : (float)(t & 63)) : 0.f; const float a0 = pos * f0, a1 = pos * f1;
            const float cs0 = __cosf(a0), sn0 = __sinf(a0), cs1 = __cosf(a1), sn1 = __sinf(a1);
#pragma unroll
            for (int h = 0; h < 10; ++h) {
                const unsigned q = qw[u][h];
                const float x0 = bflo(q), x1 = bfhi(q);
                const float r = rsqrtf(wave_sum(x0 * x0 + x1 * x1) * (1.f / 128.f) + RMS_EPS);
                const float n0 = x0 * r * (h < 8 ? qg0 : kg0), n1 = x1 * r * (h < 8 ? qg1 : kg1);
                const float p0 = __shfl_xor(n0, 32), p1 = __shfl_xor(n1, 32);
                const float o0 = hi ? (n0 * cs0 + p0 * sn0) : (n0 * cs0 - p0 * sn0), o1 = hi ? (n1 * cs1 + p1 * sn1) : (n1 * cs1 - p1 * sn1);
                const float qs = (h < 8) ? QSCALE128 : 1.f;
                const unsigned short w8 = (unsigned short)__builtin_amdgcn_cvt_pk_fp8_f32(o0 * qs, o1 * qs, 0, false);
                if (h < 8) *(unsigned short*)(Q8 + (size_t)row * 1024 + h * 128 + c0) = w8; else *(unsigned short*)(K8 + (size_t)row * 256 + (h - 8) * 128 + c0) = w8;
            }
        }
    }
    vt_prep<1536, 1280, 2>(F, G, F.ws() + WS_VT8);
}
template <bool DRY> __device__ __forceinline__ void p_diff_prep(Frame& F) {
    const bf16_t* G = (const bf16_t*)(F.ws() + WS_G); unsigned char* Q8 = F.ws() + WS_Q8; unsigned char* K8 = F.ws() + WS_K8;
    const int l31 = F.lane & 31, j0 = 2 * l31; const bool first = l31 < 16; const int jj = j0 & 31;
    const float f0 = __builtin_amdgcn_exp2f(-(float)(jj & 15) * (LOG2_THETA / 16.f)), f1 = __builtin_amdgcn_exp2f(-(float)((jj + 1) & 15) * (LOG2_THETA / 16.f));
    for (int rr = F.gw; rr < T; rr += 2 * F.NGW) {
        unsigned qw[2][16];
#pragma unroll
        for (int u = 0; u < 2; ++u) { const int row = min(rr + u * F.NGW, T - 1); const bf16_t* gr = G + (size_t)row * 3072 + 2 * F.lane;
#pragma unroll
            for (int ch = 0; ch < 16; ++ch) qw[u][ch] = *(const unsigned*)(gr + ch * 128); }
#pragma unroll
        for (int u = 0; u < 2; ++u) {
            const int row = min(rr + u * F.NGW, T - 1);
            const int b = row >= SB ? 1 : 0, w = row - b * SB; const int t = w - NCTX;
            const float pos = (w >= NCTX) ? ((jj < 16) ? (float)(t >> 6) : (float)(t & 63)) : 0.f; const float a0 = pos * f0, a1 = pos * f1;
            const float cs0 = __cosf(a0), sn0 = __sinf(a0), cs1 = __cosf(a1), sn1 = __sinf(a1);
#pragma unroll
            for (int ch = 0; ch < 16; ++ch) {
                const unsigned q = qw[u][ch];
                const float x0 = bflo(q), x1 = bfhi(q);
                const float p0 = __shfl_xor(x0, 16), p1 = __shfl_xor(x1, 16);
                const float o0 = first ? (x0 * cs0 - p0 * sn0) : (x0 * cs0 + p0 * sn0), o1 = first ? (x1 * cs1 - p1 * sn1) : (x1 * cs1 + p1 * sn1);
                const float qs = (ch < 8) ? QSCALE64 : 1.f;
                const unsigned short w8 = (unsigned short)__builtin_amdgcn_cvt_pk_fp8_f32(o0 * qs, o1 * qs, 0, false);
                if (ch < 8) *(unsigned short*)(Q8 + (size_t)row * 1024 + ch * 128 + 2 * F.lane) = w8; else *(unsigned short*)(K8 + (size_t)row * 1024 + (ch - 8) * 128 + 2 * F.lane) = w8;
            }
        }
    }
    vt_prep<3072, 2048, 8>(F, G, F.ws() + WS_VT8);
}
template <bool DRY> __device__ __forceinline__ void p_conv_prep(Frame& F) {
    const bf16_t* G = (const bf16_t*)(F.ws() + WS_G); unsigned char* Z = F.ws() + WS_O + (DRY ? WS_JUNK : 0); const float* wd = F.in(I_CDW);
    for (int rr = F.gw; rr < T; rr += 2 * F.NGW) {
        u32x2 qc[2][3][4], qx[2][3][4], qb[2][4]; float wm[2][3];
#pragma unroll
        for (int u = 0; u < 2; ++u) {
            const int row = min(rr + u * F.NGW, T - 1); const int b = row >= SB ? 1 : 0, w = row - b * SB;
            const int s0 = (w < NCTX) ? b * SB : b * SB + NCTX, s1 = (w < NCTX) ? b * SB + NCTX : (b + 1) * SB;
            const bool hasp = row - 1 >= s0, hasn = row + 1 < s1;
            const int rws[3] = {hasp ? row - 1 : row, row, hasn ? row + 1 : row}; wm[u][0] = hasp ? 1.f : 0.f; wm[u][1] = 1.f; wm[u][2] = hasn ? 1.f : 0.f;
#pragma unroll
            for (int j = 0; j < 4; ++j) { const int c = 256 * j + 4 * F.lane; qb[u][j] = *(const u32x2*)(G + (size_t)row * 3072 + c);
#pragma unroll
                for (int d = 0; d < 3; ++d) { const bf16_t* gp = G + (size_t)rws[d] * 3072 + c; qc[u][d][j] = *(const u32x2*)(gp + 1024); qx[u][d][j] = *(const u32x2*)(gp + 2048); } }
        }
#pragma unroll
        for (int u = 0; u < 2; ++u) {
            const int row = min(rr + u * F.NGW, T - 1);
#pragma unroll
            for (int j = 0; j < 4; ++j) { const int c = 256 * j + 4 * F.lane; f32x4 acc = {0, 0, 0, 0};
#pragma unroll
                for (int d = 0; d < 3; ++d) { const u32x2 a = qc[u][d][j], x = qx[u][d][j];
                    const f32x4 uu = (f32x4){bflo(a.x), bfhi(a.x), bflo(a.y), bfhi(a.y)} * (f32x4){bflo(x.x), bfhi(x.x), bflo(x.y), bfhi(x.y)};
                    acc += uu * (*(const f32x4*)(wd + d * D + c) * wm[u][d]); }
                const u32x2 g = qb[u][j];
                const f32x4 z = acc * (f32x4){bflo(g.x), bfhi(g.x), bflo(g.y), bfhi(g.y)};
                int w8 = 0; w8 = __builtin_amdgcn_cvt_pk_fp8_f32(z.x * OS_CONV, z.y * OS_CONV, w8, false); w8 = __builtin_amdgcn_cvt_pk_fp8_f32(z.z * OS_CONV, z.w * OS_CONV, w8, true);
                *(int*)(Z + (size_t)row * D + c) = w8; }
        }
    }
}
template <int PV> __device__ __forceinline__ void p_gqa_attn(Frame& F) {
    const unsigned char* Q8 = F.ws() + WS_Q8; const unsigned char* K8 = F.ws() + WS_K8; const unsigned char* VT8 = F.ws() + WS_VT8; unsigned char* O = F.ws() + WS_O + (PV ? WS_JUNK : 0);
    for (int idx = F.vcu; idx < 1024 + 16; idx += F.G) {
        int b, hq, qrow, seq;
        if (idx < 1024) { const int r = idx >> 8, wi = idx & 255; b = r >> 1; hq = (r & 1) * 4 + (wi >> 6); qrow = b * SB + NCTX + (wi & 63) * 256; seq = SB; }
        else { const int j = idx - 1024; b = j >> 3; hq = j & 7; qrow = b * SB; seq = NCTX; }
        const int kvh = hq >> 2;
        att8::attn_body8<128, 1024, 256, 1024, false, (PV > 0 ? PV - 1 : 0)>(Q8 + (size_t)qrow * 1024 + hq * 128, K8 + (size_t)(b * SB) * 256 + kvh * 128, VT8 + (size_t)((b * 2 + kvh) * 128) * SB,
                                                      O + (size_t)qrow * D + hq * 128, seq, F.ldsg, 0, 0.f, nullptr);
    }
}
__device__ __forceinline__ void p_diff_attn(Frame& F) {
    const unsigned char* Q8 = F.ws() + WS_Q8; const unsigned char* K8 = F.ws() + WS_K8; const unsigned char* VT8 = F.ws() + WS_VT8; unsigned char* O = F.ws() + WS_O;
    const float* lv = F.in(I_DLAM);
    const float lam = __expf(wave_sum(lv[F.lane] * lv[64 + F.lane])) - __expf(wave_sum(lv[128 + F.lane] * lv[192 + F.lane])) + LAM_INIT;
    for (int idx = F.vcu; idx < 1024; idx += F.G) {
#pragma unroll 1
        for (int s = 0; s < 2; ++s) {
            int ix = idx; asm volatile("" : "+s"(ix));
            const int r = ix >> 6, b = r >> 3, h = r & 7, qrow = b * SB + NCTX + (ix & 63) * 256;
            att8::attn_body8<64, 1024, 1024, 1024, true>(Q8 + (size_t)qrow * 1024 + h * 128 + s * 64, K8 + (size_t)(b * SB) * 1024 + h * 128 + s * 64, VT8 + (size_t)((b * 8 + h) * 128) * SB,
                                                         O + (size_t)qrow * D + h * 128, SB, F.ldsg, s, lam, F.in(I_DSUB));
        }
    }
}


#define PG8_ALIGN true
#define PG8_SP2 true

template <int L, int P0> __device__ __forceinline__ void moe_layer(Frame& F, const XcdBarrier& bar, int lo, int hi, int rep_mask);

__global__ void __launch_bounds__(NWAVES * 64, 2) mk_fwd(Args args) {
    extern __shared__ __attribute__((aligned(16))) unsigned char lds[];
    Frame F;
    F.lds = (LAS unsigned char*)lds; F.ldsg = (char*)lds;
    F.tid = threadIdx.x; F.lane = F.tid & 63; F.wave = __builtin_amdgcn_readfirstlane(F.tid >> 6);
    F.G = gridDim.x; { const int bx = blockIdx.x; F.vcu = (F.G % 8 == 0) ? (bx % 8) * (F.G / 8) + bx / 8 : bx; }
    F.gw = F.vcu * NWAVES + F.wave; F.NGW = F.G * NWAVES;
    refresh(F);
    for (int u = F.tid; u < (LDS_BYTES - RING_BYTES) / 4; u += NWAVES * 64) ((LAS unsigned*)(F.lds + RING_BYTES))[u] = 0u;
    __syncthreads();
    XcdBarrier bar; bar.bar = F.ctl() + CW_BAR; bar.x = 0; bar.st = nullptr;
    if (!MK_MULTI) bar = xcd_barrier_post(F.ctl() + CW_BAR, (volatile LAS unsigned*)(F.lds + LC_MISC));
    const int lo = args.ph_lo, hi = args.ph_hi; const int rep_mask = args.pad;
#define IN(k) (lo <= (k) && (k) < hi && refresh(F))
#define NREP(bit) (REP_MASK ? 1 + ((rep_mask & (bit)) ? 1 : 0) : 1)
#define PHM(k) asm volatile("; === PHASE %0" :: "i"(k))
#define SEAM(k) do { if (IN(k) && IN((k) + 1)) { xcd_barrier(bar); if constexpr ((REP_MASK & 256) != 0) xcd_barrier(bar); } } while (0)
    bf16_t* const Hb = (bf16_t*)(F.ws() + WS_H); bf16_t* const Gb = (bf16_t*)(F.ws() + WS_G); bf16_t* const Ob = (bf16_t*)(F.ws() + WS_O); bf16_t* const Yb = (bf16_t*)(F.ws() + WS_Y);

    if (IN(0)) { PHM(0); for (int rep = 0; rep < NREP(16); ++rep) p0_prologue(F); } SEAM(0);
    if (IN(1)) { PHM(1); if constexpr ((REP_MASK & 128) != 0) p_hpass0<true>(F); p_hpass0<false>(F); } SEAM(1);
    if (IN(2)) { PHM(2); if constexpr ((REP_MASK & 128) != 0) p_poolprep<true>(F); p_poolprep<false>(F); } SEAM(2);
    if (IN(3)) { PHM(3);
        int kpool = 256; asm volatile("" : "+s"(kpool));
        pg8::Gemm g{Ob, (const bf16_t*)(F.ws() + WS_POOLW), 4 * T, 256, kpool}; pg8::PoolOrder S{F.G, F.vcu};
        pg8::EpiPool E{Yb, D};
        for (int rep = 0; rep < NREP(32); ++rep) pg8::gemm_phase<pg8::EpiPool, pg8::PoolOrder, PG8_ALIGN, PG8_SP2>(F.lds, g, S, E);
    } SEAM(3);
    moe_layer<0, 4>(F, bar, lo, hi, rep_mask);
    if (IN(9)) { PHM(9);
        int kop = D; asm volatile("" : "+s"(kop));
        pg8::Gemm g{Hb, (const bf16_t*)(F.ws() + WS_GQKV), T, 1536, kop}; pg8::StaticOrder S; S.init(T, 1536, F.G, (int)blockIdx.x);
        pg8::EpiScaled E{Gb, 1536, 1.f / W8_SCALE};
        pg8::gemm_phase<pg8::EpiScaled, pg8::StaticOrder, PG8_ALIGN, PG8_SP2, 1>(F.lds, g, S, E);
    } SEAM(9);
    if (IN(10)) { PHM(10); if constexpr ((REP_MASK & 128) != 0) p_gqa_prep<true>(F); p_gqa_prep<false>(F); } SEAM(10);
    if (IN(11)) { PHM(11); if constexpr ((REP_MASK & 1) != 0) { p_gqa_attn<ATT_PROBE + 1>(F); refresh(F); } p_gqa_attn<0>(F); } SEAM(11);
    if (IN(12)) { PHM(12);
        int kop = D; asm volatile("" : "+s"(kop));
        pg8::Gemm g{Ob, (const bf16_t*)(F.ws() + WS_GO), T, D, kop}; pg8::StaticOrder S; S.init(T, D, F.G, (int)blockIdx.x);
        pg8::EpiScaled E{Yb, D, 1.f / (W8_SCALE * OS_GQA)};
        for (int rep = 0; rep < NREP(32); ++rep) pg8::gemm_phase<pg8::EpiScaled, pg8::StaticOrder, PG8_ALIGN, PG8_SP2, 1>(F.lds, g, S, E);
    } SEAM(12);
    moe_layer<1, 13>(F, bar, lo, hi, rep_mask);
    if (IN(18)) { PHM(18);
        int kop = D; asm volatile("" : "+s"(kop));
        pg8::Gemm g{Hb, (const bf16_t*)(F.ws() + WS_CIN), T, 3072, kop}; pg8::StaticOrder S; S.init(T, 3072, F.G, (int)blockIdx.x);
        pg8::EpiScaled E{Gb, 3072, 1.f / W8_SCALE};
        pg8::gemm_phase<pg8::EpiScaled, pg8::StaticOrder, PG8_ALIGN, PG8_SP2, 1>(F.lds, g, S, E);
    } SEAM(18);
    if (IN(19)) { PHM(19); if constexpr ((REP_MASK & 128) != 0) p_conv_prep<true>(F); p_conv_prep<false>(F); } SEAM(19);
    if (IN(20)) { PHM(20);
        int kop = D; asm volatile("" : "+s"(kop));
        pg8::Gemm g{Ob, (const bf16_t*)(F.ws() + WS_COUT), T, D, kop}; pg8::StaticOrder S; S.init(T, D, F.G, (int)blockIdx.x);
        pg8::EpiScaled E{Yb, D, 1.f / (W8_SCALE * OS_CONV)};
        for (int rep = 0; rep < NREP(32); ++rep) pg8::gemm_phase<pg8::EpiScaled, pg8::StaticOrder, PG8_ALIGN, PG8_SP2, 1>(F.lds, g, S, E);
    } SEAM(20);
    moe_layer<2, 21>(F, bar, lo, hi, rep_mask);
    if (IN(26)) { PHM(26);
        int kop = D; asm volatile("" : "+s"(kop));
        pg8::Gemm g{Hb, (const bf16_t*)(F.ws() + WS_DQKV), T, 3072, kop}; pg8::StaticOrder S; S.init(T, 3072, F.G, (int)blockIdx.x);
        pg8::EpiScaled E{Gb, 3072, 1.f / W8_SCALE};
        pg8::gemm_phase<pg8::EpiScaled, pg8::StaticOrder, PG8_ALIGN, PG8_SP2, 1>(F.lds, g, S, E);
    } SEAM(26);
    if (IN(27)) { PHM(27); if constexpr ((REP_MASK & 128) != 0) p_diff_prep<true>(F); p_diff_prep<false>(F); } SEAM(27);
    if (IN(28)) { PHM(28); for (int rep = 0; rep < NREP(2); ++rep) p_diff_attn(F); } if (IN(28) && IN(30)) xcd_barrier(bar);
    if (IN(30)) { PHM(30);
        int kop = D; asm volatile("" : "+s"(kop));
        pg8::Gemm g{Ob, (const bf16_t*)(F.ws() + WS_DO), T, D, kop}; pg8::LatentOrder S; S.init(D, F.G, (int)blockIdx.x);
        pg8::EpiScaled E{Yb, D, 1.f / (W8_SCALE * OS_DIFF)};
        for (int rep = 0; rep < NREP(32); ++rep) pg8::gemm_phase<pg8::EpiScaled, pg8::LatentOrder, PG8_ALIGN, PG8_SP2, 1>(F.lds, g, S, E);
    } SEAM(30);
    moe_layer<3, 31>(F, bar, lo, hi, rep_mask);
    if (args.dump) {
        if (!MK_MULTI) xcd_barrier(bar);
        const bf16_t* X = (const bf16_t*)(F.ws() + WS_X);
        for (int row = F.gw; row < T; row += F.NGW) { const int b = row >= SB ? 1 : 0, w = row - b * SB; if (w < NCTX) continue;
            f32x4 v[4]; ld_row_bf16(X + (size_t)row * D, F.lane, v); st_row_f32(F.out() + ((size_t)(b * SEQ + (w - NCTX))) * D, F.lane, v); }
    }
}
struct MoeDeal { int base, stride, limit, nun; };
__device__ __forceinline__ MoeDeal moe_deal(const Frame& F, int U) {
    MoeDeal d;
    if (F.G % 8 == 0) { const int per = F.G / 8, x = F.vcu / per, cl = F.vcu - x * per; d.base = (int)(((long)U * x) / 8) + cl; d.stride = per; d.limit = (int)(((long)U * (x + 1)) / 8); }
    else { d.base = F.vcu; d.stride = F.G; d.limit = U; }
    d.nun = (d.base < d.limit) ? (d.limit - d.base + d.stride - 1) / d.stride : 0;
    return d;
}
template <int L, int P0> __device__ __forceinline__ void moe_layer(Frame& F, const XcdBarrier& bar, int lo, int hi, int rep_mask) {
    if (IN(P0)) { PHM(P0); if constexpr ((REP_MASK & 512) != 0) { p_moe_a<L>(F, true); refresh(F); } p_moe_a<L>(F, false); } if (IN(P0) && IN(P0 + 2)) xcd_barrier(bar);
    if (IN(P0 + 2)) { PHM(P0 + 2);
        const int ntiles = moe_setup<L>(F); const MoeDeal dl = moe_deal(F, ntiles * 8);
        int kop = D; asm volatile("" : "+s"(kop));
        { LAS unsigned short* tk = (LAS unsigned short*)(F.lds + LC_TOK16); const LAS int* cnt = (const LAS int*)(F.lds + LC_CNT); const LAS int* tbase = (const LAS int*)(F.lds + LC_TBASE); const LAS int* tile_e = (const LAS int*)(F.lds + LC_TILEE);
          const int* list = (const int*)(F.ws() + WS_LIST); int nun = dl.nun; if (nun > MAXU) nun = MAXU;
          for (int idx = F.tid; idx < nun * 256; idx += NWAVES * 64) { const int i = idx >> 8, r = idx & 255, pm = (dl.base + i * dl.stride) >> 3, ee = tile_e[pm], pos = (pm - tbase[ee]) * 256 + r;
              tk[idx] = (unsigned short)((pos < cnt[ee]) ? (list[(size_t)ee * T + pos] >> 2) : 0); }
          __syncthreads(); }
        pg8::Gemm g{(const bf16_t*)(F.ws() + WS_H), (const bf16_t*)(F.ws() + WS_W1T + (size_t)L * NE * 2048 * D), T, 2048, kop};
        pg8::MoeOrder S{(const LAS int*)(F.lds + LC_TILEE), dl.limit, 8, dl.stride, dl.base};
        pg8::EpiSwiGLU E{F.ws() + WS_ACT, (const bf16_t*)(F.ws() + WS_B1H) + (size_t)L * NE * 2048, 1.f / W8_SCALE};
        if constexpr ((REP_MASK & 4) != 0) { pg8::EpiSwiGLUT<(G1_PROBE & 3)> E2{F.ws() + WS_HS, (const bf16_t*)(F.ws() + WS_B1H) + (size_t)L * NE * 2048, 1.f / W8_SCALE};
            pg8::gemm_phase<pg8::EpiSwiGLUT<(G1_PROBE & 3)>, pg8::MoeOrder, PG8_ALIGN, PG8_SP2, 1, true, (G1_PROBE >> 2)>(F.lds, g, S, E2, (const LAS unsigned short*)(F.lds + LC_TOK16)); }
        pg8::gemm_phase<pg8::EpiSwiGLU, pg8::MoeOrder, PG8_ALIGN, PG8_SP2, 1, true>(F.lds, g, S, E, (const LAS unsigned short*)(F.lds + LC_TOK16));
    } SEAM(P0 + 2);
    if (IN(P0 + 3)) { PHM(P0 + 3);
        const int ntiles = moe_setup<L>(F); const MoeDeal dl = moe_deal(F, ntiles * 4);
        int kop = D; asm volatile("" : "+s"(kop));
        pg8::Gemm g{(const bf16_t*)(F.ws() + WS_ACT), (const bf16_t*)(F.ws() + WS_W2T + (size_t)L * NE * D * D), CROWS, D, kop};
        pg8::MoeOrder S{(const LAS int*)(F.lds + LC_TILEE), dl.limit, 4, dl.stride, dl.base};
        { LAS int* st = (LAS int*)(F.lds + LC_TOK16); const LAS int* cnt = (const LAS int*)(F.lds + LC_CNT); const LAS int* tbase = (const LAS int*)(F.lds + LC_TBASE); const LAS int* tile_e = (const LAS int*)(F.lds + LC_TILEE);
          const int* list = (const int*)(F.ws() + WS_LIST); int nun = dl.nun; if (nun > MAXU / 2) nun = MAXU / 2;
          for (int idx = F.tid; idx < nun * 256; idx += NWAVES * 64) { const int i = idx >> 8, r = idx & 255, pm = (dl.base + i * dl.stride) >> 2, ee = tile_e[pm], pos = (pm - tbase[ee]) * 256 + r;
              st[idx] = (pos < cnt[ee]) ? list[(size_t)ee * T + pos] : -1; }
          __syncthreads(); }
        pg8::EpiScatter E{F.ws() + WS_SLOT, (const LAS int*)(F.lds + LC_TOK16), dl.stride, dl.base, (const bf16_t*)(F.ws() + WS_B2H) + (size_t)L * NE * D, 1.f / W8_SCALE, 0};
        pg8::gemm_phase<pg8::EpiScatter, pg8::MoeOrder, PG8_ALIGN, PG8_SP2, 1>(F.lds, g, S, E);
        if constexpr ((REP_MASK & 8) != 0) { pg8::EpiScatter E2{F.ws() + WS_HS, (const LAS int*)(F.lds + LC_TOK16), dl.stride, dl.base, (const bf16_t*)(F.ws() + WS_B2H) + (size_t)L * NE * D, 1.f / W8_SCALE, (REP_MASK & 8192) ? 2 : ((REP_MASK & 4096) ? 1 : 0)};
            pg8::gemm_phase<pg8::EpiScatter, pg8::MoeOrder, PG8_ALIGN, PG8_SP2, 1>(F.lds, g, S, E2); }
    } SEAM(P0 + 3);
    if (IN(P0 + 4)) { PHM(P0 + 4); if constexpr ((REP_MASK & 1024) != 0) p_moe_b<L, true>(F); p_moe_b<L, false>(F); } SEAM(P0 + 4);
}
#undef IN
#undef SEAM

extern "C" void kernel_launch(void* const* d_in, const int* in_sizes, int n_in, void* d_out, int out_size, void* d_ws, size_t ws_size, hipStream_t stream) {
    static int grid = 0;
    if (grid == 0) {
        if (n_in != N_IN || in_sizes[0] != NB * SEQ * D || out_size != NB * SEQ * D || ws_size < WS_END) {
            fprintf(stderr, "kernel_launch: shape mismatch (n_in %d, in0 %d, out %d, ws %zu, need %zu); nothing launched\n", n_in, n_in > 0 ? in_sizes[0] : -1, out_size, ws_size, (size_t)WS_END); grid = -1; return; }
        { const long long exp_sz[N_IN] = {(long long)NB * SEQ * D, NB * D, NB * NCTX * D, D, 4LL * D * 6 * D, 4 * 6 * D, 4 * 4 * D, 4 * 256 * 256, D, D * 1536, D * D, 128, 128, D * 3072, 3 * D, D * D, D * 3072, D * D, 4 * 64, 128,
                                             4 * D * NE, 4 * NE, 4LL * NE * D * 2048, 4 * NE * 2048, 4LL * NE * D * D, 4 * NE * D};
          for (int i = 0; i < N_IN; ++i) if ((long long)in_sizes[i] != exp_sz[i]) { fprintf(stderr, "kernel_launch: input %d has %d elements, expected %lld; nothing launched\n", i, in_sizes[i], exp_sz[i]); grid = -1; return; } }
        int dev = 0, cus = 0, per_cu = 0;
        if (hipGetDevice(&dev) != hipSuccess || hipDeviceGetAttribute(&cus, hipDeviceAttributeMultiprocessorCount, dev) != hipSuccess) { fprintf(stderr, "kernel_launch: device query failed\n"); grid = -1; return; }
        if (hipFuncSetAttribute((const void*)mk_fwd, hipFuncAttributeMaxDynamicSharedMemorySize, LDS_BYTES) != hipSuccess) { fprintf(stderr, "kernel_launch: hipFuncSetAttribute failed\n"); grid = -1; return; }
        if (hipOccupancyMaxActiveBlocksPerMultiprocessor(&per_cu, (const void*)mk_fwd, NWAVES * 64, LDS_BYTES) != hipSuccess || per_cu < 1)
            fprintf(stderr, "kernel_launch: note: occupancy query reports %d workgroups per CU\n", per_cu);
        (void)hipGetLastError();
        grid = cus;
    }
    if (grid < 0) return;
    if (hipMemsetAsync((char*)d_ws + WS_CTL, 0, CTL_ZERO_BYTES, stream) != hipSuccess) { fprintf(stderr, "kernel_launch: memset failed\n"); return; }
    Args a{};
    for (int i = 0; i < N_IN; ++i) a.in[i] = (const float*)d_in[i];
    a.out = (float*)d_out; a.ws = (unsigned char*)d_ws; a.pad = REP_MASK;
    constexpr int STOP = MK_STOP;
#if MK_MULTI
    for (int p = 0; p < STOP; ++p) { a.ph_lo = p; a.ph_hi = p + 1; a.dump = 0; hipLaunchKernelGGL(mk_fwd, dim3(grid), dim3(NWAVES * 64), LDS_BYTES, stream, a); }
    if (STOP < N_PHASES) { a.ph_lo = 0; a.ph_hi = 0; a.dump = 1; hipLaunchKernelGGL(mk_fwd, dim3(grid), dim3(NWAVES * 64), LDS_BYTES, stream, a); }
#else
    a.ph_lo = 0; a.ph_hi = STOP; a.dump = (STOP < N_PHASES) ? 1 : 0;
    hipLaunchKernelGGL(mk_fwd, dim3(grid), dim3(NWAVES * 64), LDS_BYTES, stream, a);
#endif
    const hipError_t le = hipPeekAtLastError();
    if (le != hipSuccess) fprintf(stderr, "kernel_launch: launch failed: %s\n", hipGetErrorName(le));
}
```

```cpp
#include <hip/hip_runtime.h>
#include <cstdio>
#include <cstdint>

#define GAS __attribute__((address_space(1)))
#define LAS __attribute__((address_space(3)))

constexpr int D = 1024, NB = 2, SEQ = 16384, NCTX = 256, SB = SEQ + NCTX  , T = NB * SB  ;
constexpr int NE = 32, TOPK = 4, DFF = 1024;
constexpr int MAXTILES = T * TOPK / 256 + NE;
constexpr int CROWS = MAXTILES * 256;
constexpr float RMS_EPS = 1e-6f;
constexpr float LAM_INIT = 0.55605818f;
constexpr float LOG2_THETA = 13.287712379549449f;
constexpr float INV_2PI = 0.15915494309189535f;
constexpr float OS_GQA = 32.f, OS_DIFF = 16.f, OS_CONV = 4.f;

enum { I_X = 0, I_C, I_CTX, I_CCTX, I_MODW, I_MODB, I_NORMG, I_POOLW, I_POOLS, I_GQKV, I_GO, I_GQG, I_GKG, I_CIN, I_CDW, I_COUT, I_DQKV, I_DO, I_DLAM, I_DSUB,
       I_RW, I_RB, I_W1, I_B1, I_W2, I_B2, N_IN };

constexpr size_t MiB = 1u << 20;
constexpr size_t WS_CTL = 0, CTL_ZERO_BYTES = 1 * MiB;
constexpr size_t WS_MOD = 1 * MiB;
constexpr size_t WS_POOLW = 2 * MiB;
constexpr size_t WS_GQKV = 3 * MiB;
constexpr size_t WS_GO = 6 * MiB;
constexpr size_t WS_CIN = 8 * MiB;
constexpr size_t WS_COUT = 14 * MiB;
constexpr size_t WS_DQKV = 16 * MiB;
constexpr size_t WS_DO = 22 * MiB;
constexpr size_t WS_GATE = 24 * MiB;
constexpr size_t WS_B1H = 25 * MiB;
constexpr size_t WS_B2H = WS_B1H + 512 * 1024;
constexpr size_t WS_LIST = 26 * MiB;
constexpr size_t WS_W1T = 32 * MiB;
constexpr size_t WS_W2T = WS_W1T + 512 * MiB;
constexpr size_t WS_X = WS_W2T + 256 * MiB;
constexpr size_t WS_H = WS_X + 130 * MiB;
constexpr size_t WS_G = WS_H + 65 * MiB;
constexpr size_t WS_O = WS_G + 195 * MiB;
constexpr size_t WS_OA = WS_O + 65 * MiB;
constexpr size_t WS_OB = WS_OA + 65 * MiB;
constexpr size_t WS_Y = WS_OB + 65 * MiB;
constexpr size_t WS_HS = WS_Y + 65 * MiB;
constexpr size_t WS_ACT = WS_HS + 276 * MiB;
constexpr size_t WS_SLOT = WS_ACT + 276 * MiB;
constexpr size_t WS_Q8 = WS_SLOT + 260 * MiB;
constexpr size_t WS_K8 = WS_Q8 + 33 * MiB;
constexpr size_t WS_VT8 = WS_K8 + 33 * MiB;
constexpr size_t WS_END = WS_VT8 + 33 * MiB;
static_assert(((size_t)T * 4 + 256) * 1024 <= 260 * MiB, "slot junk rows");
static_assert((size_t)T * 1024 <= 33 * MiB && (size_t)NB * 8 * 128 * SB <= 33 * MiB, "ws map fp8");
static_assert((size_t)T * D * 4 <= 130 * MiB && (size_t)T * D * 2 <= 65 * MiB && (size_t)T * 3072 * 2 <= 195 * MiB && (size_t)CROWS * D * 2 <= 276 * MiB && (size_t)T * 4 * D * 2 <= 260 * MiB, "ws map");
static_assert((size_t)NE * T * 4 <= 6 * MiB && (size_t)CROWS * 4 <= 1 * MiB && (size_t)T * 4 * 4 <= 1 * MiB && 4 * 3 * 6144 * 4 <= 1 * MiB, "ws map small");
constexpr int CW_CNT = 64;
constexpr int CW_BAR = 4096;

constexpr int RING_BYTES = 131072;
constexpr int LC_MISC = RING_BYTES;
constexpr int LC_CNT = LC_MISC + 64;
constexpr int LC_TBASE = LC_CNT + 128;
constexpr int LC_LCNT = LC_TBASE + 192;
constexpr int LC_GBASE = LC_LCNT + 128;
constexpr int LC_TILEE = LC_GBASE + 128;
constexpr int LC_TOK16 = LC_TILEE + MAXTILES * 4;
constexpr int MAXU = 26;
constexpr int LDS_BYTES = 147456;
static_assert(LC_TOK16 % 16 == 0 && LC_TOK16 + MAXU * 512 <= LDS_BYTES, "LDS map");

typedef unsigned short bf16_t;
typedef float f32x4 __attribute__((ext_vector_type(4)));
typedef float f32x2 __attribute__((ext_vector_type(2)));
typedef unsigned u32x2 __attribute__((ext_vector_type(2)));
typedef unsigned u32x4 __attribute__((ext_vector_type(4)));

__device__ __forceinline__ unsigned pkbf(float lo, float hi) { unsigned r; asm("v_cvt_pk_bf16_f32 %0, %1, %2" : "=v"(r) : "v"(lo), "v"(hi)); return r; }
__device__ __forceinline__ float bflo(unsigned w) { return __uint_as_float(w << 16); }
__device__ __forceinline__ float bfhi(unsigned w) { return __uint_as_float(w & 0xffff0000u); }
__device__ __forceinline__ float wave_sum(float v) {
#pragma unroll
    for (int o = 1; o < 64; o <<= 1) v += __shfl_xor(v, o);
    return v;
}
#define LDS_WAIT() asm volatile("s_waitcnt lgkmcnt(0)" ::: "memory")
#define VM_WAIT() asm volatile("s_waitcnt vmcnt(0)" ::: "memory")

namespace pg8 {
#define PG8_LAS __attribute__((address_space(3)))
typedef unsigned short bf16_t;
typedef short bf16x8 __attribute__((ext_vector_type(8)));
typedef float f32x4 __attribute__((ext_vector_type(4)));
typedef unsigned u32x4 __attribute__((ext_vector_type(4)));
typedef int i32x4 __attribute__((ext_vector_type(4)));
typedef int i32x8 __attribute__((ext_vector_type(8)));
typedef unsigned u32x2 __attribute__((ext_vector_type(2)));
constexpr int BM = 256, BK = 64, HALF = 128, HTB = HALF * BK * 2  , STAGE_BYTES = 8 * HTB, NXCD = 8, WGM = 8;

__host__ __device__ __forceinline__ int lds_byte(int r, int c) { const int st = (r >> 4) * 2 + (c >> 5), rr = r & 15, cc = c & 31, ob = rr * 64 + cc * 2; return st * 1024 + (ob ^ (((ob >> 9) & 1) << 5)); }
__host__ __device__ __forceinline__ void stage_rc(int b, int& R, int& C) { const int st = b / 1024, sb = b % 1024, swz = sb ^ (((sb >> 9) & 1) << 5); R = (st >> 1) * 16 + swz / 64; C = (st & 1) * 32 + (swz % 64) / 2; }
__host__ __device__ __forceinline__ int perm32(int rho) { const int n = rho >> 4, i = rho & 15; return 8 * (i >> 2) + 4 * n + (i & 3); }

struct Unit { int pm, pn; };
struct Gemm { const bf16_t* A; const bf16_t* Bt; int M, N, K; };

struct StaticOrder {
    int nM, nN, nwg, G, c;
    __host__ __device__ void init(int M, int N, int G_, int c_) { nM = M / BM; nN = N / BM; nwg = nM * nN; G = G_; c = c_; }
    __host__ __device__ bool next(int i, Unit& u) const {
        const long L = (long)i * G + c; if (L >= nwg) return false;
        int wgid = (int)L; { const int q = nwg / NXCD, r = nwg % NXCD, xcd = wgid % NXCD, off = wgid / NXCD; wgid = (xcd < r ? xcd * (q + 1) : r * (q + 1) + (xcd - r) * q) + off; }
        const int nig = WGM * nN, gid = wgid / nig, fm = gid * WGM, gsz = (nM - fm) < WGM ? (nM - fm) : WGM;
        u.pm = fm + ((wgid % nig) % gsz); u.pn = (wgid % nig) / gsz; return true;
    }
    __device__ __forceinline__ void a_ready(const Unit&) const {}
    __device__ __forceinline__ void done(const Unit&) const {}
};


struct PoolOrder {
    int G, c;
    __device__ __forceinline__ bool next(int i, Unit& u) const { const int L = i * G + c; if (L >= 4 * 130) return false; const int g = L & 3, pm = L >> 2; u.pm = g * 130 + pm; u.pn = g; return true; }
    __device__ __forceinline__ void a_ready(const Unit&) const {}
    __device__ __forceinline__ void done(const Unit&) const {}
};
struct LatentOrder {
    StaticOrder S;
    __device__ void init(int N, int G_, int c_) { S.init(NB * SEQ, N, G_, c_); }
    __device__ bool next(int i, Unit& u) const { if (!S.next(i, u)) return false; u.pm += (u.pm >= SEQ / 256) ? 2 : 1; return true; }
    __device__ __forceinline__ void a_ready(const Unit&) const {}
    __device__ __forceinline__ void done(const Unit&) const {}
};
struct MoeOrder {
    const PG8_LAS int* tile_e; int lim, nN, G, c;
    __device__ __forceinline__ bool next(int i, Unit& u) const { const int L = i * G + c; if (L >= lim) return false; const int pm = L / nN, pl = L - pm * nN; u.pm = pm; u.pn = tile_e[pm] * nN + pl; return true; }
    __device__ __forceinline__ void a_ready(const Unit&) const {}
    __device__ __forceinline__ void done(const Unit&) const {}
};

__device__ __forceinline__ unsigned cvt_pk_bf16(float lo, float hi) { unsigned r; asm volatile("v_cvt_pk_bf16_f32 %0, %1, %2" : "=v"(r) : "v"(lo), "v"(hi)); return r; }

template <bool POOL> struct EpiPlainT {
    static constexpr bool PERM = true, AFTER_DRAIN = false, HAS_PRE = false; struct Pre {}; static constexpr int NST = 16;
    bf16_t* O; int ldc;
    __device__ __forceinline__ void operator()(const f32x4 (&acc)[2][2][4][2], const Unit& u, int wr, int wc, int fr, int fq) const {
        const int rt = POOL ? (u.pm - 130 * u.pn) : u.pm;
        const int row0 = rt * BM + wr * 64 + fr, col0 = u.pn * BM + wc * 32 + 8 * fq;
#pragma unroll
        for (int ai = 0; ai < 2; ++ai)
#pragma unroll
            for (int m = 0; m < 4; ++m) { bf16_t* rowp = O + (size_t)(row0 + ai * HALF + m * 16) * ldc + col0;
#pragma unroll
                for (int bj = 0; bj < 2; ++bj) { const f32x4 v0 = acc[ai][bj][m][0], v1 = acc[ai][bj][m][1];
                    u32x4 w; w.x = cvt_pk_bf16(v0[0], v0[1]); w.y = cvt_pk_bf16(v0[2], v0[3]); w.z = cvt_pk_bf16(v1[0], v1[1]); w.w = cvt_pk_bf16(v1[2], v1[3]);
                    *(u32x4*)(rowp + bj * HALF) = w; } }
    }
};
struct EpiScaled {
    static constexpr bool PERM = true, AFTER_DRAIN = false, HAS_PRE = false; struct Pre {}; static constexpr int NST = 16;
    bf16_t* O; int ldc; float asc;
    __device__ __forceinline__ void operator()(const f32x4 (&acc)[2][2][4][2], const Unit& u, int wr, int wc, int fr, int fq) const {
        const int row0 = u.pm * BM + wr * 64 + fr, col0 = u.pn * BM + wc * 32 + 8 * fq;
#pragma unroll
        for (int ai = 0; ai < 2; ++ai)
#pragma unroll
            for (int m = 0; m < 4; ++m) { bf16_t* rowp = O + (size_t)(row0 + ai * HALF + m * 16) * ldc + col0;
#pragma unroll
                for (int bj = 0; bj < 2; ++bj) { const f32x4 v0 = acc[ai][bj][m][0] * asc, v1 = acc[ai][bj][m][1] * asc;
                    u32x4 w; w.x = cvt_pk_bf16(v0[0], v0[1]); w.y = cvt_pk_bf16(v0[2], v0[3]); w.z = cvt_pk_bf16(v1[0], v1[1]); w.w = cvt_pk_bf16(v1[2], v1[3]);
                    *(u32x4*)(rowp + bj * HALF) = w; } }
    }
};
typedef EpiPlainT<false> EpiPlain;
typedef EpiPlainT<true> EpiPool;
template <int CHEAP> struct EpiSwiGLUT {
    static constexpr bool PERM = true, AFTER_DRAIN = false; static constexpr int NST = (CHEAP == 2) ? 0 : 4;
    unsigned char* ACT; const bf16_t* b1h; float asc;
    static constexpr bool HAS_PRE = true; struct Pre { u32x4 bg, bu; };
    __device__ __forceinline__ void pre(const Unit& u, int wc, int fq, Pre& p) const {
        const int e = u.pn >> 3, pl = u.pn & 7, oc0 = pl * 128 + wc * 32 + 8 * fq;
        const bf16_t* a = b1h + e * 2048 + oc0;
        asm volatile("global_load_dwordx4 %0, %1, off" : "=v"(p.bg) : "v"(a) : "memory");
        asm volatile("global_load_dwordx4 %0, %1, off offset:2048" : "=v"(p.bu) : "v"(a) : "memory");
    }
    __device__ __forceinline__ void operator()(const f32x4 (&acc)[2][2][4][2], const Unit& u, int wr, int wc, int fr, int fq, const Pre& p) const {
        if constexpr (CHEAP == 2) return;
        const int pl = u.pn & 7;
        const int row0 = u.pm * BM + wr * 64 + fr, oc0 = pl * 128 + wc * 32 + 8 * fq;
        f32x4 bg[2], bu[2];
#pragma unroll
        for (int n = 0; n < 2; ++n) { bg[n] = (f32x4){__uint_as_float(p.bg[2 * n] << 16), __uint_as_float(p.bg[2 * n] & 0xffff0000u), __uint_as_float(p.bg[2 * n + 1] << 16), __uint_as_float(p.bg[2 * n + 1] & 0xffff0000u)};
            bu[n] = (f32x4){__uint_as_float(p.bu[2 * n] << 16), __uint_as_float(p.bu[2 * n] & 0xffff0000u), __uint_as_float(p.bu[2 * n + 1] << 16), __uint_as_float(p.bu[2 * n + 1] & 0xffff0000u)} + 1.0f; }
#pragma unroll
        for (int ai = 0; ai < 2; ++ai)
#pragma unroll
            for (int mp = 0; mp < 2; ++mp) {
                unsigned w[2][2];
#pragma unroll
                for (int mm = 0; mm < 2; ++mm) { const int m = 2 * mp + mm; float o[8];
#pragma unroll
                    for (int n = 0; n < 2; ++n) { const f32x4 gv = acc[ai][0][m][n] * asc + bg[n], uv = acc[ai][1][m][n] * asc + bu[n];
#pragma unroll
                        for (int j = 0; j < 4; ++j) { const float g = fminf(gv[j], 7.0f), uu = fminf(fmaxf(uv[j], -6.0f), 8.0f);
                            const float sg = (CHEAP != 0) ? 0.5f : __builtin_amdgcn_rcpf(1.0f + __builtin_amdgcn_exp2f(g * (-1.702f * 1.4426950408889634f)));
                            o[4 * n + j] = g * sg * uu; } }
                    int w0 = 0, w1 = 0; w0 = __builtin_amdgcn_cvt_pk_fp8_f32(o[0], o[1], w0, false); w0 = __builtin_amdgcn_cvt_pk_fp8_f32(o[2], o[3], w0, true);
                    w1 = __builtin_amdgcn_cvt_pk_fp8_f32(o[4], o[5], w1, false); w1 = __builtin_amdgcn_cvt_pk_fp8_f32(o[6], o[7], w1, true);
                    w[mm][0] = (unsigned)w0; w[mm][1] = (unsigned)w1; }
                const auto lo = __builtin_amdgcn_permlane16_swap(w[0][0], w[1][0], false, false), hi2 = __builtin_amdgcn_permlane16_swap(w[0][1], w[1][1], false, false);
                const int m = 2 * mp + (fq & 1);
                *(u32x4*)(ACT + (size_t)(row0 + ai * HALF + m * 16) * 1024 + (oc0 & ~15)) = (u32x4){lo[0], hi2[0], lo[1], hi2[1]}; }
    }
};
typedef EpiSwiGLUT<0> EpiSwiGLU;
struct EpiScatter {
    static constexpr bool PERM = true, AFTER_DRAIN = false;
    static constexpr int NST = 8;
    unsigned char* SLOT; const PG8_LAS int* slot_tab; int G, c; const bf16_t* b2h; float asc; int seq; int junk0;
    static constexpr bool HAS_PRE = true; struct Pre { u32x4 bv[2]; };
    __device__ __forceinline__ void pre(const Unit& u, int wc, int fq, Pre& p) const {
        const int e = u.pn >> 2, pl = u.pn & 3, col0 = pl * BM + wc * 32 + 8 * fq;
        const bf16_t* a = b2h + e * 1024 + col0;
        asm volatile("global_load_dwordx4 %0, %1, off" : "=v"(p.bv[0]) : "v"(a) : "memory");
        asm volatile("global_load_dwordx4 %0, %1, off offset:256" : "=v"(p.bv[1]) : "v"(a) : "memory");
    }
    __device__ __forceinline__ void operator()(const f32x4 (&acc)[2][2][4][2], const Unit& u, int wr, int wc, int fr, int fq, const Pre& p) const {
        const int pl = u.pn & 3, ui = (u.pm * 4 + pl - c) / G;
        const int col0 = pl * BM + wc * 32 + 8 * fq;
        f32x4 bv[2][2];
#pragma unroll
        for (int bj = 0; bj < 2; ++bj)
#pragma unroll
            for (int n = 0; n < 2; ++n) bv[bj][n] = (f32x4){__uint_as_float(p.bv[bj][2 * n] << 16), __uint_as_float(p.bv[bj][2 * n] & 0xffff0000u), __uint_as_float(p.bv[bj][2 * n + 1] << 16), __uint_as_float(p.bv[bj][2 * n + 1] & 0xffff0000u)};
#pragma unroll
        for (int ai = 0; ai < 2; ++ai)
#pragma unroll
            for (int mp = 0; mp < 2; ++mp) {
                const int m = 2 * mp + (fq & 1), rit = wr * 64 + fr + ai * HALF + m * 16;
                int slot = seq ? (u.pm * BM + rit) : slot_tab[ui * BM + rit];
                if (slot < 0) slot = junk0 + rit;
#pragma unroll
                for (int bj = 0; bj < 2; ++bj) { unsigned w[2][2];
#pragma unroll
                    for (int mm = 0; mm < 2; ++mm) { const f32x4 v0 = acc[ai][bj][2 * mp + mm][0] * asc + bv[bj][0], v1 = acc[ai][bj][2 * mp + mm][1] * asc + bv[bj][1];
                        int w0 = 0, w1 = 0; w0 = __builtin_amdgcn_cvt_pk_fp8_f32(v0[0], v0[1], w0, false); w0 = __builtin_amdgcn_cvt_pk_fp8_f32(v0[2], v0[3], w0, true);
                        w1 = __builtin_amdgcn_cvt_pk_fp8_f32(v1[0], v1[1], w1, false); w1 = __builtin_amdgcn_cvt_pk_fp8_f32(v1[2], v1[3], w1, true);
                        w[mm][0] = (unsigned)w0; w[mm][1] = (unsigned)w1; }
                    const auto lo = __builtin_amdgcn_permlane16_swap(w[0][0], w[1][0], false, false), hi2 = __builtin_amdgcn_permlane16_swap(w[0][1], w[1][1], false, false);
                    *(u32x4*)(SLOT + (size_t)slot * 1024 + (col0 & ~15) + bj * HALF) = (u32x4){lo[0], hi2[0], lo[1], hi2[1]}; }
            }
    }
};

template <class Epi, class Sched, bool ALIGN_EPI = false, bool SP2 = false, int ES = 2, bool GATHER = false, int PRB = 0>
__device__ __forceinline__ void gemm_phase(PG8_LAS unsigned char* lds, const Gemm g, const Sched& S, const Epi& E, const PG8_LAS unsigned short* tok16 = nullptr) {
    static_assert(SP2 || !GATHER, "GATHER is implemented for the SP2 loop");
    int tid_ = threadIdx.x; asm volatile("" : "+v"(tid_));
    const int tid = tid_, wid = __builtin_amdgcn_readfirstlane(tid >> 6), lane = tid & 63, wr = wid >> 2, wc = wid & 3, fr = lane & 15, fq = lane >> 4;
    const int K = g.K, nt = K * ES / (BK * 2);
    unsigned voffA[2], voffB[2]; int rowA[2]; unsigned colA[2];
#pragma unroll
    for (int i = 0; i < 2; ++i) { int R, C; stage_rc(tid * 16 + i * 8192, R, C); const int Rb = Epi::PERM ? ((R & ~31) + perm32(R & 31)) : R;
        voffA[i] = (unsigned)(R * K * ES + C * 2); voffB[i] = (unsigned)(Rb * K * ES + C * 2); rowA[i] = R; colA[i] = (unsigned)(C * 2); }
    const size_t kstep = (size_t)(BK * 2);
    const size_t hstep = (size_t)HALF * K * ES;
    const size_t hstepA = GATHER ? 0 : hstep;
    const size_t tstep = 2 * hstep;
    const unsigned ldsw = (unsigned)wid * 1024u;
    const int aoff = lds_byte(wr * 64 + fr, fq * 8), boff = lds_byte(wc * 32 + fr, fq * 8);
#define PG8_SA(b, h) (((b) * 2 + (h)) * HTB)
#define PG8_SB(b, h) ((4 + (b) * 2 + (h)) * HTB)
#define PG8_STAGE(bufoff, gbase, voff) do { _Pragma("unroll") for (int _i = 0; _i < 2; ++_i) \
        __builtin_amdgcn_global_load_lds((const unsigned*)((const char*)(gbase) + (voff)[_i]), (PG8_LAS unsigned*)(lds + (bufoff) + ldsw + _i * 8192), 16, 0, 0); } while (0)
#define PG8_GOFF(dst, ui_) do { _Pragma("unroll") for (int _h = 0; _h < 2; ++_h) _Pragma("unroll") for (int _i = 0; _i < 2; ++_i) dst[_h][_i] = (unsigned)tok16[(ui_) * 256 + _h * HALF + rowA[_i]] * (unsigned)(K * ES) + colA[_i]; } while (0)
#define PG8_STAGE_A(bufoff, gbase, h, usenext) do { if constexpr (GATHER) { _Pragma("unroll") for (int _i = 0; _i < 2; ++_i) { const unsigned vo_ = (usenext) ? goffN[h][_i] : goffC[h][_i]; \
        __builtin_amdgcn_global_load_lds((const unsigned*)((const char*)(gbase) + vo_), (PG8_LAS unsigned*)(lds + (bufoff) + ldsw + _i * 8192), 16, 0, 0); } } else PG8_STAGE(bufoff, gbase, voffA); } while (0)
#define PG8_LDA(dst, b, h) do { _Pragma("unroll") for (int m = 0; m < 4; ++m) _Pragma("unroll") for (int k = 0; k < 2; ++k) dst[m][k] = *(const PG8_LAS bf16x8*)(lds + PG8_SA(b, h) + aoff + m * 2048 + k * 1024); } while (0)
#define PG8_LDB(dst, b, h) do { _Pragma("unroll") for (int n = 0; n < 2; ++n) _Pragma("unroll") for (int k = 0; k < 2; ++k) dst[n][k] = *(const PG8_LAS bf16x8*)(lds + PG8_SB(b, h) + boff + n * 2048 + k * 1024); } while (0)
#define PG8_CAT8(lo, hi) __builtin_shufflevector(__builtin_bit_cast(i32x4, lo), __builtin_bit_cast(i32x4, hi), 0, 1, 2, 3, 4, 5, 6, 7)
#define PG8_MFMA8(accv, bv, av) asm volatile("v_mfma_scale_f32_16x16x128_f8f6f4 %0, %1, %2, %0, %3, %3 op_sel_hi:[0,0,0]" : "+v"(accv) : "v"(bv), "v"(av), "v"(sc1))
#define PG8_MMA(ai, bj, At, Bt) do { if constexpr (PRB == 1) break; __builtin_amdgcn_s_setprio(1); if constexpr (ES == 2) { _Pragma("unroll") for (int m = 0; m < 4; ++m) _Pragma("unroll") for (int n = 0; n < 2; ++n) _Pragma("unroll") for (int k = 0; k < 2; ++k) \
        acc[ai][bj][m][n] = __builtin_amdgcn_mfma_f32_16x16x32_bf16(Bt[n][k], At[m][k], acc[ai][bj][m][n], 0, 0, 0); } else { _Pragma("unroll") for (int m = 0; m < 4; ++m) _Pragma("unroll") for (int n = 0; n < 2; ++n) { \
        const i32x8 b8_ = PG8_CAT8(Bt[n][0], Bt[n][1]), a8_ = PG8_CAT8(At[m][0], At[m][1]); PG8_MFMA8(acc[ai][bj][m][n], b8_, a8_); } } __builtin_amdgcn_s_setprio(0); } while (0)
#define PG8_WAIT_V(n) asm volatile("s_waitcnt vmcnt(" #n ")" ::: "memory")
#define PG8_WAIT_L(n) asm volatile("s_waitcnt lgkmcnt(" #n ")" ::: "memory")
#define PG8_BAR __builtin_amdgcn_s_barrier()
#define PG8_SCHED __builtin_amdgcn_sched_barrier(0)
    Unit cur, nxt; int ui = 0; typename Epi::Pre epre;
    if (!S.next(0, cur)) return;
    int sc1 = 0x7f7f7f7f; asm volatile("" : "+v"(sc1));
    f32x4 acc[2][2][4][2];
#pragma unroll
    for (int a = 0; a < 2; ++a)
#pragma unroll
        for (int b = 0; b < 2; ++b)
#pragma unroll
            for (int m = 0; m < 4; ++m)
#pragma unroll
                for (int n = 0; n < 2; ++n) acc[a][b][m][n] = (f32x4){0.f, 0.f, 0.f, 0.f};
    bf16x8 At[4][2], B0[2][2], B1[2][2];
    const char* cA = (const char*)g.A + (GATHER ? (size_t)0 : (size_t)cur.pm * tstep); const char* cB = (const char*)g.Bt + (size_t)cur.pn * tstep;
    unsigned goffC[2][2] = {{0u, 0u}, {0u, 0u}}, goffN[2][2] = {{0u, 0u}, {0u, 0u}};
    if constexpr (GATHER) PG8_GOFF(goffC, 0);
    S.a_ready(cur);
    if constexpr (SP2) {
        PG8_STAGE(PG8_SB(0, 0), cB, voffB); PG8_STAGE(PG8_SB(0, 1), cB + hstep, voffB); PG8_STAGE_A(PG8_SA(0, 0), cA, 0, false); PG8_STAGE_A(PG8_SA(0, 1), cA + hstepA, 1, false);
        if (wr == 1) PG8_BAR;
        PG8_WAIT_V(2); PG8_BAR;
        PG8_STAGE(PG8_SB(1, 0), cB + kstep, voffB); PG8_STAGE_A(PG8_SA(1, 0), cA + kstep, 0, false); PG8_STAGE(PG8_SB(1, 1), cB + hstep + kstep, voffB);
        PG8_WAIT_V(6); PG8_BAR;
    } else {
        PG8_STAGE(PG8_SB(0, 0), cB, voffB); PG8_STAGE(PG8_SA(0, 0), cA, voffA); PG8_STAGE(PG8_SB(0, 1), cB + hstep, voffB); PG8_STAGE(PG8_SA(0, 1), cA + hstep, voffA);
        if (wr == 1) PG8_BAR;
        PG8_WAIT_V(4); PG8_BAR;
        PG8_STAGE(PG8_SB(1, 0), cB + kstep, voffB); PG8_STAGE(PG8_SA(1, 0), cA + kstep, voffA); PG8_STAGE(PG8_SB(1, 1), cB + hstep + kstep, voffB);
        PG8_WAIT_V(6); PG8_BAR;
    }
    bool seam = false;
#define PG8_WAIT_VX(rx_) asm volatile("v_cmp_ne_u32_e32 vcc, 0, %0\n\ts_cbranch_vccz 1f\n\ts_waitcnt vmcnt(%1)\n\ts_branch 2f\n1:\n\ts_waitcnt vmcnt(8)\n2:" :: "v"(rx_), "n"(8 + Epi::NST) : "memory", "vcc")
    for (;;) {
        const bool has_next = S.next(ui + 1, nxt);
        const char* nA = (has_next && !GATHER) ? (const char*)g.A + (size_t)nxt.pm * tstep : cA;
        const char* nB = has_next ? (const char*)g.Bt + (size_t)nxt.pn * tstep : cB;
        for (int t = 0; t < nt; t += 2) {
            const bool last = (t == nt - 2);
            const int rx = (SP2 && seam && t == 0) ? 1 : 0;
            const char* a1 = cA + (size_t)(t + 1) * kstep;
            const char* a2 = last ? nA : cA + (size_t)(t + 2) * kstep; const char* b2 = last ? nB : cB + (size_t)(t + 2) * kstep;
            const char* a3 = a2 + kstep; const char* b3 = b2 + kstep;
            if (last && has_next) S.a_ready(nxt);
            if constexpr (Epi::HAS_PRE) { if (last) E.pre(cur, wc, fq, epre); }
            if constexpr (GATHER) { if (last) { if (has_next) PG8_GOFF(goffN, ui + 1); else { _Pragma("unroll") for (int _h = 0; _h < 2; ++_h) _Pragma("unroll") for (int _i = 0; _i < 2; ++_i) goffN[_h][_i] = goffC[_h][_i]; } } }
            if constexpr (SP2) {
            PG8_LDB(B0, 0, 0); PG8_LDB(B1, 0, 1); PG8_SCHED; PG8_LDA(At, 0, 0); PG8_STAGE_A(PG8_SA(1, 1), a1 + hstepA, 1, false);
            PG8_WAIT_VX(rx); PG8_WAIT_L(0); PG8_BAR; PG8_MMA(0, 0, At, B0); PG8_MMA(0, 1, At, B1); PG8_BAR; PG8_SCHED;
            PG8_LDA(At, 0, 1); PG8_STAGE(PG8_SB(0, 0), b2, voffB); PG8_STAGE(PG8_SB(0, 1), b2 + hstep, voffB); PG8_STAGE_A(PG8_SA(0, 0), a2, 0, last);
            PG8_WAIT_VX(rx); PG8_WAIT_L(0); PG8_BAR; PG8_MMA(1, 0, At, B0); PG8_MMA(1, 1, At, B1); PG8_BAR; PG8_SCHED;
            PG8_LDB(B0, 1, 0); PG8_LDB(B1, 1, 1); PG8_SCHED; PG8_LDA(At, 1, 0); PG8_STAGE_A(PG8_SA(0, 1), a2 + hstepA, 1, last);
            PG8_WAIT_V(8); PG8_WAIT_L(0); PG8_BAR; PG8_MMA(0, 0, At, B0); PG8_MMA(0, 1, At, B1); PG8_BAR; PG8_SCHED;
            PG8_LDA(At, 1, 1); PG8_STAGE(PG8_SB(1, 0), b3, voffB); PG8_STAGE(PG8_SB(1, 1), b3 + hstep, voffB); PG8_STAGE_A(PG8_SA(1, 0), a3, 0, last);
            PG8_WAIT_V(8); PG8_WAIT_L(0); PG8_BAR; PG8_MMA(1, 0, At, B0); PG8_MMA(1, 1, At, B1); PG8_BAR; PG8_SCHED;
            } else {
            PG8_LDB(B0, 0, 0); PG8_SCHED; PG8_LDA(At, 0, 0); PG8_STAGE(PG8_SA(1, 1), a1 + hstep, voffA);
            PG8_WAIT_L(8); PG8_BAR; PG8_WAIT_L(0); PG8_MMA(0, 0, At, B0); PG8_BAR; PG8_SCHED;
            PG8_LDB(B1, 0, 1); PG8_STAGE(PG8_SB(0, 0), b2, voffB);
            PG8_BAR; PG8_WAIT_L(0); PG8_MMA(0, 1, At, B1); PG8_BAR;
            PG8_LDA(At, 0, 1); PG8_STAGE(PG8_SA(0, 0), a2, voffA);
            PG8_BAR; PG8_WAIT_L(0); PG8_MMA(1, 0, At, B0); PG8_BAR; PG8_SCHED;
            PG8_STAGE(PG8_SB(0, 1), b2 + hstep, voffB);
            PG8_WAIT_V(6); PG8_BAR; PG8_MMA(1, 1, At, B1); PG8_BAR;
            PG8_LDB(B0, 1, 0); PG8_SCHED; PG8_LDA(At, 1, 0); PG8_STAGE(PG8_SA(0, 1), a2 + hstep, voffA);
            PG8_WAIT_L(8); PG8_BAR; PG8_WAIT_L(0); PG8_MMA(0, 0, At, B0); PG8_BAR; PG8_SCHED;
            PG8_LDB(B1, 1, 1); PG8_STAGE(PG8_SB(1, 0), b3, voffB);
            PG8_BAR; PG8_WAIT_L(0); PG8_MMA(0, 1, At, B1); PG8_BAR;
            PG8_LDA(At, 1, 1); PG8_STAGE(PG8_SA(1, 0), a3, voffA);
            PG8_BAR; PG8_WAIT_L(0); PG8_MMA(1, 0, At, B0); PG8_BAR; PG8_SCHED;
            PG8_STAGE(PG8_SB(1, 1), b3 + hstep, voffB);
            PG8_WAIT_V(6); PG8_BAR; PG8_MMA(1, 1, At, B1); PG8_BAR;
            }
        }
        if constexpr (ES == 1) { PG8_SCHED; asm volatile("s_nop 15\n\ts_nop 15" ::: "memory"); PG8_SCHED; }
        if constexpr (ALIGN_EPI) { if (wr == 0) PG8_BAR; }
        if constexpr (!Epi::AFTER_DRAIN) { if constexpr (Epi::HAS_PRE) E(acc, cur, wr, wc, fr, fq, epre); else E(acc, cur, wr, wc, fr, fq); S.done(cur); }
        if (!has_next) break;
#pragma unroll
        for (int a = 0; a < 2; ++a)
#pragma unroll
            for (int b = 0; b < 2; ++b)
#pragma unroll
                for (int m = 0; m < 4; ++m)
#pragma unroll
                    for (int n = 0; n < 2; ++n) acc[a][b][m][n] = (f32x4){0.f, 0.f, 0.f, 0.f};
        cur = nxt; cA = nA; cB = nB; ++ui; seam = SP2;
        if constexpr (GATHER) { _Pragma("unroll") for (int _h = 0; _h < 2; ++_h) _Pragma("unroll") for (int _i = 0; _i < 2; ++_i) goffC[_h][_i] = goffN[_h][_i]; }
        if constexpr (ALIGN_EPI) { if (wr == 1) PG8_BAR; }
    }
    PG8_WAIT_V(0);
    if constexpr (!ALIGN_EPI) { if (wr == 0) PG8_BAR; }
    PG8_BAR;
    if constexpr (Epi::AFTER_DRAIN) { E.fused(acc, cur, wr, wc, fr, fq, lds, wid, lane); S.done(cur); }
#undef PG8_SA
#undef PG8_SB
#undef PG8_STAGE
#undef PG8_STAGE_A
#undef PG8_GOFF
#undef PG8_LDA
#undef PG8_LDB
#undef PG8_MMA
#undef PG8_CAT8
#undef PG8_MFMA8
#undef PG8_WAIT_V
#undef PG8_WAIT_VX
#undef PG8_WAIT_L
#undef PG8_BAR
#undef PG8_SCHED
}
}

namespace att {
using f32x16 = __attribute__((ext_vector_type(16))) float;
__device__ __forceinline__ int crow(int r, int hi) { return (r & 3) + 8 * (r >> 2) + 4 * hi; }
__device__ __forceinline__ unsigned cvtpk(float lo, float hi) { unsigned r; asm volatile("v_cvt_pk_bf16_f32 %0, %1, %2" : "=v"(r) : "v"(lo), "v"(hi)); return r; }
}

namespace att8 {
using att::f32x16; using att::crow;
typedef int i32x4 __attribute__((ext_vector_type(4)));
typedef int i32x8 __attribute__((ext_vector_type(8)));
constexpr int NW = 8, QBLK = 32, KVBLK = 64;
#define SBAR() __builtin_amdgcn_sched_barrier(0)
template <int OFF> __device__ __forceinline__ i32x4 rd128(int a) { i32x4 r; asm volatile("ds_read_b128 %0, %1 offset:%2" : "=&v"(r) : "v"(a), "i"(OFF) : "memory"); return r; }
__device__ __forceinline__ i32x8 cat8(i32x4 lo, i32x4 hi) { return __builtin_shufflevector(lo, hi, 0, 1, 2, 3, 4, 5, 6, 7); }
__device__ __forceinline__ float mx3(float a, float b, float c) { float r; asm("v_max3_f32 %0, %1, %2, %3" : "=v"(r) : "v"(a), "v"(b), "v"(c)); return r; }
constexpr float CSC = 1.f / 65536.f;
template <bool FIRST>
__device__ __forceinline__ void softmax8(f32x16& p0, f32x16& p1, float& M_run, float& alpha, i32x8& pf) {
  constexpr float CTHR = (56.f + 8.f * (5.f * 1.4426950408889634f)) * CSC;
  float a0 = mx3(p0[0], p0[1], p0[2]), a1 = mx3(p0[8], p0[9], p0[10]), a2 = mx3(p1[0], p1[1], p1[2]), a3 = mx3(p1[8], p1[9], p1[10]);
  a0 = mx3(a0, p0[3], p0[4]); a1 = mx3(a1, p0[11], p0[12]); a2 = mx3(a2, p1[3], p1[4]); a3 = mx3(a3, p1[11], p1[12]);
  a0 = mx3(a0, p0[5], p0[6]); a1 = mx3(a1, p0[13], p0[14]); a2 = mx3(a2, p1[5], p1[6]); a3 = mx3(a3, p1[13], p1[14]);
  a0 = mx3(a0, p0[7], a1); a2 = mx3(a2, p1[7], a3);
  float cmax = mx3(a0, p0[15], a2); cmax = mx3(cmax, p1[15], cmax);
  { auto rr = __builtin_amdgcn_permlane32_swap(__float_as_uint(cmax), __float_as_uint(cmax), false, false); cmax = mx3(__uint_as_float(rr[0]), __uint_as_float(rr[1]), __uint_as_float(rr[1])); }
  alpha = 1.f;
  if (FIRST || !__builtin_expect(__all(cmax <= CTHR), 1)) {
    const float tmax = (cmax * 65536.f - 56.f) * 0.125f, d = FIRST ? tmax : fmaxf(tmax, 0.f), d8 = 8.f * d * CSC;
    alpha = __builtin_amdgcn_exp2f(-d); M_run += d;
#pragma unroll
    for (int r = 0; r < 16; ++r) { p0[r] -= d8; p1[r] -= d8; }
  }
  typedef unsigned short us2 __attribute__((ext_vector_type(2)));
#pragma unroll
  for (int w = 0; w < 4; ++w) { const unsigned A = __builtin_bit_cast(unsigned, __builtin_amdgcn_cvt_pknorm_u16(p0[4 * w], p0[4 * w + 1])), B = __builtin_bit_cast(unsigned, __builtin_amdgcn_cvt_pknorm_u16(p0[4 * w + 2], p0[4 * w + 3]));
    pf[w] = (int)__builtin_amdgcn_perm(B, A, 0x06040200u); }
#pragma unroll
  for (int w = 0; w < 4; ++w) { const unsigned A = __builtin_bit_cast(unsigned, __builtin_amdgcn_cvt_pknorm_u16(p1[4 * w], p1[4 * w + 1])), B = __builtin_bit_cast(unsigned, __builtin_amdgcn_cvt_pknorm_u16(p1[4 * w + 2], p1[4 * w + 3]));
    pf[4 + w] = (int)__builtin_amdgcn_perm(B, A, 0x06040200u); }
}

template <int DQK, int LDQ, int LDK, int LDO, bool DIFF, int PROBE = 0>
__device__ __forceinline__ void attn_body8(const unsigned char* __restrict__ Qb, const unsigned char* __restrict__ Kh, const unsigned char* __restrict__ VT, unsigned char* __restrict__ Ob, int seq, char* lds,
                                           int dmode, float lam, const float* __restrict__ subg) {
  constexpr int SHM_V = 128 * 64, SHM_K = 64 * DQK, SLOT = SHM_V + SHM_K, NS = DQK / 64;
  int tid_ = threadIdx.x; asm volatile("" : "+v"(tid_));
  const int tid = tid_, wid = __builtin_amdgcn_readfirstlane(tid >> 6), lane = tid & 63, r32 = lane & 31, hi = lane >> 5, half = wid >> 2;
  constexpr int RD = 4;
  float* ws = (float*)(lds + RD * SLOT) + wid * 64; float* al_l = ws + 32;
  int sc1 = 0x7f7f7f7f; asm volatile("" : "+v"(sc1));
  int scq = 0x6f6f6f6f; asm volatile("" : "+v"(scq));
  float M_run = 0.f; asm volatile("" : "+v"(M_run));
  f32x16 o[4] = {};
  typedef float f32x4_ __attribute__((ext_vector_type(4)));
  f32x4_ osum = {0.f, 0.f, 0.f, 0.f};
  i32x8 sel8;
  { const int onv = (((lane & 15) == 0 && ((lane >> 4) & 1) == 0) || ((lane & 15) == 1 && ((lane >> 4) & 1) == 1)) ? 0x38383838 : 0;
#pragma unroll
    for (int i = 0; i < 8; ++i) { int t_; asm volatile("v_mov_b32 %0, %1" : "=v"(t_) : "v"(onv)); sel8[i] = t_; } }
#define MFMA16S(acc4, a8, b8) asm volatile("v_mfma_scale_f32_16x16x128_f8f6f4 %0, %1, %2, %0, %3, %3 op_sel_hi:[0,0,0]" : "+v"(acc4) : "v"(a8), "v"(b8), "v"(sc1))
  i32x8 qf[NS];
  { const unsigned char* Qw = Qb + (long)(wid * QBLK + r32) * LDQ + hi * 32;
#pragma unroll
    for (int s = 0; s < NS; ++s) qf[s] = cat8(*reinterpret_cast<const i32x4*>(Qw + s * 64), *reinterpret_cast<const i32x4*>(Qw + s * 64 + 16)); }
  const int vrow = 16 * wid + (lane >> 2), vpc = lane & 3;
  const int krow = 8 * wid + ((DQK == 128) ? (lane >> 3) : ((lane >> 2) & 7)), kpc = (DQK == 128) ? (lane & 7) : (lane & 3);
  const unsigned char* vsrc = VT + (long)vrow * SB + ((vpc ^ ((vrow >> 2) & 3)) << 4);
  const unsigned char* ksrc = Kh + (long)krow * LDK + ((DQK == 128) ? ((kpc ^ ((krow >> 1) & 7)) << 4) : ((kpc ^ ((krow >> 2) & 3)) << 4));
  const bool kact = (DQK == 128) || (lane < 32);
  const unsigned ldv = (unsigned)__builtin_amdgcn_readfirstlane((int)(uintptr_t)lds + wid * 1024), ldk = (unsigned)__builtin_amdgcn_readfirstlane((int)(uintptr_t)lds + SHM_V + wid * (DQK == 128 ? 1024 : 512));
#define GLDS16(gsrc, ldst) do { unsigned keep_; asm volatile("s_mov_b32 %0, m0\n\ts_mov_b32 m0, %2\n\ts_nop 0\n\tglobal_load_lds_dwordx4 %1, off\n\ts_mov_b32 m0, %0" : "=&s"(keep_) : "v"(gsrc), "s"(ldst) : "memory"); } while (0)
#define SDMA8(t_, sl_) do { GLDS16(vsrc + (t_) * KVBLK, ldv + (unsigned)((sl_) * SLOT)); if (kact) GLDS16(ksrc + (long)((t_) * KVBLK) * LDK, ldk + (unsigned)((sl_) * SLOT)); } while (0)
#define VMWAIT8(n) asm volatile("s_waitcnt vmcnt(" #n ")" ::: "memory")
#define BARL8() do { SBAR(); asm volatile("s_waitcnt lgkmcnt(0)\n\ts_barrier" ::: "memory"); SBAR(); } while (0)
#define LWAIT8(n) do { asm volatile("s_waitcnt lgkmcnt(" #n ")" ::: "memory"); SBAR(); } while (0)
#define RESC8(a) do { if (__any((a) < 1.f)) { if (hi == 0) al_l[r32] = (a); asm volatile("s_waitcnt lgkmcnt(0)" ::: "memory"); \
    _Pragma("unroll") for (int g = 0; g < 4; ++g) { const f32x4 a4_ = *(const f32x4*)(al_l + 8 * g + 4 * hi);      \
      _Pragma("unroll") for (int i = 0; i < 4; ++i) { _Pragma("unroll") for (int d = 0; d < 4; ++d) o[d][4 * g + i] *= a4_[i]; } SBAR(); } \
    { const f32x4 a4_ = *(const f32x4*)(al_l + (lane & 1) * 16 + 4 * (lane >> 4)); _Pragma("unroll") for (int i = 0; i < 4; ++i) osum[i] *= a4_[i]; }     \
    CIN_SET8(); } } while (0)
#define MFMA8(acc, a8, b8) asm volatile("v_mfma_scale_f32_32x32x64_f8f6f4 %0, %1, %2, %0, %3, %3 op_sel_hi:[0,0,0]" : "+v"(acc) : "v"(a8), "v"(b8), "v"(sc1))
#define MFMA8QC(acc, a8, b8, cin_) asm volatile("v_mfma_scale_f32_32x32x64_f8f6f4 %0, %1, %2, %3, %4, %5 op_sel_hi:[0,0,0]" : "=&v"(acc) : "v"(a8), "v"(b8), "v"(cin_), "v"(scq), "v"(sc1))
#define MFMA8Q(acc, a8, b8) asm volatile("v_mfma_scale_f32_32x32x64_f8f6f4 %0, %1, %2, %0, %3, %4 op_sel_hi:[0,0,0]" : "+v"(acc) : "v"(a8), "v"(b8), "v"(scq), "v"(sc1))
  const int lb = (int)(uintptr_t)lds;
  const int va0 = lb + r32 * 64 + (((2 * hi) ^ ((r32 >> 2) & 3)) << 4), va1 = lb + r32 * 64 + (((2 * hi + 1) ^ ((r32 >> 2) & 3)) << 4);
  const int kz = (DQK == 128) ? ((r32 >> 1) & 7) : ((r32 >> 2) & 3), krb = lb + SHM_V + r32 * DQK;
  const int ka00 = krb + (((2 * hi) ^ kz) << 4), ka01 = krb + (((2 * hi + 1) ^ kz) << 4), ka10 = krb + (((4 + 2 * hi) ^ kz) << 4), ka11 = krb + (((5 + 2 * hi) ^ kz) << 4);
#define KREAD8(so) do { k00 = rd128<0>(ka00 + (so)); k01 = rd128<0>(ka01 + (so)); k10 = rd128<32 * DQK>(ka00 + (so)); k11 = rd128<32 * DQK>(ka01 + (so)); \
    if constexpr (NS == 2) { k20 = rd128<0>(ka10 + (so)); k21 = rd128<0>(ka11 + (so)); k30 = rd128<32 * DQK>(ka10 + (so)); k31 = rd128<32 * DQK>(ka11 + (so)); } } while (0)
#define KREAD8C(SO) do { k00 = rd128<(SO)>(ka00); k01 = rd128<(SO)>(ka01); k10 = rd128<(SO) + 32 * DQK>(ka00); k11 = rd128<(SO) + 32 * DQK>(ka01); \
    if constexpr (NS == 2) { k20 = rd128<(SO)>(ka10); k21 = rd128<(SO)>(ka11); k30 = rd128<(SO) + 32 * DQK>(ka10); k31 = rd128<(SO) + 32 * DQK>(ka11); } } while (0)
#define VREAD8AC(SO) do { v00 = rd128<(SO)>(va0); v01 = rd128<(SO)>(va1); v10 = rd128<(SO) + 2048>(va0); v11 = rd128<(SO) + 2048>(va1); } while (0)
#define VREAD8BC(SO) do { if constexpr (NS == 2) { k00 = rd128<(SO) + 4096>(va0); k01 = rd128<(SO) + 4096>(va1); k10 = rd128<(SO) + 6144>(va0); k11 = rd128<(SO) + 6144>(va1); } \
    else { k20 = rd128<(SO) + 4096>(va0); k21 = rd128<(SO) + 4096>(va1); k30 = rd128<(SO) + 6144>(va0); k31 = rd128<(SO) + 6144>(va1); } } while (0)
#define VREAD8A(so) do { v00 = rd128<0>(va0 + (so)); v01 = rd128<0>(va1 + (so)); v10 = rd128<2048>(va0 + (so)); v11 = rd128<2048>(va1 + (so)); } while (0)
#define VREAD8B(so) do { if constexpr (NS == 2) { k00 = rd128<4096>(va0 + (so)); k01 = rd128<4096>(va1 + (so)); k10 = rd128<6144>(va0 + (so)); k11 = rd128<6144>(va1 + (so)); } \
    else { k20 = rd128<4096>(va0 + (so)); k21 = rd128<4096>(va1 + (so)); k30 = rd128<6144>(va0 + (so)); k31 = rd128<6144>(va1 + (so)); } } while (0)
#define QK8(NV) do { if constexpr (NS == 2) { LWAIT8_(NV + 6); MFMA8QC(p0, cat8(k00, k01), qf[0], cin); LWAIT8_(NV + 4); MFMA8QC(p1, cat8(k10, k11), qf[0], cin); LWAIT8_(NV + 2); MFMA8Q(p0, cat8(k20, k21), qf[NS - 1]); LWAIT8_(NV); MFMA8Q(p1, cat8(k30, k31), qf[NS - 1]); } \
    else { LWAIT8_(NV + 2); MFMA8QC(p0, cat8(k00, k01), qf[0], cin); LWAIT8_(NV); MFMA8QC(p1, cat8(k10, k11), qf[0], cin); } } while (0)
#define LWAIT8_(n) do { asm volatile("s_waitcnt lgkmcnt(%0)" :: "n"(n) : "memory"); SBAR(); } while (0)
#define PV8() do { MFMA16S(osum, pf, sel8); LWAIT8(6); MFMA8(o[0], pf, cat8(v00, v01)); LWAIT8(4); MFMA8(o[1], pf, cat8(v10, v11)); \
    if constexpr (NS == 2) { LWAIT8(2); MFMA8(o[2], pf, cat8(k00, k01)); LWAIT8(0); MFMA8(o[3], pf, cat8(k10, k11)); } else { LWAIT8(2); MFMA8(o[2], pf, cat8(k20, k21)); LWAIT8(0); MFMA8(o[3], pf, cat8(k30, k31)); } } while (0)
  f32x16 p0, p1; float al; i32x8 pf; const int NT = seq / KVBLK;
  f32x16 cin;
#define CIN_SET8() do { const float nm_ = (56.f - 8.f * M_run) * CSC; _Pragma("unroll") for (int r = 0; r < 16; ++r) cin[r] = nm_; asm volatile("" : "+v"(cin)); SBAR(); } while (0)
  i32x4 k00, k01, k10, k11, k20, k21, k30, k31, v00, v01, v10, v11;
#define ACC_INIT8() do { const float nm = (56.f - 8.f * M_run) * CSC; typedef float f2_ __attribute__((ext_vector_type(2))); f2_ n2 = {nm, nm}; asm volatile("" : "+v"(n2)); \
      f2_ q_[16]; _Pragma("unroll") for (int i = 0; i < 16; ++i) asm volatile("v_mov_b64 %0, %1" : "=v"(q_[i]) : "v"(n2)); \
      typedef float f4_ __attribute__((ext_vector_type(4))); typedef float f8_ __attribute__((ext_vector_type(8))); \
      { const f4_ a = __builtin_shufflevector(q_[0], q_[1], 0, 1, 2, 3), b = __builtin_shufflevector(q_[2], q_[3], 0, 1, 2, 3), c = __builtin_shufflevector(q_[4], q_[5], 0, 1, 2, 3), d = __builtin_shufflevector(q_[6], q_[7], 0, 1, 2, 3); \
        const f8_ ab = __builtin_shufflevector(a, b, 0, 1, 2, 3, 4, 5, 6, 7), cd = __builtin_shufflevector(c, d, 0, 1, 2, 3, 4, 5, 6, 7); p0 = __builtin_shufflevector(ab, cd, 0, 1, 2, 3, 4, 5, 6, 7, 8, 9, 10, 11, 12, 13, 14, 15); } \
      { const f4_ a = __builtin_shufflevector(q_[8], q_[9], 0, 1, 2, 3), b = __builtin_shufflevector(q_[10], q_[11], 0, 1, 2, 3), c = __builtin_shufflevector(q_[12], q_[13], 0, 1, 2, 3), d = __builtin_shufflevector(q_[14], q_[15], 0, 1, 2, 3); \
        const f8_ ab = __builtin_shufflevector(a, b, 0, 1, 2, 3, 4, 5, 6, 7), cd = __builtin_shufflevector(c, d, 0, 1, 2, 3, 4, 5, 6, 7); p1 = __builtin_shufflevector(ab, cd, 0, 1, 2, 3, 4, 5, 6, 7, 8, 9, 10, 11, 12, 13, 14, 15); } \
      asm volatile("" : "+v"(p0), "+v"(p1)); SBAR(); } while (0)
  SDMA8(0, 0); SDMA8(1, 1); SDMA8(2, 2); if (half) SDMA8(3, 3);
  VMWAIT8(0); BARL8();
  CIN_SET8();
  KREAD8(0); QK8(0);
  SBAR(); asm volatile("s_nop 15\n\ts_nop 15\n\ts_nop 15\n\ts_nop 15\n\ts_nop 15\n\ts_nop 15" ::: "memory"); SBAR();
  softmax8<true>(p0, p1, M_run, al, pf);
  CIN_SET8();
  if (half) BARL8();
  int sw = (3 + half) & 3;
#define MSEG8(KO, VO) do { \
    if constexpr (NS == 2) { \
      k00 = rd128<(KO)>(ka00); k01 = rd128<(KO)>(ka01); k10 = rd128<(KO) + 32 * DQK>(ka00); k11 = rd128<(KO) + 32 * DQK>(ka01); k20 = rd128<(KO)>(ka10); k21 = rd128<(KO)>(ka11); \
      LWAIT8(4); MFMA8QC(p0, cat8(k00, k01), qf[0], cin); k30 = rd128<(KO) + 32 * DQK>(ka10); k31 = rd128<(KO) + 32 * DQK>(ka11); \
      LWAIT8(4); MFMA8QC(p1, cat8(k10, k11), qf[0], cin); v00 = rd128<(VO)>(va0); v01 = rd128<(VO)>(va1); \
      LWAIT8(4); MFMA8Q(p0, cat8(k20, k21), qf[NS - 1]); v10 = rd128<(VO) + 2048>(va0); v11 = rd128<(VO) + 2048>(va1); \
      LWAIT8(4); MFMA8Q(p1, cat8(k30, k31), qf[NS - 1]); k00 = rd128<(VO) + 4096>(va0); k01 = rd128<(VO) + 4096>(va1); \
      MFMA16S(osum, pf, sel8); k10 = rd128<(VO) + 6144>(va0); k11 = rd128<(VO) + 6144>(va1); \
      LWAIT8(6); MFMA8(o[0], pf, cat8(v00, v01)); LWAIT8(4); MFMA8(o[1], pf, cat8(v10, v11)); LWAIT8(2); MFMA8(o[2], pf, cat8(k00, k01)); LWAIT8(0); MFMA8(o[3], pf, cat8(k10, k11)); \
    } else { \
      k00 = rd128<(KO)>(ka00); k01 = rd128<(KO)>(ka01); k10 = rd128<(KO) + 32 * DQK>(ka00); k11 = rd128<(KO) + 32 * DQK>(ka01); v00 = rd128<(VO)>(va0); v01 = rd128<(VO)>(va1); \
      LWAIT8(4); MFMA8QC(p0, cat8(k00, k01), qf[0], cin); v10 = rd128<(VO) + 2048>(va0); v11 = rd128<(VO) + 2048>(va1); \
      LWAIT8(4); MFMA8QC(p1, cat8(k10, k11), qf[0], cin); k20 = rd128<(VO) + 4096>(va0); k21 = rd128<(VO) + 4096>(va1); \
      MFMA16S(osum, pf, sel8); k30 = rd128<(VO) + 6144>(va0); k31 = rd128<(VO) + 6144>(va1); \
      LWAIT8(6); MFMA8(o[0], pf, cat8(v00, v01)); LWAIT8(4); MFMA8(o[1], pf, cat8(v10, v11)); LWAIT8(2); MFMA8(o[2], pf, cat8(k20, k21)); LWAIT8(0); MFMA8(o[3], pf, cat8(k30, k31)); } } while (0)
#define STEP8(KS, VS, jj) do { \
    MSEG8((KS) * SLOT, (VS) * SLOT); \
    BARL8(); \
    softmax8<false>(p0, p1, M_run, al, pf); RESC8(al); \
    { const int t = (jj) + 3 + half; if (t < NT) { SDMA8(t, sw); VMWAIT8(2); } else VMWAIT8(0); } \
    BARL8(); \
    sw = (sw + 1) & 3; } while (0)
  int j = 0;
  for (; j + 4 < NT; j += 4) { STEP8(1, 0, j); STEP8(2, 1, j + 1); STEP8(3, 2, j + 2); STEP8(0, 3, j + 3); }
  if (j + 1 < NT) { STEP8(1, 0, j); ++j; }
  if (j + 1 < NT) { STEP8(2, 1, j); ++j; }
  if (j + 1 < NT) { STEP8(3, 2, j); ++j; }
  const int sv = j & 3;
#undef STEP8
#undef MSEG8
#undef ACC_INIT8
#undef CIN_SET8
  VREAD8A(sv * SLOT); VREAD8B(sv * SLOT); PV8();
  SBAR(); asm volatile("s_nop 15\n\ts_nop 15\n\ts_nop 15\n\ts_nop 15\n\ts_nop 15\n\ts_nop 15" ::: "memory"); SBAR();
  if (!half) BARL8();
  float rli[16];
  { if ((lane & 15) < 2) *(f32x4*)(al_l + (lane & 15) * 16 + 4 * (lane >> 4)) = (f32x4){osum[0], osum[1], osum[2], osum[3]};
    asm volatile("s_waitcnt lgkmcnt(0)" ::: "memory");
#pragma unroll
    for (int g = 0; g < 4; ++g) { const f32x4 a4 = *(const f32x4*)(al_l + 8 * g + 4 * hi);
#pragma unroll
      for (int i = 0; i < 4; ++i) rli[4 * g + i] = __builtin_amdgcn_rcpf(a4[i]); } }
  unsigned char* Ow = Ob + (long)(wid * QBLK) * LDO;
  if constexpr (!DIFF) {
#pragma unroll
    for (int r = 0; r < 16; ++r) { int orow = crow(r, hi);
#pragma unroll
      for (int d0 = 0; d0 < 4; ++d0) { const float v_ = o[d0][r] * (rli[r] * OS_GQA); Ow[(long)orow * LDO + d0 * 32 + r32] = (unsigned char)__builtin_amdgcn_cvt_pk_fp8_f32(v_, v_, 0, false); } }
  } else {
    char* stash = lds + RD * SLOT + 2048 + wid * 8192 + lane * 16;
    if (dmode == 0) {
#pragma unroll
      for (int q = 0; q < 8; ++q) { const int d0 = q >> 1, r0 = (q & 1) * 8; i32x4 w;
#pragma unroll
        for (int i = 0; i < 4; ++i) w[i] = (int)att::cvtpk(o[d0][r0 + 2 * i] * rli[r0 + 2 * i], o[d0][r0 + 2 * i + 1] * rli[r0 + 2 * i + 1]);
        *(i32x4*)(stash + q * 1024) = w; }
    } else {
      float ss[16];
#pragma unroll
      for (int r = 0; r < 16; ++r) ss[r] = 0.f;
#pragma unroll
      for (int q = 0; q < 8; ++q) { const int d0 = q >> 1, r0 = (q & 1) * 8; const i32x4 w = *(const i32x4*)(stash + q * 1024);
#pragma unroll
        for (int i = 0; i < 4; ++i) { const int r = r0 + 2 * i;
          const float a = bflo((unsigned)w[i]) - lam * (o[d0][r] * rli[r]), b = bfhi((unsigned)w[i]) - lam * (o[d0][r + 1] * rli[r + 1]);
          o[d0][r] = a; o[d0][r + 1] = b; ss[r] += a * a; ss[r + 1] += b * b; } }
      float sg[4];
#pragma unroll
      for (int d0 = 0; d0 < 4; ++d0) sg[d0] = subg[d0 * 32 + r32] * ((1.f - LAM_INIT) * OS_DIFF);
#pragma unroll
      for (int r = 0; r < 16; ++r) { float s = ss[r];
#pragma unroll
        for (int x = 1; x < 32; x <<= 1) s += __shfl_xor(s, x);
        const float rs = rsqrtf(s * (1.f / 128.f) + RMS_EPS); const int orow = crow(r, hi);
#pragma unroll
        for (int d0 = 0; d0 < 4; ++d0) { const float v_ = o[d0][r] * rs * sg[d0]; Ow[(long)orow * LDO + d0 * 32 + r32] = (unsigned char)__builtin_amdgcn_cvt_pk_fp8_f32(v_, v_, 0, false); } }
    }
  }
  BARL8();
#undef GLDS16
#undef SDMA8
#undef VMWAIT8
#undef BARL8
#undef LWAIT8
#undef LWAIT8_
#undef RESC8
#undef MFMA8
#undef MFMA8Q
#undef MFMA16S
#undef KREAD8
#undef VREAD8A
#undef VREAD8B
#undef KREAD8C
#undef VREAD8AC
#undef VREAD8BC
#undef QK8
#undef PV8
}
#undef SBAR
}
#define XB_TMO      128
#define XB_XCNT(j)  (256  + 64 * (j))
#define XB_XSUB(j)  (1280 + 64 * (j))
#define XB_XGEN(j)  (2304 + 64 * (j))
#define XB_TOP      3328
#define XB_TOPGEN   3392
#define XCD_BAR_WORDS 3456
#define XB_SPIN_CAP (1u << 18)

__device__ __forceinline__ unsigned xb_ld(unsigned* p)              { return __hip_atomic_load(p, __ATOMIC_RELAXED, __HIP_MEMORY_SCOPE_AGENT); }
__device__ __forceinline__ unsigned xb_add(unsigned* p, unsigned v) { return __hip_atomic_fetch_add(p, v, __ATOMIC_RELAXED, __HIP_MEMORY_SCOPE_AGENT); }
__device__ __forceinline__ unsigned xb_xcc_id() { return (unsigned)__builtin_amdgcn_s_getreg((3 << 11) | 20) & 0xFu; }
#define XB_SPIN(cond, bar) do { unsigned _sp = 0; while (cond) { __builtin_amdgcn_s_sleep(1); \
    if ((++_sp & 255u) == 0u) { if (xb_ld(&(bar)[XB_TMO])) break; if (_sp > XB_SPIN_CAP) { atomicAdd(&(bar)[XB_TMO], 1u); break; } } } } while (0)

struct XcdBarrier {
    unsigned* bar; unsigned x;
    volatile LAS unsigned* st;
};

__device__ __forceinline__ XcdBarrier xcd_barrier_post(unsigned* bar, volatile LAS unsigned* st) {
    XcdBarrier b; b.bar = bar; b.x = xb_xcc_id(); b.st = st;
    if (threadIdx.x == 0) (void)xb_add(&bar[XB_XCNT(b.x)], 1u);
    return b;
}
__device__ __forceinline__ void xcd_barrier_complete(unsigned* bar, unsigned x, unsigned& nloc, unsigned& nx) {
    const unsigned G = gridDim.x * gridDim.y * gridDim.z;
    unsigned sum, cnt, mine, sp = 0u;
    for (;;) {
        sum = 0u; cnt = 0u; mine = 0u;
#pragma unroll
        for (unsigned j = 0; j < 16; ++j) { const unsigned c = xb_ld(&bar[XB_XCNT(j)]); sum += c; cnt += (c > 0u) ? 1u : 0u; mine = (j == x) ? c : mine; }
        if (sum == G) break;
        __builtin_amdgcn_s_sleep(1);
        if ((++sp & 255u) == 0u) { if (xb_ld(&bar[XB_TMO])) break; if (sp > XB_SPIN_CAP) { atomicAdd(&bar[XB_TMO], 1u); break; } }
    }
    nloc = mine > 0u ? mine : 1u; nx = cnt > 0u ? cnt : 1u;
}

__device__ __forceinline__ void xcd_barrier(const XcdBarrier& b) {
    asm volatile("s_waitcnt vmcnt(0)" ::: "memory");
    __syncthreads();
    if (threadIdx.x == 0) {
        unsigned* bar = b.bar;
        __builtin_amdgcn_s_waitcnt(0);
        unsigned nloc = b.st[0], nx = b.st[1];
        if (nloc == 0u) { xcd_barrier_complete(bar, b.x, nloc, nx); b.st[0] = nloc; b.st[1] = nx; }
        const unsigned old = xb_add(&bar[XB_XSUB(b.x)], 1u);
        const unsigned gen = old / nloc;
        if (old + 1u == (gen + 1u) * nloc) {
            __builtin_amdgcn_fence(__ATOMIC_RELEASE, "agent");
            asm volatile("s_waitcnt vmcnt(0)" ::: "memory");
            const unsigned og = xb_add(&bar[XB_TOP], 1u);
            const unsigned tg = og / nx;
            if (og + 1u == (tg + 1u) * nx) xb_add(&bar[XB_TOPGEN], 1u);
            else XB_SPIN(xb_ld(&bar[XB_TOPGEN]) == tg, bar);
            __builtin_amdgcn_fence(__ATOMIC_ACQUIRE, "agent");
            xb_add(&bar[XB_XGEN(b.x)], 1u);
            asm volatile("s_waitcnt vmcnt(0)" ::: "memory");
        } else {
            XB_SPIN(xb_ld(&bar[XB_XGEN(b.x)]) == gen, bar);
            __builtin_amdgcn_fence(__ATOMIC_ACQUIRE, "agent");
            asm volatile("s_waitcnt vmcnt(0)" ::: "memory");
        }
    }
    __syncthreads();
}

constexpr int NWAVES = 8;
constexpr int N_PHASES = 36;
#ifndef MK_STOP
#define MK_STOP N_PHASES
#endif
#ifndef ATT_SDEPTH
#define ATT_SDEPTH 1
#endif
#ifndef G1_PROBE
#define G1_PROBE 0
#endif
#ifndef ATT_PROBE
#define ATT_PROBE 0
#endif
#ifndef REP_MASK
#define REP_MASK 0
#endif
constexpr size_t WS_JUNK = WS_END - WS_GATE;
constexpr float W8_SCALE = 32.f;
constexpr float QSCALE128 = 8.f * 0.088388347648318440f * 1.4426950408889634f, QSCALE64 = 8.f * 0.125f * 1.4426950408889634f;
#ifndef SM_MASK
#define SM_MASK 127
#endif
#ifndef PRO_PARTS
#define PRO_PARTS 15
#endif
#ifndef MK_MULTI
#define MK_MULTI 0
#endif

struct Args { const float* in[N_IN]; float* out; unsigned char* ws; int ph_lo, ph_hi, dump, pad; };
static_assert(sizeof(Args) == N_IN * 8 + 8 + 8 + 16, "Args has no padding");
typedef const __attribute__((address_space(4))) Args* KArgs;
struct Frame {
    LAS unsigned char* lds;
    char* ldsg;
    int tid, lane, wave, vcu, G, gw, NGW;
    KArgs kp;
    __device__ __forceinline__ const float* in(int i) const { return kp->in[i]; }
    __device__ __forceinline__ float* out() const { return kp->out; }
    __device__ __forceinline__ unsigned char* ws() const { return kp->ws; }
    __device__ __forceinline__ unsigned* ctl() const { return (unsigned*)(kp->ws + WS_CTL); }
};
__device__ __forceinline__ bool refresh(Frame& F) { int t = threadIdx.x; asm volatile("" : "+v"(t)); F.tid = t; F.lane = t & 63; KArgs k = (KArgs)__builtin_amdgcn_kernarg_segment_ptr(); asm volatile("" : "+s"(k)); F.kp = k; return true; }
__device__ __forceinline__ const float* input_row(const Frame& F, int row) {
    const int b = row >= SB ? 1 : 0, w = row - b * SB;
    return (w < NCTX) ? F.in(I_CTX) + ((size_t)(b * NCTX + w)) * D : F.in(I_X) + ((size_t)(b * SEQ + (w - NCTX))) * D;
}
__device__ __forceinline__ int stream_of(int row) { const int b = row >= SB ? 1 : 0, w = row - b * SB; return (w < NCTX) ? 2 : b; }
__device__ __forceinline__ const float* modp(const Frame& F, int layer, int s, int chunk) { return (const float*)(F.ws() + WS_MOD) + ((size_t)(layer * 3 + s) * 6 + chunk) * D; }
__device__ __forceinline__ const float* normg(const Frame& F, int layer, int k) { return F.in(I_NORMG) + (size_t)(layer * 4 + k) * D; }

__device__ __forceinline__ void ld_row_f32(const float* p, int lane, f32x4 (&v)[4]) {
#pragma unroll
    for (int j = 0; j < 4; ++j) v[j] = *(const f32x4*)(p + 256 * j + 4 * lane);
}
__device__ __forceinline__ void st_row_f32(float* p, int lane, const f32x4 (&v)[4]) {
#pragma unroll
    for (int j = 0; j < 4; ++j) *(f32x4*)(p + 256 * j + 4 * lane) = v[j];
}
__device__ __forceinline__ void ld_row_bf16(const bf16_t* p, int lane, f32x4 (&v)[4]) {
#pragma unroll
    for (int j = 0; j < 4; ++j) { const u32x2 w = *(const u32x2*)(p + 256 * j + 4 * lane); v[j] = (f32x4){bflo(w.x), bfhi(w.x), bflo(w.y), bfhi(w.y)}; }
}
__device__ __forceinline__ void ld_row_fp8(const unsigned char* p, int lane, f32x4 (&v)[4]) {
#pragma unroll
    for (int j = 0; j < 4; ++j) { const int w = *(const int*)(p + 256 * j + 4 * lane);
        v[j] = (f32x4){__builtin_amdgcn_cvt_f32_fp8(w, 0), __builtin_amdgcn_cvt_f32_fp8(w, 1), __builtin_amdgcn_cvt_f32_fp8(w, 2), __builtin_amdgcn_cvt_f32_fp8(w, 3)}; }
}
__device__ __forceinline__ void st_row_bf16(bf16_t* p, int lane, const f32x4 (&v)[4]) {
#pragma unroll
    for (int j = 0; j < 4; ++j) { u32x2 w; w.x = pkbf(v[j].x, v[j].y); w.y = pkbf(v[j].z, v[j].w); *(u32x2*)(p + 256 * j + 4 * lane) = w; }
}
__device__ __forceinline__ float row_ss(const f32x4 (&v)[4]) {
    float s = 0.f;
#pragma unroll
    for (int j = 0; j < 4; ++j) s += (v[j].x * v[j].x + v[j].y * v[j].y) + (v[j].z * v[j].z + v[j].w * v[j].w);
    return wave_sum(s);
}
__device__ __forceinline__ void modnorm(const f32x4 (&v)[4], const float* g, const float* m1, const float* m0, int lane, f32x4 (&h)[4]) {
    const float r = rsqrtf(row_ss(v) * (1.f / D) + RMS_EPS);
#pragma unroll
    for (int j = 0; j < 4; ++j) { const f32x4 gv = *(const f32x4*)(g + 256 * j + 4 * lane), a = *(const f32x4*)(m1 + 256 * j + 4 * lane), b = *(const f32x4*)(m0 + 256 * j + 4 * lane);
        h[j] = (v[j] * r) * gv * (a + 1.f) + b; }
}

__device__ __forceinline__ void tr_item(const float* W, int K, int N, bf16_t* WT, int k0, int n0, int dst_row0, LAS float* scr, int lane, const float* colscale = nullptr) {
    float tmp[32]; const float csv = colscale ? colscale[lane & 31] : 1.f;
#pragma unroll
    for (int i = 0; i < 32; ++i) { const int kk = 2 * i + (lane >> 5); tmp[i] = W[(size_t)(k0 + kk) * N + n0 + (lane & 31)]; }
#pragma unroll
    for (int i = 0; i < 32; ++i) { const int kk = 2 * i + (lane >> 5); scr[kk * 33 + (lane & 31)] = tmp[i] * csv; }
    LDS_WAIT(); asm volatile("" ::: "memory");
    const int c = lane & 7;
#pragma unroll
    for (int j = 0; j < 4; ++j) { const int n = (lane >> 3) + 8 * j; const LAS float* s = scr + (8 * c) * 33 + n;
        u32x4 o; o.x = pkbf(s[0 * 33], s[1 * 33]); o.y = pkbf(s[2 * 33], s[3 * 33]); o.z = pkbf(s[4 * 33], s[5 * 33]); o.w = pkbf(s[6 * 33], s[7 * 33]);
        *(u32x4*)(WT + (size_t)(dst_row0 + n) * K + k0 + 8 * c) = o; }
    LDS_WAIT(); asm volatile("" ::: "memory");
}
__device__ __forceinline__ void tr_item8(const float* W, int K, int N, unsigned char* WT, int k0, int n0, int dst_row0, LAS float* scr, int lane, float wscale) {
    float tmp[32];
#pragma unroll
    for (int i = 0; i < 32; ++i) { const int kk = 2 * i + (lane >> 5); tmp[i] = W[(size_t)(k0 + kk) * N + n0 + (lane & 31)]; }
#pragma unroll
    for (int i = 0; i < 32; ++i) { const int kk = 2 * i + (lane >> 5); scr[kk * 33 + (lane & 31)] = tmp[i] * wscale; }
    LDS_WAIT(); asm volatile("" ::: "memory");
    const int c = lane & 7;
#pragma unroll
    for (int j = 0; j < 4; ++j) { const int n = (lane >> 3) + 8 * j; const LAS float* s = scr + (8 * c) * 33 + n;
        int w0 = 0, w1 = 0; w0 = __builtin_amdgcn_cvt_pk_fp8_f32(s[0 * 33], s[1 * 33], w0, false); w0 = __builtin_amdgcn_cvt_pk_fp8_f32(s[2 * 33], s[3 * 33], w0, true);
        w1 = __builtin_amdgcn_cvt_pk_fp8_f32(s[4 * 33], s[5 * 33], w1, false); w1 = __builtin_amdgcn_cvt_pk_fp8_f32(s[6 * 33], s[7 * 33], w1, true);
        *(u32x2*)(WT + (size_t)(dst_row0 + n) * K + k0 + 8 * c) = (u32x2){(unsigned)w0, (unsigned)w1}; }
    LDS_WAIT(); asm volatile("" ::: "memory");
}
__device__ __forceinline__ void tr_plain(const float* W, int K, int N, bf16_t* WT, int row_off, LAS float* scr, int item, int lane, const float* colscale = nullptr) {
    const int nblk = N / 32, kb = item / nblk, nb = item - kb * nblk;
    tr_item(W, K, N, WT, 64 * kb, 32 * nb, row_off + 32 * nb, scr, lane, colscale ? colscale + 32 * nb : nullptr);
}
__device__ __forceinline__ void tr_plain8(const float* W, int K, int N, unsigned char* WT, LAS float* scr, int item, int lane) {
    const int nblk = N / 32, kb = item / nblk, nb = item - kb * nblk;
    tr_item8(W, K, N, WT, 64 * kb, 32 * nb, 32 * nb, scr, lane, W8_SCALE);
}
__device__ __forceinline__ void p0_prologue(Frame& F) {
    {
        LAS float* sv = (LAS float*)(F.lds);
        LAS float* red = (LAS float*)(F.lds + 16384);
        if ((PRO_PARTS & 1) && F.vcu < 192) {
            for (int i = F.tid; i < 3 * D; i += 512) { const int s = i >> 10, k = i & 1023; const float c = (s < 2) ? F.in(I_C)[s * D + k] : F.in(I_CCTX)[k]; sv[i] = c / (1.f + __expf(-c)); }
            __syncthreads();
            for (int task = F.vcu; task < 192; task += F.G) {
                const int layer = task / 48, n0 = (task % 48) * 128;
                const int tx = F.tid & 31, ty = F.tid >> 5;
                const float* wp = F.in(I_MODW) + ((size_t)layer * D + ty * 64) * 6144 + n0 + 4 * tx;
                f32x4 a0 = {0, 0, 0, 0}, a1 = a0, a2 = a0;
#pragma unroll 8
                for (int k = 0; k < 64; ++k) { const f32x4 w = *(const f32x4*)(wp + (size_t)k * 6144); const int kk = ty * 64 + k;
                    a0 += w * sv[kk]; a1 += w * sv[D + kk]; a2 += w * sv[2 * D + kk]; }
                *(LAS f32x4*)(red + (ty * 3 + 0) * 128 + 4 * tx) = a0; *(LAS f32x4*)(red + (ty * 3 + 1) * 128 + 4 * tx) = a1; *(LAS f32x4*)(red + (ty * 3 + 2) * 128 + 4 * tx) = a2;
                __syncthreads();
                if (F.tid < 384) { const int s = F.tid >> 7, n = F.tid & 127; float acc = F.in(I_MODB)[layer * 6144 + n0 + n];
#pragma unroll
                    for (int y = 0; y < 16; ++y) acc += red[(y * 3 + s) * 128 + n];
                    ((float*)(F.ws() + WS_MOD))[((size_t)(layer * 3 + s)) * 6144 + n0 + n] = acc; }
                __syncthreads();
            }
        }
        __syncthreads();
    }
    { bf16_t* b1h = (bf16_t*)(F.ws() + WS_B1H); bf16_t* b2h = (bf16_t*)(F.ws() + WS_B2H); const float* b1 = F.in(I_B1); const float* b2 = F.in(I_B2);
      const int gt = F.vcu * (NWAVES * 64) + F.tid, ngt = F.G * NWAVES * 64;
      for (int i = gt; i < 4 * NE * 2048 / 2; i += ngt) ((unsigned*)b1h)[i] = pkbf(b1[2 * i], b1[2 * i + 1]);
      for (int i = gt; i < 4 * NE * 1024 / 2; i += ngt) ((unsigned*)b2h)[i] = pkbf(b2[2 * i], b2[2 * i + 1]); }
    LAS float* scr = (LAS float*)(F.lds + F.wave * 16384);
    if (PRO_PARTS & 2) {
        constexpr int I_POOL = 4 * (256 / 64) * (256 / 32);
        constexpr int I_GQ = 16 * 48, I_SQ = 16 * 32, I_W3 = 16 * 96;
        constexpr int NSMALL = I_POOL + I_GQ + I_SQ + I_W3 + I_SQ + I_W3 + I_SQ;
        for (int it = F.gw; it < NSMALL; it += F.NGW) {
            int r = it;
            if (r < I_POOL) { if (!(SM_MASK & 1)) continue; const int g = r >> 5; tr_plain(F.in(I_POOLW) + (size_t)g * 65536, 256, 256, (bf16_t*)(F.ws() + WS_POOLW), g * 256, scr, r & 31, F.lane, F.in(I_POOLS) + g * 256); continue; } r -= I_POOL;
            if (r < I_GQ) { if (!(SM_MASK & 2)) continue; tr_plain8(F.in(I_GQKV), D, 1536, F.ws() + WS_GQKV, scr, r, F.lane); continue; } r -= I_GQ;
            if (r < I_SQ) { if (!(SM_MASK & 4)) continue; tr_plain8(F.in(I_GO), D, D, F.ws() + WS_GO, scr, r, F.lane); continue; } r -= I_SQ;
            if (r < I_W3) { if (!(SM_MASK & 8)) continue; tr_plain8(F.in(I_CIN), D, 3072, F.ws() + WS_CIN, scr, r, F.lane); continue; } r -= I_W3;
            if (r < I_SQ) { if (!(SM_MASK & 16)) continue; tr_plain8(F.in(I_COUT), D, D, F.ws() + WS_COUT, scr, r, F.lane); continue; } r -= I_SQ;
            if (r < I_W3) { if (!(SM_MASK & 32)) continue; tr_plain8(F.in(I_DQKV), D, 3072, F.ws() + WS_DQKV, scr, r, F.lane); continue; } r -= I_W3;
            if (!(SM_MASK & 64)) continue; tr_plain8(F.in(I_DO), D, D, F.ws() + WS_DO, scr, r, F.lane);
        }
    }
    if (PRO_PARTS & 12) {
        constexpr int NI1 = 128 * 1024, NIT = NI1 + 128 * 512;
        float cur[32], nxt[32];
#define XW_DECODE(it_) const bool w1_ = (it_) < NI1; const int r2_ = w1_ ? (it_) : (it_) - NI1; const int mat_ = w1_ ? (r2_ >> 10) : (r2_ >> 9), rr_ = w1_ ? (r2_ & 1023) : (r2_ & 511), kb_ = w1_ ? (rr_ >> 7) : (rr_ >> 6), n0_ = 16 * (w1_ ? (rr_ & 127) : (rr_ & 63)), N_ = w1_ ? 2048 : 1024; \
        const float* W_ = w1_ ? F.in(I_W1) + (size_t)mat_ * D * 2048 : F.in(I_W2) + (size_t)mat_ * D * D;
#define XW_LOAD(it_, buf) do { XW_DECODE(it_) _Pragma("unroll") for (int i = 0; i < 32; ++i) { const int kk = 4 * i + (F.lane >> 4); buf[i] = W_[(size_t)(128 * kb_ + kk) * N_ + n0_ + (F.lane & 15)]; } } while (0)
        int it = F.gw;
        if (it < NIT) XW_LOAD(it, cur);
        for (; it < NIT; it += F.NGW) {
            const int itn = it + F.NGW;
            if (itn < NIT) XW_LOAD(itn, nxt);
            XW_DECODE(it)
            const int drow = w1_ ? (mat_ * 2048 + ((n0_ & 1023) >> 7) * 256 + (n0_ >> 10) * 128 + (n0_ & 127)) : (mat_ * 1024 + n0_);
            unsigned char* WT = F.ws() + (w1_ ? WS_W1T : WS_W2T);
#pragma unroll
            for (int i = 0; i < 32; ++i) { const int kk = 4 * i + (F.lane >> 4); scr[kk * 17 + (F.lane & 15)] = cur[i] * W8_SCALE; }
            LDS_WAIT(); asm volatile("" ::: "memory");
            { const int n = F.lane >> 2, c = F.lane & 3; const LAS float* s = scr + (32 * c) * 17 + n; unsigned o8[8];
#pragma unroll
              for (int q = 0; q < 8; ++q) { int w0 = 0; w0 = __builtin_amdgcn_cvt_pk_fp8_f32(s[(4 * q) * 17], s[(4 * q + 1) * 17], w0, false); w0 = __builtin_amdgcn_cvt_pk_fp8_f32(s[(4 * q + 2) * 17], s[(4 * q + 3) * 17], w0, true); o8[q] = (unsigned)w0; }
              unsigned char* d = WT + (size_t)(drow + n) * D + 128 * kb_ + 32 * c;
              *(u32x4*)d = (u32x4){o8[0], o8[1], o8[2], o8[3]}; *(u32x4*)(d + 16) = (u32x4){o8[4], o8[5], o8[6], o8[7]}; }
            LDS_WAIT(); asm volatile("" ::: "memory");
#pragma unroll
            for (int i = 0; i < 32; ++i) cur[i] = nxt[i];
        }
#undef XW_DECODE
#undef XW_LOAD
    }
    __syncthreads();
}

template <bool DRY> __device__ __forceinline__ void p_hpass0(Frame& F) {
    bf16_t* H = (bf16_t*)(F.ws() + WS_H + (DRY ? WS_JUNK : 0));
    int cs = -1; f32x4 pg[4], p0v[4];
    for (int rr = F.gw; rr < T; rr += 2 * F.NGW) {
        const int r0 = rr, r1 = min(rr + F.NGW, T - 1);
        f32x4 v0[4], v1[4], h[4]; ld_row_f32(input_row(F, r0), F.lane, v0); ld_row_f32(input_row(F, r1), F.lane, v1);
#define HP_ROW(v_, r_) do { const int s = stream_of(r_); if (s != cs) { cs = s; const float* gn = normg(F, 0, 0); const float* m1n = modp(F, 0, s, 1); const float* m0n = modp(F, 0, s, 0); \
            _Pragma("unroll") for (int j = 0; j < 4; ++j) { const int o = 256 * j + 4 * F.lane; pg[j] = *(const f32x4*)(gn + o) * (*(const f32x4*)(m1n + o) + 1.f); p0v[j] = *(const f32x4*)(m0n + o); } } \
          const float rx = rsqrtf(row_ss(v_) * (1.f / D) + RMS_EPS); _Pragma("unroll") for (int j = 0; j < 4; ++j) h[j] = (v_[j] * rx) * pg[j] + p0v[j]; st_row_bf16(H + (size_t)(r_) * D, F.lane, h); } while (0)
        HP_ROW(v0, r0); HP_ROW(v1, r1);
#undef HP_ROW
    }
}
template <bool DRY> __device__ __forceinline__ void p_poolprep(Frame& F) {
    const bf16_t* H = (const bf16_t*)(F.ws() + WS_H); bf16_t* Dp = (bf16_t*)(F.ws() + WS_O + (DRY ? WS_JUNK : 0));
    for (int row = F.gw; row < T; row += F.NGW) {
        const int b = row >= SB ? 1 : 0, w = row - b * SB;
        const int s0 = (w < NCTX) ? b * SB : b * SB + NCTX, s1 = (w < NCTX) ? b * SB + NCTX : (b + 1) * SB;
#pragma unroll
        for (int j = 0; j < 4; ++j) {
            constexpr int dummy = 0; (void)dummy;
            const int half = 1 << j;
            const int lo = max(row - half, s0), hi = min(row + half, s1);
            u32x2 q[16];
#pragma unroll
            for (int i = 0; i < 2 * half; ++i) { const int rr = row - half + i; const int rc = (rr >= lo && rr < hi) ? rr : row; q[i] = *(const u32x2*)(H + (size_t)rc * D + 256 * j + 4 * F.lane); }
            const u32x2 qs = *(const u32x2*)(H + (size_t)row * D + 256 * j + 4 * F.lane);
            f32x4 acc = {0, 0, 0, 0};
#pragma unroll
            for (int i = 0; i < 2 * half; ++i) { const int rr = row - half + i; const float wgt = (rr >= lo && rr < hi) ? 1.f : 0.f; acc += (f32x4){bflo(q[i].x), bfhi(q[i].x), bflo(q[i].y), bfhi(q[i].y)} * wgt; }
            const f32x4 self = {bflo(qs.x), bfhi(qs.x), bflo(qs.y), bfhi(qs.y)};
            const f32x4 d = acc * (1.f / (float)(hi - lo)) - self;
            u32x2 o; o.x = pkbf(d.x, d.y); o.y = pkbf(d.z, d.w);
            *(u32x2*)(Dp + ((size_t)j * T + row) * 256 + 4 * F.lane) = o;
        }
    }
}

template <int L>
__device__ __forceinline__ void p_moe_a(Frame& F, const bool DRY) {
    const bf16_t* Y = (const bf16_t*)(F.ws() + WS_Y); const bf16_t* X = (const bf16_t*)(F.ws() + WS_X); bf16_t* Xo = (bf16_t*)(F.ws() + WS_X + (DRY ? WS_JUNK : 0)); unsigned char* H8 = F.ws() + WS_H + (DRY ? WS_JUNK : 0);
    float* gate = (float*)(F.ws() + WS_GATE + (DRY ? WS_JUNK : 0)); int* list = (int*)(F.ws() + WS_LIST);
    LAS float* hbuf = (LAS float*)(F.lds);
    LAS float* part = (LAS float*)(F.lds + 65536);
    LAS int* sel = (LAS int*)(F.lds + 83968);
    LAS int* lcnt = (LAS int*)(F.lds + LC_LCNT); LAS int* gbase = (LAS int*)(F.lds + LC_GBASE);
    const float* g1 = normg(F, L, 1); const float* g2 = normg(F, L, 2);
    const float* rw = F.in(I_RW) + (size_t)L * D * NE; const float* rb = F.in(I_RB) + L * NE;
    const int e = F.lane & 31, kh = F.lane >> 5;
    typedef short rbf16x8 __attribute__((ext_vector_type(8)));
    rbf16x8 wh[4][2], wl[4][2];
#pragma unroll
    for (int s = 0; s < 4; ++s)
#pragma unroll
        for (int n = 0; n < 2; ++n) { unsigned hw[4], lw[4];
#pragma unroll
            for (int q = 0; q < 4; ++q) { const int k = 128 * F.wave + 32 * s + 8 * (F.lane >> 4) + 2 * q; const float w0 = rw[(size_t)k * NE + 16 * n + (F.lane & 15)], w1 = rw[(size_t)(k + 1) * NE + 16 * n + (F.lane & 15)];
                hw[q] = pkbf(w0, w1); lw[q] = pkbf(w0 - bflo(hw[q]), w1 - bfhi(hw[q])); }
            const u32x4 hv = {hw[0], hw[1], hw[2], hw[3]}, lv = {lw[0], lw[1], lw[2], lw[3]}; wh[s][n] = __builtin_bit_cast(rbf16x8, hv); wl[s][n] = __builtin_bit_cast(rbf16x8, lv); }
    const float bias = rb[e];
    if (F.tid < 32) lcnt[F.tid] = 0;
    __syncthreads();
    constexpr int NRA = (L == 3) ? NB * SEQ : T;
#define MA_ROW(n_) ((L == 3) ? (((n_) >> 14) * SB + NCTX + ((n_) & (SEQ - 1))) : (n_))
    const int chunk = (NRA + F.G - 1) / F.G, tok0 = min(NRA, (int)blockIdx.x * chunk), tok1 = min(NRA, tok0 + chunk);
    int cs = -1; f32x4 qm[4], qg[4], q0v[4];
    f32x4 y[2][4], x[2][4];
#define MA_LOAD(base_) do { _Pragma("unroll") for (int tt = 0; tt < 2; ++tt) { const int tok_ = (base_) + F.wave * 2 + tt; if (tok_ < tok1) { \
        const int row_ = MA_ROW(tok_); ld_row_bf16(Y + (size_t)row_ * D, F.lane, y[tt]); if constexpr (L == 0) ld_row_f32(input_row(F, row_), F.lane, x[tt]); else ld_row_bf16(X + (size_t)row_ * D, F.lane, x[tt]); } } } while (0)
    MA_LOAD(tok0);
    for (int base = tok0; base < tok1; base += 16) {
#pragma unroll
        for (int tt = 0; tt < 2; ++tt) {
            const int tl = F.wave * 2 + tt, tok = base + tl;
            if (tok < tok1) {
                const int row = MA_ROW(tok), s = stream_of(row);
                f32x4 h[4];
                if (s != cs) { cs = s; const float* m2 = modp(F, L, s, 2); const float* m4 = modp(F, L, s, 4); const float* m3 = modp(F, L, s, 3);
#pragma unroll
                    for (int j = 0; j < 4; ++j) { const int o = 256 * j + 4 * F.lane; qm[j] = *(const f32x4*)(m2 + o) * *(const f32x4*)(g1 + o); qg[j] = *(const f32x4*)(g2 + o) * (*(const f32x4*)(m4 + o) + 1.f); q0v[j] = *(const f32x4*)(m3 + o); } }
                const float ry = rsqrtf(row_ss(y[tt]) * (1.f / D) + RMS_EPS);
#pragma unroll
                for (int j = 0; j < 4; ++j) x[tt][j] = x[tt][j] + qm[j] * (y[tt][j] * ry);
                st_row_bf16(Xo + (size_t)row * D, F.lane, x[tt]);
                { const float rx = rsqrtf(row_ss(x[tt]) * (1.f / D) + RMS_EPS);
#pragma unroll
                  for (int j = 0; j < 4; ++j) h[j] = (x[tt][j] * rx) * qg[j] + q0v[j]; }
#pragma unroll
                for (int j = 0; j < 4; ++j) { int w = 0; w = __builtin_amdgcn_cvt_pk_fp8_f32(h[j].x, h[j].y, w, false); w = __builtin_amdgcn_cvt_pk_fp8_f32(h[j].z, h[j].w, w, true); *(int*)(H8 + (size_t)row * D + 256 * j + 4 * F.lane) = w; }
#pragma unroll
                for (int j = 0; j < 4; ++j) *(LAS f32x4*)(hbuf + tl * D + 256 * j + 4 * F.lane) = h[j];
            }
        }
        __syncthreads();
        if (base + 16 < tok1) MA_LOAD(base + 16);
        {
            f32x4 lg0 = {0.f, 0.f, 0.f, 0.f}, lg1 = {0.f, 0.f, 0.f, 0.f};
#pragma unroll
            for (int s = 0; s < 4; ++s) {
                const LAS float* hp = hbuf + (F.lane & 15) * D + 128 * F.wave + 32 * s + 8 * (F.lane >> 4);
                const f32x4 x0 = *(const LAS f32x4*)hp, x1 = *(const LAS f32x4*)(hp + 4);
                const unsigned h0 = pkbf(x0.x, x0.y), h1 = pkbf(x0.z, x0.w), h2 = pkbf(x1.x, x1.y), h3 = pkbf(x1.z, x1.w);
                const unsigned l0 = pkbf(x0.x - bflo(h0), x0.y - bfhi(h0)), l1 = pkbf(x0.z - bflo(h1), x0.w - bfhi(h1)), l2 = pkbf(x1.x - bflo(h2), x1.y - bfhi(h2)), l3 = pkbf(x1.z - bflo(h3), x1.w - bfhi(h3));
                const u32x4 hv = {h0, h1, h2, h3}, lv = {l0, l1, l2, l3};
                const rbf16x8 ah = __builtin_bit_cast(rbf16x8, hv), al = __builtin_bit_cast(rbf16x8, lv);
                lg0 = __builtin_amdgcn_mfma_f32_16x16x32_bf16(ah, wh[s][0], lg0, 0, 0, 0); lg1 = __builtin_amdgcn_mfma_f32_16x16x32_bf16(ah, wh[s][1], lg1, 0, 0, 0);
                lg0 = __builtin_amdgcn_mfma_f32_16x16x32_bf16(ah, wl[s][0], lg0, 0, 0, 0); lg1 = __builtin_amdgcn_mfma_f32_16x16x32_bf16(ah, wl[s][1], lg1, 0, 0, 0);
                lg0 = __builtin_amdgcn_mfma_f32_16x16x32_bf16(al, wh[s][0], lg0, 0, 0, 0); lg1 = __builtin_amdgcn_mfma_f32_16x16x32_bf16(al, wh[s][1], lg1, 0, 0, 0);
            }
#pragma unroll
            for (int r = 0; r < 4; ++r) { const int tl = 4 * (F.lane >> 4) + r; part[(F.wave * 16 + tl) * 32 + (F.lane & 15)] = lg0[r]; part[(F.wave * 16 + tl) * 32 + 16 + (F.lane & 15)] = lg1[r]; }
        }
        __syncthreads();
        {
            const int tl = F.wave * 2 + kh, tok = base + tl;
            float v = bias;
#pragma unroll
            for (int w = 0; w < 8; ++w) v += part[(w * 16 + tl) * 32 + e];
            float tv[4]; int ti[4];
#pragma unroll
            for (int k = 0; k < 4; ++k) {
                float cv = v; int ci = e;
#pragma unroll
                for (int o = 1; o < 32; o <<= 1) { const float ov = __shfl_xor(cv, o); const int oi = __shfl_xor(ci, o); if (ov > cv || (ov == cv && oi < ci)) { cv = ov; ci = oi; } }
                tv[k] = cv; ti[k] = ci; if (e == ci) v = -3.0e38f;
            }
            if (tok < tok1) {
                const float e1 = __expf(tv[1] - tv[0]), e2 = __expf(tv[2] - tv[0]), e3 = __expf(tv[3] - tv[0]); const float inv = 1.f / (1.f + e1 + e2 + e3);
                if (e == 0) *(f32x4*)(gate + (size_t)MA_ROW(tok) * 4) = (f32x4){inv, e1 * inv, e2 * inv, e3 * inv};
                if (!DRY && e < 4) { const int ex = (e == 0) ? ti[0] : (e == 1) ? ti[1] : (e == 2) ? ti[2] : ti[3];
                    const int rank = __hip_atomic_fetch_add(lcnt + ex, 1, __ATOMIC_RELAXED, __HIP_MEMORY_SCOPE_WORKGROUP); sel[(tok - tok0) * 4 + e] = ex | (rank << 8); }
            }
        }
    }
#undef MA_LOAD
    __syncthreads();
    if (DRY) return;
    if (F.tid < 32) gbase[F.tid] = (int)__hip_atomic_fetch_add(F.ctl() + CW_CNT + L * 32 + F.tid, (unsigned)lcnt[F.tid], __ATOMIC_RELAXED, __HIP_MEMORY_SCOPE_AGENT);
    __syncthreads();
    for (int i = F.tid; i < (tok1 - tok0) * 4; i += 512) { const int v = sel[i], ee = v & 255, rank = v >> 8; list[(size_t)ee * T + gbase[ee] + rank] = MA_ROW(tok0 + (i >> 2)) * 4 + (i & 3); }
    __syncthreads();
#undef MA_ROW
}
template <int L>
__device__ __forceinline__ int moe_setup(Frame& F) {
    LAS int* cnt = (LAS int*)(F.lds + LC_CNT); LAS int* tbase = (LAS int*)(F.lds + LC_TBASE); LAS int* tile_e = (LAS int*)(F.lds + LC_TILEE);
    __syncthreads();
    if (F.tid < 64) {
        const int c = (F.lane < 32) ? (int)__hip_atomic_load(F.ctl() + CW_CNT + L * 32 + F.lane, __ATOMIC_RELAXED, __HIP_MEMORY_SCOPE_AGENT) : 0;
        const int nt = (c + 255) >> 8;
        int incl = nt;
#pragma unroll
        for (int o = 1; o < 32; o <<= 1) { const int t = __shfl_up(incl, o); if (F.lane >= o) incl += t; }
        const int excl = incl - nt;
        if (F.lane < 32) { cnt[F.lane] = c; tbase[F.lane] = excl; for (int t = 0; t < nt; ++t) tile_e[excl + t] = F.lane; }
        if (F.lane == 31) tbase[32] = incl;
    }
    __syncthreads();
    return tbase[32];
}
template <int L, bool DRY>
__device__ __forceinline__ void p_moe_b(Frame& F) {
    const unsigned char* SLOT = F.ws() + WS_SLOT; const bf16_t* X = (const bf16_t*)(F.ws() + WS_X); bf16_t* Xo = (bf16_t*)(F.ws() + WS_X + (DRY ? WS_JUNK : 0)); unsigned char* H8 = F.ws() + WS_H + (DRY ? WS_JUNK : 0); const float* gate = (const float*)(F.ws() + WS_GATE);
    const float* g3 = normg(F, L, 3);
    constexpr int NR = (L == 3) ? NB * SEQ : T;
    int sl[4][4], sn[4][4]; f32x4 xc[4], xn[4], gc, gn;
#define MB_ROW(n_) ((L == 3) ? (((n_) >> 14) * SB + NCTX + ((n_) & (SEQ - 1))) : (n_))
#define MB_LOAD(n_, S_, X_, G_) do { const int r_ = MB_ROW(n_); G_ = *(const f32x4*)(gate + (size_t)r_ * 4); \
        _Pragma("unroll") for (int k = 0; k < 4; ++k) _Pragma("unroll") for (int j = 0; j < 4; ++j) S_[k][j] = *(const int*)(SLOT + ((size_t)r_ * 4 + k) * D + 256 * j + 4 * F.lane); \
        ld_row_bf16(X + (size_t)r_ * D, F.lane, X_); } while (0)
    int cs = -1; f32x4 pm[4], pg[4], p0v[4];
    int n = F.gw;
    if (n < NR) MB_LOAD(n, sl, xc, gc);
    for (; n < NR; n += F.NGW) {
        const int nn = n + F.NGW;
        if (nn < NR) MB_LOAD(nn, sn, xn, gn);
        const int row = MB_ROW(n), b = row >= SB ? 1 : 0, w = row - b * SB, s = (w < NCTX) ? 2 : b;
        f32x4 y[4], x[4];
#pragma unroll
        for (int j = 0; j < 4; ++j) { y[j] = (f32x4){0, 0, 0, 0}; x[j] = xc[j];
#pragma unroll
            for (int k = 0; k < 4; ++k) { const int q = sl[k][j]; y[j] += (f32x4){__builtin_amdgcn_cvt_f32_fp8(q, 0), __builtin_amdgcn_cvt_f32_fp8(q, 1), __builtin_amdgcn_cvt_f32_fp8(q, 2), __builtin_amdgcn_cvt_f32_fp8(q, 3)} * gc[k]; } }
        if (s != cs) { cs = s; constexpr int LN_ = (L < 3) ? L + 1 : 3; const float* m5 = modp(F, L, s, 5); const float* gn = normg(F, LN_, 0); const float* m1n = modp(F, LN_, s, 1); const float* m0n = modp(F, LN_, s, 0);
#pragma unroll
            for (int j = 0; j < 4; ++j) { const int o = 256 * j + 4 * F.lane; pm[j] = *(const f32x4*)(m5 + o) * *(const f32x4*)(g3 + o); pg[j] = *(const f32x4*)(gn + o) * (*(const f32x4*)(m1n + o) + 1.f); p0v[j] = *(const f32x4*)(m0n + o); } }
        const float ry = rsqrtf(row_ss(y) * (1.f / D) + RMS_EPS);
#pragma unroll
        for (int j = 0; j < 4; ++j) x[j] = x[j] + pm[j] * (y[j] * ry);
        if (L == 3) { st_row_f32((DRY ? (float*)Xo : F.out()) + ((size_t)(b * SEQ + (w - NCTX))) * D, F.lane, x); }
        else {
            st_row_bf16(Xo + (size_t)row * D, F.lane, x);
            f32x4 h[4]; const float rx = rsqrtf(row_ss(x) * (1.f / D) + RMS_EPS);
#pragma unroll
            for (int j = 0; j < 4; ++j) h[j] = (x[j] * rx) * pg[j] + p0v[j];
#pragma unroll
            for (int j = 0; j < 4; ++j) { int w8 = 0; w8 = __builtin_amdgcn_cvt_pk_fp8_f32(h[j].x, h[j].y, w8, false); w8 = __builtin_amdgcn_cvt_pk_fp8_f32(h[j].z, h[j].w, w8, true); *(int*)(H8 + (size_t)row * D + 256 * j + 4 * F.lane) = w8; }
        }
#pragma unroll
        for (int k = 0; k < 4; ++k)
#pragma unroll
            for (int j = 0; j < 4; ++j) sl[k][j] = sn[k][j];
#pragma unroll
        for (int j = 0; j < 4; ++j) xc[j] = xn[j];
        gc = gn;
    }
#undef MB_ROW
#undef MB_LOAD
}
template <int LDG, int VCOL0, int NH>
__device__ __forceinline__ void vt_prep(Frame& F, const bf16_t* G, unsigned char* VT8) {
    LAS unsigned char* scr = F.lds + F.wave * 4096;
    constexpr int NTI = SB / 64;
    const int dvl = F.lane >> 1, hf = F.lane & 1;
    for (int it = F.gw; it < NB * NH * NTI; it += F.NGW) {
        const int tile = it % NTI, bh = it / NTI, b = bh / NH, hd = bh - b * NH;
        const bf16_t* src = G + (size_t)(b * SB + tile * 64 + F.lane) * LDG + VCOL0 + hd * 128;
        unsigned char* dst = VT8 + (size_t)(bh * 128) * SB + tile * 64 + hf * 32;
#pragma unroll 1
        for (int c = 0; c < 4; ++c) {
            u32x4 a[4];
#pragma unroll
            for (int i = 0; i < 4; ++i) a[i] = *(const u32x4*)(src + c * 32 + i * 8);
#pragma unroll
            for (int i = 0; i < 4; ++i) {
                int w0 = 0, w1 = 0;
                w0 = __builtin_amdgcn_cvt_pk_fp8_f32(bflo(a[i].x), bfhi(a[i].x), w0, false); w0 = __builtin_amdgcn_cvt_pk_fp8_f32(bflo(a[i].y), bfhi(a[i].y), w0, true);
                w1 = __builtin_amdgcn_cvt_pk_fp8_f32(bflo(a[i].z), bfhi(a[i].z), w1, false); w1 = __builtin_amdgcn_cvt_pk_fp8_f32(bflo(a[i].w), bfhi(a[i].w), w1, true);
                *(LAS int*)(scr + F.lane * 36 + 8 * i) = w0; *(LAS int*)(scr + F.lane * 36 + 8 * i + 4) = w1;
            }
            LDS_WAIT(); asm volatile("" ::: "memory");
            unsigned o8[8];
#pragma unroll
            for (int q = 0; q < 8; ++q) { const int kb = 32 * (q >> 2) + 8 * (q & 3) + 4 * hf; const LAS unsigned char* p = scr + kb * 36 + dvl;
                o8[q] = (unsigned)p[0] | ((unsigned)p[36] << 8) | ((unsigned)p[72] << 16) | ((unsigned)p[108] << 24); }
            unsigned char* d = dst + (size_t)(c * 32 + dvl) * SB;
            *(u32x4*)d = (u32x4){o8[0], o8[1], o8[2], o8[3]}; *(u32x4*)(d + 16) = (u32x4){o8[4], o8[5], o8[6], o8[7]};
            LDS_WAIT(); asm volatile("" ::: "memory");
        }
    }
}
template <bool DRY> __device__ __forceinline__ void p_gqa_prep(Frame& F) {
    const bf16_t* G = (const bf16_t*)(F.ws() + WS_G); unsigned char* Q8 = F.ws() + WS_Q8; unsigned char* K8 = F.ws() + WS_K8; const float* qg = F.in(I_GQG); const float* kg = F.in(I_GKG);
    const int hi = F.lane >> 5, jl = (F.lane & 31) * 2, c0 = hi * 64 + jl;
    const float f0 = __builtin_amdgcn_exp2f(-(float)(jl & 31) * (LOG2_THETA / 32.f)), f1 = __builtin_amdgcn_exp2f(-(float)((jl + 1) & 31) * (LOG2_THETA / 32.f));
    const float qg0 = qg[c0], qg1 = qg[c0 + 1], kg0 = kg[c0], kg1 = kg[c0 + 1];
    for (int rr = F.gw; rr < T; rr += 2 * F.NGW) {
        unsigned qw[2][10];
#pragma unroll
        for (int u = 0; u < 2; ++u) { const int row = min(rr + u * F.NGW, T - 1); const bf16_t* gr = G + (size_t)row * 1536 + c0;
#pragma unroll
            for (int h = 0; h < 10; ++h) qw[u][h] = *(const unsigned*)(gr + h * 128); }
#pragma unroll
        for (int u = 0; u < 2; ++u) {
            const int row = min(rr + u * F.NGW, T - 1);
            const int b = row >= SB ? 1 : 0, w = row - b * SB; const bool lat = w >= NCTX; const int t = w - NCTX;
            const float pos = lat ? ((jl < 32) ? (float)(t >> 6) : (float)(t & 63)) : 0.f; const float a0 = pos * f0, a1 = pos * f1;
            const float cs0 = __cosf(a0), sn0 = __sinf(a0), cs1 = __cosf(a1), sn1 = __sinf(a1);
#pragma unroll
            for (int h = 0; h < 10; ++h) {
                const unsigned q = qw[u][h];
                const float x0 = bflo(q), x1 = bfhi(q);
                const float r = rsqrtf(wave_sum(x0 * x0 + x1 * x1) * (1.f / 128.f) + RMS_EPS);
                const float n0 = x0 * r * (h < 8 ? qg0 : kg0), n1 = x1 * r * (h < 8 ? qg1 : kg1);
                const float p0 = __shfl_xor(n0, 32), p1 = __shfl_xor(n1, 32);
                const float o0 = hi ? (n0 * cs0 + p0 * sn0) : (n0 * cs0 - p0 * sn0), o1 = hi ? (n1 * cs1 + p1 * sn1) : (n1 * cs1 - p1 * sn1);
                const float qs = (h < 8) ? QSCALE128 : 1.f;
                const unsigned short w8 = (unsigned short)__builtin_amdgcn_cvt_pk_fp8_f32(o0 * qs, o1 * qs, 0, false);
                if (h < 8) *(unsigned short*)(Q8 + (size_t)row * 1024 + h * 128 + c0) = w8; else *(unsigned short*)(K8 + (size_t)row * 256 + (h - 8) * 128 + c0) = w8;
            }
        }
    }
    vt_prep<1536, 1280, 2>(F, G, F.ws() + WS_VT8);
}
template <bool DRY> __device__ __forceinline__ void p_diff_prep(Frame& F) {
    const bf16_t* G = (const bf16_t*)(F.ws() + WS_G); unsigned char* Q8 = F.ws() + WS_Q8; unsigned char* K8 = F.ws() + WS_K8;
    const int l31 = F.lane & 31, j0 = 2 * l31; const bool first = l31 < 16; const int jj = j0 & 31;
    const float f0 = __builtin_amdgcn_exp2f(-(float)(jj & 15) * (LOG2_THETA / 16.f)), f1 = __builtin_amdgcn_exp2f(-(float)((jj + 1) & 15) * (LOG2_THETA / 16.f));
    for (int rr = F.gw; rr < T; rr += 2 * F.NGW) {
        unsigned qw[2][16];
#pragma unroll
        for (int u = 0; u < 2; ++u) { const int row = min(rr + u * F.NGW, T - 1); const bf16_t* gr = G + (size_t)row * 3072 + 2 * F.lane;
#pragma unroll
            for (int ch = 0; ch < 16; ++ch) qw[u][ch] = *(const unsigned*)(gr + ch * 128); }
#pragma unroll
        for (int u = 0; u < 2; ++u) {
            const int row = min(rr + u * F.NGW, T - 1);
            const int b = row >= SB ? 1 : 0, w = row - b * SB; const int t = w - NCTX;
            const float pos = (w >= NCTX) ? ((jj < 16) ? (float)(t >> 6) : (float)(t & 63)) : 0.f; const float a0 = pos * f0, a1 = pos * f1;
            const float cs0 = __cosf(a0), sn0 = __sinf(a0), cs1 = __cosf(a1), sn1 = __sinf(a1);
#pragma unroll
            for (int ch = 0; ch < 16; ++ch) {
                const unsigned q = qw[u][ch];
                const float x0 = bflo(q), x1 = bfhi(q);
                const float p0 = __shfl_xor(x0, 16), p1 = __shfl_xor(x1, 16);
                const float o0 = first ? (x0 * cs0 - p0 * sn0) : (x0 * cs0 + p0 * sn0), o1 = first ? (x1 * cs1 - p1 * sn1) : (x1 * cs1 + p1 * sn1);
                const float qs = (ch < 8) ? QSCALE64 : 1.f;
                const unsigned short w8 = (unsigned short)__builtin_amdgcn_cvt_pk_fp8_f32(o0 * qs, o1 * qs, 0, false);
                if (ch < 8) *(unsigned short*)(Q8 + (size_t)row * 1024 + ch * 128 + 2 * F.lane) = w8; else *(unsigned short*)(K8 + (size_t)row * 1024 + (ch - 8) * 128 + 2 * F.lane) = w8;
            }
        }
    }
    vt_prep<3072, 2048, 8>(F, G, F.ws() + WS_VT8);
}
template <bool DRY> __device__ __forceinline__ void p_conv_prep(Frame& F) {
    const bf16_t* G = (const bf16_t*)(F.ws() + WS_G); unsigned char* Z = F.ws() + WS_O + (DRY ? WS_JUNK : 0); const float* wd = F.in(I_CDW);
    for (int rr = F.gw; rr < T; rr += 2 * F.NGW) {
        u32x2 qc[2][3][4], qx[2][3][4], qb[2][4]; float wm[2][3];
#pragma unroll
        for (int u = 0; u < 2; ++u) {
            const int row = min(rr + u * F.NGW, T - 1); const int b = row >= SB ? 1 : 0, w = row - b * SB;
            const int s0 = (w < NCTX) ? b * SB : b * SB + NCTX, s1 = (w < NCTX) ? b * SB + NCTX : (b + 1) * SB;
            const bool hasp = row - 1 >= s0, hasn = row + 1 < s1;
            const int rws[3] = {hasp ? row - 1 : row, row, hasn ? row + 1 : row}; wm[u][0] = hasp ? 1.f : 0.f; wm[u][1] = 1.f; wm[u][2] = hasn ? 1.f : 0.f;
#pragma unroll
            for (int j = 0; j < 4; ++j) { const int c = 256 * j + 4 * F.lane; qb[u][j] = *(const u32x2*)(G + (size_t)row * 3072 + c);
#pragma unroll
                for (int d = 0; d < 3; ++d) { const bf16_t* gp = G + (size_t)rws[d] * 3072 + c; qc[u][d][j] = *(const u32x2*)(gp + 1024); qx[u][d][j] = *(const u32x2*)(gp + 2048); } }
        }
#pragma unroll
        for (int u = 0; u < 2; ++u) {
            const int row = min(rr + u * F.NGW, T - 1);
#pragma unroll
            for (int j = 0; j < 4; ++j) { const int c = 256 * j + 4 * F.lane; f32x4 acc = {0, 0, 0, 0};
#pragma unroll
                for (int d = 0; d < 3; ++d) { const u32x2 a = qc[u][d][j], x = qx[u][d][j];
                    const f32x4 uu = (f32x4){bflo(a.x), bfhi(a.x), bflo(a.y), bfhi(a.y)} * (f32x4){bflo(x.x), bfhi(x.x), bflo(x.y), bfhi(x.y)};
                    acc += uu * (*(const f32x4*)(wd + d * D + c) * wm[u][d]); }
                const u32x2 g = qb[u][j];
                const f32x4 z = acc * (f32x4){bflo(g.x), bfhi(g.x), bflo(g.y), bfhi(g.y)};
                int w8 = 0; w8 = __builtin_amdgcn_cvt_pk_fp8_f32(z.x * OS_CONV, z.y * OS_CONV, w8, false); w8 = __builtin_amdgcn_cvt_pk_fp8_f32(z.z * OS_CONV, z.w * OS_CONV, w8, true);
                *(int*)(Z + (size_t)row * D + c) = w8; }
        }
    }
}
template <int PV> __device__ __forceinline__ void p_gqa_attn(Frame& F) {
    const unsigned char* Q8 = F.ws() + WS_Q8; const unsigned char* K8 = F.ws() + WS_K8; const unsigned char* VT8 = F.ws() + WS_VT8; unsigned char* O = F.ws() + WS_O + (PV ? WS_JUNK : 0);
    for (int idx = F.vcu; idx < 1024 + 16; idx += F.G) {
        int b, hq, qrow, seq;
        if (idx < 1024) { const int r = idx >> 8, wi = idx & 255; b = r >> 1; hq = (r & 1) * 4 + (wi >> 6); qrow = b * SB + NCTX + (wi & 63) * 256; seq = SB; }
        else { const int j = idx - 1024; b = j >> 3; hq = j & 7; qrow = b * SB; seq = NCTX; }
        const int kvh = hq >> 2;
        att8::attn_body8<128, 1024, 256, 1024, false, (PV > 0 ? PV - 1 : 0)>(Q8 + (size_t)qrow * 1024 + hq * 128, K8 + (size_t)(b * SB) * 256 + kvh * 128, VT8 + (size_t)((b * 2 + kvh) * 128) * SB,
                                                      O + (size_t)qrow * D + hq * 128, seq, F.ldsg, 0, 0.f, nullptr);
    }
}
__device__ __forceinline__ void p_diff_attn(Frame& F) {
    const unsigned char* Q8 = F.ws() + WS_Q8; const unsigned char* K8 = F.ws() + WS_K8; const unsigned char* VT8 = F.ws() + WS_VT8; unsigned char* O = F.ws() + WS_O;
    const float* lv = F.in(I_DLAM);
    const float lam = __expf(wave_sum(lv[F.lane] * lv[64 + F.lane])) - __expf(wave_sum(lv[128 + F.lane] * lv[192 + F.lane])) + LAM_INIT;
    for (int idx = F.vcu; idx < 1024; idx += F.G) {
#pragma unroll 1
        for (int s = 0; s < 2; ++s) {
            int ix = idx; asm volatile("" : "+s"(ix));
            const int r = ix >> 6, b = r >> 3, h = r & 7, qrow = b * SB + NCTX + (ix & 63) * 256;
            att8::attn_body8<64, 1024, 1024, 1024, true>(Q8 + (size_t)qrow * 1024 + h * 128 + s * 64, K8 + (size_t)(b * SB) * 1024 + h * 128 + s * 64, VT8 + (size_t)((b * 8 + h) * 128) * SB,
                                                         O + (size_t)qrow * D + h * 128, SB, F.ldsg, s, lam, F.in(I_DSUB));
        }
    }
}


#define PG8_ALIGN true
#define PG8_SP2 true

template <int L, int P0> __device__ __forceinline__ void moe_layer(Frame& F, const XcdBarrier& bar, int lo, int hi, int rep_mask);

__global__ void __launch_bounds__(NWAVES * 64, 2) mk_fwd(Args args) {
    extern __shared__ __attribute__((aligned(16))) unsigned char lds[];
    Frame F;
    F.lds = (LAS unsigned char*)lds; F.ldsg = (char*)lds;
    F.tid = threadIdx.x; F.lane = F.tid & 63; F.wave = __builtin_amdgcn_readfirstlane(F.tid >> 6);
    F.G = gridDim.x; { const int bx = blockIdx.x; F.vcu = (F.G % 8 == 0) ? (bx % 8) * (F.G / 8) + bx / 8 : bx; }
    F.gw = F.vcu * NWAVES + F.wave; F.NGW = F.G * NWAVES;
    refresh(F);
    for (int u = F.tid; u < (LDS_BYTES - RING_BYTES) / 4; u += NWAVES * 64) ((LAS unsigned*)(F.lds + RING_BYTES))[u] = 0u;
    __syncthreads();
    XcdBarrier bar; bar.bar = F.ctl() + CW_BAR; bar.x = 0; bar.st = nullptr;
    if (!MK_MULTI) bar = xcd_barrier_post(F.ctl() + CW_BAR, (volatile LAS unsigned*)(F.lds + LC_MISC));
    const int lo = args.ph_lo, hi = args.ph_hi; const int rep_mask = args.pad;
#define IN(k) (lo <= (k) && (k) < hi && refresh(F))
#define NREP(bit) (REP_MASK ? 1 + ((rep_mask & (bit)) ? 1 : 0) : 1)
#define PHM(k) asm volatile("; === PHASE %0" :: "i"(k))
#define SEAM(k) do { if (IN(k) && IN((k) + 1)) { xcd_barrier(bar); if constexpr ((REP_MASK & 256) != 0) xcd_barrier(bar); } } while (0)
    bf16_t* const Hb = (bf16_t*)(F.ws() + WS_H); bf16_t* const Gb = (bf16_t*)(F.ws() + WS_G); bf16_t* const Ob = (bf16_t*)(F.ws() + WS_O); bf16_t* const Yb = (bf16_t*)(F.ws() + WS_Y);

    if (IN(0)) { PHM(0); for (int rep = 0; rep < NREP(16); ++rep) p0_prologue(F); } SEAM(0);
    if (IN(1)) { PHM(1); if constexpr ((REP_MASK & 128) != 0) p_hpass0<true>(F); p_hpass0<false>(F); } SEAM(1);
    if (IN(2)) { PHM(2); if constexpr ((REP_MASK & 128) != 0) p_poolprep<true>(F); p_poolprep<false>(F); } SEAM(2);
    if (IN(3)) { PHM(3);
        int kpool = 256; asm volatile("" : "+s"(kpool));
        pg8::Gemm g{Ob, (const bf16_t*)(F.ws() + WS_POOLW), 4 * T, 256, kpool}; pg8::PoolOrder S{F.G, F.vcu};
        pg8::EpiPool E{Yb, D};
        for (int rep = 0; rep < NREP(32); ++rep) pg8::gemm_phase<pg8::EpiPool, pg8::PoolOrder, PG8_ALIGN, PG8_SP2>(F.lds, g, S, E);
    } SEAM(3);
    moe_layer<0, 4>(F, bar, lo, hi, rep_mask);
    if (IN(9)) { PHM(9);
        int kop = D; asm volatile("" : "+s"(kop));
        pg8::Gemm g{Hb, (const bf16_t*)(F.ws() + WS_GQKV), T, 1536, kop}; pg8::StaticOrder S; S.init(T, 1536, F.G, (int)blockIdx.x);
        pg8::EpiScaled E{Gb, 1536, 1.f / W8_SCALE};
        pg8::gemm_phase<pg8::EpiScaled, pg8::StaticOrder, PG8_ALIGN, PG8_SP2, 1>(F.lds, g, S, E);
    } SEAM(9);
    if (IN(10)) { PHM(10); if constexpr ((REP_MASK & 128) != 0) p_gqa_prep<true>(F); p_gqa_prep<false>(F); } SEAM(10);
    if (IN(11)) { PHM(11); if constexpr ((REP_MASK & 1) != 0) { p_gqa_attn<ATT_PROBE + 1>(F); refresh(F); } p_gqa_attn<0>(F); } SEAM(11);
    if (IN(12)) { PHM(12);
        int kop = D; asm volatile("" : "+s"(kop));
        pg8::Gemm g{Ob, (const bf16_t*)(F.ws() + WS_GO), T, D, kop}; pg8::StaticOrder S; S.init(T, D, F.G, (int)blockIdx.x);
        pg8::EpiScaled E{Yb, D, 1.f / (W8_SCALE * OS_GQA)};
        for (int rep = 0; rep < NREP(32); ++rep) pg8::gemm_phase<pg8::EpiScaled, pg8::StaticOrder, PG8_ALIGN, PG8_SP2, 1>(F.lds, g, S, E);
    } SEAM(12);
    moe_layer<1, 13>(F, bar, lo, hi, rep_mask);
    if (IN(18)) { PHM(18);
        int kop = D; asm volatile("" : "+s"(kop));
        pg8::Gemm g{Hb, (const bf16_t*)(F.ws() + WS_CIN), T, 3072, kop}; pg8::StaticOrder S; S.init(T, 3072, F.G, (int)blockIdx.x);
        pg8::EpiScaled E{Gb, 3072, 1.f / W8_SCALE};
        pg8::gemm_phase<pg8::EpiScaled, pg8::StaticOrder, PG8_ALIGN, PG8_SP2, 1>(F.lds, g, S, E);
    } SEAM(18);
    if (IN(19)) { PHM(19); if constexpr ((REP_MASK & 128) != 0) p_conv_prep<true>(F); p_conv_prep<false>(F); } SEAM(19);
    if (IN(20)) { PHM(20);
        int kop = D; asm volatile("" : "+s"(kop));
        pg8::Gemm g{Ob, (const bf16_t*)(F.ws() + WS_COUT), T, D, kop}; pg8::StaticOrder S; S.init(T, D, F.G, (int)blockIdx.x);
        pg8::EpiScaled E{Yb, D, 1.f / (W8_SCALE * OS_CONV)};
        for (int rep = 0; rep < NREP(32); ++rep) pg8::gemm_phase<pg8::EpiScaled, pg8::StaticOrder, PG8_ALIGN, PG8_SP2, 1>(F.lds, g, S, E);
    } SEAM(20);
    moe_layer<2, 21>(F, bar, lo, hi, rep_mask);
    if (IN(26)) { PHM(26);
        int kop = D; asm volatile("" : "+s"(kop));
        pg8::Gemm g{Hb, (const bf16_t*)(F.ws() + WS_DQKV), T, 3072, kop}; pg8::StaticOrder S; S.init(T, 3072, F.G, (int)blockIdx.x);
        pg8::EpiScaled E{Gb, 3072, 1.f / W8_SCALE};
        pg8::gemm_phase<pg8::EpiScaled, pg8::StaticOrder, PG8_ALIGN, PG8_SP2, 1>(F.lds, g, S, E);
    } SEAM(26);
    if (IN(27)) { PHM(27); if constexpr ((REP_MASK & 128) != 0) p_diff_prep<true>(F); p_diff_prep<false>(F); } SEAM(27);
    if (IN(28)) { PHM(28); for (int rep = 0; rep < NREP(2); ++rep) p_diff_attn(F); } if (IN(28) && IN(30)) xcd_barrier(bar);
    if (IN(30)) { PHM(30);
        int kop = D; asm volatile("" : "+s"(kop));
        pg8::Gemm g{Ob, (const bf16_t*)(F.ws() + WS_DO), T, D, kop}; pg8::LatentOrder S; S.init(D, F.G, (int)blockIdx.x);
        pg8::EpiScaled E{Yb, D, 1.f / (W8_SCALE * OS_DIFF)};
        for (int rep = 0; rep < NREP(32); ++rep) pg8::gemm_phase<pg8::EpiScaled, pg8::LatentOrder, PG8_ALIGN, PG8_SP2, 1>(F.lds, g, S, E);
    } SEAM(30);
    moe_layer<3, 31>(F, bar, lo, hi, rep_mask);
    if (args.dump) {
        if (!MK_MULTI) xcd_barrier(bar);
        const bf16_t* X = (const bf16_t*)(F.ws() + WS_X);
        for (int row = F.gw; row < T; row += F.NGW) { const int b = row >= SB ? 1 : 0, w = row - b * SB; if (w < NCTX) continue;
            f32x4 v[4]; ld_row_bf16(X + (size_t)row * D, F.lane, v); st_row_f32(F.out() + ((size_t)(b * SEQ + (w - NCTX))) * D, F.lane, v); }
    }
}
struct MoeDeal { int base, stride, limit, nun; };
__device__ __forceinline__ MoeDeal moe_deal(const Frame& F, int U) {
    MoeDeal d;
    if (F.G % 8 == 0) { const int per = F.G / 8, x = F.vcu / per, cl = F.vcu - x * per; d.base = (int)(((long)U * x) / 8) + cl; d.stride = per; d.limit = (int)(((long)U * (x + 1)) / 8); }
    else { d.base = F.vcu; d.stride = F.G; d.limit = U; }
    d.nun = (d.base < d.limit) ? (d.limit - d.base + d.stride - 1) / d.stride : 0;
    return d;
}
template <int L, int P0> __device__ __forceinline__ void moe_layer(Frame& F, const XcdBarrier& bar, int lo, int hi, int rep_mask) {
    if (IN(P0)) { PHM(P0); if constexpr ((REP_MASK & 512) != 0) { p_moe_a<L>(F, true); refresh(F); } p_moe_a<L>(F, false); } if (IN(P0) && IN(P0 + 2)) xcd_barrier(bar);
    if (IN(P0 + 2)) { PHM(P0 + 2);
        const int ntiles = moe_setup<L>(F); const MoeDeal dl = moe_deal(F, ntiles * 8);
        int kop = D; asm volatile("" : "+s"(kop));
        { LAS unsigned short* tk = (LAS unsigned short*)(F.lds + LC_TOK16); const LAS int* cnt = (const LAS int*)(F.lds + LC_CNT); const LAS int* tbase = (const LAS int*)(F.lds + LC_TBASE); const LAS int* tile_e = (const LAS int*)(F.lds + LC_TILEE);
          const int* list = (const int*)(F.ws() + WS_LIST); int nun = dl.nun; if (nun > MAXU) nun = MAXU;
          for (int idx = F.tid; idx < nun * 256; idx += NWAVES * 64) { const int i = idx >> 8, r = idx & 255, pm = (dl.base + i * dl.stride) >> 3, ee = tile_e[pm], pos = (pm - tbase[ee]) * 256 + r;
              tk[idx] = (unsigned short)((pos < cnt[ee]) ? (list[(size_t)ee * T + pos] >> 2) : 0); }
          __syncthreads(); }
        pg8::Gemm g{(const bf16_t*)(F.ws() + WS_H), (const bf16_t*)(F.ws() + WS_W1T + (size_t)L * NE * 2048 * D), T, 2048, kop};
        pg8::MoeOrder S{(const LAS int*)(F.lds + LC_TILEE), dl.limit, 8, dl.stride, dl.base};
        pg8::EpiSwiGLU E{F.ws() + WS_ACT, (const bf16_t*)(F.ws() + WS_B1H) + (size_t)L * NE * 2048, 1.f / W8_SCALE};
        if constexpr ((REP_MASK & 4) != 0) { pg8::EpiSwiGLUT<(G1_PROBE & 3)> E2{F.ws() + WS_HS, (const bf16_t*)(F.ws() + WS_B1H) + (size_t)L * NE * 2048, 1.f / W8_SCALE};
            pg8::gemm_phase<pg8::EpiSwiGLUT<(G1_PROBE & 3)>, pg8::MoeOrder, PG8_ALIGN, PG8_SP2, 1, true, (G1_PROBE >> 2)>(F.lds, g, S, E2, (const LAS unsigned short*)(F.lds + LC_TOK16)); }
        pg8::gemm_phase<pg8::EpiSwiGLU, pg8::MoeOrder, PG8_ALIGN, PG8_SP2, 1, true>(F.lds, g, S, E, (const LAS unsigned short*)(F.lds + LC_TOK16));
    } SEAM(P0 + 2);
    if (IN(P0 + 3)) { PHM(P0 + 3);
        const int ntiles = moe_setup<L>(F); const MoeDeal dl = moe_deal(F, ntiles * 4);
        int kop = D; asm volatile("" : "+s"(kop));
        pg8::Gemm g{(const bf16_t*)(F.ws() + WS_ACT), (const bf16_t*)(F.ws() + WS_W2T + (size_t)L * NE * D * D), CROWS, D, kop};
        pg8::MoeOrder S{(const LAS int*)(F.lds + LC_TILEE), dl.limit, 4, dl.stride, dl.base};
        { LAS int* st = (LAS int*)(F.lds + LC_TOK16); const LAS int* cnt = (const LAS int*)(F.lds + LC_CNT); const LAS int* tbase = (const LAS int*)(F.lds + LC_TBASE); const LAS int* tile_e = (const LAS int*)(F.lds + LC_TILEE);
          const int* list = (const int*)(F.ws() + WS_LIST); int nun = dl.nun; if (nun > MAXU / 2) nun = MAXU / 2;
          for (int idx = F.tid; idx < nun * 256; idx += NWAVES * 64) { const int i = idx >> 8, r = idx & 255, pm = (dl.base + i * dl.stride) >> 2, ee = tile_e[pm], pos = (pm - tbase[ee]) * 256 + r;
              st[idx] = (pos < cnt[ee]) ? list[(size_t)ee * T + pos] : -1; }
          __syncthreads(); }
        pg8::EpiScatter E{F.ws() + WS_SLOT, (const LAS int*)(F.lds + LC_TOK16), dl.stride, dl.base, (const bf16_t*)(F.ws() + WS_B2H) + (size_t)L * NE * D, 1.f / W8_SCALE, 0, T * 4};
        pg8::gemm_phase<pg8::EpiScatter, pg8::MoeOrder, PG8_ALIGN, PG8_SP2, 1>(F.lds, g, S, E);
        if constexpr ((REP_MASK & 8) != 0) { pg8::EpiScatter E2{F.ws() + WS_HS, (const LAS int*)(F.lds + LC_TOK16), dl.stride, dl.base, (const bf16_t*)(F.ws() + WS_B2H) + (size_t)L * NE * D, 1.f / W8_SCALE, ((REP_MASK & 4096) ? 1 : 0), CROWS};
            pg8::gemm_phase<pg8::EpiScatter, pg8::MoeOrder, PG8_ALIGN, PG8_SP2, 1>(F.lds, g, S, E2); }
    } SEAM(P0 + 3);
    if (IN(P0 + 4)) { PHM(P0 + 4); if constexpr ((REP_MASK & 1024) != 0) p_moe_b<L, true>(F); p_moe_b<L, false>(F); } SEAM(P0 + 4);
}
#undef IN
#undef SEAM

extern "C" void kernel_launch(void* const* d_in, const int* in_sizes, int n_in, void* d_out, int out_size, void* d_ws, size_t ws_size, hipStream_t stream) {
    static int grid = 0;
    if (grid == 0) {
        if (n_in != N_IN || in_sizes[0] != NB * SEQ * D || out_size != NB * SEQ * D || ws_size < WS_END) {
            fprintf(stderr, "kernel_launch: shape mismatch (n_in %d, in0 %d, out %d, ws %zu, need %zu); nothing launched\n", n_in, n_in > 0 ? in_sizes[0] : -1, out_size, ws_size, (size_t)WS_END); grid = -1; return; }
        { const long long exp_sz[N_IN] = {(long long)NB * SEQ * D, NB * D, NB * NCTX * D, D, 4LL * D * 6 * D, 4 * 6 * D, 4 * 4 * D, 4 * 256 * 256, D, D * 1536, D * D, 128, 128, D * 3072, 3 * D, D * D, D * 3072, D * D, 4 * 64, 128,
                                             4 * D * NE, 4 * NE, 4LL * NE * D * 2048, 4 * NE * 2048, 4LL * NE * D * D, 4 * NE * D};
          for (int i = 0; i < N_IN; ++i) if ((long long)in_sizes[i] != exp_sz[i]) { fprintf(stderr, "kernel_launch: input %d has %d elements, expected %lld; nothing launched\n", i, in_sizes[i], exp_sz[i]); grid = -1; return; } }
        int dev = 0, cus = 0, per_cu = 0;
        if (hipGetDevice(&dev) != hipSuccess || hipDeviceGetAttribute(&cus, hipDeviceAttributeMultiprocessorCount, dev) != hipSuccess) { fprintf(stderr, "kernel_launch: device query failed\n"); grid = -1; return; }
        if (hipFuncSetAttribute((const void*)mk_fwd, hipFuncAttributeMaxDynamicSharedMemorySize, LDS_BYTES) != hipSuccess) { fprintf(stderr, "kernel_launch: hipFuncSetAttribute failed\n"); grid = -1; return; }
        if (hipOccupancyMaxActiveBlocksPerMultiprocessor(&per_cu, (const void*)mk_fwd, NWAVES * 64, LDS_BYTES) != hipSuccess || per_cu < 1)
            fprintf(stderr, "kernel_launch: note: occupancy query reports %d workgroups per CU\n", per_cu);
        (void)hipGetLastError();
        grid = cus;
    }
    if (grid < 0) return;
    if (hipMemsetAsync((char*)d_ws + WS_CTL, 0, CTL_ZERO_BYTES, stream) != hipSuccess) { fprintf(stderr, "kernel_launch: memset failed\n"); return; }
    Args a{};
    for (int i = 0; i < N_IN; ++i) a.in[i] = (const float*)d_in[i];
    a.out = (float*)d_out; a.ws = (unsigned char*)d_ws; a.pad = REP_MASK;
    constexpr int STOP = MK_STOP;
#if MK_MULTI
    for (int p = 0; p < STOP; ++p) { a.ph_lo = p; a.ph_hi = p + 1; a.dump = 0; hipLaunchKernelGGL(mk_fwd, dim3(grid), dim3(NWAVES * 64), LDS_BYTES, stream, a); }
    if (STOP < N_PHASES) { a.ph_lo = 0; a.ph_hi = 0; a.dump = 1; hipLaunchKernelGGL(mk_fwd, dim3(grid), dim3(NWAVES * 64), LDS_BYTES, stream, a); }
#else
    a.ph_lo = 0; a.ph_hi = STOP; a.dump = (STOP < N_PHASES) ? 1 : 0;
    hipLaunchKernelGGL(mk_fwd, dim3(grid), dim3(NWAVES * 64), LDS_BYTES, stream, a);
#endif
    const hipError_t le = hipPeekAtLastError();
    if (le != hipSuccess) fprintf(stderr, "kernel_launch: launch failed: %s\n", hipGetErrorName(le));
}
```

```cpp
#include <hip/hip_runtime.h>
#include <cstdio>
#include <cstdint>

#define GAS __attribute__((address_space(1)))
#define LAS __attribute__((address_space(3)))

constexpr int D = 1024, NB = 2, SEQ = 16384, NCTX = 256, SB = SEQ + NCTX  , T = NB * SB  ;
constexpr int NE = 32, TOPK = 4, DFF = 1024;
constexpr int MAXTILES = T * TOPK / 256 + NE;
constexpr int CROWS = MAXTILES * 256;
constexpr float RMS_EPS = 1e-6f;
constexpr float LAM_INIT = 0.55605818f;
constexpr float LOG2_THETA = 13.287712379549449f;
constexpr float INV_2PI = 0.15915494309189535f;
constexpr float OS_GQA = 32.f, OS_DIFF = 16.f, OS_CONV = 4.f;

enum { I_X = 0, I_C, I_CTX, I_CCTX, I_MODW, I_MODB, I_NORMG, I_POOLW, I_POOLS, I_GQKV, I_GO, I_GQG, I_GKG, I_CIN, I_CDW, I_COUT, I_DQKV, I_DO, I_DLAM, I_DSUB,
       I_RW, I_RB, I_W1, I_B1, I_W2, I_B2, N_IN };

constexpr size_t MiB = 1u << 20;
constexpr size_t WS_CTL = 0, CTL_ZERO_BYTES = 1 * MiB;
constexpr size_t WS_MOD = 1 * MiB;
constexpr size_t WS_POOLW = 2 * MiB;
constexpr size_t WS_GQKV = 3 * MiB;
constexpr size_t WS_GO = 6 * MiB;
constexpr size_t WS_CIN = 8 * MiB;
constexpr size_t WS_COUT = 14 * MiB;
constexpr size_t WS_DQKV = 16 * MiB;
constexpr size_t WS_DO = 22 * MiB;
constexpr size_t WS_GATE = 24 * MiB;
constexpr size_t WS_B1H = 25 * MiB;
constexpr size_t WS_B2H = WS_B1H + 512 * 1024;
constexpr size_t WS_LIST = 26 * MiB;
constexpr size_t WS_W1T = 32 * MiB;
constexpr size_t WS_W2T = WS_W1T + 512 * MiB;
constexpr size_t WS_X = WS_W2T + 256 * MiB;
constexpr size_t WS_H = WS_X + 130 * MiB;
constexpr size_t WS_G = WS_H + 65 * MiB;
constexpr size_t WS_O = WS_G + 195 * MiB;
constexpr size_t WS_OA = WS_O + 65 * MiB;
constexpr size_t WS_OB = WS_OA + 65 * MiB;
constexpr size_t WS_Y = WS_OB + 65 * MiB;
constexpr size_t WS_HS = WS_Y + 65 * MiB;
constexpr size_t WS_ACT = WS_HS + 276 * MiB;
constexpr size_t WS_SLOT = WS_ACT + 276 * MiB;
constexpr size_t WS_Q8 = WS_SLOT + 260 * MiB;
constexpr size_t WS_K8 = WS_Q8 + 33 * MiB;
constexpr size_t WS_VT8 = WS_K8 + 33 * MiB;
constexpr size_t WS_END = WS_VT8 + 33 * MiB;
static_assert(((size_t)T * 4 + 256) * 1024 <= 260 * MiB, "slot junk rows");
static_assert((size_t)T * 1024 <= 33 * MiB && (size_t)NB * 8 * 128 * SB <= 33 * MiB, "ws map fp8");
static_assert((size_t)T * D * 4 <= 130 * MiB && (size_t)T * D * 2 <= 65 * MiB && (size_t)T * 3072 * 2 <= 195 * MiB && (size_t)CROWS * D * 2 <= 276 * MiB && (size_t)T * 4 * D * 2 <= 260 * MiB, "ws map");
static_assert((size_t)NE * T * 4 <= 6 * MiB && (size_t)CROWS * 4 <= 1 * MiB && (size_t)T * 4 * 4 <= 1 * MiB && 4 * 3 * 6144 * 4 <= 1 * MiB, "ws map small");
constexpr int CW_CNT = 64;
constexpr int CW_BAR = 4096;

constexpr int RING_BYTES = 131072;
constexpr int LC_MISC = RING_BYTES;
constexpr int LC_CNT = LC_MISC + 64;
constexpr int LC_TBASE = LC_CNT + 128;
constexpr int LC_LCNT = LC_TBASE + 192;
constexpr int LC_GBASE = LC_LCNT + 128;
constexpr int LC_TILEE = LC_GBASE + 128;
constexpr int LC_TOK16 = LC_TILEE + MAXTILES * 4;
constexpr int MAXU = 26;
constexpr int LDS_BYTES = 147456;
static_assert(LC_TOK16 % 16 == 0 && LC_TOK16 + MAXU * 512 <= LDS_BYTES, "LDS map");

typedef unsigned short bf16_t;
typedef float f32x4 __attribute__((ext_vector_type(4)));
typedef float f32x2 __attribute__((ext_vector_type(2)));
typedef unsigned u32x2 __attribute__((ext_vector_type(2)));
typedef unsigned u32x4 __attribute__((ext_vector_type(4)));

__device__ __forceinline__ unsigned pkbf(float lo, float hi) { unsigned r; asm("v_cvt_pk_bf16_f32 %0, %1, %2" : "=v"(r) : "v"(lo), "v"(hi)); return r; }
__device__ __forceinline__ float bflo(unsigned w) { return __uint_as_float(w << 16); }
__device__ __forceinline__ float bfhi(unsigned w) { return __uint_as_float(w & 0xffff0000u); }
__device__ __forceinline__ float wave_sum(float v) {
#pragma unroll
    for (int o = 1; o < 64; o <<= 1) v += __shfl_xor(v, o);
    return v;
}
#define LDS_WAIT() asm volatile("s_waitcnt lgkmcnt(0)" ::: "memory")
#define VM_WAIT() asm volatile("s_waitcnt vmcnt(0)" ::: "memory")

namespace pg8 {
#define PG8_LAS __attribute__((address_space(3)))
typedef unsigned short bf16_t;
typedef short bf16x8 __attribute__((ext_vector_type(8)));
typedef float f32x4 __attribute__((ext_vector_type(4)));
typedef unsigned u32x4 __attribute__((ext_vector_type(4)));
typedef int i32x4 __attribute__((ext_vector_type(4)));
typedef int i32x8 __attribute__((ext_vector_type(8)));
typedef unsigned u32x2 __attribute__((ext_vector_type(2)));
constexpr int BM = 256, BK = 64, HALF = 128, HTB = HALF * BK * 2  , STAGE_BYTES = 8 * HTB, NXCD = 8, WGM = 8;

__host__ __device__ __forceinline__ int lds_byte(int r, int c) { const int st = (r >> 4) * 2 + (c >> 5), rr = r & 15, cc = c & 31, ob = rr * 64 + cc * 2; return st * 1024 + (ob ^ (((ob >> 9) & 1) << 5)); }
__host__ __device__ __forceinline__ void stage_rc(int b, int& R, int& C) { const int st = b / 1024, sb = b % 1024, swz = sb ^ (((sb >> 9) & 1) << 5); R = (st >> 1) * 16 + swz / 64; C = (st & 1) * 32 + (swz % 64) / 2; }
__host__ __device__ __forceinline__ int perm32(int rho) { const int n = rho >> 4, i = rho & 15; return 8 * (i >> 2) + 4 * n + (i & 3); }

struct Unit { int pm, pn; };
struct Gemm { const bf16_t* A; const bf16_t* Bt; int M, N, K; };

struct StaticOrder {
    int nM, nN, nwg, G, c;
    __host__ __device__ void init(int M, int N, int G_, int c_) { nM = M / BM; nN = N / BM; nwg = nM * nN; G = G_; c = c_; }
    __host__ __device__ bool next(int i, Unit& u) const {
        const long L = (long)i * G + c; if (L >= nwg) return false;
        int wgid = (int)L; { const int q = nwg / NXCD, r = nwg % NXCD, xcd = wgid % NXCD, off = wgid / NXCD; wgid = (xcd < r ? xcd * (q + 1) : r * (q + 1) + (xcd - r) * q) + off; }
        const int nig = WGM * nN, gid = wgid / nig, fm = gid * WGM, gsz = (nM - fm) < WGM ? (nM - fm) : WGM;
        u.pm = fm + ((wgid % nig) % gsz); u.pn = (wgid % nig) / gsz; return true;
    }
    __device__ __forceinline__ void a_ready(const Unit&) const {}
    __device__ __forceinline__ void done(const Unit&) const {}
};


struct PoolOrder {
    int G, c;
    __device__ __forceinline__ bool next(int i, Unit& u) const { const int L = i * G + c; if (L >= 4 * 130) return false; const int g = L & 3, pm = L >> 2; u.pm = g * 130 + pm; u.pn = g; return true; }
    __device__ __forceinline__ void a_ready(const Unit&) const {}
    __device__ __forceinline__ void done(const Unit&) const {}
};
struct LatentOrder {
    StaticOrder S;
    __device__ void init(int N, int G_, int c_) { S.init(NB * SEQ, N, G_, c_); }
    __device__ bool next(int i, Unit& u) const { if (!S.next(i, u)) return false; u.pm += (u.pm >= SEQ / 256) ? 2 : 1; return true; }
    __device__ __forceinline__ void a_ready(const Unit&) const {}
    __device__ __forceinline__ void done(const Unit&) const {}
};
struct MoeOrder {
    const PG8_LAS int* tile_e; int lim, nN, G, c;
    __device__ __forceinline__ bool next(int i, Unit& u) const { const int L = i * G + c; if (L >= lim) return false; const int pm = L / nN, pl = L - pm * nN; u.pm = pm; u.pn = tile_e[pm] * nN + pl; return true; }
    __device__ __forceinline__ void a_ready(const Unit&) const {}
    __device__ __forceinline__ void done(const Unit&) const {}
};

__device__ __forceinline__ unsigned cvt_pk_bf16(float lo, float hi) { unsigned r; asm volatile("v_cvt_pk_bf16_f32 %0, %1, %2" : "=v"(r) : "v"(lo), "v"(hi)); return r; }

template <bool POOL> struct EpiPlainT {
    static constexpr bool PERM = true, AFTER_DRAIN = false, HAS_PRE = false; struct Pre {}; static constexpr int NST = 16;
    bf16_t* O; int ldc;
    __device__ __forceinline__ void operator()(const f32x4 (&acc)[2][2][4][2], const Unit& u, int wr, int wc, int fr, int fq) const {
        const int rt = POOL ? (u.pm - 130 * u.pn) : u.pm;
        const int row0 = rt * BM + wr * 64 + fr, col0 = u.pn * BM + wc * 32 + 8 * fq;
#pragma unroll
        for (int ai = 0; ai < 2; ++ai)
#pragma unroll
            for (int m = 0; m < 4; ++m) { bf16_t* rowp = O + (size_t)(row0 + ai * HALF + m * 16) * ldc + col0;
#pragma unroll
                for (int bj = 0; bj < 2; ++bj) { const f32x4 v0 = acc[ai][bj][m][0], v1 = acc[ai][bj][m][1];
                    u32x4 w; w.x = cvt_pk_bf16(v0[0], v0[1]); w.y = cvt_pk_bf16(v0[2], v0[3]); w.z = cvt_pk_bf16(v1[0], v1[1]); w.w = cvt_pk_bf16(v1[2], v1[3]);
                    *(u32x4*)(rowp + bj * HALF) = w; } }
    }
};
struct EpiScaled {
    static constexpr bool PERM = true, AFTER_DRAIN = false, HAS_PRE = false; struct Pre {}; static constexpr int NST = 16;
    bf16_t* O; int ldc; float asc;
    __device__ __forceinline__ void operator()(const f32x4 (&acc)[2][2][4][2], const Unit& u, int wr, int wc, int fr, int fq) const {
        const int row0 = u.pm * BM + wr * 64 + fr, col0 = u.pn * BM + wc * 32 + 8 * fq;
#pragma unroll
        for (int ai = 0; ai < 2; ++ai)
#pragma unroll
            for (int m = 0; m < 4; ++m) { bf16_t* rowp = O + (size_t)(row0 + ai * HALF + m * 16) * ldc + col0;
#pragma unroll
                for (int bj = 0; bj < 2; ++bj) { const f32x4 v0 = acc[ai][bj][m][0] * asc, v1 = acc[ai][bj][m][1] * asc;
                    u32x4 w; w.x = cvt_pk_bf16(v0[0], v0[1]); w.y = cvt_pk_bf16(v0[2], v0[3]); w.z = cvt_pk_bf16(v1[0], v1[1]); w.w = cvt_pk_bf16(v1[2], v1[3]);
                    *(u32x4*)(rowp + bj * HALF) = w; } }
    }
};
typedef EpiPlainT<false> EpiPlain;
typedef EpiPlainT<true> EpiPool;
template <int CHEAP> struct EpiSwiGLUT {
    static constexpr bool PERM = true, AFTER_DRAIN = false; static constexpr int NST = (CHEAP == 2) ? 0 : 4;
    unsigned char* ACT; const bf16_t* b1h; float asc;
    static constexpr bool HAS_PRE = true; struct Pre { u32x4 bg, bu; };
    __device__ __forceinline__ void pre(const Unit& u, int wc, int fq, Pre& p) const {
        const int e = u.pn >> 3, pl = u.pn & 7, oc0 = pl * 128 + wc * 32 + 8 * fq;
        const bf16_t* a = b1h + e * 2048 + oc0;
        asm volatile("global_load_dwordx4 %0, %1, off" : "=v"(p.bg) : "v"(a) : "memory");
        asm volatile("global_load_dwordx4 %0, %1, off offset:2048" : "=v"(p.bu) : "v"(a) : "memory");
    }
    __device__ __forceinline__ void operator()(const f32x4 (&acc)[2][2][4][2], const Unit& u, int wr, int wc, int fr, int fq, const Pre& p) const {
        if constexpr (CHEAP == 2) return;
        const int pl = u.pn & 7;
        const int row0 = u.pm * BM + wr * 64 + fr, oc0 = pl * 128 + wc * 32 + 8 * fq;
        f32x4 bg[2], bu[2];
#pragma unroll
        for (int n = 0; n < 2; ++n) { bg[n] = (f32x4){__uint_as_float(p.bg[2 * n] << 16), __uint_as_float(p.bg[2 * n] & 0xffff0000u), __uint_as_float(p.bg[2 * n + 1] << 16), __uint_as_float(p.bg[2 * n + 1] & 0xffff0000u)};
            bu[n] = (f32x4){__uint_as_float(p.bu[2 * n] << 16), __uint_as_float(p.bu[2 * n] & 0xffff0000u), __uint_as_float(p.bu[2 * n + 1] << 16), __uint_as_float(p.bu[2 * n + 1] & 0xffff0000u)} + 1.0f; }
#pragma unroll
        for (int ai = 0; ai < 2; ++ai)
#pragma unroll
            for (int mp = 0; mp < 2; ++mp) {
                unsigned w[2][2];
#pragma unroll
                for (int mm = 0; mm < 2; ++mm) { const int m = 2 * mp + mm; float o[8];
#pragma unroll
                    for (int n = 0; n < 2; ++n) {
#pragma unroll
                        for (int jp = 0; jp < 2; ++jp) { typedef float f2e __attribute__((ext_vector_type(2)));
                            const f32x4 ag = acc[ai][0][m][n], au = acc[ai][1][m][n];
                            const f2e a2 = {asc, asc};
                            f2e gv = (f2e){ag[2 * jp], ag[2 * jp + 1]} * a2 + (f2e){bg[n][2 * jp], bg[n][2 * jp + 1]};
                            f2e uv = (f2e){au[2 * jp], au[2 * jp + 1]} * a2 + (f2e){bu[n][2 * jp], bu[n][2 * jp + 1]};
                            gv.x = fminf(gv.x, 7.0f); gv.y = fminf(gv.y, 7.0f);
                            uv.x = fminf(fmaxf(uv.x, -6.0f), 8.0f); uv.y = fminf(fmaxf(uv.y, -6.0f), 8.0f);
                            const f2e tt = gv * (f2e){-1.702f * 1.4426950408889634f, -1.702f * 1.4426950408889634f};
                            f2e dd = (f2e){(CHEAP != 0) ? 1.0f : __builtin_amdgcn_exp2f(tt.x), (CHEAP != 0) ? 1.0f : __builtin_amdgcn_exp2f(tt.y)} + (f2e){1.0f, 1.0f};
                            const f2e sg = {(CHEAP != 0) ? 0.5f : __builtin_amdgcn_rcpf(dd.x), (CHEAP != 0) ? 0.5f : __builtin_amdgcn_rcpf(dd.y)};
                            const f2e oo = (gv * sg) * uv;
                            o[4 * n + 2 * jp] = oo.x; o[4 * n + 2 * jp + 1] = oo.y; } }
                    int w0 = 0, w1 = 0; w0 = __builtin_amdgcn_cvt_pk_fp8_f32(o[0], o[1], w0, false); w0 = __builtin_amdgcn_cvt_pk_fp8_f32(o[2], o[3], w0, true);
                    w1 = __builtin_amdgcn_cvt_pk_fp8_f32(o[4], o[5], w1, false); w1 = __builtin_amdgcn_cvt_pk_fp8_f32(o[6], o[7], w1, true);
                    w[mm][0] = (unsigned)w0; w[mm][1] = (unsigned)w1; }
                const auto lo = __builtin_amdgcn_permlane16_swap(w[0][0], w[1][0], false, false), hi2 = __builtin_amdgcn_permlane16_swap(w[0][1], w[1][1], false, false);
                const int m = 2 * mp + (fq & 1);
                *(u32x4*)(ACT + (size_t)(row0 + ai * HALF + m * 16) * 1024 + (oc0 & ~15)) = (u32x4){lo[0], hi2[0], lo[1], hi2[1]}; }
    }
};
typedef EpiSwiGLUT<0> EpiSwiGLU;
struct EpiScatter {
    static constexpr bool PERM = true, AFTER_DRAIN = false;
    static constexpr int NST = 8;
    unsigned char* SLOT; const PG8_LAS int* slot_tab; int G, c; const bf16_t* b2h; float asc; int seq; int junk0;
    static constexpr bool HAS_PRE = true; struct Pre { u32x4 bv[2]; };
    __device__ __forceinline__ void pre(const Unit& u, int wc, int fq, Pre& p) const {
        const int e = u.pn >> 2, pl = u.pn & 3, col0 = pl * BM + wc * 32 + 8 * fq;
        const bf16_t* a = b2h + e * 1024 + col0;
        asm volatile("global_load_dwordx4 %0, %1, off" : "=v"(p.bv[0]) : "v"(a) : "memory");
        asm volatile("global_load_dwordx4 %0, %1, off offset:256" : "=v"(p.bv[1]) : "v"(a) : "memory");
    }
    __device__ __forceinline__ void operator()(const f32x4 (&acc)[2][2][4][2], const Unit& u, int wr, int wc, int fr, int fq, const Pre& p) const {
        const int pl = u.pn & 3, ui = (u.pm * 4 + pl - c) / G;
        const int col0 = pl * BM + wc * 32 + 8 * fq;
        f32x4 bv[2][2];
#pragma unroll
        for (int bj = 0; bj < 2; ++bj)
#pragma unroll
            for (int n = 0; n < 2; ++n) bv[bj][n] = (f32x4){__uint_as_float(p.bv[bj][2 * n] << 16), __uint_as_float(p.bv[bj][2 * n] & 0xffff0000u), __uint_as_float(p.bv[bj][2 * n + 1] << 16), __uint_as_float(p.bv[bj][2 * n + 1] & 0xffff0000u)};
#pragma unroll
        for (int ai = 0; ai < 2; ++ai)
#pragma unroll
            for (int mp = 0; mp < 2; ++mp) {
                const int m = 2 * mp + (fq & 1), rit = wr * 64 + fr + ai * HALF + m * 16;
                int slot = seq ? (u.pm * BM + rit) : slot_tab[ui * BM + rit];
                if (slot < 0) slot = junk0 + rit;
#pragma unroll
                for (int bj = 0; bj < 2; ++bj) { unsigned w[2][2];
#pragma unroll
                    for (int mm = 0; mm < 2; ++mm) { const f32x4 v0 = acc[ai][bj][2 * mp + mm][0] * asc + bv[bj][0], v1 = acc[ai][bj][2 * mp + mm][1] * asc + bv[bj][1];
                        int w0 = 0, w1 = 0; w0 = __builtin_amdgcn_cvt_pk_fp8_f32(v0[0], v0[1], w0, false); w0 = __builtin_amdgcn_cvt_pk_fp8_f32(v0[2], v0[3], w0, true);
                        w1 = __builtin_amdgcn_cvt_pk_fp8_f32(v1[0], v1[1], w1, false); w1 = __builtin_amdgcn_cvt_pk_fp8_f32(v1[2], v1[3], w1, true);
                        w[mm][0] = (unsigned)w0; w[mm][1] = (unsigned)w1; }
                    const auto lo = __builtin_amdgcn_permlane16_swap(w[0][0], w[1][0], false, false), hi2 = __builtin_amdgcn_permlane16_swap(w[0][1], w[1][1], false, false);
                    *(u32x4*)(SLOT + (size_t)slot * 1024 + (col0 & ~15) + bj * HALF) = (u32x4){lo[0], hi2[0], lo[1], hi2[1]}; }
            }
    }
};

template <class Epi, class Sched, bool ALIGN_EPI = false, bool SP2 = false, int ES = 2, bool GATHER = false, int PRB = 0>
__device__ __forceinline__ void gemm_phase(PG8_LAS unsigned char* lds, const Gemm g, const Sched& S, const Epi& E, const PG8_LAS unsigned short* tok16 = nullptr) {
    static_assert(SP2 || !GATHER, "GATHER is implemented for the SP2 loop");
    int tid_ = threadIdx.x; asm volatile("" : "+v"(tid_));
    const int tid = tid_, wid = __builtin_amdgcn_readfirstlane(tid >> 6), lane = tid & 63, wr = wid >> 2, wc = wid & 3, fr = lane & 15, fq = lane >> 4;
    const int K = g.K, nt = K * ES / (BK * 2);
    unsigned voffA[2], voffB[2]; int rowA[2]; unsigned colA[2];
#pragma unroll
    for (int i = 0; i < 2; ++i) { int R, C; stage_rc(tid * 16 + i * 8192, R, C); const int Rb = Epi::PERM ? ((R & ~31) + perm32(R & 31)) : R;
        voffA[i] = (unsigned)(R * K * ES + C * 2); voffB[i] = (unsigned)(Rb * K * ES + C * 2); rowA[i] = R; colA[i] = (unsigned)(C * 2); }
    const size_t kstep = (size_t)(BK * 2);
    const size_t hstep = (size_t)HALF * K * ES;
    const size_t hstepA = GATHER ? 0 : hstep;
    const size_t tstep = 2 * hstep;
    const unsigned ldsw = (unsigned)wid * 1024u;
    const int aoff = lds_byte(wr * 64 + fr, fq * 8), boff = lds_byte(wc * 32 + fr, fq * 8);
#define PG8_SA(b, h) (((b) * 2 + (h)) * HTB)
#define PG8_SB(b, h) ((4 + (b) * 2 + (h)) * HTB)
#define PG8_STAGE(bufoff, gbase, voff) do { _Pragma("unroll") for (int _i = 0; _i < 2; ++_i) \
        __builtin_amdgcn_global_load_lds((const unsigned*)((const char*)(gbase) + (voff)[_i]), (PG8_LAS unsigned*)(lds + (bufoff) + ldsw + _i * 8192), 16, 0, 0); } while (0)
#define PG8_GOFF(dst, ui_) do { _Pragma("unroll") for (int _h = 0; _h < 2; ++_h) _Pragma("unroll") for (int _i = 0; _i < 2; ++_i) dst[_h][_i] = (unsigned)tok16[(ui_) * 256 + _h * HALF + rowA[_i]] * (unsigned)(K * ES) + colA[_i]; } while (0)
#define PG8_STAGE_A(bufoff, gbase, h, usenext) do { if constexpr (GATHER) { _Pragma("unroll") for (int _i = 0; _i < 2; ++_i) { const unsigned vo_ = (usenext) ? goffN[h][_i] : goffC[h][_i]; \
        __builtin_amdgcn_global_load_lds((const unsigned*)((const char*)(gbase) + vo_), (PG8_LAS unsigned*)(lds + (bufoff) + ldsw + _i * 8192), 16, 0, 0); } } else PG8_STAGE(bufoff, gbase, voffA); } while (0)
#define PG8_LDA(dst, b, h) do { _Pragma("unroll") for (int m = 0; m < 4; ++m) _Pragma("unroll") for (int k = 0; k < 2; ++k) dst[m][k] = *(const PG8_LAS bf16x8*)(lds + PG8_SA(b, h) + aoff + m * 2048 + k * 1024); } while (0)
#define PG8_LDB(dst, b, h) do { _Pragma("unroll") for (int n = 0; n < 2; ++n) _Pragma("unroll") for (int k = 0; k < 2; ++k) dst[n][k] = *(const PG8_LAS bf16x8*)(lds + PG8_SB(b, h) + boff + n * 2048 + k * 1024); } while (0)
#define PG8_CAT8(lo, hi) __builtin_shufflevector(__builtin_bit_cast(i32x4, lo), __builtin_bit_cast(i32x4, hi), 0, 1, 2, 3, 4, 5, 6, 7)
#define PG8_MFMA8(accv, bv, av) asm volatile("v_mfma_scale_f32_16x16x128_f8f6f4 %0, %1, %2, %0, %3, %3 op_sel_hi:[0,0,0]" : "+v"(accv) : "v"(bv), "v"(av), "v"(sc1))
#define PG8_MMA(ai, bj, At, Bt) do { if constexpr (PRB == 1) break; __builtin_amdgcn_s_setprio(1); if constexpr (ES == 2) { _Pragma("unroll") for (int m = 0; m < 4; ++m) _Pragma("unroll") for (int n = 0; n < 2; ++n) _Pragma("unroll") for (int k = 0; k < 2; ++k) \
        acc[ai][bj][m][n] = __builtin_amdgcn_mfma_f32_16x16x32_bf16(Bt[n][k], At[m][k], acc[ai][bj][m][n], 0, 0, 0); } else { _Pragma("unroll") for (int m = 0; m < 4; ++m) _Pragma("unroll") for (int n = 0; n < 2; ++n) { \
        const i32x8 b8_ = PG8_CAT8(Bt[n][0], Bt[n][1]), a8_ = PG8_CAT8(At[m][0], At[m][1]); PG8_MFMA8(acc[ai][bj][m][n], b8_, a8_); } } __builtin_amdgcn_s_setprio(0); } while (0)
#define PG8_WAIT_V(n) asm volatile("s_waitcnt vmcnt(" #n ")" ::: "memory")
#define PG8_WAIT_L(n) asm volatile("s_waitcnt lgkmcnt(" #n ")" ::: "memory")
#define PG8_BAR __builtin_amdgcn_s_barrier()
#define PG8_SCHED __builtin_amdgcn_sched_barrier(0)
    Unit cur, nxt; int ui = 0; typename Epi::Pre epre;
    if (!S.next(0, cur)) return;
    int sc1 = 0x7f7f7f7f; asm volatile("" : "+v"(sc1));
    f32x4 acc[2][2][4][2];
#pragma unroll
    for (int a = 0; a < 2; ++a)
#pragma unroll
        for (int b = 0; b < 2; ++b)
#pragma unroll
            for (int m = 0; m < 4; ++m)
#pragma unroll
                for (int n = 0; n < 2; ++n) acc[a][b][m][n] = (f32x4){0.f, 0.f, 0.f, 0.f};
    bf16x8 At[4][2], B0[2][2], B1[2][2];
    const char* cA = (const char*)g.A + (GATHER ? (size_t)0 : (size_t)cur.pm * tstep); const char* cB = (const char*)g.Bt + (size_t)cur.pn * tstep;
    unsigned goffC[2][2] = {{0u, 0u}, {0u, 0u}}, goffN[2][2] = {{0u, 0u}, {0u, 0u}};
    if constexpr (GATHER) PG8_GOFF(goffC, 0);
    S.a_ready(cur);
    if constexpr (SP2) {
        PG8_STAGE(PG8_SB(0, 0), cB, voffB); PG8_STAGE(PG8_SB(0, 1), cB + hstep, voffB); PG8_STAGE_A(PG8_SA(0, 0), cA, 0, false); PG8_STAGE_A(PG8_SA(0, 1), cA + hstepA, 1, false);
        if (wr == 1) PG8_BAR;
        PG8_WAIT_V(2); PG8_BAR;
        PG8_STAGE(PG8_SB(1, 0), cB + kstep, voffB); PG8_STAGE_A(PG8_SA(1, 0), cA + kstep, 0, false); PG8_STAGE(PG8_SB(1, 1), cB + hstep + kstep, voffB);
        PG8_WAIT_V(6); PG8_BAR;
    } else {
        PG8_STAGE(PG8_SB(0, 0), cB, voffB); PG8_STAGE(PG8_SA(0, 0), cA, voffA); PG8_STAGE(PG8_SB(0, 1), cB + hstep, voffB); PG8_STAGE(PG8_SA(0, 1), cA + hstep, voffA);
        if (wr == 1) PG8_BAR;
        PG8_WAIT_V(4); PG8_BAR;
        PG8_STAGE(PG8_SB(1, 0), cB + kstep, voffB); PG8_STAGE(PG8_SA(1, 0), cA + kstep, voffA); PG8_STAGE(PG8_SB(1, 1), cB + hstep + kstep, voffB);
        PG8_WAIT_V(6); PG8_BAR;
    }
    bool seam = false;
#define PG8_WAIT_VX(rx_) asm volatile("v_cmp_ne_u32_e32 vcc, 0, %0\n\ts_cbranch_vccz 1f\n\ts_waitcnt vmcnt(%1)\n\ts_branch 2f\n1:\n\ts_waitcnt vmcnt(8)\n2:" :: "v"(rx_), "n"(8 + Epi::NST) : "memory", "vcc")
    for (;;) {
        const bool has_next = S.next(ui + 1, nxt);
        const char* nA = (has_next && !GATHER) ? (const char*)g.A + (size_t)nxt.pm * tstep : cA;
        const char* nB = has_next ? (const char*)g.Bt + (size_t)nxt.pn * tstep : cB;
        for (int t = 0; t < nt; t += 2) {
            const bool last = (t == nt - 2);
            const int rx = (SP2 && seam && t == 0) ? 1 : 0;
            const char* a1 = cA + (size_t)(t + 1) * kstep;
            const char* a2 = last ? nA : cA + (size_t)(t + 2) * kstep; const char* b2 = last ? nB : cB + (size_t)(t + 2) * kstep;
            const char* a3 = a2 + kstep; const char* b3 = b2 + kstep;
            if (last && has_next) S.a_ready(nxt);
            if constexpr (Epi::HAS_PRE) { if (last) E.pre(cur, wc, fq, epre); }
            if constexpr (GATHER) { if (last) { if (has_next) PG8_GOFF(goffN, ui + 1); else { _Pragma("unroll") for (int _h = 0; _h < 2; ++_h) _Pragma("unroll") for (int _i = 0; _i < 2; ++_i) goffN[_h][_i] = goffC[_h][_i]; } } }
            if constexpr (SP2) {
            PG8_LDB(B0, 0, 0); PG8_LDB(B1, 0, 1); PG8_SCHED; PG8_LDA(At, 0, 0); PG8_STAGE_A(PG8_SA(1, 1), a1 + hstepA, 1, false);
            PG8_WAIT_VX(rx); PG8_WAIT_L(0); PG8_BAR; PG8_MMA(0, 0, At, B0); PG8_MMA(0, 1, At, B1); PG8_BAR; PG8_SCHED;
            PG8_LDA(At, 0, 1); PG8_STAGE(PG8_SB(0, 0), b2, voffB); PG8_STAGE(PG8_SB(0, 1), b2 + hstep, voffB); PG8_STAGE_A(PG8_SA(0, 0), a2, 0, last);
            PG8_WAIT_VX(rx); PG8_WAIT_L(0); PG8_BAR; PG8_MMA(1, 0, At, B0); PG8_MMA(1, 1, At, B1); PG8_BAR; PG8_SCHED;
            PG8_LDB(B0, 1, 0); PG8_LDB(B1, 1, 1); PG8_SCHED; PG8_LDA(At, 1, 0); PG8_STAGE_A(PG8_SA(0, 1), a2 + hstepA, 1, last);
            PG8_WAIT_V(8); PG8_WAIT_L(0); PG8_BAR; PG8_MMA(0, 0, At, B0); PG8_MMA(0, 1, At, B1); PG8_BAR; PG8_SCHED;
            PG8_LDA(At, 1, 1); PG8_STAGE(PG8_SB(1, 0), b3, voffB); PG8_STAGE(PG8_SB(1, 1), b3 + hstep, voffB); PG8_STAGE_A(PG8_SA(1, 0), a3, 0, last);
            PG8_WAIT_V(8); PG8_WAIT_L(0); PG8_BAR; PG8_MMA(1, 0, At, B0); PG8_MMA(1, 1, At, B1); PG8_BAR; PG8_SCHED;
            } else {
            PG8_LDB(B0, 0, 0); PG8_SCHED; PG8_LDA(At, 0, 0); PG8_STAGE(PG8_SA(1, 1), a1 + hstep, voffA);
            PG8_WAIT_L(8); PG8_BAR; PG8_WAIT_L(0); PG8_MMA(0, 0, At, B0); PG8_BAR; PG8_SCHED;
            PG8_LDB(B1, 0, 1); PG8_STAGE(PG8_SB(0, 0), b2, voffB);
            PG8_BAR; PG8_WAIT_L(0); PG8_MMA(0, 1, At, B1); PG8_BAR;
            PG8_LDA(At, 0, 1); PG8_STAGE(PG8_SA(0, 0), a2, voffA);
            PG8_BAR; PG8_WAIT_L(0); PG8_MMA(1, 0, At, B0); PG8_BAR; PG8_SCHED;
            PG8_STAGE(PG8_SB(0, 1), b2 + hstep, voffB);
            PG8_WAIT_V(6); PG8_BAR; PG8_MMA(1, 1, At, B1); PG8_BAR;
            PG8_LDB(B0, 1, 0); PG8_SCHED; PG8_LDA(At, 1, 0); PG8_STAGE(PG8_SA(0, 1), a2 + hstep, voffA);
            PG8_WAIT_L(8); PG8_BAR; PG8_WAIT_L(0); PG8_MMA(0, 0, At, B0); PG8_BAR; PG8_SCHED;
            PG8_LDB(B1, 1, 1); PG8_STAGE(PG8_SB(1, 0), b3, voffB);
            PG8_BAR; PG8_WAIT_L(0); PG8_MMA(0, 1, At, B1); PG8_BAR;
            PG8_LDA(At, 1, 1); PG8_STAGE(PG8_SA(1, 0), a3, voffA);
            PG8_BAR; PG8_WAIT_L(0); PG8_MMA(1, 0, At, B0); PG8_BAR; PG8_SCHED;
            PG8_STAGE(PG8_SB(1, 1), b3 + hstep, voffB);
            PG8_WAIT_V(6); PG8_BAR; PG8_MMA(1, 1, At, B1); PG8_BAR;
            }
        }
        if constexpr (ES == 1) { PG8_SCHED; asm volatile("s_nop 15\n\ts_nop 15" ::: "memory"); PG8_SCHED; }
        if constexpr (ALIGN_EPI) { if (wr == 0) PG8_BAR; }
        if constexpr (!Epi::AFTER_DRAIN) { if constexpr (Epi::HAS_PRE) E(acc, cur, wr, wc, fr, fq, epre); else E(acc, cur, wr, wc, fr, fq); S.done(cur); }
        if (!has_next) break;
#pragma unroll
        for (int a = 0; a < 2; ++a)
#pragma unroll
            for (int b = 0; b < 2; ++b)
#pragma unroll
                for (int m = 0; m < 4; ++m)
#pragma unroll
                    for (int n = 0; n < 2; ++n) acc[a][b][m][n] = (f32x4){0.f, 0.f, 0.f, 0.f};
        cur = nxt; cA = nA; cB = nB; ++ui; seam = SP2;
        if constexpr (GATHER) { _Pragma("unroll") for (int _h = 0; _h < 2; ++_h) _Pragma("unroll") for (int _i = 0; _i < 2; ++_i) goffC[_h][_i] = goffN[_h][_i]; }
        if constexpr (ALIGN_EPI) { if (wr == 1) PG8_BAR; }
    }
    PG8_WAIT_V(0);
    if constexpr (!ALIGN_EPI) { if (wr == 0) PG8_BAR; }
    PG8_BAR;
    if constexpr (Epi::AFTER_DRAIN) { E.fused(acc, cur, wr, wc, fr, fq, lds, wid, lane); S.done(cur); }
#undef PG8_SA
#undef PG8_SB
#undef PG8_STAGE
#undef PG8_STAGE_A
#undef PG8_GOFF
#undef PG8_LDA
#undef PG8_LDB
#undef PG8_MMA
#undef PG8_CAT8
#undef PG8_MFMA8
#undef PG8_WAIT_V
#undef PG8_WAIT_VX
#undef PG8_WAIT_L
#undef PG8_BAR
#undef PG8_SCHED
}
}

namespace att {
using f32x16 = __attribute__((ext_vector_type(16))) float;
__device__ __forceinline__ int crow(int r, int hi) { return (r & 3) + 8 * (r >> 2) + 4 * hi; }
__device__ __forceinline__ unsigned cvtpk(float lo, float hi) { unsigned r; asm volatile("v_cvt_pk_bf16_f32 %0, %1, %2" : "=v"(r) : "v"(lo), "v"(hi)); return r; }
}

namespace att8 {
using att::f32x16; using att::crow;
typedef int i32x4 __attribute__((ext_vector_type(4)));
typedef int i32x8 __attribute__((ext_vector_type(8)));
constexpr int NW = 8, QBLK = 32, KVBLK = 64;
#define SBAR() __builtin_amdgcn_sched_barrier(0)
template <int OFF> __device__ __forceinline__ i32x4 rd128(int a) { i32x4 r; asm volatile("ds_read_b128 %0, %1 offset:%2" : "=&v"(r) : "v"(a), "i"(OFF) : "memory"); return r; }
__device__ __forceinline__ i32x8 cat8(i32x4 lo, i32x4 hi) { return __builtin_shufflevector(lo, hi, 0, 1, 2, 3, 4, 5, 6, 7); }
__device__ __forceinline__ float mx3(float a, float b, float c) { float r; asm("v_max3_f32 %0, %1, %2, %3" : "=v"(r) : "v"(a), "v"(b), "v"(c)); return r; }
constexpr float CSC = 1.f / 65536.f;
template <bool FIRST>
__device__ __forceinline__ void softmax8(f32x16& p0, f32x16& p1, float& M_run, float& alpha, i32x8& pf) {
  constexpr float CTHR = (56.f + 8.f * (5.f * 1.4426950408889634f)) * CSC;
  float a0 = mx3(p0[0], p0[1], p0[2]), a1 = mx3(p0[8], p0[9], p0[10]), a2 = mx3(p1[0], p1[1], p1[2]), a3 = mx3(p1[8], p1[9], p1[10]);
  a0 = mx3(a0, p0[3], p0[4]); a1 = mx3(a1, p0[11], p0[12]); a2 = mx3(a2, p1[3], p1[4]); a3 = mx3(a3, p1[11], p1[12]);
  a0 = mx3(a0, p0[5], p0[6]); a1 = mx3(a1, p0[13], p0[14]); a2 = mx3(a2, p1[5], p1[6]); a3 = mx3(a3, p1[13], p1[14]);
  a0 = mx3(a0, p0[7], a1); a2 = mx3(a2, p1[7], a3);
  float cmax = mx3(a0, p0[15], a2); cmax = mx3(cmax, p1[15], cmax);
  { auto rr = __builtin_amdgcn_permlane32_swap(__float_as_uint(cmax), __float_as_uint(cmax), false, false); cmax = mx3(__uint_as_float(rr[0]), __uint_as_float(rr[1]), __uint_as_float(rr[1])); }
  alpha = 1.f;
  if (FIRST || !__builtin_expect(__all(cmax <= CTHR), 1)) {
    const float tmax = (cmax * 65536.f - 56.f) * 0.125f, d = FIRST ? tmax : fmaxf(tmax, 0.f), d8 = 8.f * d * CSC;
    alpha = __builtin_amdgcn_exp2f(-d); M_run += d;
#pragma unroll
    for (int r = 0; r < 16; ++r) { p0[r] -= d8; p1[r] -= d8; }
  }
  typedef unsigned short us2 __attribute__((ext_vector_type(2)));
#pragma unroll
  for (int w = 0; w < 4; ++w) { const unsigned A = __builtin_bit_cast(unsigned, __builtin_amdgcn_cvt_pknorm_u16(p0[4 * w], p0[4 * w + 1])), B = __builtin_bit_cast(unsigned, __builtin_amdgcn_cvt_pknorm_u16(p0[4 * w + 2], p0[4 * w + 3]));
    pf[w] = (int)__builtin_amdgcn_perm(B, A, 0x06040200u); }
#pragma unroll
  for (int w = 0; w < 4; ++w) { const unsigned A = __builtin_bit_cast(unsigned, __builtin_amdgcn_cvt_pknorm_u16(p1[4 * w], p1[4 * w + 1])), B = __builtin_bit_cast(unsigned, __builtin_amdgcn_cvt_pknorm_u16(p1[4 * w + 2], p1[4 * w + 3]));
    pf[4 + w] = (int)__builtin_amdgcn_perm(B, A, 0x06040200u); }
}

template <int DQK, int LDQ, int LDK, int LDO, bool DIFF, int PROBE = 0>
__device__ __forceinline__ void attn_body8(const unsigned char* __restrict__ Qb, const unsigned char* __restrict__ Kh, const unsigned char* __restrict__ VT, unsigned char* __restrict__ Ob, int seq, char* lds,
                                           int dmode, float lam, const float* __restrict__ subg) {
  constexpr int SHM_V = 128 * 64, SHM_K = 64 * DQK, SLOT = SHM_V + SHM_K, NS = DQK / 64;
  int tid_ = threadIdx.x; asm volatile("" : "+v"(tid_));
  const int tid = tid_, wid = __builtin_amdgcn_readfirstlane(tid >> 6), lane = tid & 63, r32 = lane & 31, hi = lane >> 5, half = wid >> 2;
  constexpr int RD = 4;
  float* ws = (float*)(lds + RD * SLOT) + wid * 64; float* al_l = ws + 32;
  int sc1 = 0x7f7f7f7f; asm volatile("" : "+v"(sc1));
  int scq = 0x6f6f6f6f; asm volatile("" : "+v"(scq));
  float M_run = 0.f; asm volatile("" : "+v"(M_run));
  f32x16 o[4] = {};
  typedef float f32x4_ __attribute__((ext_vector_type(4)));
  f32x4_ osum = {0.f, 0.f, 0.f, 0.f};
  i32x8 sel8;
  { const int onv = (((lane & 15) == 0 && ((lane >> 4) & 1) == 0) || ((lane & 15) == 1 && ((lane >> 4) & 1) == 1)) ? 0x38383838 : 0;
#pragma unroll
    for (int i = 0; i < 8; ++i) { int t_; asm volatile("v_mov_b32 %0, %1" : "=v"(t_) : "v"(onv)); sel8[i] = t_; } }
#define MFMA16S(acc4, a8, b8) asm volatile("v_mfma_scale_f32_16x16x128_f8f6f4 %0, %1, %2, %0, %3, %3 op_sel_hi:[0,0,0]" : "+v"(acc4) : "v"(a8), "v"(b8), "v"(sc1))
  i32x8 qf[NS];
  { const unsigned char* Qw = Qb + (long)(wid * QBLK + r32) * LDQ + hi * 32;
#pragma unroll
    for (int s = 0; s < NS; ++s) qf[s] = cat8(*reinterpret_cast<const i32x4*>(Qw + s * 64), *reinterpret_cast<const i32x4*>(Qw + s * 64 + 16)); }
  const int vrow = 16 * wid + (lane >> 2), vpc = lane & 3;
  const int krow = 8 * wid + ((DQK == 128) ? (lane >> 3) : ((lane >> 2) & 7)), kpc = (DQK == 128) ? (lane & 7) : (lane & 3);
  const unsigned char* vsrc = VT + (long)vrow * SB + ((vpc ^ ((vrow >> 2) & 3)) << 4);
  const unsigned char* ksrc = Kh + (long)krow * LDK + ((DQK == 128) ? ((kpc ^ ((krow >> 1) & 7)) << 4) : ((kpc ^ ((krow >> 2) & 3)) << 4));
  const bool kact = (DQK == 128) || (lane < 32);
  const unsigned ldv = (unsigned)__builtin_amdgcn_readfirstlane((int)(uintptr_t)lds + wid * 1024), ldk = (unsigned)__builtin_amdgcn_readfirstlane((int)(uintptr_t)lds + SHM_V + wid * (DQK == 128 ? 1024 : 512));
#define GLDS16(gsrc, ldst) do { unsigned keep_; asm volatile("s_mov_b32 %0, m0\n\ts_mov_b32 m0, %2\n\ts_nop 0\n\tglobal_load_lds_dwordx4 %1, off\n\ts_mov_b32 m0, %0" : "=&s"(keep_) : "v"(gsrc), "s"(ldst) : "memory"); } while (0)
#define SDMA8(t_, sl_) do { GLDS16(vsrc + (t_) * KVBLK, ldv + (unsigned)((sl_) * SLOT)); if (kact) GLDS16(ksrc + (long)((t_) * KVBLK) * LDK, ldk + (unsigned)((sl_) * SLOT)); } while (0)
#define VMWAIT8(n) asm volatile("s_waitcnt vmcnt(" #n ")" ::: "memory")
#define BARL8() do { SBAR(); asm volatile("s_waitcnt lgkmcnt(0)\n\ts_barrier" ::: "memory"); SBAR(); } while (0)
#define LWAIT8(n) do { asm volatile("s_waitcnt lgkmcnt(" #n ")" ::: "memory"); SBAR(); } while (0)
#define RESC8(a) do { if (__any((a) < 1.f)) { if (hi == 0) al_l[r32] = (a); asm volatile("s_waitcnt lgkmcnt(0)" ::: "memory"); \
    _Pragma("unroll") for (int g = 0; g < 4; ++g) { const f32x4 a4_ = *(const f32x4*)(al_l + 8 * g + 4 * hi);      \
      _Pragma("unroll") for (int i = 0; i < 4; ++i) { _Pragma("unroll") for (int d = 0; d < 4; ++d) o[d][4 * g + i] *= a4_[i]; } SBAR(); } \
    { const f32x4 a4_ = *(const f32x4*)(al_l + (lane & 1) * 16 + 4 * (lane >> 4)); _Pragma("unroll") for (int i = 0; i < 4; ++i) osum[i] *= a4_[i]; }     \
    CIN_SET8(); } } while (0)
#define MFMA8(acc, a8, b8) asm volatile("v_mfma_scale_f32_32x32x64_f8f6f4 %0, %1, %2, %0, %3, %3 op_sel_hi:[0,0,0]" : "+v"(acc) : "v"(a8), "v"(b8), "v"(sc1))
#define MFMA8QC(acc, a8, b8, cin_) asm volatile("v_mfma_scale_f32_32x32x64_f8f6f4 %0, %1, %2, %3, %4, %5 op_sel_hi:[0,0,0]" : "=&v"(acc) : "v"(a8), "v"(b8), "v"(cin_), "v"(scq), "v"(sc1))
#define MFMA8Q(acc, a8, b8) asm volatile("v_mfma_scale_f32_32x32x64_f8f6f4 %0, %1, %2, %0, %3, %4 op_sel_hi:[0,0,0]" : "+v"(acc) : "v"(a8), "v"(b8), "v"(scq), "v"(sc1))
  const int lb = (int)(uintptr_t)lds;
  const int va0 = lb + r32 * 64 + (((2 * hi) ^ ((r32 >> 2) & 3)) << 4), va1 = lb + r32 * 64 + (((2 * hi + 1) ^ ((r32 >> 2) & 3)) << 4);
  const int kz = (DQK == 128) ? ((r32 >> 1) & 7) : ((r32 >> 2) & 3), krb = lb + SHM_V + r32 * DQK;
  const int ka00 = krb + (((2 * hi) ^ kz) << 4), ka01 = krb + (((2 * hi + 1) ^ kz) << 4), ka10 = krb + (((4 + 2 * hi) ^ kz) << 4), ka11 = krb + (((5 + 2 * hi) ^ kz) << 4);
#define KREAD8(so) do { k00 = rd128<0>(ka00 + (so)); k01 = rd128<0>(ka01 + (so)); k10 = rd128<32 * DQK>(ka00 + (so)); k11 = rd128<32 * DQK>(ka01 + (so)); \
    if constexpr (NS == 2) { k20 = rd128<0>(ka10 + (so)); k21 = rd128<0>(ka11 + (so)); k30 = rd128<32 * DQK>(ka10 + (so)); k31 = rd128<32 * DQK>(ka11 + (so)); } } while (0)
#define KREAD8C(SO) do { k00 = rd128<(SO)>(ka00); k01 = rd128<(SO)>(ka01); k10 = rd128<(SO) + 32 * DQK>(ka00); k11 = rd128<(SO) + 32 * DQK>(ka01); \
    if constexpr (NS == 2) { k20 = rd128<(SO)>(ka10); k21 = rd128<(SO)>(ka11); k30 = rd128<(SO) + 32 * DQK>(ka10); k31 = rd128<(SO) + 32 * DQK>(ka11); } } while (0)
#define VREAD8AC(SO) do { v00 = rd128<(SO)>(va0); v01 = rd128<(SO)>(va1); v10 = rd128<(SO) + 2048>(va0); v11 = rd128<(SO) + 2048>(va1); } while (0)
#define VREAD8BC(SO) do { if constexpr (NS == 2) { k00 = rd128<(SO) + 4096>(va0); k01 = rd128<(SO) + 4096>(va1); k10 = rd128<(SO) + 6144>(va0); k11 = rd128<(SO) + 6144>(va1); } \
    else { k20 = rd128<(SO) + 4096>(va0); k21 = rd128<(SO) + 4096>(va1); k30 = rd128<(SO) + 6144>(va0); k31 = rd128<(SO) + 6144>(va1); } } while (0)
#define VREAD8A(so) do { v00 = rd128<0>(va0 + (so)); v01 = rd128<0>(va1 + (so)); v10 = rd128<2048>(va0 + (so)); v11 = rd128<2048>(va1 + (so)); } while (0)
#define VREAD8B(so) do { if constexpr (NS == 2) { k00 = rd128<4096>(va0 + (so)); k01 = rd128<4096>(va1 + (so)); k10 = rd128<6144>(va0 + (so)); k11 = rd128<6144>(va1 + (so)); } \
    else { k20 = rd128<4096>(va0 + (so)); k21 = rd128<4096>(va1 + (so)); k30 = rd128<6144>(va0 + (so)); k31 = rd128<6144>(va1 + (so)); } } while (0)
#define QK8(NV) do { if constexpr (NS == 2) { LWAIT8_(NV + 6); MFMA8QC(p0, cat8(k00, k01), qf[0], cin); LWAIT8_(NV + 4); MFMA8QC(p1, cat8(k10, k11), qf[0], cin); LWAIT8_(NV + 2); MFMA8Q(p0, cat8(k20, k21), qf[NS - 1]); LWAIT8_(NV); MFMA8Q(p1, cat8(k30, k31), qf[NS - 1]); } \
    else { LWAIT8_(NV + 2); MFMA8QC(p0, cat8(k00, k01), qf[0], cin); LWAIT8_(NV); MFMA8QC(p1, cat8(k10, k11), qf[0], cin); } } while (0)
#define LWAIT8_(n) do { asm volatile("s_waitcnt lgkmcnt(%0)" :: "n"(n) : "memory"); SBAR(); } while (0)
#define PV8() do { MFMA16S(osum, pf, sel8); LWAIT8(6); MFMA8(o[0], pf, cat8(v00, v01)); LWAIT8(4); MFMA8(o[1], pf, cat8(v10, v11)); \
    if constexpr (NS == 2) { LWAIT8(2); MFMA8(o[2], pf, cat8(k00, k01)); LWAIT8(0); MFMA8(o[3], pf, cat8(k10, k11)); } else { LWAIT8(2); MFMA8(o[2], pf, cat8(k20, k21)); LWAIT8(0); MFMA8(o[3], pf, cat8(k30, k31)); } } while (0)
  f32x16 p0, p1; float al; i32x8 pf; const int NT = seq / KVBLK;
  f32x16 cin;
#define CIN_SET8() do { const float nm_ = (56.f - 8.f * M_run) * CSC; _Pragma("unroll") for (int r = 0; r < 16; ++r) cin[r] = nm_; asm volatile("" : "+v"(cin)); SBAR(); } while (0)
  i32x4 k00, k01, k10, k11, k20, k21, k30, k31, v00, v01, v10, v11;
#define ACC_INIT8() do { const float nm = (56.f - 8.f * M_run) * CSC; typedef float f2_ __attribute__((ext_vector_type(2))); f2_ n2 = {nm, nm}; asm volatile("" : "+v"(n2)); \
      f2_ q_[16]; _Pragma("unroll") for (int i = 0; i < 16; ++i) asm volatile("v_mov_b64 %0, %1" : "=v"(q_[i]) : "v"(n2)); \
      typedef float f4_ __attribute__((ext_vector_type(4))); typedef float f8_ __attribute__((ext_vector_type(8))); \
      { const f4_ a = __builtin_shufflevector(q_[0], q_[1], 0, 1, 2, 3), b = __builtin_shufflevector(q_[2], q_[3], 0, 1, 2, 3), c = __builtin_shufflevector(q_[4], q_[5], 0, 1, 2, 3), d = __builtin_shufflevector(q_[6], q_[7], 0, 1, 2, 3); \
        const f8_ ab = __builtin_shufflevector(a, b, 0, 1, 2, 3, 4, 5, 6, 7), cd = __builtin_shufflevector(c, d, 0, 1, 2, 3, 4, 5, 6, 7); p0 = __builtin_shufflevector(ab, cd, 0, 1, 2, 3, 4, 5, 6, 7, 8, 9, 10, 11, 12, 13, 14, 15); } \
      { const f4_ a = __builtin_shufflevector(q_[8], q_[9], 0, 1, 2, 3), b = __builtin_shufflevector(q_[10], q_[11], 0, 1, 2, 3), c = __builtin_shufflevector(q_[12], q_[13], 0, 1, 2, 3), d = __builtin_shufflevector(q_[14], q_[15], 0, 1, 2, 3); \
        const f8_ ab = __builtin_shufflevector(a, b, 0, 1, 2, 3, 4, 5, 6, 7), cd = __builtin_shufflevector(c, d, 0, 1, 2, 3, 4, 5, 6, 7); p1 = __builtin_shufflevector(ab, cd, 0, 1, 2, 3, 4, 5, 6, 7, 8, 9, 10, 11, 12, 13, 14, 15); } \
      asm volatile("" : "+v"(p0), "+v"(p1)); SBAR(); } while (0)
  SDMA8(0, 0); SDMA8(1, 1); SDMA8(2, 2); if (half) SDMA8(3, 3);
  VMWAIT8(0); BARL8();
  CIN_SET8();
  KREAD8(0); QK8(0);
  SBAR(); asm volatile("s_nop 15\n\ts_nop 15\n\ts_nop 15\n\ts_nop 15\n\ts_nop 15\n\ts_nop 15" ::: "memory"); SBAR();
  softmax8<true>(p0, p1, M_run, al, pf);
  CIN_SET8();
  if (half) BARL8();
  int sw = (3 + half) & 3;
#define MSEG8(KO, VO) do { \
    if constexpr (NS == 2) { \
      k00 = rd128<(KO)>(ka00); k01 = rd128<(KO)>(ka01); k10 = rd128<(KO) + 32 * DQK>(ka00); k11 = rd128<(KO) + 32 * DQK>(ka01); k20 = rd128<(KO)>(ka10); k21 = rd128<(KO)>(ka11); \
      LWAIT8(4); MFMA8QC(p0, cat8(k00, k01), qf[0], cin); k30 = rd128<(KO) + 32 * DQK>(ka10); k31 = rd128<(KO) + 32 * DQK>(ka11); \
      LWAIT8(4); MFMA8QC(p1, cat8(k10, k11), qf[0], cin); v00 = rd128<(VO)>(va0); v01 = rd128<(VO)>(va1); \
      LWAIT8(4); MFMA8Q(p0, cat8(k20, k21), qf[NS - 1]); v10 = rd128<(VO) + 2048>(va0); v11 = rd128<(VO) + 2048>(va1); \
      LWAIT8(4); MFMA8Q(p1, cat8(k30, k31), qf[NS - 1]); k00 = rd128<(VO) + 4096>(va0); k01 = rd128<(VO) + 4096>(va1); \
      MFMA16S(osum, pf, sel8); k10 = rd128<(VO) + 6144>(va0); k11 = rd128<(VO) + 6144>(va1); \
      LWAIT8(6); MFMA8(o[0], pf, cat8(v00, v01)); LWAIT8(4); MFMA8(o[1], pf, cat8(v10, v11)); LWAIT8(2); MFMA8(o[2], pf, cat8(k00, k01)); LWAIT8(0); MFMA8(o[3], pf, cat8(k10, k11)); \
    } else { \
      k00 = rd128<(KO)>(ka00); k01 = rd128<(KO)>(ka01); k10 = rd128<(KO) + 32 * DQK>(ka00); k11 = rd128<(KO) + 32 * DQK>(ka01); v00 = rd128<(VO)>(va0); v01 = rd128<(VO)>(va1); \
      LWAIT8(4); MFMA8QC(p0, cat8(k00, k01), qf[0], cin); v10 = rd128<(VO) + 2048>(va0); v11 = rd128<(VO) + 2048>(va1); \
      LWAIT8(4); MFMA8QC(p1, cat8(k10, k11), qf[0], cin); k20 = rd128<(VO) + 4096>(va0); k21 = rd128<(VO) + 4096>(va1); \
      MFMA16S(osum, pf, sel8); k30 = rd128<(VO) + 6144>(va0); k31 = rd128<(VO) + 6144>(va1); \
      LWAIT8(6); MFMA8(o[0], pf, cat8(v00, v01)); LWAIT8(4); MFMA8(o[1], pf, cat8(v10, v11)); LWAIT8(2); MFMA8(o[2], pf, cat8(k20, k21)); LWAIT8(0); MFMA8(o[3], pf, cat8(k30, k31)); } } while (0)
#define STEP8(KS, VS, jj) do { \
    MSEG8((KS) * SLOT, (VS) * SLOT); \
    BARL8(); \
    softmax8<false>(p0, p1, M_run, al, pf); RESC8(al); \
    { const int t = (jj) + 3 + half; if (t < NT) { SDMA8(t, sw); VMWAIT8(2); } else VMWAIT8(0); } \
    BARL8(); \
    sw = (sw + 1) & 3; } while (0)
  int j = 0;
  for (; j + 4 < NT; j += 4) { STEP8(1, 0, j); STEP8(2, 1, j + 1); STEP8(3, 2, j + 2); STEP8(0, 3, j + 3); }
  if (j + 1 < NT) { STEP8(1, 0, j); ++j; }
  if (j + 1 < NT) { STEP8(2, 1, j); ++j; }
  if (j + 1 < NT) { STEP8(3, 2, j); ++j; }
  const int sv = j & 3;
#undef STEP8
#undef MSEG8
#undef ACC_INIT8
#undef CIN_SET8
  VREAD8A(sv * SLOT); VREAD8B(sv * SLOT); PV8();
  SBAR(); asm volatile("s_nop 15\n\ts_nop 15\n\ts_nop 15\n\ts_nop 15\n\ts_nop 15\n\ts_nop 15" ::: "memory"); SBAR();
  if (!half) BARL8();
  float rli[16];
  { if ((lane & 15) < 2) *(f32x4*)(al_l + (lane & 15) * 16 + 4 * (lane >> 4)) = (f32x4){osum[0], osum[1], osum[2], osum[3]};
    asm volatile("s_waitcnt lgkmcnt(0)" ::: "memory");
#pragma unroll
    for (int g = 0; g < 4; ++g) { const f32x4 a4 = *(const f32x4*)(al_l + 8 * g + 4 * hi);
#pragma unroll
      for (int i = 0; i < 4; ++i) rli[4 * g + i] = __builtin_amdgcn_rcpf(a4[i]); } }
  unsigned char* Ow = Ob + (long)(wid * QBLK) * LDO;
  if constexpr (!DIFF) {
#pragma unroll
    for (int r = 0; r < 16; ++r) { int orow = crow(r, hi);
#pragma unroll
      for (int d0 = 0; d0 < 4; ++d0) { const float v_ = o[d0][r] * (rli[r] * OS_GQA); Ow[(long)orow * LDO + d0 * 32 + r32] = (unsigned char)__builtin_amdgcn_cvt_pk_fp8_f32(v_, v_, 0, false); } }
  } else {
    char* stash = lds + RD * SLOT + 2048 + wid * 8192 + lane * 16;
    if (dmode == 0) {
#pragma unroll
      for (int q = 0; q < 8; ++q) { const int d0 = q >> 1, r0 = (q & 1) * 8; i32x4 w;
#pragma unroll
        for (int i = 0; i < 4; ++i) w[i] = (int)att::cvtpk(o[d0][r0 + 2 * i] * rli[r0 + 2 * i], o[d0][r0 + 2 * i + 1] * rli[r0 + 2 * i + 1]);
        *(i32x4*)(stash + q * 1024) = w; }
    } else {
      float ss[16];
#pragma unroll
      for (int r = 0; r < 16; ++r) ss[r] = 0.f;
#pragma unroll
      for (int q = 0; q < 8; ++q) { const int d0 = q >> 1, r0 = (q & 1) * 8; const i32x4 w = *(const i32x4*)(stash + q * 1024);
#pragma unroll
        for (int i = 0; i < 4; ++i) { const int r = r0 + 2 * i;
          const float a = bflo((unsigned)w[i]) - lam * (o[d0][r] * rli[r]), b = bfhi((unsigned)w[i]) - lam * (o[d0][r + 1] * rli[r + 1]);
          o[d0][r] = a; o[d0][r + 1] = b; ss[r] += a * a; ss[r + 1] += b * b; } }
      float sg[4];
#pragma unroll
      for (int d0 = 0; d0 < 4; ++d0) sg[d0] = subg[d0 * 32 + r32] * ((1.f - LAM_INIT) * OS_DIFF);
#pragma unroll
      for (int r = 0; r < 16; ++r) { float s = ss[r];
#pragma unroll
        for (int x = 1; x < 32; x <<= 1) s += __shfl_xor(s, x);
        const float rs = rsqrtf(s * (1.f / 128.f) + RMS_EPS); const int orow = crow(r, hi);
#pragma unroll
        for (int d0 = 0; d0 < 4; ++d0) { const float v_ = o[d0][r] * rs * sg[d0]; Ow[(long)orow * LDO + d0 * 32 + r32] = (unsigned char)__builtin_amdgcn_cvt_pk_fp8_f32(v_, v_, 0, false); } }
    }
  }
  BARL8();
#undef GLDS16
#undef SDMA8
#undef VMWAIT8
#undef BARL8
#undef LWAIT8
#undef LWAIT8_
#undef RESC8
#undef MFMA8
#undef MFMA8Q
#undef MFMA16S
#undef KREAD8
#undef VREAD8A
#undef VREAD8B
#undef KREAD8C
#undef VREAD8AC
#undef VREAD8BC
#undef QK8
#undef PV8
}
#undef SBAR
}
#define XB_TMO      128
#define XB_XCNT(j)  (256  + 64 * (j))
#define XB_XSUB(j)  (1280 + 64 * (j))
#define XB_XGEN(j)  (2304 + 64 * (j))
#define XB_TOP      3328
#define XB_TOPGEN   3392
#define XCD_BAR_WORDS 3456
#define XB_SPIN_CAP (1u << 18)

__device__ __forceinline__ unsigned xb_ld(unsigned* p)              { return __hip_atomic_load(p, __ATOMIC_RELAXED, __HIP_MEMORY_SCOPE_AGENT); }
__device__ __forceinline__ unsigned xb_add(unsigned* p, unsigned v) { return __hip_atomic_fetch_add(p, v, __ATOMIC_RELAXED, __HIP_MEMORY_SCOPE_AGENT); }
__device__ __forceinline__ unsigned xb_xcc_id() { return (unsigned)__builtin_amdgcn_s_getreg((3 << 11) | 20) & 0xFu; }
#define XB_SPIN(cond, bar) do { unsigned _sp = 0; while (cond) { __builtin_amdgcn_s_sleep(1); \
    if ((++_sp & 255u) == 0u) { if (xb_ld(&(bar)[XB_TMO])) break; if (_sp > XB_SPIN_CAP) { atomicAdd(&(bar)[XB_TMO], 1u); break; } } } } while (0)

struct XcdBarrier {
    unsigned* bar; unsigned x;
    volatile LAS unsigned* st;
};

__device__ __forceinline__ XcdBarrier xcd_barrier_post(unsigned* bar, volatile LAS unsigned* st) {
    XcdBarrier b; b.bar = bar; b.x = xb_xcc_id(); b.st = st;
    if (threadIdx.x == 0) (void)xb_add(&bar[XB_XCNT(b.x)], 1u);
    return b;
}
__device__ __forceinline__ void xcd_barrier_complete(unsigned* bar, unsigned x, unsigned& nloc, unsigned& nx) {
    const unsigned G = gridDim.x * gridDim.y * gridDim.z;
    unsigned sum, cnt, mine, sp = 0u;
    for (;;) {
        sum = 0u; cnt = 0u; mine = 0u;
#pragma unroll
        for (unsigned j = 0; j < 16; ++j) { const unsigned c = xb_ld(&bar[XB_XCNT(j)]); sum += c; cnt += (c > 0u) ? 1u : 0u; mine = (j == x) ? c : mine; }
        if (sum == G) break;
        __builtin_amdgcn_s_sleep(1);
        if ((++sp & 255u) == 0u) { if (xb_ld(&bar[XB_TMO])) break; if (sp > XB_SPIN_CAP) { atomicAdd(&bar[XB_TMO], 1u); break; } }
    }
    nloc = mine > 0u ? mine : 1u; nx = cnt > 0u ? cnt : 1u;
}

__device__ __forceinline__ void xcd_barrier(const XcdBarrier& b) {
    asm volatile("s_waitcnt vmcnt(0)" ::: "memory");
    __syncthreads();
    if (threadIdx.x == 0) {
        unsigned* bar = b.bar;
        __builtin_amdgcn_s_waitcnt(0);
        unsigned nloc = b.st[0], nx = b.st[1];
        if (nloc == 0u) { xcd_barrier_complete(bar, b.x, nloc, nx); b.st[0] = nloc; b.st[1] = nx; }
        const unsigned old = xb_add(&bar[XB_XSUB(b.x)], 1u);
        const unsigned gen = old / nloc;
        if (old + 1u == (gen + 1u) * nloc) {
            __builtin_amdgcn_fence(__ATOMIC_RELEASE, "agent");
            asm volatile("s_waitcnt vmcnt(0)" ::: "memory");
            const unsigned og = xb_add(&bar[XB_TOP], 1u);
            const unsigned tg = og / nx;
            if (og + 1u == (tg + 1u) * nx) xb_add(&bar[XB_TOPGEN], 1u);
            else XB_SPIN(xb_ld(&bar[XB_TOPGEN]) == tg, bar);
            __builtin_amdgcn_fence(__ATOMIC_ACQUIRE, "agent");
            xb_add(&bar[XB_XGEN(b.x)], 1u);
            asm volatile("s_waitcnt vmcnt(0)" ::: "memory");
        } else {
            XB_SPIN(xb_ld(&bar[XB_XGEN(b.x)]) == gen, bar);
            __builtin_amdgcn_fence(__ATOMIC_ACQUIRE, "agent");
            asm volatile("s_waitcnt vmcnt(0)" ::: "memory");
        }
    }
    __syncthreads();
}

constexpr int NWAVES = 8;
constexpr int N_PHASES = 36;
#ifndef MK_STOP
#define MK_STOP N_PHASES
#endif
#ifndef ATT_SDEPTH
#define ATT_SDEPTH 1
#endif
#ifndef G1_PROBE
#define G1_PROBE 0
#endif
#ifndef ATT_PROBE
#define ATT_PROBE 0
#endif
#ifndef REP_MASK
#define REP_MASK 0
#endif
constexpr size_t WS_JUNK = WS_END - WS_GATE;
constexpr float W8_SCALE = 32.f;
constexpr float QSCALE128 = 8.f * 0.088388347648318440f * 1.4426950408889634f, QSCALE64 = 8.f * 0.125f * 1.4426950408889634f;
#ifndef SM_MASK
#define SM_MASK 127
#endif
#ifndef PRO_PARTS
#define PRO_PARTS 15
#endif
#ifndef MK_MULTI
#define MK_MULTI 0
#endif

struct Args { const float* in[N_IN]; float* out; unsigned char* ws; int ph_lo, ph_hi, dump, pad; };
static_assert(sizeof(Args) == N_IN * 8 + 8 + 8 + 16, "Args has no padding");
typedef const __attribute__((address_space(4))) Args* KArgs;
struct Frame {
    LAS unsigned char* lds;
    char* ldsg;
    int tid, lane, wave, vcu, G, gw, NGW;
    KArgs kp;
    __device__ __forceinline__ const float* in(int i) const { return kp->in[i]; }
    __device__ __forceinline__ float* out() const { return kp->out; }
    __device__ __forceinline__ unsigned char* ws() const { return kp->ws; }
    __device__ __forceinline__ unsigned* ctl() const { return (unsigned*)(kp->ws + WS_CTL); }
};
__device__ __forceinline__ bool refresh(Frame& F) { int t = threadIdx.x; asm volatile("" : "+v"(t)); F.tid = t; F.lane = t & 63; KArgs k = (KArgs)__builtin_amdgcn_kernarg_segment_ptr(); asm volatile("" : "+s"(k)); F.kp = k; return true; }
__device__ __forceinline__ const float* input_row(const Frame& F, int row) {
    const int b = row >= SB ? 1 : 0, w = row - b * SB;
    return (w < NCTX) ? F.in(I_CTX) + ((size_t)(b * NCTX + w)) * D : F.in(I_X) + ((size_t)(b * SEQ + (w - NCTX))) * D;
}
__device__ __forceinline__ int stream_of(int row) { const int b = row >= SB ? 1 : 0, w = row - b * SB; return (w < NCTX) ? 2 : b; }
__device__ __forceinline__ const float* modp(const Frame& F, int layer, int s, int chunk) { return (const float*)(F.ws() + WS_MOD) + ((size_t)(layer * 3 + s) * 6 + chunk) * D; }
__device__ __forceinline__ const float* normg(const Frame& F, int layer, int k) { return F.in(I_NORMG) + (size_t)(layer * 4 + k) * D; }

__device__ __forceinline__ void ld_row_f32(const float* p, int lane, f32x4 (&v)[4]) {
#pragma unroll
    for (int j = 0; j < 4; ++j) v[j] = *(const f32x4*)(p + 256 * j + 4 * lane);
}
__device__ __forceinline__ void st_row_f32(float* p, int lane, const f32x4 (&v)[4]) {
#pragma unroll
    for (int j = 0; j < 4; ++j) *(f32x4*)(p + 256 * j + 4 * lane) = v[j];
}
__device__ __forceinline__ void ld_row_bf16(const bf16_t* p, int lane, f32x4 (&v)[4]) {
#pragma unroll
    for (int j = 0; j < 4; ++j) { const u32x2 w = *(const u32x2*)(p + 256 * j + 4 * lane); v[j] = (f32x4){bflo(w.x), bfhi(w.x), bflo(w.y), bfhi(w.y)}; }
}
__device__ __forceinline__ void ld_row_fp8(const unsigned char* p, int lane, f32x4 (&v)[4]) {
#pragma unroll
    for (int j = 0; j < 4; ++j) { const int w = *(const int*)(p + 256 * j + 4 * lane);
        v[j] = (f32x4){__builtin_amdgcn_cvt_f32_fp8(w, 0), __builtin_amdgcn_cvt_f32_fp8(w, 1), __builtin_amdgcn_cvt_f32_fp8(w, 2), __builtin_amdgcn_cvt_f32_fp8(w, 3)}; }
}
__device__ __forceinline__ void st_row_bf16(bf16_t* p, int lane, const f32x4 (&v)[4]) {
#pragma unroll
    for (int j = 0; j < 4; ++j) { u32x2 w; w.x = pkbf(v[j].x, v[j].y); w.y = pkbf(v[j].z, v[j].w); *(u32x2*)(p + 256 * j + 4 * lane) = w; }
}
__device__ __forceinline__ float row_ss(const f32x4 (&v)[4]) {
    float s = 0.f;
#pragma unroll
    for (int j = 0; j < 4; ++j) s += (v[j].x * v[j].x + v[j].y * v[j].y) + (v[j].z * v[j].z + v[j].w * v[j].w);
    return wave_sum(s);
}
__device__ __forceinline__ void modnorm(const f32x4 (&v)[4], const float* g, const float* m1, const float* m0, int lane, f32x4 (&h)[4]) {
    const float r = rsqrtf(row_ss(v) * (1.f / D) + RMS_EPS);
#pragma unroll
    for (int j = 0; j < 4; ++j) { const f32x4 gv = *(const f32x4*)(g + 256 * j + 4 * lane), a = *(const f32x4*)(m1 + 256 * j + 4 * lane), b = *(const f32x4*)(m0 + 256 * j + 4 * lane);
        h[j] = (v[j] * r) * gv * (a + 1.f) + b; }
}

__device__ __forceinline__ void tr_item(const float* W, int K, int N, bf16_t* WT, int k0, int n0, int dst_row0, LAS float* scr, int lane, const float* colscale = nullptr) {
    float tmp[32]; const float csv = colscale ? colscale[lane & 31] : 1.f;
#pragma unroll
    for (int i = 0; i < 32; ++i) { const int kk = 2 * i + (lane >> 5); tmp[i] = W[(size_t)(k0 + kk) * N + n0 + (lane & 31)]; }
#pragma unroll
    for (int i = 0; i < 32; ++i) { const int kk = 2 * i + (lane >> 5); scr[kk * 33 + (lane & 31)] = tmp[i] * csv; }
    LDS_WAIT(); asm volatile("" ::: "memory");
    const int c = lane & 7;
#pragma unroll
    for (int j = 0; j < 4; ++j) { const int n = (lane >> 3) + 8 * j; const LAS float* s = scr + (8 * c) * 33 + n;
        u32x4 o; o.x = pkbf(s[0 * 33], s[1 * 33]); o.y = pkbf(s[2 * 33], s[3 * 33]); o.z = pkbf(s[4 * 33], s[5 * 33]); o.w = pkbf(s[6 * 33], s[7 * 33]);
        *(u32x4*)(WT + (size_t)(dst_row0 + n) * K + k0 + 8 * c) = o; }
    LDS_WAIT(); asm volatile("" ::: "memory");
}
__device__ __forceinline__ void tr_item8(const float* W, int K, int N, unsigned char* WT, int k0, int n0, int dst_row0, LAS float* scr, int lane, float wscale) {
    float tmp[32];
#pragma unroll
    for (int i = 0; i < 32; ++i) { const int kk = 2 * i + (lane >> 5); tmp[i] = W[(size_t)(k0 + kk) * N + n0 + (lane & 31)]; }
#pragma unroll
    for (int i = 0; i < 32; ++i) { const int kk = 2 * i + (lane >> 5); scr[kk * 33 + (lane & 31)] = tmp[i] * wscale; }
    LDS_WAIT(); asm volatile("" ::: "memory");
    const int c = lane & 7;
#pragma unroll
    for (int j = 0; j < 4; ++j) { const int n = (lane >> 3) + 8 * j; const LAS float* s = scr + (8 * c) * 33 + n;
        int w0 = 0, w1 = 0; w0 = __builtin_amdgcn_cvt_pk_fp8_f32(s[0 * 33], s[1 * 33], w0, false); w0 = __builtin_amdgcn_cvt_pk_fp8_f32(s[2 * 33], s[3 * 33], w0, true);
        w1 = __builtin_amdgcn_cvt_pk_fp8_f32(s[4 * 33], s[5 * 33], w1, false); w1 = __builtin_amdgcn_cvt_pk_fp8_f32(s[6 * 33], s[7 * 33], w1, true);
        *(u32x2*)(WT + (size_t)(dst_row0 + n) * K + k0 + 8 * c) = (u32x2){(unsigned)w0, (unsigned)w1}; }
    LDS_WAIT(); asm volatile("" ::: "memory");
}
__device__ __forceinline__ void tr_plain(const float* W, int K, int N, bf16_t* WT, int row_off, LAS float* scr, int item, int lane, const float* colscale = nullptr) {
    const int nblk = N / 32, kb = item / nblk, nb = item - kb * nblk;
    tr_item(W, K, N, WT, 64 * kb, 32 * nb, row_off + 32 * nb, scr, lane, colscale ? colscale + 32 * nb : nullptr);
}
__device__ __forceinline__ void tr_plain8(const float* W, int K, int N, unsigned char* WT, LAS float* scr, int item, int lane) {
    const int nblk = N / 32, kb = item / nblk, nb = item - kb * nblk;
    tr_item8(W, K, N, WT, 64 * kb, 32 * nb, 32 * nb, scr, lane, W8_SCALE);
}
__device__ __forceinline__ void p0_prologue(Frame& F) {
    {
        LAS float* sv = (LAS float*)(F.lds);
        LAS float* red = (LAS float*)(F.lds + 16384);
        if ((PRO_PARTS & 1) && F.vcu < 192) {
            for (int i = F.tid; i < 3 * D; i += 512) { const int s = i >> 10, k = i & 1023; const float c = (s < 2) ? F.in(I_C)[s * D + k] : F.in(I_CCTX)[k]; sv[i] = c / (1.f + __expf(-c)); }
            __syncthreads();
            for (int task = F.vcu; task < 192; task += F.G) {
                const int layer = task / 48, n0 = (task % 48) * 128;
                const int tx = F.tid & 31, ty = F.tid >> 5;
                const float* wp = F.in(I_MODW) + ((size_t)layer * D + ty * 64) * 6144 + n0 + 4 * tx;
                f32x4 a0 = {0, 0, 0, 0}, a1 = a0, a2 = a0;
#pragma unroll 8
                for (int k = 0; k < 64; ++k) { const f32x4 w = *(const f32x4*)(wp + (size_t)k * 6144); const int kk = ty * 64 + k;
                    a0 += w * sv[kk]; a1 += w * sv[D + kk]; a2 += w * sv[2 * D + kk]; }
                *(LAS f32x4*)(red + (ty * 3 + 0) * 128 + 4 * tx) = a0; *(LAS f32x4*)(red + (ty * 3 + 1) * 128 + 4 * tx) = a1; *(LAS f32x4*)(red + (ty * 3 + 2) * 128 + 4 * tx) = a2;
                __syncthreads();
                if (F.tid < 384) { const int s = F.tid >> 7, n = F.tid & 127; float acc = F.in(I_MODB)[layer * 6144 + n0 + n];
#pragma unroll
                    for (int y = 0; y < 16; ++y) acc += red[(y * 3 + s) * 128 + n];
                    ((float*)(F.ws() + WS_MOD))[((size_t)(layer * 3 + s)) * 6144 + n0 + n] = acc; }
                __syncthreads();
            }
        }
        __syncthreads();
    }
    { bf16_t* b1h = (bf16_t*)(F.ws() + WS_B1H); bf16_t* b2h = (bf16_t*)(F.ws() + WS_B2H); const float* b1 = F.in(I_B1); const float* b2 = F.in(I_B2);
      const int gt = F.vcu * (NWAVES * 64) + F.tid, ngt = F.G * NWAVES * 64;
      for (int i = gt; i < 4 * NE * 2048 / 2; i += ngt) ((unsigned*)b1h)[i] = pkbf(b1[2 * i], b1[2 * i + 1]);
      for (int i = gt; i < 4 * NE * 1024 / 2; i += ngt) ((unsigned*)b2h)[i] = pkbf(b2[2 * i], b2[2 * i + 1]); }
    LAS float* scr = (LAS float*)(F.lds + F.wave * 16384);
    if (PRO_PARTS & 2) {
        constexpr int I_POOL = 4 * (256 / 64) * (256 / 32);
        constexpr int I_GQ = 16 * 48, I_SQ = 16 * 32, I_W3 = 16 * 96;
        constexpr int NSMALL = I_POOL + I_GQ + I_SQ + I_W3 + I_SQ + I_W3 + I_SQ;
        for (int it = F.gw; it < NSMALL; it += F.NGW) {
            int r = it;
            if (r < I_POOL) { if (!(SM_MASK & 1)) continue; const int g = r >> 5; tr_plain(F.in(I_POOLW) + (size_t)g * 65536, 256, 256, (bf16_t*)(F.ws() + WS_POOLW), g * 256, scr, r & 31, F.lane, F.in(I_POOLS) + g * 256); continue; } r -= I_POOL;
            if (r < I_GQ) { if (!(SM_MASK & 2)) continue; tr_plain8(F.in(I_GQKV), D, 1536, F.ws() + WS_GQKV, scr, r, F.lane); continue; } r -= I_GQ;
            if (r < I_SQ) { if (!(SM_MASK & 4)) continue; tr_plain8(F.in(I_GO), D, D, F.ws() + WS_GO, scr, r, F.lane); continue; } r -= I_SQ;
            if (r < I_W3) { if (!(SM_MASK & 8)) continue; tr_plain8(F.in(I_CIN), D, 3072, F.ws() + WS_CIN, scr, r, F.lane); continue; } r -= I_W3;
            if (r < I_SQ) { if (!(SM_MASK & 16)) continue; tr_plain8(F.in(I_COUT), D, D, F.ws() + WS_COUT, scr, r, F.lane); continue; } r -= I_SQ;
            if (r < I_W3) { if (!(SM_MASK & 32)) continue; tr_plain8(F.in(I_DQKV), D, 3072, F.ws() + WS_DQKV, scr, r, F.lane); continue; } r -= I_W3;
            if (!(SM_MASK & 64)) continue; tr_plain8(F.in(I_DO), D, D, F.ws() + WS_DO, scr, r, F.lane);
        }
    }
    if (PRO_PARTS & 12) {
        constexpr int NI1 = 128 * 1024, NIT = NI1 + 128 * 512;
        float cur[32], nxt[32];
#define XW_DECODE(it_) const bool w1_ = (it_) < NI1; const int r2_ = w1_ ? (it_) : (it_) - NI1; const int mat_ = w1_ ? (r2_ >> 10) : (r2_ >> 9), rr_ = w1_ ? (r2_ & 1023) : (r2_ & 511), kb_ = w1_ ? (rr_ >> 7) : (rr_ >> 6), n0_ = 16 * (w1_ ? (rr_ & 127) : (rr_ & 63)), N_ = w1_ ? 2048 : 1024; \
        const float* W_ = w1_ ? F.in(I_W1) + (size_t)mat_ * D * 2048 : F.in(I_W2) + (size_t)mat_ * D * D;
#define XW_LOAD(it_, buf) do { XW_DECODE(it_) _Pragma("unroll") for (int i = 0; i < 32; ++i) { const int kk = 4 * i + (F.lane >> 4); buf[i] = W_[(size_t)(128 * kb_ + kk) * N_ + n0_ + (F.lane & 15)]; } } while (0)
        int it = F.gw;
        if (it < NIT) XW_LOAD(it, cur);
        for (; it < NIT; it += F.NGW) {
            const int itn = it + F.NGW;
            if (itn < NIT) XW_LOAD(itn, nxt);
            XW_DECODE(it)
            const int drow = w1_ ? (mat_ * 2048 + ((n0_ & 1023) >> 7) * 256 + (n0_ >> 10) * 128 + (n0_ & 127)) : (mat_ * 1024 + n0_);
            unsigned char* WT = F.ws() + (w1_ ? WS_W1T : WS_W2T);
#pragma unroll
            for (int i = 0; i < 32; ++i) { const int kk = 4 * i + (F.lane >> 4); scr[kk * 17 + (F.lane & 15)] = cur[i] * W8_SCALE; }
            LDS_WAIT(); asm volatile("" ::: "memory");
            { const int n = F.lane >> 2, c = F.lane & 3; const LAS float* s = scr + (32 * c) * 17 + n; unsigned o8[8];
#pragma unroll
              for (int q = 0; q < 8; ++q) { int w0 = 0; w0 = __builtin_amdgcn_cvt_pk_fp8_f32(s[(4 * q) * 17], s[(4 * q + 1) * 17], w0, false); w0 = __builtin_amdgcn_cvt_pk_fp8_f32(s[(4 * q + 2) * 17], s[(4 * q + 3) * 17], w0, true); o8[q] = (unsigned)w0; }
              unsigned char* d = WT + (size_t)(drow + n) * D + 128 * kb_ + 32 * c;
              *(u32x4*)d = (u32x4){o8[0], o8[1], o8[2], o8[3]}; *(u32x4*)(d + 16) = (u32x4){o8[4], o8[5], o8[6], o8[7]}; }
            LDS_WAIT(); asm volatile("" ::: "memory");
#pragma unroll
            for (int i = 0; i < 32; ++i) cur[i] = nxt[i];
        }
#undef XW_DECODE
#undef XW_LOAD
    }
    __syncthreads();
}

template <bool DRY> __device__ __forceinline__ void p_hpass0(Frame& F) {
    bf16_t* H = (bf16_t*)(F.ws() + WS_H + (DRY ? WS_JUNK : 0));
    int cs = -1; f32x4 pg[4], p0v[4];
    for (int rr = F.gw; rr < T; rr += 2 * F.NGW) {
        const int r0 = rr, r1 = min(rr + F.NGW, T - 1);
        f32x4 v0[4], v1[4], h[4]; ld_row_f32(input_row(F, r0), F.lane, v0); ld_row_f32(input_row(F, r1), F.lane, v1);
#define HP_ROW(v_, r_) do { const int s = stream_of(r_); if (s != cs) { cs = s; const float* gn = normg(F, 0, 0); const float* m1n = modp(F, 0, s, 1); const float* m0n = modp(F, 0, s, 0); \
            _Pragma("unroll") for (int j = 0; j < 4; ++j) { const int o = 256 * j + 4 * F.lane; pg[j] = *(const f32x4*)(gn + o) * (*(const f32x4*)(m1n + o) + 1.f); p0v[j] = *(const f32x4*)(m0n + o); } } \
          const float rx = rsqrtf(row_ss(v_) * (1.f / D) + RMS_EPS); _Pragma("unroll") for (int j = 0; j < 4; ++j) h[j] = (v_[j] * rx) * pg[j] + p0v[j]; st_row_bf16(H + (size_t)(r_) * D, F.lane, h); } while (0)
        HP_ROW(v0, r0); HP_ROW(v1, r1);
#undef HP_ROW
    }
}
template <bool DRY> __device__ __forceinline__ void p_poolprep(Frame& F) {
    const bf16_t* H = (const bf16_t*)(F.ws() + WS_H); bf16_t* Dp = (bf16_t*)(F.ws() + WS_O + (DRY ? WS_JUNK : 0));
    for (int row = F.gw; row < T; row += F.NGW) {
        const int b = row >= SB ? 1 : 0, w = row - b * SB;
        const int s0 = (w < NCTX) ? b * SB : b * SB + NCTX, s1 = (w < NCTX) ? b * SB + NCTX : (b + 1) * SB;
#pragma unroll
        for (int j = 0; j < 4; ++j) {
            constexpr int dummy = 0; (void)dummy;
            const int half = 1 << j;
            const int lo = max(row - half, s0), hi = min(row + half, s1);
            u32x2 q[16];
#pragma unroll
            for (int i = 0; i < 2 * half; ++i) { const int rr = row - half + i; const int rc = (rr >= lo && rr < hi) ? rr : row; q[i] = *(const u32x2*)(H + (size_t)rc * D + 256 * j + 4 * F.lane); }
            const u32x2 qs = *(const u32x2*)(H + (size_t)row * D + 256 * j + 4 * F.lane);
            f32x4 acc = {0, 0, 0, 0};
#pragma unroll
            for (int i = 0; i < 2 * half; ++i) { const int rr = row - half + i; const float wgt = (rr >= lo && rr < hi) ? 1.f : 0.f; acc += (f32x4){bflo(q[i].x), bfhi(q[i].x), bflo(q[i].y), bfhi(q[i].y)} * wgt; }
            const f32x4 self = {bflo(qs.x), bfhi(qs.x), bflo(qs.y), bfhi(qs.y)};
            const f32x4 d = acc * (1.f / (float)(hi - lo)) - self;
            u32x2 o; o.x = pkbf(d.x, d.y); o.y = pkbf(d.z, d.w);
            *(u32x2*)(Dp + ((size_t)j * T + row) * 256 + 4 * F.lane) = o;
        }
    }
}

template <int L>
__device__ __forceinline__ void p_moe_a(Frame& F, const bool DRY) {
    const bf16_t* Y = (const bf16_t*)(F.ws() + WS_Y); const bf16_t* X = (const bf16_t*)(F.ws() + WS_X); bf16_t* Xo = (bf16_t*)(F.ws() + WS_X + (DRY ? WS_JUNK : 0)); unsigned char* H8 = F.ws() + WS_H + (DRY ? WS_JUNK : 0);
    float* gate = (float*)(F.ws() + WS_GATE + (DRY ? WS_JUNK : 0)); int* list = (int*)(F.ws() + WS_LIST);
    LAS float* hbuf = (LAS float*)(F.lds);
    LAS float* part = (LAS float*)(F.lds + 65536);
    LAS int* sel = (LAS int*)(F.lds + 83968);
    LAS int* lcnt = (LAS int*)(F.lds + LC_LCNT); LAS int* gbase = (LAS int*)(F.lds + LC_GBASE);
    const float* g1 = normg(F, L, 1); const float* g2 = normg(F, L, 2);
    const float* rw = F.in(I_RW) + (size_t)L * D * NE; const float* rb = F.in(I_RB) + L * NE;
    const int e = F.lane & 31, kh = F.lane >> 5;
    typedef short rbf16x8 __attribute__((ext_vector_type(8)));
    rbf16x8 wh[4][2], wl[4][2];
#pragma unroll
    for (int s = 0; s < 4; ++s)
#pragma unroll
        for (int n = 0; n < 2; ++n) { unsigned hw[4], lw[4];
#pragma unroll
            for (int q = 0; q < 4; ++q) { const int k = 128 * F.wave + 32 * s + 8 * (F.lane >> 4) + 2 * q; const float w0 = rw[(size_t)k * NE + 16 * n + (F.lane & 15)], w1 = rw[(size_t)(k + 1) * NE + 16 * n + (F.lane & 15)];
                hw[q] = pkbf(w0, w1); lw[q] = pkbf(w0 - bflo(hw[q]), w1 - bfhi(hw[q])); }
            const u32x4 hv = {hw[0], hw[1], hw[2], hw[3]}, lv = {lw[0], lw[1], lw[2], lw[3]}; wh[s][n] = __builtin_bit_cast(rbf16x8, hv); wl[s][n] = __builtin_bit_cast(rbf16x8, lv); }
    const float bias = rb[e];
    if (F.tid < 32) lcnt[F.tid] = 0;
    __syncthreads();
    constexpr int NRA = (L == 3) ? NB * SEQ : T;
#define MA_ROW(n_) ((L == 3) ? (((n_) >> 14) * SB + NCTX + ((n_) & (SEQ - 1))) : (n_))
    const int chunk = (NRA + F.G - 1) / F.G, tok0 = min(NRA, (int)blockIdx.x * chunk), tok1 = min(NRA, tok0 + chunk);
    int cs = -1; f32x4 qm[4], qg[4], q0v[4];
    f32x4 y[2][4], x[2][4];
#define MA_LOAD(base_) do { _Pragma("unroll") for (int tt = 0; tt < 2; ++tt) { const int tok_ = (base_) + F.wave * 2 + tt; if (tok_ < tok1) { \
        const int row_ = MA_ROW(tok_); ld_row_bf16(Y + (size_t)row_ * D, F.lane, y[tt]); if constexpr (L == 0) ld_row_f32(input_row(F, row_), F.lane, x[tt]); else ld_row_bf16(X + (size_t)row_ * D, F.lane, x[tt]); } } } while (0)
    MA_LOAD(tok0);
    for (int base = tok0; base < tok1; base += 16) {
#pragma unroll
        for (int tt = 0; tt < 2; ++tt) {
            const int tl = F.wave * 2 + tt, tok = base + tl;
            if (tok < tok1) {
                const int row = MA_ROW(tok), s = stream_of(row);
                f32x4 h[4];
                if (s != cs) { cs = s; const float* m2 = modp(F, L, s, 2); const float* m4 = modp(F, L, s, 4); const float* m3 = modp(F, L, s, 3);
#pragma unroll
                    for (int j = 0; j < 4; ++j) { const int o = 256 * j + 4 * F.lane; qm[j] = *(const f32x4*)(m2 + o) * *(const f32x4*)(g1 + o); qg[j] = *(const f32x4*)(g2 + o) * (*(const f32x4*)(m4 + o) + 1.f); q0v[j] = *(const f32x4*)(m3 + o); } }
                const float ry = rsqrtf(row_ss(y[tt]) * (1.f / D) + RMS_EPS);
#pragma unroll
                for (int j = 0; j < 4; ++j) x[tt][j] = x[tt][j] + qm[j] * (y[tt][j] * ry);
                st_row_bf16(Xo + (size_t)row * D, F.lane, x[tt]);
                { const float rx = rsqrtf(row_ss(x[tt]) * (1.f / D) + RMS_EPS);
#pragma unroll
                  for (int j = 0; j < 4; ++j) h[j] = (x[tt][j] * rx) * qg[j] + q0v[j]; }
#pragma unroll
                for (int j = 0; j < 4; ++j) { int w = 0; w = __builtin_amdgcn_cvt_pk_fp8_f32(h[j].x, h[j].y, w, false); w = __builtin_amdgcn_cvt_pk_fp8_f32(h[j].z, h[j].w, w, true); *(int*)(H8 + (size_t)row * D + 256 * j + 4 * F.lane) = w; }
#pragma unroll
                for (int j = 0; j < 4; ++j) *(LAS f32x4*)(hbuf + tl * D + 256 * j + 4 * F.lane) = h[j];
            }
        }
        __syncthreads();
        if (base + 16 < tok1) MA_LOAD(base + 16);
        {
            f32x4 lg0 = {0.f, 0.f, 0.f, 0.f}, lg1 = {0.f, 0.f, 0.f, 0.f};
#pragma unroll
            for (int s = 0; s < 4; ++s) {
                const LAS float* hp = hbuf + (F.lane & 15) * D + 128 * F.wave + 32 * s + 8 * (F.lane >> 4);
                const f32x4 x0 = *(const LAS f32x4*)hp, x1 = *(const LAS f32x4*)(hp + 4);
                const unsigned h0 = pkbf(x0.x, x0.y), h1 = pkbf(x0.z, x0.w), h2 = pkbf(x1.x, x1.y), h3 = pkbf(x1.z, x1.w);
                const unsigned l0 = pkbf(x0.x - bflo(h0), x0.y - bfhi(h0)), l1 = pkbf(x0.z - bflo(h1), x0.w - bfhi(h1)), l2 = pkbf(x1.x - bflo(h2), x1.y - bfhi(h2)), l3 = pkbf(x1.z - bflo(h3), x1.w - bfhi(h3));
                const u32x4 hv = {h0, h1, h2, h3}, lv = {l0, l1, l2, l3};
                const rbf16x8 ah = __builtin_bit_cast(rbf16x8, hv), al = __builtin_bit_cast(rbf16x8, lv);
                lg0 = __builtin_amdgcn_mfma_f32_16x16x32_bf16(ah, wh[s][0], lg0, 0, 0, 0); lg1 = __builtin_amdgcn_mfma_f32_16x16x32_bf16(ah, wh[s][1], lg1, 0, 0, 0);
                lg0 = __builtin_amdgcn_mfma_f32_16x16x32_bf16(ah, wl[s][0], lg0, 0, 0, 0); lg1 = __builtin_amdgcn_mfma_f32_16x16x32_bf16(ah, wl[s][1], lg1, 0, 0, 0);
                lg0 = __builtin_amdgcn_mfma_f32_16x16x32_bf16(al, wh[s][0], lg0, 0, 0, 0); lg1 = __builtin_amdgcn_mfma_f32_16x16x32_bf16(al, wh[s][1], lg1, 0, 0, 0);
            }
#pragma unroll
            for (int r = 0; r < 4; ++r) { const int tl = 4 * (F.lane >> 4) + r; part[(F.wave * 16 + tl) * 32 + (F.lane & 15)] = lg0[r]; part[(F.wave * 16 + tl) * 32 + 16 + (F.lane & 15)] = lg1[r]; }
        }
        __syncthreads();
        {
            const int tl = F.wave * 2 + kh, tok = base + tl;
            float v = bias;
#pragma unroll
            for (int w = 0; w < 8; ++w) v += part[(w * 16 + tl) * 32 + e];
            float tv[4]; int ti[4];
#pragma unroll
            for (int k = 0; k < 4; ++k) {
                float cv = v; int ci = e;
#pragma unroll
                for (int o = 1; o < 32; o <<= 1) { const float ov = __shfl_xor(cv, o); const int oi = __shfl_xor(ci, o); if (ov > cv || (ov == cv && oi < ci)) { cv = ov; ci = oi; } }
                tv[k] = cv; ti[k] = ci; if (e == ci) v = -3.0e38f;
            }
            if (tok < tok1) {
                const float e1 = __expf(tv[1] - tv[0]), e2 = __expf(tv[2] - tv[0]), e3 = __expf(tv[3] - tv[0]); const float inv = 1.f / (1.f + e1 + e2 + e3);
                if (e == 0) *(f32x4*)(gate + (size_t)MA_ROW(tok) * 4) = (f32x4){inv, e1 * inv, e2 * inv, e3 * inv};
                if (!DRY && e < 4) { const int ex = (e == 0) ? ti[0] : (e == 1) ? ti[1] : (e == 2) ? ti[2] : ti[3];
                    const int rank = __hip_atomic_fetch_add(lcnt + ex, 1, __ATOMIC_RELAXED, __HIP_MEMORY_SCOPE_WORKGROUP); sel[(tok - tok0) * 4 + e] = ex | (rank << 8); }
            }
        }
    }
#undef MA_LOAD
    __syncthreads();
    if (DRY) return;
    if (F.tid < 32) gbase[F.tid] = (int)__hip_atomic_fetch_add(F.ctl() + CW_CNT + L * 32 + F.tid, (unsigned)lcnt[F.tid], __ATOMIC_RELAXED, __HIP_MEMORY_SCOPE_AGENT);
    __syncthreads();
    for (int i = F.tid; i < (tok1 - tok0) * 4; i += 512) { const int v = sel[i], ee = v & 255, rank = v >> 8; list[(size_t)ee * T + gbase[ee] + rank] = MA_ROW(tok0 + (i >> 2)) * 4 + (i & 3); }
    __syncthreads();
#undef MA_ROW
}
template <int L>
__device__ __forceinline__ int moe_setup(Frame& F) {
    LAS int* cnt = (LAS int*)(F.lds + LC_CNT); LAS int* tbase = (LAS int*)(F.lds + LC_TBASE); LAS int* tile_e = (LAS int*)(F.lds + LC_TILEE);
    __syncthreads();
    if (F.tid < 64) {
        const int c = (F.lane < 32) ? (int)__hip_atomic_load(F.ctl() + CW_CNT + L * 32 + F.lane, __ATOMIC_RELAXED, __HIP_MEMORY_SCOPE_AGENT) : 0;
        const int nt = (c + 255) >> 8;
        int incl = nt;
#pragma unroll
        for (int o = 1; o < 32; o <<= 1) { const int t = __shfl_up(incl, o); if (F.lane >= o) incl += t; }
        const int excl = incl - nt;
        if (F.lane < 32) { cnt[F.lane] = c; tbase[F.lane] = excl; for (int t = 0; t < nt; ++t) tile_e[excl + t] = F.lane; }
        if (F.lane == 31) tbase[32] = incl;
    }
    __syncthreads();
    return tbase[32];
}
template <int L, bool DRY>
__device__ __forceinline__ void p_moe_b(Frame& F) {
    const unsigned char* SLOT = F.ws() + WS_SLOT; const bf16_t* X = (const bf16_t*)(F.ws() + WS_X); bf16_t* Xo = (bf16_t*)(F.ws() + WS_X + (DRY ? WS_JUNK : 0)); unsigned char* H8 = F.ws() + WS_H + (DRY ? WS_JUNK : 0); const float* gate = (const float*)(F.ws() + WS_GATE);
    const float* g3 = normg(F, L, 3);
    constexpr int NR = (L == 3) ? NB * SEQ : T;
    int sl[4][4], sn[4][4]; f32x4 xc[4], xn[4], gc, gn;
#define MB_ROW(n_) ((L == 3) ? (((n_) >> 14) * SB + NCTX + ((n_) & (SEQ - 1))) : (n_))
#define MB_LOAD(n_, S_, X_, G_) do { const int r_ = MB_ROW(n_); G_ = *(const f32x4*)(gate + (size_t)r_ * 4); \
        _Pragma("unroll") for (int k = 0; k < 4; ++k) _Pragma("unroll") for (int j = 0; j < 4; ++j) S_[k][j] = *(const int*)(SLOT + ((size_t)r_ * 4 + k) * D + 256 * j + 4 * F.lane); \
        ld_row_bf16(X + (size_t)r_ * D, F.lane, X_); } while (0)
    int cs = -1; f32x4 pm[4], pg[4], p0v[4];
    int n = F.gw;
    if (n < NR) MB_LOAD(n, sl, xc, gc);
    for (; n < NR; n += F.NGW) {
        const int nn = n + F.NGW;
        if (nn < NR) MB_LOAD(nn, sn, xn, gn);
        const int row = MB_ROW(n), b = row >= SB ? 1 : 0, w = row - b * SB, s = (w < NCTX) ? 2 : b;
        f32x4 y[4], x[4];
#pragma unroll
        for (int j = 0; j < 4; ++j) { y[j] = (f32x4){0, 0, 0, 0}; x[j] = xc[j];
#pragma unroll
            for (int k = 0; k < 4; ++k) { const int q = sl[k][j]; y[j] += (f32x4){__builtin_amdgcn_cvt_f32_fp8(q, 0), __builtin_amdgcn_cvt_f32_fp8(q, 1), __builtin_amdgcn_cvt_f32_fp8(q, 2), __builtin_amdgcn_cvt_f32_fp8(q, 3)} * gc[k]; } }
        if (s != cs) { cs = s; constexpr int LN_ = (L < 3) ? L + 1 : 3; const float* m5 = modp(F, L, s, 5); const float* gn = normg(F, LN_, 0); const float* m1n = modp(F, LN_, s, 1); const float* m0n = modp(F, LN_, s, 0);
#pragma unroll
            for (int j = 0; j < 4; ++j) { const int o = 256 * j + 4 * F.lane; pm[j] = *(const f32x4*)(m5 + o) * *(const f32x4*)(g3 + o); pg[j] = *(const f32x4*)(gn + o) * (*(const f32x4*)(m1n + o) + 1.f); p0v[j] = *(const f32x4*)(m0n + o); } }
        const float ry = rsqrtf(row_ss(y) * (1.f / D) + RMS_EPS);
#pragma unroll
        for (int j = 0; j < 4; ++j) x[j] = x[j] + pm[j] * (y[j] * ry);
        if (L == 3) { st_row_f32((DRY ? (float*)Xo : F.out()) + ((size_t)(b * SEQ + (w - NCTX))) * D, F.lane, x); }
        else {
            st_row_bf16(Xo + (size_t)row * D, F.lane, x);
            f32x4 h[4]; const float rx = rsqrtf(row_ss(x) * (1.f / D) + RMS_EPS);
#pragma unroll
            for (int j = 0; j < 4; ++j) h[j] = (x[j] * rx) * pg[j] + p0v[j];
#pragma unroll
            for (int j = 0; j < 4; ++j) { int w8 = 0; w8 = __builtin_amdgcn_cvt_pk_fp8_f32(h[j].x, h[j].y, w8, false); w8 = __builtin_amdgcn_cvt_pk_fp8_f32(h[j].z, h[j].w, w8, true); *(int*)(H8 + (size_t)row * D + 256 * j + 4 * F.lane) = w8; }
        }
#pragma unroll
        for (int k = 0; k < 4; ++k)
#pragma unroll
            for (int j = 0; j < 4; ++j) sl[k][j] = sn[k][j];
#pragma unroll
        for (int j = 0; j < 4; ++j) xc[j] = xn[j];
        gc = gn;
    }
#undef MB_ROW
#undef MB_LOAD
}
template <int LDG, int VCOL0, int NH>
__device__ __forceinline__ void vt_prep(Frame& F, const bf16_t* G, unsigned char* VT8) {
    LAS unsigned char* scr = F.lds + F.wave * 4096;
    constexpr int NTI = SB / 64;
    const int dvl = F.lane >> 1, hf = F.lane & 1;
    for (int it = F.gw; it < NB * NH * NTI; it += F.NGW) {
        const int tile = it % NTI, bh = it / NTI, b = bh / NH, hd = bh - b * NH;
        const bf16_t* src = G + (size_t)(b * SB + tile * 64 + F.lane) * LDG + VCOL0 + hd * 128;
        unsigned char* dst = VT8 + (size_t)(bh * 128) * SB + tile * 64 + hf * 32;
#pragma unroll 1
        for (int c = 0; c < 4; ++c) {
            u32x4 a[4];
#pragma unroll
            for (int i = 0; i < 4; ++i) a[i] = *(const u32x4*)(src + c * 32 + i * 8);
#pragma unroll
            for (int i = 0; i < 4; ++i) {
                int w0 = 0, w1 = 0;
                w0 = __builtin_amdgcn_cvt_pk_fp8_f32(bflo(a[i].x), bfhi(a[i].x), w0, false); w0 = __builtin_amdgcn_cvt_pk_fp8_f32(bflo(a[i].y), bfhi(a[i].y), w0, true);
                w1 = __builtin_amdgcn_cvt_pk_fp8_f32(bflo(a[i].z), bfhi(a[i].z), w1, false); w1 = __builtin_amdgcn_cvt_pk_fp8_f32(bflo(a[i].w), bfhi(a[i].w), w1, true);
                *(LAS int*)(scr + F.lane * 36 + 8 * i) = w0; *(LAS int*)(scr + F.lane * 36 + 8 * i + 4) = w1;
            }
            LDS_WAIT(); asm volatile("" ::: "memory");
            unsigned o8[8];
#pragma unroll
            for (int q = 0; q < 8; ++q) { const int kb = 32 * (q >> 2) + 8 * (q & 3) + 4 * hf; const LAS unsigned char* p = scr + kb * 36 + dvl;
                o8[q] = (unsigned)p[0] | ((unsigned)p[36] << 8) | ((unsigned)p[72] << 16) | ((unsigned)p[108] << 24); }
            unsigned char* d = dst + (size_t)(c * 32 + dvl) * SB;
            *(u32x4*)d = (u32x4){o8[0], o8[1], o8[2], o8[3]}; *(u32x4*)(d + 16) = (u32x4){o8[4], o8[5], o8[6], o8[7]};
            LDS_WAIT(); asm volatile("" ::: "memory");
        }
    }
}
template <bool DRY> __device__ __forceinline__ void p_gqa_prep(Frame& F) {
    const bf16_t* G = (const bf16_t*)(F.ws() + WS_G); unsigned char* Q8 = F.ws() + WS_Q8; unsigned char* K8 = F.ws() + WS_K8; const float* qg = F.in(I_GQG); const float* kg = F.in(I_GKG);
    const int hi = F.lane >> 5, jl = (F.lane & 31) * 2, c0 = hi * 64 + jl;
    const float f0 = __builtin_amdgcn_exp2f(-(float)(jl & 31) * (LOG2_THETA / 32.f)), f1 = __builtin_amdgcn_exp2f(-(float)((jl + 1) & 31) * (LOG2_THETA / 32.f));
    const float qg0 = qg[c0], qg1 = qg[c0 + 1], kg0 = kg[c0], kg1 = kg[c0 + 1];
    for (int rr = F.gw; rr < T; rr += 2 * F.NGW) {
        unsigned qw[2][10];
#pragma unroll
        for (int u = 0; u < 2; ++u) { const int row = min(rr + u * F.NGW, T - 1); const bf16_t* gr = G + (size_t)row * 1536 + c0;
#pragma unroll
            for (int h = 0; h < 10; ++h) qw[u][h] = *(const unsigned*)(gr + h * 128); }
#pragma unroll
        for (int u = 0; u < 2; ++u) {
            const int row = min(rr + u * F.NGW, T - 1);
            const int b = row >= SB ? 1 : 0, w = row - b * SB; const bool lat = w >= NCTX; const int t = w - NCTX;
            const float pos = lat ? ((jl < 32) ? (float)(t >> 6) : (float)(t & 63)) : 0.f; const float a0 = pos * f0, a1 = pos * f1;
            const float cs0 = __cosf(a0), sn0 = __sinf(a0), cs1 = __cosf(a1), sn1 = __sinf(a1);
#pragma unroll
            for (int h = 0; h < 10; ++h) {
                const unsigned q = qw[u][h];
                const float x0 = bflo(q), x1 = bfhi(q);
                const float r = rsqrtf(wave_sum(x0 * x0 + x1 * x1) * (1.f / 128.f) + RMS_EPS);
                const float n0 = x0 * r * (h < 8 ? qg0 : kg0), n1 = x1 * r * (h < 8 ? qg1 : kg1);
                const float p0 = __shfl_xor(n0, 32), p1 = __shfl_xor(n1, 32);
                const float o0 = hi ? (n0 * cs0 + p0 * sn0) : (n0 * cs0 - p0 * sn0), o1 = hi ? (n1 * cs1 + p1 * sn1) : (n1 * cs1 - p1 * sn1);
                const float qs = (h < 8) ? QSCALE128 : 1.f;
                const unsigned short w8 = (unsigned short)__builtin_amdgcn_cvt_pk_fp8_f32(o0 * qs, o1 * qs, 0, false);
                if (h < 8) *(unsigned short*)(Q8 + (size_t)row * 1024 + h * 128 + c0) = w8; else *(unsigned short*)(K8 + (size_t)row * 256 + (h - 8) * 128 + c0) = w8;
            }
        }
    }
    vt_prep<1536, 1280, 2>(F, G, F.ws() + WS_VT8);
}
template <bool DRY> __device__ __forceinline__ void p_diff_prep(Frame& F) {
    const bf16_t* G = (const bf16_t*)(F.ws() + WS_G); unsigned char* Q8 = F.ws() + WS_Q8; unsigned char* K8 = F.ws() + WS_K8;
    const int l31 = F.lane & 31, j0 = 2 * l31; const bool first = l31 < 16; const int jj = j0 & 31;
    const float f0 = __builtin_amdgcn_exp2f(-(float)(jj & 15) * (LOG2_THETA / 16.f)), f1 = __builtin_amdgcn_exp2f(-(float)((jj + 1) & 15) * (LOG2_THETA / 16.f));
    for (int rr = F.gw; rr < T; rr += 2 * F.NGW) {
        unsigned qw[2][16];
#pragma unroll
        for (int u = 0; u < 2; ++u) { const int row = min(rr + u * F.NGW, T - 1); const bf16_t* gr = G + (size_t)row * 3072 + 2 * F.lane;
#pragma unroll
            for (int ch = 0; ch < 16; ++ch) qw[u][ch] = *(const unsigned*)(gr + ch * 128); }
#pragma unroll
        for (int u = 0; u < 2; ++u) {
            const int row = min(rr + u * F.NGW, T - 1);
            const int b = row >= SB ? 1 : 0, w = row - b * SB; const int t = w - NCTX;
            const float pos = (w >= NCTX) ? ((jj < 16) ? (float)(t >> 6) : (float)(t & 63)) : 0.f; const float a0 = pos * f0, a1 = pos * f1;
            const float cs0 = __cosf(a0), sn0 = __sinf(a0), cs1 = __cosf(a1), sn1 = __sinf(a1);
#pragma unroll
            for (int ch = 0; ch < 16; ++ch) {
                const unsigned q = qw[u][ch];
                const float x0 = bflo(q), x1 = bfhi(q);
                const float p0 = __shfl_xor(x0, 16), p1 = __shfl_xor(x1, 16);
                const float o0 = first ? (x0 * cs0 - p0 * sn0) : (x0 * cs0 + p0 * sn0), o1 = first ? (x1 * cs1 - p1 * sn1) : (x1 * cs1 + p1 * sn1);
                const float qs = (ch < 8) ? QSCALE64 : 1.f;
                const unsigned short w8 = (unsigned short)__builtin_amdgcn_cvt_pk_fp8_f32(o0 * qs, o1 * qs, 0, false);
                if (ch < 8) *(unsigned short*)(Q8 + (size_t)row * 1024 + ch * 128 + 2 * F.lane) = w8; else *(unsigned short*)(K8 + (size_t)row * 1024 + (ch - 8) * 128 + 2 * F.lane) = w8;
            }
        }
    }
    vt_prep<3072, 2048, 8>(F, G, F.ws() + WS_VT8);
}
template <bool DRY> __device__ __forceinline__ void p_conv_prep(Frame& F) {
    const bf16_t* G = (const bf16_t*)(F.ws() + WS_G); unsigned char* Z = F.ws() + WS_O + (DRY ? WS_JUNK : 0); const float* wd = F.in(I_CDW);
    for (int rr = F.gw; rr < T; rr += 2 * F.NGW) {
        u32x2 qc[2][3][4], qx[2][3][4], qb[2][4]; float wm[2][3];
#pragma unroll
        for (int u = 0; u < 2; ++u) {
            const int row = min(rr + u * F.NGW, T - 1); const int b = row >= SB ? 1 : 0, w = row - b * SB;
            const int s0 = (w < NCTX) ? b * SB : b * SB + NCTX, s1 = (w < NCTX) ? b * SB + NCTX : (b + 1) * SB;
            const bool hasp = row - 1 >= s0, hasn = row + 1 < s1;
            const int rws[3] = {hasp ? row - 1 : row, row, hasn ? row + 1 : row}; wm[u][0] = hasp ? 1.f : 0.f; wm[u][1] = 1.f; wm[u][2] = hasn ? 1.f : 0.f;
#pragma unroll
            for (int j = 0; j < 4; ++j) { const int c = 256 * j + 4 * F.lane; qb[u][j] = *(const u32x2*)(G + (size_t)row * 3072 + c);
#pragma unroll
                for (int d = 0; d < 3; ++d) { const bf16_t* gp = G + (size_t)rws[d] * 3072 + c; qc[u][d][j] = *(const u32x2*)(gp + 1024); qx[u][d][j] = *(const u32x2*)(gp + 2048); } }
        }
#pragma unroll
        for (int u = 0; u < 2; ++u) {
            const int row = min(rr + u * F.NGW, T - 1);
#pragma unroll
            for (int j = 0; j < 4; ++j) { const int c = 256 * j + 4 * F.lane; f32x4 acc = {0, 0, 0, 0};
#pragma unroll
                for (int d = 0; d < 3; ++d) { const u32x2 a = qc[u][d][j], x = qx[u][d][j];
                    const f32x4 uu = (f32x4){bflo(a.x), bfhi(a.x), bflo(a.y), bfhi(a.y)} * (f32x4){bflo(x.x), bfhi(x.x), bflo(x.y), bfhi(x.y)};
                    acc += uu * (*(const f32x4*)(wd + d * D + c) * wm[u][d]); }
                const u32x2 g = qb[u][j];
                const f32x4 z = acc * (f32x4){bflo(g.x), bfhi(g.x), bflo(g.y), bfhi(g.y)};
                int w8 = 0; w8 = __builtin_amdgcn_cvt_pk_fp8_f32(z.x * OS_CONV, z.y * OS_CONV, w8, false); w8 = __builtin_amdgcn_cvt_pk_fp8_f32(z.z * OS_CONV, z.w * OS_CONV, w8, true);
                *(int*)(Z + (size_t)row * D + c) = w8; }
        }
    }
}
template <int PV> __device__ __forceinline__ void p_gqa_attn(Frame& F) {
    const unsigned char* Q8 = F.ws() + WS_Q8; const unsigned char* K8 = F.ws() + WS_K8; const unsigned char* VT8 = F.ws() + WS_VT8; unsigned char* O = F.ws() + WS_O + (PV ? WS_JUNK : 0);
    for (int idx = F.vcu; idx < 1024 + 16; idx += F.G) {
        int b, hq, qrow, seq;
        if (idx < 1024) { const int r = idx >> 8, wi = idx & 255; b = r >> 1; hq = (r & 1) * 4 + (wi >> 6); qrow = b * SB + NCTX + (wi & 63) * 256; seq = SB; }
        else { const int j = idx - 1024; b = j >> 3; hq = j & 7; qrow = b * SB; seq = NCTX; }
        const int kvh = hq >> 2;
        att8::attn_body8<128, 1024, 256, 1024, false, (PV > 0 ? PV - 1 : 0)>(Q8 + (size_t)qrow * 1024 + hq * 128, K8 + (size_t)(b * SB) * 256 + kvh * 128, VT8 + (size_t)((b * 2 + kvh) * 128) * SB,
                                                      O + (size_t)qrow * D + hq * 128, seq, F.ldsg, 0, 0.f, nullptr);
    }
}
__device__ __forceinline__ void p_diff_attn(Frame& F) {
    const unsigned char* Q8 = F.ws() + WS_Q8; const unsigned char* K8 = F.ws() + WS_K8; const unsigned char* VT8 = F.ws() + WS_VT8; unsigned char* O = F.ws() + WS_O;
    const float* lv = F.in(I_DLAM);
    const float lam = __expf(wave_sum(lv[F.lane] * lv[64 + F.lane])) - __expf(wave_sum(lv[128 + F.lane] * lv[192 + F.lane])) + LAM_INIT;
    for (int idx = F.vcu; idx < 1024; idx += F.G) {
#pragma unroll 1
        for (int s = 0; s < 2; ++s) {
            int ix = idx; asm volatile("" : "+s"(ix));
            const int r = ix >> 6, b = r >> 3, h = r & 7, qrow = b * SB + NCTX + (ix & 63) * 256;
            att8::attn_body8<64, 1024, 1024, 1024, true>(Q8 + (size_t)qrow * 1024 + h * 128 + s * 64, K8 + (size_t)(b * SB) * 1024 + h * 128 + s * 64, VT8 + (size_t)((b * 8 + h) * 128) * SB,
                                                         O + (size_t)qrow * D + h * 128, SB, F.ldsg, s, lam, F.in(I_DSUB));
        }
    }
}


#define PG8_ALIGN true
#define PG8_SP2 true

template <int L, int P0> __device__ __forceinline__ void moe_layer(Frame& F, const XcdBarrier& bar, int lo, int hi, int rep_mask);

__global__ void __launch_bounds__(NWAVES * 64, 2) mk_fwd(Args args) {
    extern __shared__ __attribute__((aligned(16))) unsigned char lds[];
    Frame F;
    F.lds = (LAS unsigned char*)lds; F.ldsg = (char*)lds;
    F.tid = threadIdx.x; F.lane = F.tid & 63; F.wave = __builtin_amdgcn_readfirstlane(F.tid >> 6);
    F.G = gridDim.x; { const int bx = blockIdx.x; F.vcu = (F.G % 8 == 0) ? (bx % 8) * (F.G / 8) + bx / 8 : bx; }
    F.gw = F.vcu * NWAVES + F.wave; F.NGW = F.G * NWAVES;
    refresh(F);
    for (int u = F.tid; u < (LDS_BYTES - RING_BYTES) / 4; u += NWAVES * 64) ((LAS unsigned*)(F.lds + RING_BYTES))[u] = 0u;
    __syncthreads();
    XcdBarrier bar; bar.bar = F.ctl() + CW_BAR; bar.x = 0; bar.st = nullptr;
    if (!MK_MULTI) bar = xcd_barrier_post(F.ctl() + CW_BAR, (volatile LAS unsigned*)(F.lds + LC_MISC));
    const int lo = args.ph_lo, hi = args.ph_hi; const int rep_mask = args.pad;
#define IN(k) (lo <= (k) && (k) < hi && refresh(F))
#define NREP(bit) (REP_MASK ? 1 + ((rep_mask & (bit)) ? 1 : 0) : 1)
#define PHM(k) asm volatile("; === PHASE %0" :: "i"(k))
#define SEAM(k) do { if (IN(k) && IN((k) + 1)) { xcd_barrier(bar); if constexpr ((REP_MASK & 256) != 0) xcd_barrier(bar); } } while (0)
    bf16_t* const Hb = (bf16_t*)(F.ws() + WS_H); bf16_t* const Gb = (bf16_t*)(F.ws() + WS_G); bf16_t* const Ob = (bf16_t*)(F.ws() + WS_O); bf16_t* const Yb = (bf16_t*)(F.ws() + WS_Y);

    if (IN(0)) { PHM(0); for (int rep = 0; rep < NREP(16); ++rep) p0_prologue(F); } SEAM(0);
    if (IN(1)) { PHM(1); if constexpr ((REP_MASK & 128) != 0) p_hpass0<true>(F); p_hpass0<false>(F); } SEAM(1);
    if (IN(2)) { PHM(2); if constexpr ((REP_MASK & 128) != 0) p_poolprep<true>(F); p_poolprep<false>(F); } SEAM(2);
    if (IN(3)) { PHM(3);
        int kpool = 256; asm volatile("" : "+s"(kpool));
        pg8::Gemm g{Ob, (const bf16_t*)(F.ws() + WS_POOLW), 4 * T, 256, kpool}; pg8::PoolOrder S{F.G, F.vcu};
        pg8::EpiPool E{Yb, D};
        for (int rep = 0; rep < NREP(32); ++rep) pg8::gemm_phase<pg8::EpiPool, pg8::PoolOrder, PG8_ALIGN, PG8_SP2>(F.lds, g, S, E);
    } SEAM(3);
    moe_layer<0, 4>(F, bar, lo, hi, rep_mask);
    if (IN(9)) { PHM(9);
        int kop = D; asm volatile("" : "+s"(kop));
        pg8::Gemm g{Hb, (const bf16_t*)(F.ws() + WS_GQKV), T, 1536, kop}; pg8::StaticOrder S; S.init(T, 1536, F.G, (int)blockIdx.x);
        pg8::EpiScaled E{Gb, 1536, 1.f / W8_SCALE};
        pg8::gemm_phase<pg8::EpiScaled, pg8::StaticOrder, PG8_ALIGN, PG8_SP2, 1>(F.lds, g, S, E);
    } SEAM(9);
    if (IN(10)) { PHM(10); if constexpr ((REP_MASK & 128) != 0) p_gqa_prep<true>(F); p_gqa_prep<false>(F); } SEAM(10);
    if (IN(11)) { PHM(11); if constexpr ((REP_MASK & 1) != 0) { p_gqa_attn<ATT_PROBE + 1>(F); refresh(F); } p_gqa_attn<0>(F); } SEAM(11);
    if (IN(12)) { PHM(12);
        int kop = D; asm volatile("" : "+s"(kop));
        pg8::Gemm g{Ob, (const bf16_t*)(F.ws() + WS_GO), T, D, kop}; pg8::StaticOrder S; S.init(T, D, F.G, (int)blockIdx.x);
        pg8::EpiScaled E{Yb, D, 1.f / (W8_SCALE * OS_GQA)};
        for (int rep = 0; rep < NREP(32); ++rep) pg8::gemm_phase<pg8::EpiScaled, pg8::StaticOrder, PG8_ALIGN, PG8_SP2, 1>(F.lds, g, S, E);
    } SEAM(12);
    moe_layer<1, 13>(F, bar, lo, hi, rep_mask);
    if (IN(18)) { PHM(18);
        int kop = D; asm volatile("" : "+s"(kop));
        pg8::Gemm g{Hb, (const bf16_t*)(F.ws() + WS_CIN), T, 3072, kop}; pg8::StaticOrder S; S.init(T, 3072, F.G, (int)blockIdx.x);
        pg8::EpiScaled E{Gb, 3072, 1.f / W8_SCALE};
        pg8::gemm_phase<pg8::EpiScaled, pg8::StaticOrder, PG8_ALIGN, PG8_SP2, 1>(F.lds, g, S, E);
    } SEAM(18);
    if (IN(19)) { PHM(19); if constexpr ((REP_MASK & 128) != 0) p_conv_prep<true>(F); p_conv_prep<false>(F); } SEAM(19);
    if (IN(20)) { PHM(20);
        int kop = D; asm volatile("" : "+s"(kop));
        pg8::Gemm g{Ob, (const bf16_t*)(F.ws() + WS_COUT), T, D, kop}; pg8::StaticOrder S; S.init(T, D, F.G, (int)blockIdx.x);
        pg8::EpiScaled E{Yb, D, 1.f / (W8_SCALE * OS_CONV)};
        for (int rep = 0; rep < NREP(32); ++rep) pg8::gemm_phase<pg8::EpiScaled, pg8::StaticOrder, PG8_ALIGN, PG8_SP2, 1>(F.lds, g, S, E);
    } SEAM(20);
    moe_layer<2, 21>(F, bar, lo, hi, rep_mask);
    if (IN(26)) { PHM(26);
        int kop = D; asm volatile("" : "+s"(kop));
        pg8::Gemm g{Hb, (const bf16_t*)(F.ws() + WS_DQKV), T, 3072, kop}; pg8::StaticOrder S; S.init(T, 3072, F.G, (int)blockIdx.x);
        pg8::EpiScaled E{Gb, 3072, 1.f / W8_SCALE};
        pg8::gemm_phase<pg8::EpiScaled, pg8::StaticOrder, PG8_ALIGN, PG8_SP2, 1>(F.lds, g, S, E);
    } SEAM(26);
    if (IN(27)) { PHM(27); if constexpr ((REP_MASK & 128) != 0) p_diff_prep<true>(F); p_diff_prep<false>(F); } SEAM(27);
    if (IN(28)) { PHM(28); for (int rep = 0; rep < NREP(2); ++rep) p_diff_attn(F); } if (IN(28) && IN(30)) xcd_barrier(bar);
    if (IN(30)) { PHM(30);
        int kop = D; asm volatile("" : "+s"(kop));
        pg8::Gemm g{Ob, (const bf16_t*)(F.ws() + WS_DO), T, D, kop}; pg8::LatentOrder S; S.init(D, F.G, (int)blockIdx.x);
        pg8::EpiScaled E{Yb, D, 1.f / (W8_SCALE * OS_DIFF)};
        for (int rep = 0; rep < NREP(32); ++rep) pg8::gemm_phase<pg8::EpiScaled, pg8::LatentOrder, PG8_ALIGN, PG8_SP2, 1>(F.lds, g, S, E);
    } SEAM(30);
    moe_layer<3, 31>(F, bar, lo, hi, rep_mask);
    if (args.dump) {
        if (!MK_MULTI) xcd_barrier(bar);
        const bf16_t* X = (const bf16_t*)(F.ws() + WS_X);
        for (int row = F.gw; row < T; row += F.NGW) { const int b = row >= SB ? 1 : 0, w = row - b * SB; if (w < NCTX) continue;
            f32x4 v[4]; ld_row_bf16(X + (size_t)row * D, F.lane, v); st_row_f32(F.out() + ((size_t)(b * SEQ + (w - NCTX))) * D, F.lane, v); }
    }
}
struct MoeDeal { int base, stride, limit, nun; };
__device__ __forceinline__ MoeDeal moe_deal(const Frame& F, int U) {
    MoeDeal d;
    if (F.G % 8 == 0) { const int per = F.G / 8, x = F.vcu / per, cl = F.vcu - x * per; d.base = (int)(((long)U * x) / 8) + cl; d.stride = per; d.limit = (int)(((long)U * (x + 1)) / 8); }
    else { d.base = F.vcu; d.stride = F.G; d.limit = U; }
    d.nun = (d.base < d.limit) ? (d.limit - d.base + d.stride - 1) / d.stride : 0;
    return d;
}
template <int L, int P0> __device__ __forceinline__ void moe_layer(Frame& F, const XcdBarrier& bar, int lo, int hi, int rep_mask) {
    if (IN(P0)) { PHM(P0); if constexpr ((REP_MASK & 512) != 0) { p_moe_a<L>(F, true); refresh(F); } p_moe_a<L>(F, false); } if (IN(P0) && IN(P0 + 2)) xcd_barrier(bar);
    if (IN(P0 + 2)) { PHM(P0 + 2);
        const int ntiles = moe_setup<L>(F); const MoeDeal dl = moe_deal(F, ntiles * 8);
        int kop = D; asm volatile("" : "+s"(kop));
        { LAS unsigned short* tk = (LAS unsigned short*)(F.lds + LC_TOK16); const LAS int* cnt = (const LAS int*)(F.lds + LC_CNT); const LAS int* tbase = (const LAS int*)(F.lds + LC_TBASE); const LAS int* tile_e = (const LAS int*)(F.lds + LC_TILEE);
          const int* list = (const int*)(F.ws() + WS_LIST); int nun = dl.nun; if (nun > MAXU) nun = MAXU;
          for (int idx = F.tid; idx < nun * 256; idx += NWAVES * 64) { const int i = idx >> 8, r = idx & 255, pm = (dl.base + i * dl.stride) >> 3, ee = tile_e[pm], pos = (pm - tbase[ee]) * 256 + r;
              tk[idx] = (unsigned short)((pos < cnt[ee]) ? (list[(size_t)ee * T + pos] >> 2) : 0); }
          __syncthreads(); }
        pg8::Gemm g{(const bf16_t*)(F.ws() + WS_H), (const bf16_t*)(F.ws() + WS_W1T + (size_t)L * NE * 2048 * D), T, 2048, kop};
        pg8::MoeOrder S{(const LAS int*)(F.lds + LC_TILEE), dl.limit, 8, dl.stride, dl.base};
        pg8::EpiSwiGLU E{F.ws() + WS_ACT, (const bf16_t*)(F.ws() + WS_B1H) + (size_t)L * NE * 2048, 1.f / W8_SCALE};
        if constexpr ((REP_MASK & 4) != 0) { pg8::EpiSwiGLUT<(G1_PROBE & 3)> E2{F.ws() + WS_HS, (const bf16_t*)(F.ws() + WS_B1H) + (size_t)L * NE * 2048, 1.f / W8_SCALE};
            pg8::gemm_phase<pg8::EpiSwiGLUT<(G1_PROBE & 3)>, pg8::MoeOrder, PG8_ALIGN, PG8_SP2, 1, true, (G1_PROBE >> 2)>(F.lds, g, S, E2, (const LAS unsigned short*)(F.lds + LC_TOK16)); }
        pg8::gemm_phase<pg8::EpiSwiGLU, pg8::MoeOrder, PG8_ALIGN, PG8_SP2, 1, true>(F.lds, g, S, E, (const LAS unsigned short*)(F.lds + LC_TOK16));
    } SEAM(P0 + 2);
    if (IN(P0 + 3)) { PHM(P0 + 3);
        const int ntiles = moe_setup<L>(F); const MoeDeal dl = moe_deal(F, ntiles * 4);
        int kop = D; asm volatile("" : "+s"(kop));
        pg8::Gemm g{(const bf16_t*)(F.ws() + WS_ACT), (const bf16_t*)(F.ws() + WS_W2T + (size_t)L * NE * D * D), CROWS, D, kop};
        pg8::MoeOrder S{(const LAS int*)(F.lds + LC_TILEE), dl.limit, 4, dl.stride, dl.base};
        { LAS int* st = (LAS int*)(F.lds + LC_TOK16); const LAS int* cnt = (const LAS int*)(F.lds + LC_CNT); const LAS int* tbase = (const LAS int*)(F.lds + LC_TBASE); const LAS int* tile_e = (const LAS int*)(F.lds + LC_TILEE);
          const int* list = (const int*)(F.ws() + WS_LIST); int nun = dl.nun; if (nun > MAXU / 2) nun = MAXU / 2;
          for (int idx = F.tid; idx < nun * 256; idx += NWAVES * 64) { const int i = idx >> 8, r = idx & 255, pm = (dl.base + i * dl.stride) >> 2, ee = tile_e[pm], pos = (pm - tbase[ee]) * 256 + r;
              st[idx] = (pos < cnt[ee]) ? list[(size_t)ee * T + pos] : -1; }
          __syncthreads(); }
        pg8::EpiScatter E{F.ws() + WS_SLOT, (const LAS int*)(F.lds + LC_TOK16), dl.stride, dl.base, (const bf16_t*)(F.ws() + WS_B2H) + (size_t)L * NE * D, 1.f / W8_SCALE, 0, T * 4};
        pg8::gemm_phase<pg8::EpiScatter, pg8::MoeOrder, PG8_ALIGN, PG8_SP2, 1>(F.lds, g, S, E);
        if constexpr ((REP_MASK & 8) != 0) { pg8::EpiScatter E2{F.ws() + WS_HS, (const LAS int*)(F.lds + LC_TOK16), dl.stride, dl.base, (const bf16_t*)(F.ws() + WS_B2H) + (size_t)L * NE * D, 1.f / W8_SCALE, ((REP_MASK & 4096) ? 1 : 0), CROWS};
            pg8::gemm_phase<pg8::EpiScatter, pg8::MoeOrder, PG8_ALIGN, PG8_SP2, 1>(F.lds, g, S, E2); }
    } SEAM(P0 + 3);
    if (IN(P0 + 4)) { PHM(P0 + 4); if constexpr ((REP_MASK & 1024) != 0) p_moe_b<L, true>(F); p_moe_b<L, false>(F); } SEAM(P0 + 4);
}
#undef IN
#undef SEAM

extern "C" void kernel_launch(void* const* d_in, const int* in_sizes, int n_in, void* d_out, int out_size, void* d_ws, size_t ws_size, hipStream_t stream) {
    static int grid = 0;
    if (grid == 0) {
        if (n_in != N_IN || in_sizes[0] != NB * SEQ * D || out_size != NB * SEQ * D || ws_size < WS_END) {
            fprintf(stderr, "kernel_launch: shape mismatch (n_in %d, in0 %d, out %d, ws %zu, need %zu); nothing launched\n", n_in, n_in > 0 ? in_sizes[0] : -1, out_size, ws_size, (size_t)WS_END); grid = -1; return; }
        { const long long exp_sz[N_IN] = {(long long)NB * SEQ * D, NB * D, NB * NCTX * D, D, 4LL * D * 6 * D, 4 * 6 * D, 4 * 4 * D, 4 * 256 * 256, D, D * 1536, D * D, 128, 128, D * 3072, 3 * D, D * D, D * 3072, D * D, 4 * 64, 128,
                                             4 * D * NE, 4 * NE, 4LL * NE * D * 2048, 4 * NE * 2048, 4LL * NE * D * D, 4 * NE * D};
          for (int i = 0; i < N_IN; ++i) if ((long long)in_sizes[i] != exp_sz[i]) { fprintf(stderr, "kernel_launch: input %d has %d elements, expected %lld; nothing launched\n", i, in_sizes[i], exp_sz[i]); grid = -1; return; } }
        int dev = 0, cus = 0, per_cu = 0;
        if (hipGetDevice(&dev) != hipSuccess || hipDeviceGetAttribute(&cus, hipDeviceAttributeMultiprocessorCount, dev) != hipSuccess) { fprintf(stderr, "kernel_launch: device query failed\n"); grid = -1; return; }
        if (hipFuncSetAttribute((const void*)mk_fwd, hipFuncAttributeMaxDynamicSharedMemorySize, LDS_BYTES) != hipSuccess) { fprintf(stderr, "kernel_launch: hipFuncSetAttribute failed\n"); grid = -1; return; }
        if (hipOccupancyMaxActiveBlocksPerMultiprocessor(&per_cu, (const void*)mk_fwd, NWAVES * 64, LDS_BYTES) != hipSuccess || per_cu < 1)
            fprintf(stderr, "kernel_launch: note: occupancy query reports %d workgroups per CU\n", per_cu);
        (void)hipGetLastError();
        grid = cus;
    }
    if (grid < 0) return;
    if (hipMemsetAsync((char*)d_ws + WS_CTL, 0, CTL_ZERO_BYTES, stream) != hipSuccess) { fprintf(stderr, "kernel_launch: memset failed\n"); return; }
    Args a{};
    for (int i = 0; i < N_IN; ++i) a.in[i] = (const float*)d_in[i];
    a.out = (float*)d_out; a.ws = (unsigned char*)d_ws; a.pad = REP_MASK;
    constexpr int STOP = MK_STOP;
#if MK_MULTI
    for (int p = 0; p < STOP; ++p) { a.ph_lo = p; a.ph_hi = p + 1; a.dump = 0; hipLaunchKernelGGL(mk_fwd, dim3(grid), dim3(NWAVES * 64), LDS_BYTES, stream, a); }
    if (STOP < N_PHASES) { a.ph_lo = 0; a.ph_hi = 0; a.dump = 1; hipLaunchKernelGGL(mk_fwd, dim3(grid), dim3(NWAVES * 64), LDS_BYTES, stream, a); }
#else
    a.ph_lo = 0; a.ph_hi = STOP; a.dump = (STOP < N_PHASES) ? 1 : 0;
    hipLaunchKernelGGL(mk_fwd, dim3(grid), dim3(NWAVES * 64), LDS_BYTES, stream, a);
#endif
    const hipError_t le = hipPeekAtLastError();
    if (le != hipSuccess) fprintf(stderr, "kernel_launch: launch failed: %s\n", hipGetErrorName(le));
}
```

```cpp
#include <hip/hip_runtime.h>
#include <cstdio>
#include <cstdint>

#define GAS __attribute__((address_space(1)))
#define LAS __attribute__((address_space(3)))

constexpr int D = 1024, NB = 2, SEQ = 16384, NCTX = 256, SB = SEQ + NCTX  , T = NB * SB  ;
constexpr int NE = 32, TOPK = 4, DFF = 1024;
constexpr int MAXTILES = T * TOPK / 256 + NE;
constexpr int CROWS = MAXTILES * 256;
constexpr float RMS_EPS = 1e-6f;
constexpr float LAM_INIT = 0.55605818f;
constexpr float LOG2_THETA = 13.287712379549449f;
constexpr float INV_2PI = 0.15915494309189535f;
constexpr float OS_GQA = 32.f, OS_DIFF = 16.f, OS_CONV = 4.f;

enum { I_X = 0, I_C, I_CTX, I_CCTX, I_MODW, I_MODB, I_NORMG, I_POOLW, I_POOLS, I_GQKV, I_GO, I_GQG, I_GKG, I_CIN, I_CDW, I_COUT, I_DQKV, I_DO, I_DLAM, I_DSUB,
       I_RW, I_RB, I_W1, I_B1, I_W2, I_B2, N_IN };

constexpr size_t MiB = 1u << 20;
constexpr size_t WS_CTL = 0, CTL_ZERO_BYTES = 1 * MiB;
constexpr size_t WS_MOD = 1 * MiB;
constexpr size_t WS_POOLW = 2 * MiB;
constexpr size_t WS_GQKV = 3 * MiB;
constexpr size_t WS_GO = 6 * MiB;
constexpr size_t WS_CIN = 8 * MiB;
constexpr size_t WS_COUT = 14 * MiB;
constexpr size_t WS_DQKV = 16 * MiB;
constexpr size_t WS_DO = 22 * MiB;
constexpr size_t WS_GATE = 24 * MiB;
constexpr size_t WS_B1H = 25 * MiB;
constexpr size_t WS_B2H = WS_B1H + 512 * 1024;
constexpr size_t WS_LIST = 26 * MiB;
constexpr size_t WS_W1T = 32 * MiB;
constexpr size_t WS_W2T = WS_W1T + 512 * MiB;
constexpr size_t WS_X = WS_W2T + 256 * MiB;
constexpr size_t WS_H = WS_X + 130 * MiB;
constexpr size_t WS_G = WS_H + 65 * MiB;
constexpr size_t WS_O = WS_G + 195 * MiB;
constexpr size_t WS_OA = WS_O + 65 * MiB;
constexpr size_t WS_OB = WS_OA + 65 * MiB;
constexpr size_t WS_Y = WS_OB + 65 * MiB;
constexpr size_t WS_HS = WS_Y + 65 * MiB;
constexpr size_t WS_ACT = WS_HS + 276 * MiB;
constexpr size_t WS_SLOT = WS_ACT + 276 * MiB;
constexpr size_t WS_Q8 = WS_SLOT + 260 * MiB;
constexpr size_t WS_K8 = WS_Q8 + 33 * MiB;
constexpr size_t WS_VT8 = WS_K8 + 33 * MiB;
constexpr size_t WS_END = WS_VT8 + 33 * MiB;
static_assert(((size_t)T * 4 + 256) * 1024 <= 260 * MiB, "slot junk rows");
static_assert((size_t)T * 1024 <= 33 * MiB && (size_t)NB * 8 * 128 * SB <= 33 * MiB, "ws map fp8");
static_assert((size_t)T * D * 4 <= 130 * MiB && (size_t)T * D * 2 <= 65 * MiB && (size_t)T * 3072 * 2 <= 195 * MiB && (size_t)CROWS * D * 2 <= 276 * MiB && (size_t)T * 4 * D * 2 <= 260 * MiB, "ws map");
static_assert((size_t)NE * T * 4 <= 6 * MiB && (size_t)CROWS * 4 <= 1 * MiB && (size_t)T * 4 * 4 <= 1 * MiB && 4 * 3 * 6144 * 4 <= 1 * MiB, "ws map small");
constexpr int CW_CNT = 64;
constexpr int CW_BAR = 4096;

constexpr int RING_BYTES = 131072;
constexpr int LC_MISC = RING_BYTES;
constexpr int LC_CNT = LC_MISC + 64;
constexpr int LC_TBASE = LC_CNT + 128;
constexpr int LC_LCNT = LC_TBASE + 192;
constexpr int LC_GBASE = LC_LCNT + 128;
constexpr int LC_TILEE = LC_GBASE + 128;
constexpr int LC_TOK16 = LC_TILEE + MAXTILES * 4;
constexpr int MAXU = 26;
constexpr int LDS_BYTES = 147456;
static_assert(LC_TOK16 % 16 == 0 && LC_TOK16 + MAXU * 512 <= LDS_BYTES, "LDS map");

typedef unsigned short bf16_t;
typedef float f32x4 __attribute__((ext_vector_type(4)));
typedef float f32x2 __attribute__((ext_vector_type(2)));
typedef unsigned u32x2 __attribute__((ext_vector_type(2)));
typedef unsigned u32x4 __attribute__((ext_vector_type(4)));

__device__ __forceinline__ unsigned pkbf(float lo, float hi) { unsigned r; asm("v_cvt_pk_bf16_f32 %0, %1, %2" : "=v"(r) : "v"(lo), "v"(hi)); return r; }
__device__ __forceinline__ float bflo(unsigned w) { return __uint_as_float(w << 16); }
__device__ __forceinline__ float bfhi(unsigned w) { return __uint_as_float(w & 0xffff0000u); }
__device__ __forceinline__ float wave_sum(float v) {
#pragma unroll
    for (int o = 1; o < 64; o <<= 1) v += __shfl_xor(v, o);
    return v;
}
#define LDS_WAIT() asm volatile("s_waitcnt lgkmcnt(0)" ::: "memory")
#define VM_WAIT() asm volatile("s_waitcnt vmcnt(0)" ::: "memory")

namespace pg8 {
#define PG8_LAS __attribute__((address_space(3)))
typedef unsigned short bf16_t;
typedef short bf16x8 __attribute__((ext_vector_type(8)));
typedef float f32x4 __attribute__((ext_vector_type(4)));
typedef unsigned u32x4 __attribute__((ext_vector_type(4)));
typedef int i32x4 __attribute__((ext_vector_type(4)));
typedef int i32x8 __attribute__((ext_vector_type(8)));
typedef unsigned u32x2 __attribute__((ext_vector_type(2)));
constexpr int BM = 256, BK = 64, HALF = 128, HTB = HALF * BK * 2  , STAGE_BYTES = 8 * HTB, NXCD = 8, WGM = 8;

__host__ __device__ __forceinline__ int lds_byte(int r, int c) { const int st = (r >> 4) * 2 + (c >> 5), rr = r & 15, cc = c & 31, ob = rr * 64 + cc * 2; return st * 1024 + (ob ^ (((ob >> 9) & 1) << 5)); }
__host__ __device__ __forceinline__ void stage_rc(int b, int& R, int& C) { const int st = b / 1024, sb = b % 1024, swz = sb ^ (((sb >> 9) & 1) << 5); R = (st >> 1) * 16 + swz / 64; C = (st & 1) * 32 + (swz % 64) / 2; }
__host__ __device__ __forceinline__ int perm32(int rho) { const int n = rho >> 4, i = rho & 15; return 8 * (i >> 2) + 4 * n + (i & 3); }

struct Unit { int pm, pn; };
struct Gemm { const bf16_t* A; const bf16_t* Bt; int M, N, K; };

struct StaticOrder {
    int nM, nN, nwg, G, c;
    __host__ __device__ void init(int M, int N, int G_, int c_) { nM = M / BM; nN = N / BM; nwg = nM * nN; G = G_; c = c_; }
    __host__ __device__ bool next(int i, Unit& u) const {
        const long L = (long)i * G + c; if (L >= nwg) return false;
        int wgid = (int)L; { const int q = nwg / NXCD, r = nwg % NXCD, xcd = wgid % NXCD, off = wgid / NXCD; wgid = (xcd < r ? xcd * (q + 1) : r * (q + 1) + (xcd - r) * q) + off; }
        const int nig = WGM * nN, gid = wgid / nig, fm = gid * WGM, gsz = (nM - fm) < WGM ? (nM - fm) : WGM;
        u.pm = fm + ((wgid % nig) % gsz); u.pn = (wgid % nig) / gsz; return true;
    }
    __device__ __forceinline__ void a_ready(const Unit&) const {}
    __device__ __forceinline__ void done(const Unit&) const {}
};


struct PoolOrder {
    int G, c;
    __device__ __forceinline__ bool next(int i, Unit& u) const { const int L = i * G + c; if (L >= 4 * 130) return false; const int g = L & 3, pm = L >> 2; u.pm = g * 130 + pm; u.pn = g; return true; }
    __device__ __forceinline__ void a_ready(const Unit&) const {}
    __device__ __forceinline__ void done(const Unit&) const {}
};
struct LatentOrder {
    StaticOrder S;
    __device__ void init(int N, int G_, int c_) { S.init(NB * SEQ, N, G_, c_); }
    __device__ bool next(int i, Unit& u) const { if (!S.next(i, u)) return false; u.pm += (u.pm >= SEQ / 256) ? 2 : 1; return true; }
    __device__ __forceinline__ void a_ready(const Unit&) const {}
    __device__ __forceinline__ void done(const Unit&) const {}
};
struct MoeOrder {
    const PG8_LAS int* tile_e; int lim, nN, G, c;
    __device__ __forceinline__ bool next(int i, Unit& u) const { const int L = i * G + c; if (L >= lim) return false; const int pm = L / nN, pl = L - pm * nN; u.pm = pm; u.pn = tile_e[pm] * nN + pl; return true; }
    __device__ __forceinline__ void a_ready(const Unit&) const {}
    __device__ __forceinline__ void done(const Unit&) const {}
};

__device__ __forceinline__ unsigned cvt_pk_bf16(float lo, float hi) { unsigned r; asm volatile("v_cvt_pk_bf16_f32 %0, %1, %2" : "=v"(r) : "v"(lo), "v"(hi)); return r; }

template <bool POOL> struct EpiPlainT {
    static constexpr bool PERM = true, AFTER_DRAIN = false, HAS_PRE = false; struct Pre {}; static constexpr int NST = 16;
    bf16_t* O; int ldc;
    __device__ __forceinline__ void operator()(const f32x4 (&acc)[2][2][4][2], const Unit& u, int wr, int wc, int fr, int fq) const {
        const int rt = POOL ? (u.pm - 130 * u.pn) : u.pm;
        const int row0 = rt * BM + wr * 64 + fr, col0 = u.pn * BM + wc * 32 + 8 * fq;
#pragma unroll
        for (int ai = 0; ai < 2; ++ai)
#pragma unroll
            for (int m = 0; m < 4; ++m) { bf16_t* rowp = O + (size_t)(row0 + ai * HALF + m * 16) * ldc + col0;
#pragma unroll
                for (int bj = 0; bj < 2; ++bj) { const f32x4 v0 = acc[ai][bj][m][0], v1 = acc[ai][bj][m][1];
                    u32x4 w; w.x = cvt_pk_bf16(v0[0], v0[1]); w.y = cvt_pk_bf16(v0[2], v0[3]); w.z = cvt_pk_bf16(v1[0], v1[1]); w.w = cvt_pk_bf16(v1[2], v1[3]);
                    *(u32x4*)(rowp + bj * HALF) = w; } }
    }
};
struct EpiScaled {
    static constexpr bool PERM = true, AFTER_DRAIN = false, HAS_PRE = false; struct Pre {}; static constexpr int NST = 16;
    bf16_t* O; int ldc; float asc;
    __device__ __forceinline__ void operator()(const f32x4 (&acc)[2][2][4][2], const Unit& u, int wr, int wc, int fr, int fq) const {
        const int row0 = u.pm * BM + wr * 64 + fr, col0 = u.pn * BM + wc * 32 + 8 * fq;
#pragma unroll
        for (int ai = 0; ai < 2; ++ai)
#pragma unroll
            for (int m = 0; m < 4; ++m) { bf16_t* rowp = O + (size_t)(row0 + ai * HALF + m * 16) * ldc + col0;
#pragma unroll
                for (int bj = 0; bj < 2; ++bj) { const f32x4 v0 = acc[ai][bj][m][0] * asc, v1 = acc[ai][bj][m][1] * asc;
                    u32x4 w; w.x = cvt_pk_bf16(v0[0], v0[1]); w.y = cvt_pk_bf16(v0[2], v0[3]); w.z = cvt_pk_bf16(v1[0], v1[1]); w.w = cvt_pk_bf16(v1[2], v1[3]);
                    *(u32x4*)(rowp + bj * HALF) = w; } }
    }
};
typedef EpiPlainT<false> EpiPlain;
typedef EpiPlainT<true> EpiPool;
template <int CHEAP> struct EpiSwiGLUT {
    static constexpr bool PERM = true, AFTER_DRAIN = false; static constexpr int NST = (CHEAP == 2) ? 0 : 4;
    unsigned char* ACT; const bf16_t* b1h; float asc;
    static constexpr bool HAS_PRE = true; struct Pre { u32x4 bg, bu; };
    __device__ __forceinline__ void pre(const Unit& u, int wc, int fq, Pre& p) const {
        const int e = u.pn >> 3, pl = u.pn & 7, oc0 = pl * 128 + wc * 32 + 8 * fq;
        const bf16_t* a = b1h + e * 2048 + oc0;
        asm volatile("global_load_dwordx4 %0, %1, off" : "=v"(p.bg) : "v"(a) : "memory");
        asm volatile("global_load_dwordx4 %0, %1, off offset:2048" : "=v"(p.bu) : "v"(a) : "memory");
    }
    __device__ __forceinline__ void operator()(const f32x4 (&acc)[2][2][4][2], const Unit& u, int wr, int wc, int fr, int fq, const Pre& p) const {
        if constexpr (CHEAP == 2) return;
        const int pl = u.pn & 7;
        const int row0 = u.pm * BM + wr * 64 + fr, oc0 = pl * 128 + wc * 32 + 8 * fq;
        f32x4 bg[2], bu[2];
#pragma unroll
        for (int n = 0; n < 2; ++n) { bg[n] = (f32x4){__uint_as_float(p.bg[2 * n] << 16), __uint_as_float(p.bg[2 * n] & 0xffff0000u), __uint_as_float(p.bg[2 * n + 1] << 16), __uint_as_float(p.bg[2 * n + 1] & 0xffff0000u)};
            bu[n] = (f32x4){__uint_as_float(p.bu[2 * n] << 16), __uint_as_float(p.bu[2 * n] & 0xffff0000u), __uint_as_float(p.bu[2 * n + 1] << 16), __uint_as_float(p.bu[2 * n + 1] & 0xffff0000u)} + 1.0f; }
#pragma unroll
        for (int ai = 0; ai < 2; ++ai)
#pragma unroll
            for (int mp = 0; mp < 2; ++mp) {
                unsigned w[2][2];
#pragma unroll
                for (int mm = 0; mm < 2; ++mm) { const int m = 2 * mp + mm; float o[8];
#pragma unroll
                    for (int n = 0; n < 2; ++n) {
#pragma unroll
                        for (int jp = 0; jp < 2; ++jp) { typedef float f2e __attribute__((ext_vector_type(2)));
                            const f32x4 ag = acc[ai][0][m][n], au = acc[ai][1][m][n];
                            const f2e a2 = {asc, asc};
                            f2e gv = (f2e){ag[2 * jp], ag[2 * jp + 1]} * a2 + (f2e){bg[n][2 * jp], bg[n][2 * jp + 1]};
                            f2e uv = (f2e){au[2 * jp], au[2 * jp + 1]} * a2 + (f2e){bu[n][2 * jp], bu[n][2 * jp + 1]};
                            gv.x = fminf(gv.x, 7.0f); gv.y = fminf(gv.y, 7.0f);
                            uv.x = fminf(fmaxf(uv.x, -6.0f), 8.0f); uv.y = fminf(fmaxf(uv.y, -6.0f), 8.0f);
                            const f2e tt = gv * (f2e){-1.702f * 1.4426950408889634f, -1.702f * 1.4426950408889634f};
                            f2e dd = (f2e){(CHEAP != 0) ? 1.0f : __builtin_amdgcn_exp2f(tt.x), (CHEAP != 0) ? 1.0f : __builtin_amdgcn_exp2f(tt.y)} + (f2e){1.0f, 1.0f};
                            const f2e sg = {(CHEAP != 0) ? 0.5f : __builtin_amdgcn_rcpf(dd.x), (CHEAP != 0) ? 0.5f : __builtin_amdgcn_rcpf(dd.y)};
                            const f2e oo = (gv * sg) * uv;
                            o[4 * n + 2 * jp] = oo.x; o[4 * n + 2 * jp + 1] = oo.y; } }
                    int w0 = 0, w1 = 0; w0 = __builtin_amdgcn_cvt_pk_fp8_f32(o[0], o[1], w0, false); w0 = __builtin_amdgcn_cvt_pk_fp8_f32(o[2], o[3], w0, true);
                    w1 = __builtin_amdgcn_cvt_pk_fp8_f32(o[4], o[5], w1, false); w1 = __builtin_amdgcn_cvt_pk_fp8_f32(o[6], o[7], w1, true);
                    w[mm][0] = (unsigned)w0; w[mm][1] = (unsigned)w1; }
                const auto lo = __builtin_amdgcn_permlane16_swap(w[0][0], w[1][0], false, false), hi2 = __builtin_amdgcn_permlane16_swap(w[0][1], w[1][1], false, false);
                const int m = 2 * mp + (fq & 1);
                *(u32x4*)(ACT + (size_t)(row0 + ai * HALF + m * 16) * 1024 + (oc0 & ~15)) = (u32x4){lo[0], hi2[0], lo[1], hi2[1]}; }
    }
};
typedef EpiSwiGLUT<0> EpiSwiGLU;
struct EpiScatter {
    static constexpr bool PERM = true, AFTER_DRAIN = false;
    static constexpr int NST = 8;
    unsigned char* SLOT; const PG8_LAS int* slot_tab; int G, c; const bf16_t* b2h; float asc; int seq; int junk0;
    static constexpr bool HAS_PRE = true; struct Pre { u32x4 bv[2]; };
    __device__ __forceinline__ void pre(const Unit& u, int wc, int fq, Pre& p) const {
        const int e = u.pn >> 2, pl = u.pn & 3, col0 = pl * BM + wc * 32 + 8 * fq;
        const bf16_t* a = b2h + e * 1024 + col0;
        asm volatile("global_load_dwordx4 %0, %1, off" : "=v"(p.bv[0]) : "v"(a) : "memory");
        asm volatile("global_load_dwordx4 %0, %1, off offset:256" : "=v"(p.bv[1]) : "v"(a) : "memory");
    }
    __device__ __forceinline__ void operator()(const f32x4 (&acc)[2][2][4][2], const Unit& u, int wr, int wc, int fr, int fq, const Pre& p) const {
        const int pl = u.pn & 3, ui = (u.pm * 4 + pl - c) / G;
        const int col0 = pl * BM + wc * 32 + 8 * fq;
        f32x4 bv[2][2];
#pragma unroll
        for (int bj = 0; bj < 2; ++bj)
#pragma unroll
            for (int n = 0; n < 2; ++n) bv[bj][n] = (f32x4){__uint_as_float(p.bv[bj][2 * n] << 16), __uint_as_float(p.bv[bj][2 * n] & 0xffff0000u), __uint_as_float(p.bv[bj][2 * n + 1] << 16), __uint_as_float(p.bv[bj][2 * n + 1] & 0xffff0000u)};
#pragma unroll
        for (int ai = 0; ai < 2; ++ai)
#pragma unroll
            for (int mp = 0; mp < 2; ++mp) {
                const int m = 2 * mp + (fq & 1), rit = wr * 64 + fr + ai * HALF + m * 16;
                int slot = seq ? (u.pm * BM + rit) : slot_tab[ui * BM + rit];
                if (slot < 0) slot = junk0 + rit;
#pragma unroll
                for (int bj = 0; bj < 2; ++bj) { unsigned w[2][2];
#pragma unroll
                    for (int mm = 0; mm < 2; ++mm) { const f32x4 v0 = acc[ai][bj][2 * mp + mm][0] * asc + bv[bj][0], v1 = acc[ai][bj][2 * mp + mm][1] * asc + bv[bj][1];
                        int w0 = 0, w1 = 0; w0 = __builtin_amdgcn_cvt_pk_fp8_f32(v0[0], v0[1], w0, false); w0 = __builtin_amdgcn_cvt_pk_fp8_f32(v0[2], v0[3], w0, true);
                        w1 = __builtin_amdgcn_cvt_pk_fp8_f32(v1[0], v1[1], w1, false); w1 = __builtin_amdgcn_cvt_pk_fp8_f32(v1[2], v1[3], w1, true);
                        w[mm][0] = (unsigned)w0; w[mm][1] = (unsigned)w1; }
                    const auto lo = __builtin_amdgcn_permlane16_swap(w[0][0], w[1][0], false, false), hi2 = __builtin_amdgcn_permlane16_swap(w[0][1], w[1][1], false, false);
                    *(u32x4*)(SLOT + (size_t)slot * 1024 + (col0 & ~15) + bj * HALF) = (u32x4){lo[0], hi2[0], lo[1], hi2[1]}; }
            }
    }
};

template <class Epi, class Sched, bool ALIGN_EPI = false, bool SP2 = false, int ES = 2, bool GATHER = false, int PRB = 0>
__device__ __forceinline__ void gemm_phase(PG8_LAS unsigned char* lds, const Gemm g, const Sched& S, const Epi& E, const PG8_LAS unsigned short* tok16 = nullptr) {
    static_assert(SP2 || !GATHER, "GATHER is implemented for the SP2 loop");
    int tid_ = threadIdx.x; asm volatile("" : "+v"(tid_));
    const int tid = tid_, wid = __builtin_amdgcn_readfirstlane(tid >> 6), lane = tid & 63, wr = wid >> 2, wc = wid & 3, fr = lane & 15, fq = lane >> 4;
    const int K = g.K, nt = K * ES / (BK * 2);
    unsigned voffA[2], voffB[2]; int rowA[2]; unsigned colA[2];
#pragma unroll
    for (int i = 0; i < 2; ++i) { int R, C; stage_rc(tid * 16 + i * 8192, R, C); const int Rb = Epi::PERM ? ((R & ~31) + perm32(R & 31)) : R;
        voffA[i] = (unsigned)(R * K * ES + C * 2); voffB[i] = (unsigned)(Rb * K * ES + C * 2); rowA[i] = R; colA[i] = (unsigned)(C * 2); }
    const size_t kstep = (size_t)(BK * 2);
    const size_t hstep = (size_t)HALF * K * ES;
    const size_t hstepA = GATHER ? 0 : hstep;
    const size_t tstep = 2 * hstep;
    const unsigned ldsw = (unsigned)wid * 1024u;
    const int aoff = lds_byte(wr * 64 + fr, fq * 8), boff = lds_byte(wc * 32 + fr, fq * 8);
#define PG8_SA(b, h) (((b) * 2 + (h)) * HTB)
#define PG8_SB(b, h) ((4 + (b) * 2 + (h)) * HTB)
#define PG8_STAGE(bufoff, gbase, voff) do { _Pragma("unroll") for (int _i = 0; _i < 2; ++_i) \
        __builtin_amdgcn_global_load_lds((const unsigned*)((const char*)(gbase) + (voff)[_i]), (PG8_LAS unsigned*)(lds + (bufoff) + ldsw + _i * 8192), 16, 0, 0); } while (0)
#define PG8_GOFF(dst, ui_) do { _Pragma("unroll") for (int _h = 0; _h < 2; ++_h) _Pragma("unroll") for (int _i = 0; _i < 2; ++_i) dst[_h][_i] = (unsigned)tok16[(ui_) * 256 + _h * HALF + rowA[_i]] * (unsigned)(K * ES) + colA[_i]; } while (0)
#define PG8_STAGE_A(bufoff, gbase, h, usenext) do { if constexpr (GATHER) { _Pragma("unroll") for (int _i = 0; _i < 2; ++_i) { const unsigned vo_ = (usenext) ? goffN[h][_i] : goffC[h][_i]; \
        __builtin_amdgcn_global_load_lds((const unsigned*)((const char*)(gbase) + vo_), (PG8_LAS unsigned*)(lds + (bufoff) + ldsw + _i * 8192), 16, 0, 0); } } else PG8_STAGE(bufoff, gbase, voffA); } while (0)
#define PG8_LDA(dst, b, h) do { _Pragma("unroll") for (int m = 0; m < 4; ++m) _Pragma("unroll") for (int k = 0; k < 2; ++k) dst[m][k] = *(const PG8_LAS bf16x8*)(lds + PG8_SA(b, h) + aoff + m * 2048 + k * 1024); } while (0)
#define PG8_LDB(dst, b, h) do { _Pragma("unroll") for (int n = 0; n < 2; ++n) _Pragma("unroll") for (int k = 0; k < 2; ++k) dst[n][k] = *(const PG8_LAS bf16x8*)(lds + PG8_SB(b, h) + boff + n * 2048 + k * 1024); } while (0)
#define PG8_CAT8(lo, hi) __builtin_shufflevector(__builtin_bit_cast(i32x4, lo), __builtin_bit_cast(i32x4, hi), 0, 1, 2, 3, 4, 5, 6, 7)
#define PG8_MFMA8(accv, bv, av) asm volatile("v_mfma_scale_f32_16x16x128_f8f6f4 %0, %1, %2, %0, %3, %3 op_sel_hi:[0,0,0]" : "+v"(accv) : "v"(bv), "v"(av), "v"(sc1))
#define PG8_MMA(ai, bj, At, Bt) do { if constexpr (PRB == 1) break; __builtin_amdgcn_s_setprio(1); if constexpr (ES == 2) { _Pragma("unroll") for (int m = 0; m < 4; ++m) _Pragma("unroll") for (int n = 0; n < 2; ++n) _Pragma("unroll") for (int k = 0; k < 2; ++k) \
        acc[ai][bj][m][n] = __builtin_amdgcn_mfma_f32_16x16x32_bf16(Bt[n][k], At[m][k], acc[ai][bj][m][n], 0, 0, 0); } else { _Pragma("unroll") for (int m = 0; m < 4; ++m) _Pragma("unroll") for (int n = 0; n < 2; ++n) { \
        const i32x8 b8_ = PG8_CAT8(Bt[n][0], Bt[n][1]), a8_ = PG8_CAT8(At[m][0], At[m][1]); PG8_MFMA8(acc[ai][bj][m][n], b8_, a8_); } } __builtin_amdgcn_s_setprio(0); } while (0)
#define PG8_WAIT_V(n) asm volatile("s_waitcnt vmcnt(" #n ")" ::: "memory")
#define PG8_WAIT_L(n) asm volatile("s_waitcnt lgkmcnt(" #n ")" ::: "memory")
#define PG8_BAR __builtin_amdgcn_s_barrier()
#define PG8_SCHED __builtin_amdgcn_sched_barrier(0)
    Unit cur, nxt; int ui = 0; typename Epi::Pre epre;
    if (!S.next(0, cur)) return;
    int sc1 = 0x7f7f7f7f; asm volatile("" : "+v"(sc1));
    f32x4 acc[2][2][4][2];
#pragma unroll
    for (int a = 0; a < 2; ++a)
#pragma unroll
        for (int b = 0; b < 2; ++b)
#pragma unroll
            for (int m = 0; m < 4; ++m)
#pragma unroll
                for (int n = 0; n < 2; ++n) acc[a][b][m][n] = (f32x4){0.f, 0.f, 0.f, 0.f};
    bf16x8 At[4][2], B0[2][2], B1[2][2];
    const char* cA = (const char*)g.A + (GATHER ? (size_t)0 : (size_t)cur.pm * tstep); const char* cB = (const char*)g.Bt + (size_t)cur.pn * tstep;
    unsigned goffC[2][2] = {{0u, 0u}, {0u, 0u}}, goffN[2][2] = {{0u, 0u}, {0u, 0u}};
    if constexpr (GATHER) PG8_GOFF(goffC, 0);
    S.a_ready(cur);
    if constexpr (SP2) {
        PG8_STAGE(PG8_SB(0, 0), cB, voffB); PG8_STAGE(PG8_SB(0, 1), cB + hstep, voffB); PG8_STAGE_A(PG8_SA(0, 0), cA, 0, false); PG8_STAGE_A(PG8_SA(0, 1), cA + hstepA, 1, false);
        if (wr == 1) PG8_BAR;
        PG8_WAIT_V(2); PG8_BAR;
        PG8_STAGE(PG8_SB(1, 0), cB + kstep, voffB); PG8_STAGE_A(PG8_SA(1, 0), cA + kstep, 0, false); PG8_STAGE(PG8_SB(1, 1), cB + hstep + kstep, voffB);
        PG8_WAIT_V(6); PG8_BAR;
    } else {
        PG8_STAGE(PG8_SB(0, 0), cB, voffB); PG8_STAGE(PG8_SA(0, 0), cA, voffA); PG8_STAGE(PG8_SB(0, 1), cB + hstep, voffB); PG8_STAGE(PG8_SA(0, 1), cA + hstep, voffA);
        if (wr == 1) PG8_BAR;
        PG8_WAIT_V(4); PG8_BAR;
        PG8_STAGE(PG8_SB(1, 0), cB + kstep, voffB); PG8_STAGE(PG8_SA(1, 0), cA + kstep, voffA); PG8_STAGE(PG8_SB(1, 1), cB + hstep + kstep, voffB);
        PG8_WAIT_V(6); PG8_BAR;
    }
    bool seam = false;
#define PG8_WAIT_VX(rx_) asm volatile("v_cmp_ne_u32_e32 vcc, 0, %0\n\ts_cbranch_vccz 1f\n\ts_waitcnt vmcnt(%1)\n\ts_branch 2f\n1:\n\ts_waitcnt vmcnt(8)\n2:" :: "v"(rx_), "n"(8 + Epi::NST) : "memory", "vcc")
    for (;;) {
        const bool has_next = S.next(ui + 1, nxt);
        const char* nA = (has_next && !GATHER) ? (const char*)g.A + (size_t)nxt.pm * tstep : cA;
        const char* nB = has_next ? (const char*)g.Bt + (size_t)nxt.pn * tstep : cB;
        for (int t = 0; t < nt; t += 2) {
            const bool last = (t == nt - 2);
            const int rx = (SP2 && seam && t == 0) ? 1 : 0;
            const char* a1 = cA + (size_t)(t + 1) * kstep;
            const char* a2 = last ? nA : cA + (size_t)(t + 2) * kstep; const char* b2 = last ? nB : cB + (size_t)(t + 2) * kstep;
            const char* a3 = a2 + kstep; const char* b3 = b2 + kstep;
            if (last && has_next) S.a_ready(nxt);
            if constexpr (Epi::HAS_PRE) { if (last) E.pre(cur, wc, fq, epre); }
            if constexpr (GATHER) { if (last) { if (has_next) PG8_GOFF(goffN, ui + 1); else { _Pragma("unroll") for (int _h = 0; _h < 2; ++_h) _Pragma("unroll") for (int _i = 0; _i < 2; ++_i) goffN[_h][_i] = goffC[_h][_i]; } } }
            if constexpr (SP2) {
            PG8_LDB(B0, 0, 0); PG8_LDB(B1, 0, 1); PG8_SCHED; PG8_LDA(At, 0, 0); PG8_STAGE_A(PG8_SA(1, 1), a1 + hstepA, 1, false);
            PG8_WAIT_VX(rx); PG8_WAIT_L(0); PG8_BAR; PG8_MMA(0, 0, At, B0); PG8_MMA(0, 1, At, B1); PG8_BAR; PG8_SCHED;
            PG8_LDA(At, 0, 1); PG8_STAGE(PG8_SB(0, 0), b2, voffB); PG8_STAGE(PG8_SB(0, 1), b2 + hstep, voffB); PG8_STAGE_A(PG8_SA(0, 0), a2, 0, last);
            PG8_WAIT_VX(rx); PG8_WAIT_L(0); PG8_BAR; PG8_MMA(1, 0, At, B0); PG8_MMA(1, 1, At, B1); PG8_BAR; PG8_SCHED;
            PG8_LDB(B0, 1, 0); PG8_LDB(B1, 1, 1); PG8_SCHED; PG8_LDA(At, 1, 0); PG8_STAGE_A(PG8_SA(0, 1), a2 + hstepA, 1, last);
            PG8_WAIT_V(8); PG8_WAIT_L(0); PG8_BAR; PG8_MMA(0, 0, At, B0); PG8_MMA(0, 1, At, B1); PG8_BAR; PG8_SCHED;
            PG8_LDA(At, 1, 1); PG8_STAGE(PG8_SB(1, 0), b3, voffB); PG8_STAGE(PG8_SB(1, 1), b3 + hstep, voffB); PG8_STAGE_A(PG8_SA(1, 0), a3, 0, last);
            PG8_WAIT_V(8); PG8_WAIT_L(0); PG8_BAR; PG8_MMA(1, 0, At, B0); PG8_MMA(1, 1, At, B1); PG8_BAR; PG8_SCHED;
            } else {
            PG8_LDB(B0, 0, 0); PG8_SCHED; PG8_LDA(At, 0, 0); PG8_STAGE(PG8_SA(1, 1), a1 + hstep, voffA);
            PG8_WAIT_L(8); PG8_BAR; PG8_WAIT_L(0); PG8_MMA(0, 0, At, B0); PG8_BAR; PG8_SCHED;
            PG8_LDB(B1, 0, 1); PG8_STAGE(PG8_SB(0, 0), b2, voffB);
            PG8_BAR; PG8_WAIT_L(0); PG8_MMA(0, 1, At, B1); PG8_BAR;
            PG8_LDA(At, 0, 1); PG8_STAGE(PG8_SA(0, 0), a2, voffA);
            PG8_BAR; PG8_WAIT_L(0); PG8_MMA(1, 0, At, B0); PG8_BAR; PG8_SCHED;
            PG8_STAGE(PG8_SB(0, 1), b2 + hstep, voffB);
            PG8_WAIT_V(6); PG8_BAR; PG8_MMA(1, 1, At, B1); PG8_BAR;
            PG8_LDB(B0, 1, 0); PG8_SCHED; PG8_LDA(At, 1, 0); PG8_STAGE(PG8_SA(0, 1), a2 + hstep, voffA);
            PG8_WAIT_L(8); PG8_BAR; PG8_WAIT_L(0); PG8_MMA(0, 0, At, B0); PG8_BAR; PG8_SCHED;
            PG8_LDB(B1, 1, 1); PG8_STAGE(PG8_SB(1, 0), b3, voffB);
            PG8_BAR; PG8_WAIT_L(0); PG8_MMA(0, 1, At, B1); PG8_BAR;
            PG8_LDA(At, 1, 1); PG8_STAGE(PG8_SA(1, 0), a3, voffA);
            PG8_BAR; PG8_WAIT_L(0); PG8_MMA(1, 0, At, B0); PG8_BAR; PG8_SCHED;
            PG8_STAGE(PG8_SB(1, 1), b3 + hstep, voffB);
            PG8_WAIT_V(6); PG8_BAR; PG8_MMA(1, 1, At, B1); PG8_BAR;
            }
        }
        if constexpr (ES == 1) { PG8_SCHED; asm volatile("s_nop 15\n\ts_nop 15" ::: "memory"); PG8_SCHED; }
        if constexpr (ALIGN_EPI) { if (wr == 0) PG8_BAR; }
        if constexpr (!Epi::AFTER_DRAIN) { if constexpr (Epi::HAS_PRE) E(acc, cur, wr, wc, fr, fq, epre); else E(acc, cur, wr, wc, fr, fq); S.done(cur); }
        if (!has_next) break;
#pragma unroll
        for (int a = 0; a < 2; ++a)
#pragma unroll
            for (int b = 0; b < 2; ++b)
#pragma unroll
                for (int m = 0; m < 4; ++m)
#pragma unroll
                    for (int n = 0; n < 2; ++n) acc[a][b][m][n] = (f32x4){0.f, 0.f, 0.f, 0.f};
        cur = nxt; cA = nA; cB = nB; ++ui; seam = SP2;
        if constexpr (GATHER) { _Pragma("unroll") for (int _h = 0; _h < 2; ++_h) _Pragma("unroll") for (int _i = 0; _i < 2; ++_i) goffC[_h][_i] = goffN[_h][_i]; }
        if constexpr (ALIGN_EPI) { if (wr == 1) PG8_BAR; }
    }
    PG8_WAIT_V(0);
    if constexpr (!ALIGN_EPI) { if (wr == 0) PG8_BAR; }
    PG8_BAR;
    if constexpr (Epi::AFTER_DRAIN) { E.fused(acc, cur, wr, wc, fr, fq, lds, wid, lane); S.done(cur); }
#undef PG8_SA
#undef PG8_SB
#undef PG8_STAGE
#undef PG8_STAGE_A
#undef PG8_GOFF
#undef PG8_LDA
#undef PG8_LDB
#undef PG8_MMA
#undef PG8_CAT8
#undef PG8_MFMA8
#undef PG8_WAIT_V
#undef PG8_WAIT_VX
#undef PG8_WAIT_L
#undef PG8_BAR
#undef PG8_SCHED
}
}

namespace att {
using f32x16 = __attribute__((ext_vector_type(16))) float;
__device__ __forceinline__ int crow(int r, int hi) { return (r & 3) + 8 * (r >> 2) + 4 * hi; }
__device__ __forceinline__ unsigned cvtpk(float lo, float hi) { unsigned r; asm volatile("v_cvt_pk_bf16_f32 %0, %1, %2" : "=v"(r) : "v"(lo), "v"(hi)); return r; }
}

namespace att8 {
using att::f32x16; using att::crow;
typedef int i32x4 __attribute__((ext_vector_type(4)));
typedef int i32x8 __attribute__((ext_vector_type(8)));
constexpr int NW = 8, QBLK = 32, KVBLK = 64;
#define SBAR() __builtin_amdgcn_sched_barrier(0)
template <int OFF> __device__ __forceinline__ i32x4 rd128(int a) { i32x4 r; asm volatile("ds_read_b128 %0, %1 offset:%2" : "=&v"(r) : "v"(a), "i"(OFF) : "memory"); return r; }
__device__ __forceinline__ i32x8 cat8(i32x4 lo, i32x4 hi) { return __builtin_shufflevector(lo, hi, 0, 1, 2, 3, 4, 5, 6, 7); }
__device__ __forceinline__ float mx3(float a, float b, float c) { float r; asm("v_max3_f32 %0, %1, %2, %3" : "=v"(r) : "v"(a), "v"(b), "v"(c)); return r; }
constexpr float CSC = 1.f / 65536.f;
template <bool FIRST>
__device__ __forceinline__ void softmax8(f32x16& p0, f32x16& p1, float& M_run, float& alpha, i32x8& pf) {
  constexpr float CTHR = (56.f + 8.f * (5.f * 1.4426950408889634f)) * CSC;
  float a0 = mx3(p0[0], p0[1], p0[2]), a1 = mx3(p0[8], p0[9], p0[10]), a2 = mx3(p1[0], p1[1], p1[2]), a3 = mx3(p1[8], p1[9], p1[10]);
  a0 = mx3(a0, p0[3], p0[4]); a1 = mx3(a1, p0[11], p0[12]); a2 = mx3(a2, p1[3], p1[4]); a3 = mx3(a3, p1[11], p1[12]);
  a0 = mx3(a0, p0[5], p0[6]); a1 = mx3(a1, p0[13], p0[14]); a2 = mx3(a2, p1[5], p1[6]); a3 = mx3(a3, p1[13], p1[14]);
  a0 = mx3(a0, p0[7], a1); a2 = mx3(a2, p1[7], a3);
  float cmax = mx3(a0, p0[15], a2); cmax = mx3(cmax, p1[15], cmax);
  { auto rr = __builtin_amdgcn_permlane32_swap(__float_as_uint(cmax), __float_as_uint(cmax), false, false); cmax = mx3(__uint_as_float(rr[0]), __uint_as_float(rr[1]), __uint_as_float(rr[1])); }
  alpha = 1.f;
  if (FIRST || !__builtin_expect(__all(cmax <= CTHR), 1)) {
    const float tmax = (cmax * 65536.f - 56.f) * 0.125f, d = FIRST ? tmax : fmaxf(tmax, 0.f), d8 = 8.f * d * CSC;
    alpha = __builtin_amdgcn_exp2f(-d); M_run += d;
#pragma unroll
    for (int r = 0; r < 16; ++r) { p0[r] -= d8; p1[r] -= d8; }
  }
  typedef unsigned short us2 __attribute__((ext_vector_type(2)));
#pragma unroll
  for (int w = 0; w < 4; ++w) { const unsigned A = __builtin_bit_cast(unsigned, __builtin_amdgcn_cvt_pknorm_u16(p0[4 * w], p0[4 * w + 1])), B = __builtin_bit_cast(unsigned, __builtin_amdgcn_cvt_pknorm_u16(p0[4 * w + 2], p0[4 * w + 3]));
    pf[w] = (int)__builtin_amdgcn_perm(B, A, 0x06040200u); }
#pragma unroll
  for (int w = 0; w < 4; ++w) { const unsigned A = __builtin_bit_cast(unsigned, __builtin_amdgcn_cvt_pknorm_u16(p1[4 * w], p1[4 * w + 1])), B = __builtin_bit_cast(unsigned, __builtin_amdgcn_cvt_pknorm_u16(p1[4 * w + 2], p1[4 * w + 3]));
    pf[4 + w] = (int)__builtin_amdgcn_perm(B, A, 0x06040200u); }
}

template <int DQK, int LDQ, int LDK, int LDO, bool DIFF, int PROBE = 0>
__device__ __forceinline__ void attn_body8(const unsigned char* __restrict__ Qb, const unsigned char* __restrict__ Kh, const unsigned char* __restrict__ VT, unsigned char* __restrict__ Ob, int seq, char* lds,
                                           int dmode, float lam, const float* __restrict__ subg) {
  constexpr int SHM_V = 128 * 64, SHM_K = 64 * DQK, SLOT = SHM_V + SHM_K, NS = DQK / 64;
  int tid_ = threadIdx.x; asm volatile("" : "+v"(tid_));
  const int tid = tid_, wid = __builtin_amdgcn_readfirstlane(tid >> 6), lane = tid & 63, r32 = lane & 31, hi = lane >> 5, half = wid >> 2;
  constexpr int RD = 4;
  float* ws = (float*)(lds + RD * SLOT) + wid * 64; float* al_l = ws + 32;
  int sc1 = 0x7f7f7f7f; asm volatile("" : "+v"(sc1));
  int scq = 0x6f6f6f6f; asm volatile("" : "+v"(scq));
  float M_run = 0.f; asm volatile("" : "+v"(M_run));
  f32x16 o[4] = {};
  typedef float f32x4_ __attribute__((ext_vector_type(4)));
  f32x4_ osum = {0.f, 0.f, 0.f, 0.f};
  i32x8 sel8;
  { const int onv = (((lane & 15) == 0 && ((lane >> 4) & 1) == 0) || ((lane & 15) == 1 && ((lane >> 4) & 1) == 1)) ? 0x38383838 : 0;
#pragma unroll
    for (int i = 0; i < 8; ++i) { int t_; asm volatile("v_mov_b32 %0, %1" : "=v"(t_) : "v"(onv)); sel8[i] = t_; } }
#define MFMA16S(acc4, a8, b8) asm volatile("v_mfma_scale_f32_16x16x128_f8f6f4 %0, %1, %2, %0, %3, %3 op_sel_hi:[0,0,0]" : "+v"(acc4) : "v"(a8), "v"(b8), "v"(sc1))
  i32x8 qf[NS];
  { const unsigned char* Qw = Qb + (long)(wid * QBLK + r32) * LDQ + hi * 32;
#pragma unroll
    for (int s = 0; s < NS; ++s) qf[s] = cat8(*reinterpret_cast<const i32x4*>(Qw + s * 64), *reinterpret_cast<const i32x4*>(Qw + s * 64 + 16)); }
  const int vrow = 16 * wid + (lane >> 2), vpc = lane & 3;
  const int krow = 8 * wid + ((DQK == 128) ? (lane >> 3) : ((lane >> 2) & 7)), kpc = (DQK == 128) ? (lane & 7) : (lane & 3);
  const unsigned char* vsrc = VT + (long)vrow * SB + ((vpc ^ ((vrow >> 2) & 3)) << 4);
  const unsigned char* ksrc = Kh + (long)krow * LDK + ((DQK == 128) ? ((kpc ^ ((krow >> 1) & 7)) << 4) : ((kpc ^ ((krow >> 2) & 3)) << 4));
  const bool kact = (DQK == 128) || (lane < 32);
  const unsigned ldv = (unsigned)__builtin_amdgcn_readfirstlane((int)(uintptr_t)lds + wid * 1024), ldk = (unsigned)__builtin_amdgcn_readfirstlane((int)(uintptr_t)lds + SHM_V + wid * (DQK == 128 ? 1024 : 512));
#define GLDS16(gsrc, ldst) do { unsigned keep_; asm volatile("s_mov_b32 %0, m0\n\ts_mov_b32 m0, %2\n\ts_nop 0\n\tglobal_load_lds_dwordx4 %1, off\n\ts_mov_b32 m0, %0" : "=&s"(keep_) : "v"(gsrc), "s"(ldst) : "memory"); } while (0)
#define SDMA8(t_, sl_) do { GLDS16(vsrc + (t_) * KVBLK, ldv + (unsigned)((sl_) * SLOT)); if (kact) GLDS16(ksrc + (long)((t_) * KVBLK) * LDK, ldk + (unsigned)((sl_) * SLOT)); } while (0)
#define VMWAIT8(n) asm volatile("s_waitcnt vmcnt(" #n ")" ::: "memory")
#define BARL8() do { SBAR(); asm volatile("s_waitcnt lgkmcnt(0)\n\ts_barrier" ::: "memory"); SBAR(); } while (0)
#define LWAIT8(n) do { asm volatile("s_waitcnt lgkmcnt(" #n ")" ::: "memory"); SBAR(); } while (0)
#define RESC8(a) do { if (__any((a) < 1.f)) { if (hi == 0) al_l[r32] = (a); asm volatile("s_waitcnt lgkmcnt(0)" ::: "memory"); \
    _Pragma("unroll") for (int g = 0; g < 4; ++g) { const f32x4 a4_ = *(const f32x4*)(al_l + 8 * g + 4 * hi);      \
      _Pragma("unroll") for (int i = 0; i < 4; ++i) { _Pragma("unroll") for (int d = 0; d < 4; ++d) o[d][4 * g + i] *= a4_[i]; } SBAR(); } \
    { const f32x4 a4_ = *(const f32x4*)(al_l + (lane & 1) * 16 + 4 * (lane >> 4)); _Pragma("unroll") for (int i = 0; i < 4; ++i) osum[i] *= a4_[i]; }     \
    CIN_SET8(); } } while (0)
#define MFMA8(acc, a8, b8) asm volatile("v_mfma_scale_f32_32x32x64_f8f6f4 %0, %1, %2, %0, %3, %3 op_sel_hi:[0,0,0]" : "+v"(acc) : "v"(a8), "v"(b8), "v"(sc1))
#define MFMA8QC(acc, a8, b8, cin_) asm volatile("v_mfma_scale_f32_32x32x64_f8f6f4 %0, %1, %2, %3, %4, %5 op_sel_hi:[0,0,0]" : "=&v"(acc) : "v"(a8), "v"(b8), "v"(cin_), "v"(scq), "v"(sc1))
#define MFMA8Q(acc, a8, b8) asm volatile("v_mfma_scale_f32_32x32x64_f8f6f4 %0, %1, %2, %0, %3, %4 op_sel_hi:[0,0,0]" : "+v"(acc) : "v"(a8), "v"(b8), "v"(scq), "v"(sc1))
  const int lb = (int)(uintptr_t)lds;
  const int va0 = lb + r32 * 64 + (((2 * hi) ^ ((r32 >> 2) & 3)) << 4), va1 = lb + r32 * 64 + (((2 * hi + 1) ^ ((r32 >> 2) & 3)) << 4);
  const int kz = (DQK == 128) ? ((r32 >> 1) & 7) : ((r32 >> 2) & 3), krb = lb + SHM_V + r32 * DQK;
  const int ka00 = krb + (((2 * hi) ^ kz) << 4), ka01 = krb + (((2 * hi + 1) ^ kz) << 4), ka10 = krb + (((4 + 2 * hi) ^ kz) << 4), ka11 = krb + (((5 + 2 * hi) ^ kz) << 4);
#define KREAD8(so) do { k00 = rd128<0>(ka00 + (so)); k01 = rd128<0>(ka01 + (so)); k10 = rd128<32 * DQK>(ka00 + (so)); k11 = rd128<32 * DQK>(ka01 + (so)); \
    if constexpr (NS == 2) { k20 = rd128<0>(ka10 + (so)); k21 = rd128<0>(ka11 + (so)); k30 = rd128<32 * DQK>(ka10 + (so)); k31 = rd128<32 * DQK>(ka11 + (so)); } } while (0)
#define KREAD8C(SO) do { k00 = rd128<(SO)>(ka00); k01 = rd128<(SO)>(ka01); k10 = rd128<(SO) + 32 * DQK>(ka00); k11 = rd128<(SO) + 32 * DQK>(ka01); \
    if constexpr (NS == 2) { k20 = rd128<(SO)>(ka10); k21 = rd128<(SO)>(ka11); k30 = rd128<(SO) + 32 * DQK>(ka10); k31 = rd128<(SO) + 32 * DQK>(ka11); } } while (0)
#define VREAD8AC(SO) do { v00 = rd128<(SO)>(va0); v01 = rd128<(SO)>(va1); v10 = rd128<(SO) + 2048>(va0); v11 = rd128<(SO) + 2048>(va1); } while (0)
#define VREAD8BC(SO) do { if constexpr (NS == 2) { k00 = rd128<(SO) + 4096>(va0); k01 = rd128<(SO) + 4096>(va1); k10 = rd128<(SO) + 6144>(va0); k11 = rd128<(SO) + 6144>(va1); } \
    else { k20 = rd128<(SO) + 4096>(va0); k21 = rd128<(SO) + 4096>(va1); k30 = rd128<(SO) + 6144>(va0); k31 = rd128<(SO) + 6144>(va1); } } while (0)
#define VREAD8A(so) do { v00 = rd128<0>(va0 + (so)); v01 = rd128<0>(va1 + (so)); v10 = rd128<2048>(va0 + (so)); v11 = rd128<2048>(va1 + (so)); } while (0)
#define VREAD8B(so) do { if constexpr (NS == 2) { k00 = rd128<4096>(va0 + (so)); k01 = rd128<4096>(va1 + (so)); k10 = rd128<6144>(va0 + (so)); k11 = rd128<6144>(va1 + (so)); } \
    else { k20 = rd128<4096>(va0 + (so)); k21 = rd128<4096>(va1 + (so)); k30 = rd128<6144>(va0 + (so)); k31 = rd128<6144>(va1 + (so)); } } while (0)
#define QK8(NV) do { if constexpr (NS == 2) { LWAIT8_(NV + 6); MFMA8QC(p0, cat8(k00, k01), qf[0], cin); LWAIT8_(NV + 4); MFMA8QC(p1, cat8(k10, k11), qf[0], cin); LWAIT8_(NV + 2); MFMA8Q(p0, cat8(k20, k21), qf[NS - 1]); LWAIT8_(NV); MFMA8Q(p1, cat8(k30, k31), qf[NS - 1]); } \
    else { LWAIT8_(NV + 2); MFMA8QC(p0, cat8(k00, k01), qf[0], cin); LWAIT8_(NV); MFMA8QC(p1, cat8(k10, k11), qf[0], cin); } } while (0)
#define LWAIT8_(n) do { asm volatile("s_waitcnt lgkmcnt(%0)" :: "n"(n) : "memory"); SBAR(); } while (0)
#define PV8() do { MFMA16S(osum, pf, sel8); LWAIT8(6); MFMA8(o[0], pf, cat8(v00, v01)); LWAIT8(4); MFMA8(o[1], pf, cat8(v10, v11)); \
    if constexpr (NS == 2) { LWAIT8(2); MFMA8(o[2], pf, cat8(k00, k01)); LWAIT8(0); MFMA8(o[3], pf, cat8(k10, k11)); } else { LWAIT8(2); MFMA8(o[2], pf, cat8(k20, k21)); LWAIT8(0); MFMA8(o[3], pf, cat8(k30, k31)); } } while (0)
  f32x16 p0, p1; float al; i32x8 pf; const int NT = seq / KVBLK;
  f32x16 cin;
#define CIN_SET8() do { const float nm_ = (56.f - 8.f * M_run) * CSC; _Pragma("unroll") for (int r = 0; r < 16; ++r) cin[r] = nm_; asm volatile("" : "+v"(cin)); SBAR(); } while (0)
  i32x4 k00, k01, k10, k11, k20, k21, k30, k31, v00, v01, v10, v11;
#define ACC_INIT8() do { const float nm = (56.f - 8.f * M_run) * CSC; typedef float f2_ __attribute__((ext_vector_type(2))); f2_ n2 = {nm, nm}; asm volatile("" : "+v"(n2)); \
      f2_ q_[16]; _Pragma("unroll") for (int i = 0; i < 16; ++i) asm volatile("v_mov_b64 %0, %1" : "=v"(q_[i]) : "v"(n2)); \
      typedef float f4_ __attribute__((ext_vector_type(4))); typedef float f8_ __attribute__((ext_vector_type(8))); \
      { const f4_ a = __builtin_shufflevector(q_[0], q_[1], 0, 1, 2, 3), b = __builtin_shufflevector(q_[2], q_[3], 0, 1, 2, 3), c = __builtin_shufflevector(q_[4], q_[5], 0, 1, 2, 3), d = __builtin_shufflevector(q_[6], q_[7], 0, 1, 2, 3); \
        const f8_ ab = __builtin_shufflevector(a, b, 0, 1, 2, 3, 4, 5, 6, 7), cd = __builtin_shufflevector(c, d, 0, 1, 2, 3, 4, 5, 6, 7); p0 = __builtin_shufflevector(ab, cd, 0, 1, 2, 3, 4, 5, 6, 7, 8, 9, 10, 11, 12, 13, 14, 15); } \
      { const f4_ a = __builtin_shufflevector(q_[8], q_[9], 0, 1, 2, 3), b = __builtin_shufflevector(q_[10], q_[11], 0, 1, 2, 3), c = __builtin_shufflevector(q_[12], q_[13], 0, 1, 2, 3), d = __builtin_shufflevector(q_[14], q_[15], 0, 1, 2, 3); \
        const f8_ ab = __builtin_shufflevector(a, b, 0, 1, 2, 3, 4, 5, 6, 7), cd = __builtin_shufflevector(c, d, 0, 1, 2, 3, 4, 5, 6, 7); p1 = __builtin_shufflevector(ab, cd, 0, 1, 2, 3, 4, 5, 6, 7, 8, 9, 10, 11, 12, 13, 14, 15); } \
      asm volatile("" : "+v"(p0), "+v"(p1)); SBAR(); } while (0)
  SDMA8(0, 0); SDMA8(1, 1); SDMA8(2, 2); if (half) SDMA8(3, 3);
  VMWAIT8(0); BARL8();
  CIN_SET8();
  KREAD8(0); QK8(0);
  SBAR(); asm volatile("s_nop 15\n\ts_nop 15\n\ts_nop 15\n\ts_nop 15\n\ts_nop 15\n\ts_nop 15" ::: "memory"); SBAR();
  softmax8<true>(p0, p1, M_run, al, pf);
  CIN_SET8();
  if (half) BARL8();
  int sw = (3 + half) & 3;
#define MSEG8(KO, VO) do { \
    if constexpr (NS == 2) { \
      k00 = rd128<(KO)>(ka00); k01 = rd128<(KO)>(ka01); k10 = rd128<(KO) + 32 * DQK>(ka00); k11 = rd128<(KO) + 32 * DQK>(ka01); k20 = rd128<(KO)>(ka10); k21 = rd128<(KO)>(ka11); \
      LWAIT8(4); MFMA8QC(p0, cat8(k00, k01), qf[0], cin); k30 = rd128<(KO) + 32 * DQK>(ka10); k31 = rd128<(KO) + 32 * DQK>(ka11); \
      LWAIT8(4); MFMA8QC(p1, cat8(k10, k11), qf[0], cin); v00 = rd128<(VO)>(va0); v01 = rd128<(VO)>(va1); \
      LWAIT8(4); MFMA8Q(p0, cat8(k20, k21), qf[NS - 1]); v10 = rd128<(VO) + 2048>(va0); v11 = rd128<(VO) + 2048>(va1); \
      LWAIT8(4); MFMA8Q(p1, cat8(k30, k31), qf[NS - 1]); k00 = rd128<(VO) + 4096>(va0); k01 = rd128<(VO) + 4096>(va1); \
      MFMA16S(osum, pf, sel8); k10 = rd128<(VO) + 6144>(va0); k11 = rd128<(VO) + 6144>(va1); \
      LWAIT8(6); MFMA8(o[0], pf, cat8(v00, v01)); LWAIT8(4); MFMA8(o[1], pf, cat8(v10, v11)); LWAIT8(2); MFMA8(o[2], pf, cat8(k00, k01)); LWAIT8(0); MFMA8(o[3], pf, cat8(k10, k11)); \
    } else { \
      k00 = rd128<(KO)>(ka00); k01 = rd128<(KO)>(ka01); k10 = rd128<(KO) + 32 * DQK>(ka00); k11 = rd128<(KO) + 32 * DQK>(ka01); v00 = rd128<(VO)>(va0); v01 = rd128<(VO)>(va1); \
      LWAIT8(4); MFMA8QC(p0, cat8(k00, k01), qf[0], cin); v10 = rd128<(VO) + 2048>(va0); v11 = rd128<(VO) + 2048>(va1); \
      LWAIT8(4); MFMA8QC(p1, cat8(k10, k11), qf[0], cin); k20 = rd128<(VO) + 4096>(va0); k21 = rd128<(VO) + 4096>(va1); \
      MFMA16S(osum, pf, sel8); k30 = rd128<(VO) + 6144>(va0); k31 = rd128<(VO) + 6144>(va1); \
      LWAIT8(6); MFMA8(o[0], pf, cat8(v00, v01)); LWAIT8(4); MFMA8(o[1], pf, cat8(v10, v11)); LWAIT8(2); MFMA8(o[2], pf, cat8(k20, k21)); LWAIT8(0); MFMA8(o[3], pf, cat8(k30, k31)); } } while (0)
#define STEP8(KS, VS, jj) do { \
    MSEG8((KS) * SLOT, (VS) * SLOT); \
    BARL8(); \
    softmax8<false>(p0, p1, M_run, al, pf); RESC8(al); \
    { const int t = (jj) + 3 + half; if (t < NT) { SDMA8(t, sw); VMWAIT8(2); } else VMWAIT8(0); } \
    BARL8(); \
    sw = (sw + 1) & 3; } while (0)
  int j = 0;
  for (; j + 4 < NT; j += 4) { STEP8(1, 0, j); STEP8(2, 1, j + 1); STEP8(3, 2, j + 2); STEP8(0, 3, j + 3); }
  if (j + 1 < NT) { STEP8(1, 0, j); ++j; }
  if (j + 1 < NT) { STEP8(2, 1, j); ++j; }
  if (j + 1 < NT) { STEP8(3, 2, j); ++j; }
  const int sv = j & 3;
#undef STEP8
#undef MSEG8
#undef ACC_INIT8
#undef CIN_SET8
  VREAD8A(sv * SLOT); VREAD8B(sv * SLOT); PV8();
  SBAR(); asm volatile("s_nop 15\n\ts_nop 15\n\ts_nop 15\n\ts_nop 15\n\ts_nop 15\n\ts_nop 15" ::: "memory"); SBAR();
  if (!half) BARL8();
  float rli[16];
  { if ((lane & 15) < 2) *(f32x4*)(al_l + (lane & 15) * 16 + 4 * (lane >> 4)) = (f32x4){osum[0], osum[1], osum[2], osum[3]};
    asm volatile("s_waitcnt lgkmcnt(0)" ::: "memory");
#pragma unroll
    for (int g = 0; g < 4; ++g) { const f32x4 a4 = *(const f32x4*)(al_l + 8 * g + 4 * hi);
#pragma unroll
      for (int i = 0; i < 4; ++i) rli[4 * g + i] = __builtin_amdgcn_rcpf(a4[i]); } }
  unsigned char* Ow = Ob + (long)(wid * QBLK) * LDO;
  if constexpr (!DIFF) {
#pragma unroll
    for (int r = 0; r < 16; ++r) { int orow = crow(r, hi);
#pragma unroll
      for (int d0 = 0; d0 < 4; ++d0) { const float v_ = o[d0][r] * (rli[r] * OS_GQA); Ow[(long)orow * LDO + d0 * 32 + r32] = (unsigned char)__builtin_amdgcn_cvt_pk_fp8_f32(v_, v_, 0, false); } }
  } else {
    char* stash = lds + RD * SLOT + 2048 + wid * 8192 + lane * 16;
    if (dmode == 0) {
#pragma unroll
      for (int q = 0; q < 8; ++q) { const int d0 = q >> 1, r0 = (q & 1) * 8; i32x4 w;
#pragma unroll
        for (int i = 0; i < 4; ++i) w[i] = (int)att::cvtpk(o[d0][r0 + 2 * i] * rli[r0 + 2 * i], o[d0][r0 + 2 * i + 1] * rli[r0 + 2 * i + 1]);
        *(i32x4*)(stash + q * 1024) = w; }
    } else {
      float ss[16];
#pragma unroll
      for (int r = 0; r < 16; ++r) ss[r] = 0.f;
#pragma unroll
      for (int q = 0; q < 8; ++q) { const int d0 = q >> 1, r0 = (q & 1) * 8; const i32x4 w = *(const i32x4*)(stash + q * 1024);
#pragma unroll
        for (int i = 0; i < 4; ++i) { const int r = r0 + 2 * i;
          const float a = bflo((unsigned)w[i]) - lam * (o[d0][r] * rli[r]), b = bfhi((unsigned)w[i]) - lam * (o[d0][r + 1] * rli[r + 1]);
          o[d0][r] = a; o[d0][r + 1] = b; ss[r] += a * a; ss[r + 1] += b * b; } }
      float sg[4];
#pragma unroll
      for (int d0 = 0; d0 < 4; ++d0) sg[d0] = subg[d0 * 32 + r32] * ((1.f - LAM_INIT) * OS_DIFF);
#pragma unroll
      for (int r = 0; r < 16; ++r) { float s = ss[r];
#pragma unroll
        for (int x = 1; x < 32; x <<= 1) s += __shfl_xor(s, x);
        const float rs = rsqrtf(s * (1.f / 128.f) + RMS_EPS); const int orow = crow(r, hi);
#pragma unroll
        for (int d0 = 0; d0 < 4; ++d0) { const float v_ = o[d0][r] * rs * sg[d0]; Ow[(long)orow * LDO + d0 * 32 + r32] = (unsigned char)__builtin_amdgcn_cvt_pk_fp8_f32(v_, v_, 0, false); } }
    }
  }
  BARL8();
#undef GLDS16
#undef SDMA8
#undef VMWAIT8
#undef BARL8
#undef LWAIT8
#undef LWAIT8_
#undef RESC8
#undef MFMA8
#undef MFMA8Q
#undef MFMA16S
#undef KREAD8
#undef VREAD8A
#undef VREAD8B
#undef KREAD8C
#undef VREAD8AC
#undef VREAD8BC
#undef QK8
#undef PV8
}
#undef SBAR
}
#define XB_TMO      128
#define XB_XCNT(j)  (256  + 64 * (j))
#define XB_XSUB(j)  (1280 + 64 * (j))
#define XB_XGEN(j)  (2304 + 64 * (j))
#define XB_TOP      3328
#define XB_TOPGEN   3392
#define XCD_BAR_WORDS 3456
#define XB_SPIN_CAP (1u << 18)

__device__ __forceinline__ unsigned xb_ld(unsigned* p)              { return __hip_atomic_load(p, __ATOMIC_RELAXED, __HIP_MEMORY_SCOPE_AGENT); }
__device__ __forceinline__ unsigned xb_add(unsigned* p, unsigned v) { return __hip_atomic_fetch_add(p, v, __ATOMIC_RELAXED, __HIP_MEMORY_SCOPE_AGENT); }
__device__ __forceinline__ unsigned xb_xcc_id() { return (unsigned)__builtin_amdgcn_s_getreg((3 << 11) | 20) & 0xFu; }
#define XB_SPIN(cond, bar) do { unsigned _sp = 0; while (cond) { __builtin_amdgcn_s_sleep(1); \
    if ((++_sp & 255u) == 0u) { if (xb_ld(&(bar)[XB_TMO])) break; if (_sp > XB_SPIN_CAP) { atomicAdd(&(bar)[XB_TMO], 1u); break; } } } } while (0)

struct XcdBarrier {
    unsigned* bar; unsigned x;
    volatile LAS unsigned* st;
};

__device__ __forceinline__ XcdBarrier xcd_barrier_post(unsigned* bar, volatile LAS unsigned* st) {
    XcdBarrier b; b.bar = bar; b.x = xb_xcc_id(); b.st = st;
    if (threadIdx.x == 0) (void)xb_add(&bar[XB_XCNT(b.x)], 1u);
    return b;
}
__device__ __forceinline__ void xcd_barrier_complete(unsigned* bar, unsigned x, unsigned& nloc, unsigned& nx) {
    const unsigned G = gridDim.x * gridDim.y * gridDim.z;
    unsigned sum, cnt, mine, sp = 0u;
    for (;;) {
        sum = 0u; cnt = 0u; mine = 0u;
#pragma unroll
        for (unsigned j = 0; j < 16; ++j) { const unsigned c = xb_ld(&bar[XB_XCNT(j)]); sum += c; cnt += (c > 0u) ? 1u : 0u; mine = (j == x) ? c : mine; }
        if (sum == G) break;
        __builtin_amdgcn_s_sleep(1);
        if ((++sp & 255u) == 0u) { if (xb_ld(&bar[XB_TMO])) break; if (sp > XB_SPIN_CAP) { atomicAdd(&bar[XB_TMO], 1u); break; } }
    }
    nloc = mine > 0u ? mine : 1u; nx = cnt > 0u ? cnt : 1u;
}

__device__ __forceinline__ void xcd_barrier(const XcdBarrier& b) {
    asm volatile("s_waitcnt vmcnt(0)" ::: "memory");
    __syncthreads();
    if (threadIdx.x == 0) {
        unsigned* bar = b.bar;
        __builtin_amdgcn_s_waitcnt(0);
        unsigned nloc = b.st[0], nx = b.st[1];
        if (nloc == 0u) { xcd_barrier_complete(bar, b.x, nloc, nx); b.st[0] = nloc; b.st[1] = nx; }
        const unsigned old = xb_add(&bar[XB_XSUB(b.x)], 1u);
        const unsigned gen = old / nloc;
        if (old + 1u == (gen + 1u) * nloc) {
            __builtin_amdgcn_fence(__ATOMIC_RELEASE, "agent");
            asm volatile("s_waitcnt vmcnt(0)" ::: "memory");
            const unsigned og = xb_add(&bar[XB_TOP], 1u);
            const unsigned tg = og / nx;
            if (og + 1u == (tg + 1u) * nx) xb_add(&bar[XB_TOPGEN], 1u);
            else XB_SPIN(xb_ld(&bar[XB_TOPGEN]) == tg, bar);
            __builtin_amdgcn_fence(__ATOMIC_ACQUIRE, "agent");
            xb_add(&bar[XB_XGEN(b.x)], 1u);
            asm volatile("s_waitcnt vmcnt(0)" ::: "memory");
        } else {
            XB_SPIN(xb_ld(&bar[XB_XGEN(b.x)]) == gen, bar);
            __builtin_amdgcn_fence(__ATOMIC_ACQUIRE, "agent");
            asm volatile("s_waitcnt vmcnt(0)" ::: "memory");
        }
    }
    __syncthreads();
}

constexpr int NWAVES = 8;
constexpr int N_PHASES = 36;
#ifndef MK_STOP
#define MK_STOP N_PHASES
#endif
#ifndef ATT_SDEPTH
#define ATT_SDEPTH 1
#endif
#ifndef G1_PROBE
#define G1_PROBE 0
#endif
#ifndef ATT_PROBE
#define ATT_PROBE 0
#endif
#ifndef REP_MASK
#define REP_MASK 0
#endif
constexpr size_t WS_JUNK = WS_END - WS_GATE;
constexpr float W8_SCALE = 32.f;
constexpr float QSCALE128 = 8.f * 0.088388347648318440f * 1.4426950408889634f, QSCALE64 = 8.f * 0.125f * 1.4426950408889634f;
#ifndef SM_MASK
#define SM_MASK 127
#endif
#ifndef PRO_PARTS
#define PRO_PARTS 15
#endif
#ifndef MK_MULTI
#define MK_MULTI 0
#endif

struct Args { const float* in[N_IN]; float* out; unsigned char* ws; int ph_lo, ph_hi, dump, pad; };
static_assert(sizeof(Args) == N_IN * 8 + 8 + 8 + 16, "Args has no padding");
typedef const __attribute__((address_space(4))) Args* KArgs;
struct Frame {
    LAS unsigned char* lds;
    char* ldsg;
    int tid, lane, wave, vcu, G, gw, NGW;
    KArgs kp;
    __device__ __forceinline__ const float* in(int i) const { return kp->in[i]; }
    __device__ __forceinline__ float* out() const { return kp->out; }
    __device__ __forceinline__ unsigned char* ws() const { return kp->ws; }
    __device__ __forceinline__ unsigned* ctl() const { return (unsigned*)(kp->ws + WS_CTL); }
};
__device__ __forceinline__ bool refresh(Frame& F) { int t = threadIdx.x; asm volatile("" : "+v"(t)); F.tid = t; F.lane = t & 63; KArgs k = (KArgs)__builtin_amdgcn_kernarg_segment_ptr(); asm volatile("" : "+s"(k)); F.kp = k; return true; }
__device__ __forceinline__ const float* input_row(const Frame& F, int row) {
    const int b = row >= SB ? 1 : 0, w = row - b * SB;
    return (w < NCTX) ? F.in(I_CTX) + ((size_t)(b * NCTX + w)) * D : F.in(I_X) + ((size_t)(b * SEQ + (w - NCTX))) * D;
}
__device__ __forceinline__ int stream_of(int row) { const int b = row >= SB ? 1 : 0, w = row - b * SB; return (w < NCTX) ? 2 : b; }
__device__ __forceinline__ const float* modp(const Frame& F, int layer, int s, int chunk) { return (const float*)(F.ws() + WS_MOD) + ((size_t)(layer * 3 + s) * 6 + chunk) * D; }
__device__ __forceinline__ const float* normg(const Frame& F, int layer, int k) { return F.in(I_NORMG) + (size_t)(layer * 4 + k) * D; }

__device__ __forceinline__ void ld_row_f32(const float* p, int lane, f32x4 (&v)[4]) {
#pragma unroll
    for (int j = 0; j < 4; ++j) v[j] = *(const f32x4*)(p + 256 * j + 4 * lane);
}
__device__ __forceinline__ void st_row_f32(float* p, int lane, const f32x4 (&v)[4]) {
#pragma unroll
    for (int j = 0; j < 4; ++j) *(f32x4*)(p + 256 * j + 4 * lane) = v[j];
}
__device__ __forceinline__ void ld_row_bf16(const bf16_t* p, int lane, f32x4 (&v)[4]) {
#pragma unroll
    for (int j = 0; j < 4; ++j) { const u32x2 w = *(const u32x2*)(p + 256 * j + 4 * lane); v[j] = (f32x4){bflo(w.x), bfhi(w.x), bflo(w.y), bfhi(w.y)}; }
}
__device__ __forceinline__ void ld_row_fp8(const unsigned char* p, int lane, f32x4 (&v)[4]) {
#pragma unroll
    for (int j = 0; j < 4; ++j) { const int w = *(const int*)(p + 256 * j + 4 * lane);
        v[j] = (f32x4){__builtin_amdgcn_cvt_f32_fp8(w, 0), __builtin_amdgcn_cvt_f32_fp8(w, 1), __builtin_amdgcn_cvt_f32_fp8(w, 2), __builtin_amdgcn_cvt_f32_fp8(w, 3)}; }
}
__device__ __forceinline__ void st_row_bf16(bf16_t* p, int lane, const f32x4 (&v)[4]) {
#pragma unroll
    for (int j = 0; j < 4; ++j) { u32x2 w; w.x = pkbf(v[j].x, v[j].y); w.y = pkbf(v[j].z, v[j].w); *(u32x2*)(p + 256 * j + 4 * lane) = w; }
}
__device__ __forceinline__ float row_ss(const f32x4 (&v)[4]) {
    float s = 0.f;
#pragma unroll
    for (int j = 0; j < 4; ++j) s += (v[j].x * v[j].x + v[j].y * v[j].y) + (v[j].z * v[j].z + v[j].w * v[j].w);
    return wave_sum(s);
}
__device__ __forceinline__ void modnorm(const f32x4 (&v)[4], const float* g, const float* m1, const float* m0, int lane, f32x4 (&h)[4]) {
    const float r = rsqrtf(row_ss(v) * (1.f / D) + RMS_EPS);
#pragma unroll
    for (int j = 0; j < 4; ++j) { const f32x4 gv = *(const f32x4*)(g + 256 * j + 4 * lane), a = *(const f32x4*)(m1 + 256 * j + 4 * lane), b = *(const f32x4*)(m0 + 256 * j + 4 * lane);
        h[j] = (v[j] * r) * gv * (a + 1.f) + b; }
}

__device__ __forceinline__ void tr_item(const float* W, int K, int N, bf16_t* WT, int k0, int n0, int dst_row0, LAS float* scr, int lane, const float* colscale = nullptr) {
    float tmp[32]; const float csv = colscale ? colscale[lane & 31] : 1.f;
#pragma unroll
    for (int i = 0; i < 32; ++i) { const int kk = 2 * i + (lane >> 5); tmp[i] = W[(size_t)(k0 + kk) * N + n0 + (lane & 31)]; }
#pragma unroll
    for (int i = 0; i < 32; ++i) { const int kk = 2 * i + (lane >> 5); scr[kk * 33 + (lane & 31)] = tmp[i] * csv; }
    LDS_WAIT(); asm volatile("" ::: "memory");
    const int c = lane & 7;
#pragma unroll
    for (int j = 0; j < 4; ++j) { const int n = (lane >> 3) + 8 * j; const LAS float* s = scr + (8 * c) * 33 + n;
        u32x4 o; o.x = pkbf(s[0 * 33], s[1 * 33]); o.y = pkbf(s[2 * 33], s[3 * 33]); o.z = pkbf(s[4 * 33], s[5 * 33]); o.w = pkbf(s[6 * 33], s[7 * 33]);
        *(u32x4*)(WT + (size_t)(dst_row0 + n) * K + k0 + 8 * c) = o; }
    LDS_WAIT(); asm volatile("" ::: "memory");
}
__device__ __forceinline__ void tr_item8(const float* W, int K, int N, unsigned char* WT, int k0, int n0, int dst_row0, LAS float* scr, int lane, float wscale) {
    float tmp[32];
#pragma unroll
    for (int i = 0; i < 32; ++i) { const int kk = 2 * i + (lane >> 5); tmp[i] = W[(size_t)(k0 + kk) * N + n0 + (lane & 31)]; }
#pragma unroll
    for (int i = 0; i < 32; ++i) { const int kk = 2 * i + (lane >> 5); scr[kk * 33 + (lane & 31)] = tmp[i] * wscale; }
    LDS_WAIT(); asm volatile("" ::: "memory");
    const int c = lane & 7;
#pragma unroll
    for (int j = 0; j < 4; ++j) { const int n = (lane >> 3) + 8 * j; const LAS float* s = scr + (8 * c) * 33 + n;
        int w0 = 0, w1 = 0; w0 = __builtin_amdgcn_cvt_pk_fp8_f32(s[0 * 33], s[1 * 33], w0, false); w0 = __builtin_amdgcn_cvt_pk_fp8_f32(s[2 * 33], s[3 * 33], w0, true);
        w1 = __builtin_amdgcn_cvt_pk_fp8_f32(s[4 * 33], s[5 * 33], w1, false); w1 = __builtin_amdgcn_cvt_pk_fp8_f32(s[6 * 33], s[7 * 33], w1, true);
        *(u32x2*)(WT + (size_t)(dst_row0 + n) * K + k0 + 8 * c) = (u32x2){(unsigned)w0, (unsigned)w1}; }
    LDS_WAIT(); asm volatile("" ::: "memory");
}
__device__ __forceinline__ void tr_plain(const float* W, int K, int N, bf16_t* WT, int row_off, LAS float* scr, int item, int lane, const float* colscale = nullptr) {
    const int nblk = N / 32, kb = item / nblk, nb = item - kb * nblk;
    tr_item(W, K, N, WT, 64 * kb, 32 * nb, row_off + 32 * nb, scr, lane, colscale ? colscale + 32 * nb : nullptr);
}
__device__ __forceinline__ void tr_plain8(const float* W, int K, int N, unsigned char* WT, LAS float* scr, int item, int lane) {
    const int nblk = N / 32, kb = item / nblk, nb = item - kb * nblk;
    tr_item8(W, K, N, WT, 64 * kb, 32 * nb, 32 * nb, scr, lane, W8_SCALE);
}
__device__ __forceinline__ void p0_prologue(Frame& F) {
    {
        LAS float* sv = (LAS float*)(F.lds);
        LAS float* red = (LAS float*)(F.lds + 16384);
        if ((PRO_PARTS & 1) && F.vcu < 192) {
            for (int i = F.tid; i < 3 * D; i += 512) { const int s = i >> 10, k = i & 1023; const float c = (s < 2) ? F.in(I_C)[s * D + k] : F.in(I_CCTX)[k]; sv[i] = c / (1.f + __expf(-c)); }
            __syncthreads();
            for (int task = F.vcu; task < 192; task += F.G) {
                const int layer = task / 48, n0 = (task % 48) * 128;
                const int tx = F.tid & 31, ty = F.tid >> 5;
                const float* wp = F.in(I_MODW) + ((size_t)layer * D + ty * 64) * 6144 + n0 + 4 * tx;
                f32x4 a0 = {0, 0, 0, 0}, a1 = a0, a2 = a0;
#pragma unroll 8
                for (int k = 0; k < 64; ++k) { const f32x4 w = *(const f32x4*)(wp + (size_t)k * 6144); const int kk = ty * 64 + k;
                    a0 += w * sv[kk]; a1 += w * sv[D + kk]; a2 += w * sv[2 * D + kk]; }
                *(LAS f32x4*)(red + (ty * 3 + 0) * 128 + 4 * tx) = a0; *(LAS f32x4*)(red + (ty * 3 + 1) * 128 + 4 * tx) = a1; *(LAS f32x4*)(red + (ty * 3 + 2) * 128 + 4 * tx) = a2;
                __syncthreads();
                if (F.tid < 384) { const int s = F.tid >> 7, n = F.tid & 127; float acc = F.in(I_MODB)[layer * 6144 + n0 + n];
#pragma unroll
                    for (int y = 0; y < 16; ++y) acc += red[(y * 3 + s) * 128 + n];
                    ((float*)(F.ws() + WS_MOD))[((size_t)(layer * 3 + s)) * 6144 + n0 + n] = acc; }
                __syncthreads();
            }
        }
        __syncthreads();
    }
    { bf16_t* b1h = (bf16_t*)(F.ws() + WS_B1H); bf16_t* b2h = (bf16_t*)(F.ws() + WS_B2H); const float* b1 = F.in(I_B1); const float* b2 = F.in(I_B2);
      const int gt = F.vcu * (NWAVES * 64) + F.tid, ngt = F.G * NWAVES * 64;
      for (int i = gt; i < 4 * NE * 2048 / 2; i += ngt) ((unsigned*)b1h)[i] = pkbf(b1[2 * i], b1[2 * i + 1]);
      for (int i = gt; i < 4 * NE * 1024 / 2; i += ngt) ((unsigned*)b2h)[i] = pkbf(b2[2 * i], b2[2 * i + 1]); }
    LAS float* scr = (LAS float*)(F.lds + F.wave * 16384);
    if (PRO_PARTS & 2) {
        constexpr int I_POOL = 4 * (256 / 64) * (256 / 32);
        constexpr int I_GQ = 16 * 48, I_SQ = 16 * 32, I_W3 = 16 * 96;
        constexpr int NSMALL = I_POOL + I_GQ + I_SQ + I_W3 + I_SQ + I_W3 + I_SQ;
        for (int it = F.gw; it < NSMALL; it += F.NGW) {
            int r = it;
            if (r < I_POOL) { if (!(SM_MASK & 1)) continue; const int g = r >> 5; tr_plain(F.in(I_POOLW) + (size_t)g * 65536, 256, 256, (bf16_t*)(F.ws() + WS_POOLW), g * 256, scr, r & 31, F.lane, F.in(I_POOLS) + g * 256); continue; } r -= I_POOL;
            if (r < I_GQ) { if (!(SM_MASK & 2)) continue; tr_plain8(F.in(I_GQKV), D, 1536, F.ws() + WS_GQKV, scr, r, F.lane); continue; } r -= I_GQ;
            if (r < I_SQ) { if (!(SM_MASK & 4)) continue; tr_plain8(F.in(I_GO), D, D, F.ws() + WS_GO, scr, r, F.lane); continue; } r -= I_SQ;
            if (r < I_W3) { if (!(SM_MASK & 8)) continue; tr_plain8(F.in(I_CIN), D, 3072, F.ws() + WS_CIN, scr, r, F.lane); continue; } r -= I_W3;
            if (r < I_SQ) { if (!(SM_MASK & 16)) continue; tr_plain8(F.in(I_COUT), D, D, F.ws() + WS_COUT, scr, r, F.lane); continue; } r -= I_SQ;
            if (r < I_W3) { if (!(SM_MASK & 32)) continue; tr_plain8(F.in(I_DQKV), D, 3072, F.ws() + WS_DQKV, scr, r, F.lane); continue; } r -= I_W3;
            if (!(SM_MASK & 64)) continue; tr_plain8(F.in(I_DO), D, D, F.ws() + WS_DO, scr, r, F.lane);
        }
    }
    if (PRO_PARTS & 12) {
        constexpr int NI1 = 128 * 1024, NIT = NI1 + 128 * 512;
        float cur[32], nxt[32];
#define XW_DECODE(it_) const bool w1_ = (it_) < NI1; const int r2_ = w1_ ? (it_) : (it_) - NI1; const int mat_ = w1_ ? (r2_ >> 10) : (r2_ >> 9), rr_ = w1_ ? (r2_ & 1023) : (r2_ & 511), kb_ = w1_ ? (rr_ >> 7) : (rr_ >> 6), n0_ = 16 * (w1_ ? (rr_ & 127) : (rr_ & 63)), N_ = w1_ ? 2048 : 1024; \
        const float* W_ = w1_ ? F.in(I_W1) + (size_t)mat_ * D * 2048 : F.in(I_W2) + (size_t)mat_ * D * D;
#define XW_LOAD(it_, buf) do { XW_DECODE(it_) _Pragma("unroll") for (int i = 0; i < 32; ++i) { const int kk = 4 * i + (F.lane >> 4); buf[i] = W_[(size_t)(128 * kb_ + kk) * N_ + n0_ + (F.lane & 15)]; } } while (0)
        int it = F.gw;
        if (it < NIT) XW_LOAD(it, cur);
        for (; it < NIT; it += F.NGW) {
            const int itn = it + F.NGW;
            if (itn < NIT) XW_LOAD(itn, nxt);
            XW_DECODE(it)
            const int drow = w1_ ? (mat_ * 2048 + ((n0_ & 1023) >> 7) * 256 + (n0_ >> 10) * 128 + (n0_ & 127)) : (mat_ * 1024 + n0_);
            unsigned char* WT = F.ws() + (w1_ ? WS_W1T : WS_W2T);
#pragma unroll
            for (int i = 0; i < 32; ++i) { const int kk = 4 * i + (F.lane >> 4); scr[kk * 17 + (F.lane & 15)] = cur[i] * W8_SCALE; }
            LDS_WAIT(); asm volatile("" ::: "memory");
            { const int n = F.lane >> 2, c = F.lane & 3; const LAS float* s = scr + (32 * c) * 17 + n; unsigned o8[8];
#pragma unroll
              for (int q = 0; q < 8; ++q) { int w0 = 0; w0 = __builtin_amdgcn_cvt_pk_fp8_f32(s[(4 * q) * 17], s[(4 * q + 1) * 17], w0, false); w0 = __builtin_amdgcn_cvt_pk_fp8_f32(s[(4 * q + 2) * 17], s[(4 * q + 3) * 17], w0, true); o8[q] = (unsigned)w0; }
              unsigned char* d = WT + (size_t)(drow + n) * D + 128 * kb_ + 32 * c;
              *(u32x4*)d = (u32x4){o8[0], o8[1], o8[2], o8[3]}; *(u32x4*)(d + 16) = (u32x4){o8[4], o8[5], o8[6], o8[7]}; }
            LDS_WAIT(); asm volatile("" ::: "memory");
#pragma unroll
            for (int i = 0; i < 32; ++i) cur[i] = nxt[i];
        }
#undef XW_DECODE
#undef XW_LOAD
    }
    __syncthreads();
}

template <bool DRY> __device__ __forceinline__ void p_hpass0(Frame& F) {
    bf16_t* H = (bf16_t*)(F.ws() + WS_H + (DRY ? WS_JUNK : 0));
    int cs = -1; f32x4 pg[4], p0v[4];
    for (int rr = F.gw; rr < T; rr += 2 * F.NGW) {
        const int r0 = rr, r1 = min(rr + F.NGW, T - 1);
        f32x4 v0[4], v1[4], h[4]; ld_row_f32(input_row(F, r0), F.lane, v0); ld_row_f32(input_row(F, r1), F.lane, v1);
#define HP_ROW(v_, r_) do { const int s = stream_of(r_); if (s != cs) { cs = s; const float* gn = normg(F, 0, 0); const float* m1n = modp(F, 0, s, 1); const float* m0n = modp(F, 0, s, 0); \
            _Pragma("unroll") for (int j = 0; j < 4; ++j) { const int o = 256 * j + 4 * F.lane; pg[j] = *(const f32x4*)(gn + o) * (*(const f32x4*)(m1n + o) + 1.f); p0v[j] = *(const f32x4*)(m0n + o); } } \
          const float rx = rsqrtf(row_ss(v_) * (1.f / D) + RMS_EPS); _Pragma("unroll") for (int j = 0; j < 4; ++j) h[j] = (v_[j] * rx) * pg[j] + p0v[j]; st_row_bf16(H + (size_t)(r_) * D, F.lane, h); } while (0)
        HP_ROW(v0, r0); HP_ROW(v1, r1);
#undef HP_ROW
    }
}
template <bool DRY> __device__ __forceinline__ void p_poolprep(Frame& F) {
    const bf16_t* H = (const bf16_t*)(F.ws() + WS_H); bf16_t* Dp = (bf16_t*)(F.ws() + WS_O + (DRY ? WS_JUNK : 0));
    for (int row = F.gw; row < T; row += F.NGW) {
        const int b = row >= SB ? 1 : 0, w = row - b * SB;
        const int s0 = (w < NCTX) ? b * SB : b * SB + NCTX, s1 = (w < NCTX) ? b * SB + NCTX : (b + 1) * SB;
#pragma unroll
        for (int j = 0; j < 4; ++j) {
            constexpr int dummy = 0; (void)dummy;
            const int half = 1 << j;
            const int lo = max(row - half, s0), hi = min(row + half, s1);
            u32x2 q[16];
#pragma unroll
            for (int i = 0; i < 2 * half; ++i) { const int rr = row - half + i; const int rc = (rr >= lo && rr < hi) ? rr : row; q[i] = *(const u32x2*)(H + (size_t)rc * D + 256 * j + 4 * F.lane); }
            const u32x2 qs = *(const u32x2*)(H + (size_t)row * D + 256 * j + 4 * F.lane);
            f32x4 acc = {0, 0, 0, 0};
#pragma unroll
            for (int i = 0; i < 2 * half; ++i) { const int rr = row - half + i; const float wgt = (rr >= lo && rr < hi) ? 1.f : 0.f; acc += (f32x4){bflo(q[i].x), bfhi(q[i].x), bflo(q[i].y), bfhi(q[i].y)} * wgt; }
            const f32x4 self = {bflo(qs.x), bfhi(qs.x), bflo(qs.y), bfhi(qs.y)};
            const f32x4 d = acc * (1.f / (float)(hi - lo)) - self;
            u32x2 o; o.x = pkbf(d.x, d.y); o.y = pkbf(d.z, d.w);
            *(u32x2*)(Dp + ((size_t)j * T + row) * 256 + 4 * F.lane) = o;
        }
    }
}

template <int L>
__device__ __forceinline__ void p_moe_a(Frame& F, const bool DRY) {
    const bf16_t* Y = (const bf16_t*)(F.ws() + WS_Y); const bf16_t* X = (const bf16_t*)(F.ws() + WS_X); bf16_t* Xo = (bf16_t*)(F.ws() + WS_X + (DRY ? WS_JUNK : 0)); unsigned char* H8 = F.ws() + WS_H + (DRY ? WS_JUNK : 0);
    float* gate = (float*)(F.ws() + WS_GATE + (DRY ? WS_JUNK : 0)); int* list = (int*)(F.ws() + WS_LIST);
    LAS float* hbuf = (LAS float*)(F.lds);
    LAS float* part = (LAS float*)(F.lds + 65536);
    LAS int* sel = (LAS int*)(F.lds + 83968);
    LAS int* lcnt = (LAS int*)(F.lds + LC_LCNT); LAS int* gbase = (LAS int*)(F.lds + LC_GBASE);
    const float* g1 = normg(F, L, 1); const float* g2 = normg(F, L, 2);
    const float* rw = F.in(I_RW) + (size_t)L * D * NE; const float* rb = F.in(I_RB) + L * NE;
    const int e = F.lane & 31, kh = F.lane >> 5;
    typedef short rbf16x8 __attribute__((ext_vector_type(8)));
    rbf16x8 wh[4][2], wl[4][2];
#pragma unroll
    for (int s = 0; s < 4; ++s)
#pragma unroll
        for (int n = 0; n < 2; ++n) { unsigned hw[4], lw[4];
#pragma unroll
            for (int q = 0; q < 4; ++q) { const int k = 128 * F.wave + 32 * s + 8 * (F.lane >> 4) + 2 * q; const float w0 = rw[(size_t)k * NE + 16 * n + (F.lane & 15)], w1 = rw[(size_t)(k + 1) * NE + 16 * n + (F.lane & 15)];
                hw[q] = pkbf(w0, w1); lw[q] = pkbf(w0 - bflo(hw[q]), w1 - bfhi(hw[q])); }
            const u32x4 hv = {hw[0], hw[1], hw[2], hw[3]}, lv = {lw[0], lw[1], lw[2], lw[3]}; wh[s][n] = __builtin_bit_cast(rbf16x8, hv); wl[s][n] = __builtin_bit_cast(rbf16x8, lv); }
    const float bias = rb[e];
    if (F.tid < 32) lcnt[F.tid] = 0;
    __syncthreads();
    constexpr int NRA = (L == 3) ? NB * SEQ : T;
#define MA_ROW(n_) ((L == 3) ? (((n_) >> 14) * SB + NCTX + ((n_) & (SEQ - 1))) : (n_))
    const int chunk = (NRA + F.G - 1) / F.G, tok0 = min(NRA, (int)blockIdx.x * chunk), tok1 = min(NRA, tok0 + chunk);
    int cs = -1; f32x4 qm[4], qg[4], q0v[4];
    f32x4 y[2][4], x[2][4];
#define MA_LOAD(base_) do { _Pragma("unroll") for (int tt = 0; tt < 2; ++tt) { const int tok_ = (base_) + F.wave * 2 + tt; if (tok_ < tok1) { \
        const int row_ = MA_ROW(tok_); ld_row_bf16(Y + (size_t)row_ * D, F.lane, y[tt]); if constexpr (L == 0) ld_row_f32(input_row(F, row_), F.lane, x[tt]); else ld_row_bf16(X + (size_t)row_ * D, F.lane, x[tt]); } } } while (0)
    MA_LOAD(tok0);
    for (int base = tok0; base < tok1; base += 16) {
#pragma unroll
        for (int tt = 0; tt < 2; ++tt) {
            const int tl = F.wave * 2 + tt, tok = base + tl;
            if (tok < tok1) {
                const int row = MA_ROW(tok), s = stream_of(row);
                f32x4 h[4];
                if (s != cs) { cs = s; const float* m2 = modp(F, L, s, 2); const float* m4 = modp(F, L, s, 4); const float* m3 = modp(F, L, s, 3);
#pragma unroll
                    for (int j = 0; j < 4; ++j) { const int o = 256 * j + 4 * F.lane; qm[j] = *(const f32x4*)(m2 + o) * *(const f32x4*)(g1 + o); qg[j] = *(const f32x4*)(g2 + o) * (*(const f32x4*)(m4 + o) + 1.f); q0v[j] = *(const f32x4*)(m3 + o); } }
                const float ry = rsqrtf(row_ss(y[tt]) * (1.f / D) + RMS_EPS);
#pragma unroll
                for (int j = 0; j < 4; ++j) x[tt][j] = x[tt][j] + qm[j] * (y[tt][j] * ry);
                st_row_bf16(Xo + (size_t)row * D, F.lane, x[tt]);
                { const float rx = rsqrtf(row_ss(x[tt]) * (1.f / D) + RMS_EPS);
#pragma unroll
                  for (int j = 0; j < 4; ++j) h[j] = (x[tt][j] * rx) * qg[j] + q0v[j]; }
#pragma unroll
                for (int j = 0; j < 4; ++j) { int w = 0; w = __builtin_amdgcn_cvt_pk_fp8_f32(h[j].x, h[j].y, w, false); w = __builtin_amdgcn_cvt_pk_fp8_f32(h[j].z, h[j].w, w, true); *(int*)(H8 + (size_t)row * D + 256 * j + 4 * F.lane) = w; }
#pragma unroll
                for (int j = 0; j < 4; ++j) *(LAS f32x4*)(hbuf + tl * D + 256 * j + 4 * F.lane) = h[j];
            }
        }
        __syncthreads();
        if (base + 16 < tok1) MA_LOAD(base + 16);
        {
            f32x4 lg0 = {0.f, 0.f, 0.f, 0.f}, lg1 = {0.f, 0.f, 0.f, 0.f};
#pragma unroll
            for (int s = 0; s < 4; ++s) {
                const LAS float* hp = hbuf + (F.lane & 15) * D + 128 * F.wave + 32 * s + 8 * (F.lane >> 4);
                const f32x4 x0 = *(const LAS f32x4*)hp, x1 = *(const LAS f32x4*)(hp + 4);
                const unsigned h0 = pkbf(x0.x, x0.y), h1 = pkbf(x0.z, x0.w), h2 = pkbf(x1.x, x1.y), h3 = pkbf(x1.z, x1.w);
                const unsigned l0 = pkbf(x0.x - bflo(h0), x0.y - bfhi(h0)), l1 = pkbf(x0.z - bflo(h1), x0.w - bfhi(h1)), l2 = pkbf(x1.x - bflo(h2), x1.y - bfhi(h2)), l3 = pkbf(x1.z - bflo(h3), x1.w - bfhi(h3));
                const u32x4 hv = {h0, h1, h2, h3}, lv = {l0, l1, l2, l3};
                const rbf16x8 ah = __builtin_bit_cast(rbf16x8, hv), al = __builtin_bit_cast(rbf16x8, lv);
                lg0 = __builtin_amdgcn_mfma_f32_16x16x32_bf16(ah, wh[s][0], lg0, 0, 0, 0); lg1 = __builtin_amdgcn_mfma_f32_16x16x32_bf16(ah, wh[s][1], lg1, 0, 0, 0);
                lg0 = __builtin_amdgcn_mfma_f32_16x16x32_bf16(ah, wl[s][0], lg0, 0, 0, 0); lg1 = __builtin_amdgcn_mfma_f32_16x16x32_bf16(ah, wl[s][1], lg1, 0, 0, 0);
                lg0 = __builtin_amdgcn_mfma_f32_16x16x32_bf16(al, wh[s][0], lg0, 0, 0, 0); lg1 = __builtin_amdgcn_mfma_f32_16x16x32_bf16(al, wh[s][1], lg1, 0, 0, 0);
            }
#pragma unroll
            for (int r = 0; r < 4; ++r) { const int tl = 4 * (F.lane >> 4) + r; part[(F.wave * 16 + tl) * 32 + (F.lane & 15)] = lg0[r]; part[(F.wave * 16 + tl) * 32 + 16 + (F.lane & 15)] = lg1[r]; }
        }
        __syncthreads();
        {
            const int tl = F.wave * 2 + kh, tok = base + tl;
            float v = bias;
#pragma unroll
            for (int w = 0; w < 8; ++w) v += part[(w * 16 + tl) * 32 + e];
            float tv[4]; int ti[4];
#pragma unroll
            for (int k = 0; k < 4; ++k) {
                float cv = v; int ci = e;
#pragma unroll
                for (int o = 1; o < 32; o <<= 1) { const float ov = __shfl_xor(cv, o); const int oi = __shfl_xor(ci, o); if (ov > cv || (ov == cv && oi < ci)) { cv = ov; ci = oi; } }
                tv[k] = cv; ti[k] = ci; if (e == ci) v = -3.0e38f;
            }
            if (tok < tok1) {
                const float e1 = __expf(tv[1] - tv[0]), e2 = __expf(tv[2] - tv[0]), e3 = __expf(tv[3] - tv[0]); const float inv = 1.f / (1.f + e1 + e2 + e3);
                if (e == 0) *(f32x4*)(gate + (size_t)MA_ROW(tok) * 4) = (f32x4){inv, e1 * inv, e2 * inv, e3 * inv};
                if (!DRY && e < 4) { const int ex = (e == 0) ? ti[0] : (e == 1) ? ti[1] : (e == 2) ? ti[2] : ti[3];
                    const int rank = __hip_atomic_fetch_add(lcnt + ex, 1, __ATOMIC_RELAXED, __HIP_MEMORY_SCOPE_WORKGROUP); sel[(tok - tok0) * 4 + e] = ex | (rank << 8); }
            }
        }
    }
#undef MA_LOAD
    __syncthreads();
    if (DRY) return;
    if (F.tid < 32) gbase[F.tid] = (int)__hip_atomic_fetch_add(F.ctl() + CW_CNT + L * 32 + F.tid, (unsigned)lcnt[F.tid], __ATOMIC_RELAXED, __HIP_MEMORY_SCOPE_AGENT);
    __syncthreads();
    for (int i = F.tid; i < (tok1 - tok0) * 4; i += 512) { const int v = sel[i], ee = v & 255, rank = v >> 8; list[(size_t)ee * T + gbase[ee] + rank] = MA_ROW(tok0 + (i >> 2)) * 4 + (i & 3); }
    __syncthreads();
#undef MA_ROW
}
template <int L>
__device__ __forceinline__ int moe_setup(Frame& F) {
    LAS int* cnt = (LAS int*)(F.lds + LC_CNT); LAS int* tbase = (LAS int*)(F.lds + LC_TBASE); LAS int* tile_e = (LAS int*)(F.lds + LC_TILEE);
    __syncthreads();
    if (F.tid < 64) {
        const int c = (F.lane < 32) ? (int)__hip_atomic_load(F.ctl() + CW_CNT + L * 32 + F.lane, __ATOMIC_RELAXED, __HIP_MEMORY_SCOPE_AGENT) : 0;
        const int nt = (c + 255) >> 8;
        int incl = nt;
#pragma unroll
        for (int o = 1; o < 32; o <<= 1) { const int t = __shfl_up(incl, o); if (F.lane >= o) incl += t; }
        const int excl = incl - nt;
        if (F.lane < 32) { cnt[F.lane] = c; tbase[F.lane] = excl; for (int t = 0; t < nt; ++t) tile_e[excl + t] = F.lane; }
        if (F.lane == 31) tbase[32] = incl;
    }
    __syncthreads();
    return tbase[32];
}
template <int L, bool DRY>
__device__ __forceinline__ void p_moe_b(Frame& F) {
    const unsigned char* SLOT = F.ws() + WS_SLOT; const bf16_t* X = (const bf16_t*)(F.ws() + WS_X); bf16_t* Xo = (bf16_t*)(F.ws() + WS_X + (DRY ? WS_JUNK : 0)); unsigned char* H8 = F.ws() + WS_H + (DRY ? WS_JUNK : 0); const float* gate = (const float*)(F.ws() + WS_GATE);
    const float* g3 = normg(F, L, 3);
    constexpr int NR = (L == 3) ? NB * SEQ : T;
    int sl[4][4], sn[4][4]; f32x4 xc[4], xn[4], gc, gn;
#define MB_ROW(n_) ((L == 3) ? (((n_) >> 14) * SB + NCTX + ((n_) & (SEQ - 1))) : (n_))
#define MB_LOAD(n_, S_, X_, G_) do { const int r_ = MB_ROW(n_); G_ = *(const f32x4*)(gate + (size_t)r_ * 4); \
        _Pragma("unroll") for (int k = 0; k < 4; ++k) _Pragma("unroll") for (int j = 0; j < 4; ++j) S_[k][j] = *(const int*)(SLOT + ((size_t)r_ * 4 + k) * D + 256 * j + 4 * F.lane); \
        ld_row_bf16(X + (size_t)r_ * D, F.lane, X_); } while (0)
    int cs = -1; f32x4 pm[4], pg[4], p0v[4];
    int n = F.gw;
    if (n < NR) MB_LOAD(n, sl, xc, gc);
    for (; n < NR; n += F.NGW) {
        const int nn = n + F.NGW;
        if (nn < NR) MB_LOAD(nn, sn, xn, gn);
        const int row = MB_ROW(n), b = row >= SB ? 1 : 0, w = row - b * SB, s = (w < NCTX) ? 2 : b;
        f32x4 y[4], x[4];
#pragma unroll
        for (int j = 0; j < 4; ++j) { y[j] = (f32x4){0, 0, 0, 0}; x[j] = xc[j];
#pragma unroll
            for (int k = 0; k < 4; ++k) { const int q = sl[k][j]; y[j] += (f32x4){__builtin_amdgcn_cvt_f32_fp8(q, 0), __builtin_amdgcn_cvt_f32_fp8(q, 1), __builtin_amdgcn_cvt_f32_fp8(q, 2), __builtin_amdgcn_cvt_f32_fp8(q, 3)} * gc[k]; } }
        if (s != cs) { cs = s; constexpr int LN_ = (L < 3) ? L + 1 : 3; const float* m5 = modp(F, L, s, 5); const float* gn = normg(F, LN_, 0); const float* m1n = modp(F, LN_, s, 1); const float* m0n = modp(F, LN_, s, 0);
#pragma unroll
            for (int j = 0; j < 4; ++j) { const int o = 256 * j + 4 * F.lane; pm[j] = *(const f32x4*)(m5 + o) * *(const f32x4*)(g3 + o); pg[j] = *(const f32x4*)(gn + o) * (*(const f32x4*)(m1n + o) + 1.f); p0v[j] = *(const f32x4*)(m0n + o); } }
        const float ry = rsqrtf(row_ss(y) * (1.f / D) + RMS_EPS);
#pragma unroll
        for (int j = 0; j < 4; ++j) x[j] = x[j] + pm[j] * (y[j] * ry);
        if (L == 3) { st_row_f32((DRY ? (float*)Xo : F.out()) + ((size_t)(b * SEQ + (w - NCTX))) * D, F.lane, x); }
        else {
            st_row_bf16(Xo + (size_t)row * D, F.lane, x);
            f32x4 h[4]; const float rx = rsqrtf(row_ss(x) * (1.f / D) + RMS_EPS);
#pragma unroll
            for (int j = 0; j < 4; ++j) h[j] = (x[j] * rx) * pg[j] + p0v[j];
#pragma unroll
            for (int j = 0; j < 4; ++j) { int w8 = 0; w8 = __builtin_amdgcn_cvt_pk_fp8_f32(h[j].x, h[j].y, w8, false); w8 = __builtin_amdgcn_cvt_pk_fp8_f32(h[j].z, h[j].w, w8, true); *(int*)(H8 + (size_t)row * D + 256 * j + 4 * F.lane) = w8; }
        }
#pragma unroll
        for (int k = 0; k < 4; ++k)
#pragma unroll
            for (int j = 0; j < 4; ++j) sl[k][j] = sn[k][j];
#pragma unroll
        for (int j = 0; j < 4; ++j) xc[j] = xn[j];
        gc = gn;
    }
#undef MB_ROW
#undef MB_LOAD
}
template <int LDG, int VCOL0, int NH>
__device__ __forceinline__ void vt_prep(Frame& F, const bf16_t* G, unsigned char* VT8) {
    LAS unsigned char* scr = F.lds + F.wave * 4096;
    constexpr int NTI = SB / 64;
    const int dvl = F.lane >> 1, hf = F.lane & 1;
    for (int it = F.gw; it < NB * NH * NTI; it += F.NGW) {
        const int tile = it % NTI, bh = it / NTI, b = bh / NH, hd = bh - b * NH;
        const bf16_t* src = G + (size_t)(b * SB + tile * 64 + F.lane) * LDG + VCOL0 + hd * 128;
        unsigned char* dst = VT8 + (size_t)(bh * 128) * SB + tile * 64 + hf * 32;
#pragma unroll 1
        for (int c = 0; c < 4; ++c) {
            u32x4 a[4];
#pragma unroll
            for (int i = 0; i < 4; ++i) a[i] = *(const u32x4*)(src + c * 32 + i * 8);
#pragma unroll
            for (int i = 0; i < 4; ++i) {
                int w0 = 0, w1 = 0;
                w0 = __builtin_amdgcn_cvt_pk_fp8_f32(bflo(a[i].x), bfhi(a[i].x), w0, false); w0 = __builtin_amdgcn_cvt_pk_fp8_f32(bflo(a[i].y), bfhi(a[i].y), w0, true);
                w1 = __builtin_amdgcn_cvt_pk_fp8_f32(bflo(a[i].z), bfhi(a[i].z), w1, false); w1 = __builtin_amdgcn_cvt_pk_fp8_f32(bflo(a[i].w), bfhi(a[i].w), w1, true);
                *(LAS int*)(scr + F.lane * 36 + 8 * i) = w0; *(LAS int*)(scr + F.lane * 36 + 8 * i + 4) = w1;
            }
            LDS_WAIT(); asm volatile("" ::: "memory");
            unsigned o8[8];
#pragma unroll
            for (int q = 0; q < 8; ++q) { const int kb = 32 * (q >> 2) + 8 * (q & 3) + 4 * hf; const LAS unsigned char* p = scr + kb * 36 + dvl;
                o8[q] = (unsigned)p[0] | ((unsigned)p[36] << 8) | ((unsigned)p[72] << 16) | ((unsigned)p[108] << 24); }
            unsigned char* d = dst + (size_t)(c * 32 + dvl) * SB;
            *(u32x4*)d = (u32x4){o8[0], o8[1], o8[2], o8[3]}; *(u32x4*)(d + 16) = (u32x4){o8[4], o8[5], o8[6], o8[7]};
            LDS_WAIT(); asm volatile("" ::: "memory");
        }
    }
}
template <bool DRY> __device__ __forceinline__ void p_gqa_prep(Frame& F) {
    const bf16_t* G = (const bf16_t*)(F.ws() + WS_G); unsigned char* Q8 = F.ws() + WS_Q8; unsigned char* K8 = F.ws() + WS_K8; const float* qg = F.in(I_GQG); const float* kg = F.in(I_GKG);
    const int hi = F.lane >> 5, jl = (F.lane & 31) * 2, c0 = hi * 64 + jl;
    const float f0 = __builtin_amdgcn_exp2f(-(float)(jl & 31) * (LOG2_THETA / 32.f)), f1 = __builtin_amdgcn_exp2f(-(float)((jl + 1) & 31) * (LOG2_THETA / 32.f));
    const float qg0 = qg[c0], qg1 = qg[c0 + 1], kg0 = kg[c0], kg1 = kg[c0 + 1];
    for (int rr = F.gw; rr < T; rr += 2 * F.NGW) {
        unsigned qw[2][10];
#pragma unroll
        for (int u = 0; u < 2; ++u) { const int row = min(rr + u * F.NGW, T - 1); const bf16_t* gr = G + (size_t)row * 1536 + c0;
#pragma unroll
            for (int h = 0; h < 10; ++h) qw[u][h] = *(const unsigned*)(gr + h * 128); }
#pragma unroll
        for (int u = 0; u < 2; ++u) {
            const int row = min(rr + u * F.NGW, T - 1);
            const int b = row >= SB ? 1 : 0, w = row - b * SB; const bool lat = w >= NCTX; const int t = w - NCTX;
            const float pos = lat ? ((jl < 32) ? (float)(t >> 6) : (float)(t & 63)) : 0.f; const float a0 = pos * f0, a1 = pos * f1;
            const float cs0 = __cosf(a0), sn0 = __sinf(a0), cs1 = __cosf(a1), sn1 = __sinf(a1);
#pragma unroll
            for (int h = 0; h < 10; ++h) {
                const unsigned q = qw[u][h];
                const float x0 = bflo(q), x1 = bfhi(q);
                const float r = rsqrtf(wave_sum(x0 * x0 + x1 * x1) * (1.f / 128.f) + RMS_EPS);
                const float n0 = x0 * r * (h < 8 ? qg0 : kg0), n1 = x1 * r * (h < 8 ? qg1 : kg1);
                const float p0 = __shfl_xor(n0, 32), p1 = __shfl_xor(n1, 32);
                const float o0 = hi ? (n0 * cs0 + p0 * sn0) : (n0 * cs0 - p0 * sn0), o1 = hi ? (n1 * cs1 + p1 * sn1) : (n1 * cs1 - p1 * sn1);
                const float qs = (h < 8) ? QSCALE128 : 1.f;
                const unsigned short w8 = (unsigned short)__builtin_amdgcn_cvt_pk_fp8_f32(o0 * qs, o1 * qs, 0, false);
                if (h < 8) *(unsigned short*)(Q8 + (size_t)row * 1024 + h * 128 + c0) = w8; else *(unsigned short*)(K8 + (size_t)row * 256 + (h - 8) * 128 + c0) = w8;
            }
        }
    }
    vt_prep<1536, 1280, 2>(F, G, F.ws() + WS_VT8);
}
template <bool DRY> __device__ __forceinline__ void p_diff_prep(Frame& F) {
    const bf16_t* G = (const bf16_t*)(F.ws() + WS_G); unsigned char* Q8 = F.ws() + WS_Q8; unsigned char* K8 = F.ws() + WS_K8;
    const int l31 = F.lane & 31, j0 = 2 * l31; const bool first = l31 < 16; const int jj = j0 & 31;
    const float f0 = __builtin_amdgcn_exp2f(-(float)(jj & 15) * (LOG2_THETA / 16.f)), f1 = __builtin_amdgcn_exp2f(-(float)((jj + 1) & 15) * (LOG2_THETA / 16.f));
    for (int rr = F.gw; rr < T; rr += 2 * F.NGW) {
        unsigned qw[2][16];
#pragma unroll
        for (int u = 0; u < 2; ++u) { const int row = min(rr + u * F.NGW, T - 1); const bf16_t* gr = G + (size_t)row * 3072 + 2 * F.lane;
#pragma unroll
            for (int ch = 0; ch < 16; ++ch) qw[u][ch] = *(const unsigned*)(gr + ch * 128); }
#pragma unroll
        for (int u = 0; u < 2; ++u) {
            const int row = min(rr + u * F.NGW, T - 1);
            const int b = row >= SB ? 1 : 0, w = row - b * SB; const int t = w - NCTX;
            const float pos = (w >= NCTX) ? ((jj < 16) ? (float)(t >> 6) : (float)(t & 63)) : 0.f; const float a0 = pos * f0, a1 = pos * f1;
            const float cs0 = __cosf(a0), sn0 = __sinf(a0), cs1 = __cosf(a1), sn1 = __sinf(a1);
#pragma unroll
            for (int ch = 0; ch < 16; ++ch) {
                const unsigned q = qw[u][ch];
                const float x0 = bflo(q), x1 = bfhi(q);
                const float p0 = __shfl_xor(x0, 16), p1 = __shfl_xor(x1, 16);
                const float o0 = first ? (x0 * cs0 - p0 * sn0) : (x0 * cs0 + p0 * sn0), o1 = first ? (x1 * cs1 - p1 * sn1) : (x1 * cs1 + p1 * sn1);
                const float qs = (ch < 8) ? QSCALE64 : 1.f;
                const unsigned short w8 = (unsigned short)__builtin_amdgcn_cvt_pk_fp8_f32(o0 * qs, o1 * qs, 0, false);
                if (ch < 8) *(unsigned short*)(Q8 + (size_t)row * 1024 + ch * 128 + 2 * F.lane) = w8; else *(unsigned short*)(K8 + (size_t)row * 1024 + (ch - 8) * 128 + 2 * F.lane) = w8;
            }
        }
    }
    vt_prep<3072, 2048, 8>(F, G, F.ws() + WS_VT8);
}
template <bool DRY> __device__ __forceinline__ void p_conv_prep(Frame& F) {
    const bf16_t* G = (const bf16_t*)(F.ws() + WS_G); unsigned char* Z = F.ws() + WS_O + (DRY ? WS_JUNK : 0); const float* wd = F.in(I_CDW);
    for (int rr = F.gw; rr < T; rr += 2 * F.NGW) {
        u32x2 qc[2][3][4], qx[2][3][4], qb[2][4]; float wm[2][3];
#pragma unroll
        for (int u = 0; u < 2; ++u) {
            const int row = min(rr + u * F.NGW, T - 1); const int b = row >= SB ? 1 : 0, w = row - b * SB;
            const int s0 = (w < NCTX) ? b * SB : b * SB + NCTX, s1 = (w < NCTX) ? b * SB + NCTX : (b + 1) * SB;
            const bool hasp = row - 1 >= s0, hasn = row + 1 < s1;
            const int rws[3] = {hasp ? row - 1 : row, row, hasn ? row + 1 : row}; wm[u][0] = hasp ? 1.f : 0.f; wm[u][1] = 1.f; wm[u][2] = hasn ? 1.f : 0.f;
#pragma unroll
            for (int j = 0; j < 4; ++j) { const int c = 256 * j + 4 * F.lane; qb[u][j] = *(const u32x2*)(G + (size_t)row * 3072 + c);
#pragma unroll
                for (int d = 0; d < 3; ++d) { const bf16_t* gp = G + (size_t)rws[d] * 3072 + c; qc[u][d][j] = *(const u32x2*)(gp + 1024); qx[u][d][j] = *(const u32x2*)(gp + 2048); } }
        }
#pragma unroll
        for (int u = 0; u < 2; ++u) {
            const int row = min(rr + u * F.NGW, T - 1);
#pragma unroll
            for (int j = 0; j < 4; ++j) { const int c = 256 * j + 4 * F.lane; f32x4 acc = {0, 0, 0, 0};
#pragma unroll
                for (int d = 0; d < 3; ++d) { const u32x2 a = qc[u][d][j], x = qx[u][d][j];
                    const f32x4 uu = (f32x4){bflo(a.x), bfhi(a.x), bflo(a.y), bfhi(a.y)} * (f32x4){bflo(x.x), bfhi(x.x), bflo(x.y), bfhi(x.y)};
                    acc += uu * (*(const f32x4*)(wd + d * D + c) * wm[u][d]); }
                const u32x2 g = qb[u][j];
                const f32x4 z = acc * (f32x4){bflo(g.x), bfhi(g.x), bflo(g.y), bfhi(g.y)};
                int w8 = 0; w8 = __builtin_amdgcn_cvt_pk_fp8_f32(z.x * OS_CONV, z.y * OS_CONV, w8, false); w8 = __builtin_amdgcn_cvt_pk_fp8_f32(z.z * OS_CONV, z.w * OS_CONV, w8, true);
                *(int*)(Z + (size_t)row * D + c) = w8; }
        }
    }
}
template <int PV> __device__ __forceinline__ void p_gqa_attn(Frame& F) {
    const unsigned char* Q8 = F.ws() + WS_Q8; const unsigned char* K8 = F.ws() + WS_K8; const unsigned char* VT8 = F.ws() + WS_VT8; unsigned char* O = F.ws() + WS_O + (PV ? WS_JUNK : 0);
    for (int idx = F.vcu; idx < 1024 + 16; idx += F.G) {
        int b, hq, qrow, seq;
        if (idx < 1024) { const int r = idx >> 8, wi = idx & 255; b = r >> 1; hq = (r & 1) * 4 + (wi >> 6); qrow = b * SB + NCTX + (wi & 63) * 256; seq = SB; }
        else { const int j = idx - 1024; b = j >> 3; hq = j & 7; qrow = b * SB; seq = NCTX; }
        const int kvh = hq >> 2;
        att8::attn_body8<128, 1024, 256, 1024, false, (PV > 0 ? PV - 1 : 0)>(Q8 + (size_t)qrow * 1024 + hq * 128, K8 + (size_t)(b * SB) * 256 + kvh * 128, VT8 + (size_t)((b * 2 + kvh) * 128) * SB,
                                                      O + (size_t)qrow * D + hq * 128, seq, F.ldsg, 0, 0.f, nullptr);
    }
}
__device__ __forceinline__ void p_diff_attn(Frame& F) {
    const unsigned char* Q8 = F.ws() + WS_Q8; const unsigned char* K8 = F.ws() + WS_K8; const unsigned char* VT8 = F.ws() + WS_VT8; unsigned char* O = F.ws() + WS_O;
    const float* lv = F.in(I_DLAM);
    const float lam = __expf(wave_sum(lv[F.lane] * lv[64 + F.lane])) - __expf(wave_sum(lv[128 + F.lane] * lv[192 + F.lane])) + LAM_INIT;
    for (int idx = F.vcu; idx < 1024; idx += F.G) {
#pragma unroll 1
        for (int s = 0; s < 2; ++s) {
            int ix = idx; asm volatile("" : "+s"(ix));
            const int r = ix >> 6, b = r >> 3, h = r & 7, qrow = b * SB + NCTX + (ix & 63) * 256;
            att8::attn_body8<64, 1024, 1024, 1024, true>(Q8 + (size_t)qrow * 1024 + h * 128 + s * 64, K8 + (size_t)(b * SB) * 1024 + h * 128 + s * 64, VT8 + (size_t)((b * 8 + h) * 128) * SB,
                                                         O + (size_t)qrow * D + h * 128, SB, F.ldsg, s, lam, F.in(I_DSUB));
        }
    }
}


#define PG8_ALIGN true
#define PG8_SP2 true

template <int L, int P0> __device__ __forceinline__ void moe_layer(Frame& F, const XcdBarrier& bar, int lo, int hi, int rep_mask);

__global__ void __launch_bounds__(NWAVES * 64, 2) mk_fwd(Args args) {
    extern __shared__ __attribute__((aligned(16))) unsigned char lds[];
    Frame F;
    F.lds = (LAS unsigned char*)lds; F.ldsg = (char*)lds;
    F.tid = threadIdx.x; F.lane = F.tid & 63; F.wave = __builtin_amdgcn_readfirstlane(F.tid >> 6);
    F.G = gridDim.x; { const int bx = blockIdx.x; F.vcu = (F.G % 8 == 0) ? (bx % 8) * (F.G / 8) + bx / 8 : bx; }
    F.gw = F.vcu * NWAVES + F.wave; F.NGW = F.G * NWAVES;
    refresh(F);
    for (int u = F.tid; u < (LDS_BYTES - RING_BYTES) / 4; u += NWAVES * 64) ((LAS unsigned*)(F.lds + RING_BYTES))[u] = 0u;
    __syncthreads();
    XcdBarrier bar; bar.bar = F.ctl() + CW_BAR; bar.x = 0; bar.st = nullptr;
    if (!MK_MULTI) bar = xcd_barrier_post(F.ctl() + CW_BAR, (volatile LAS unsigned*)(F.lds + LC_MISC));
    const int lo = args.ph_lo, hi = args.ph_hi; const int rep_mask = args.pad;
#define IN(k) (lo <= (k) && (k) < hi && refresh(F))
#define NREP(bit) (REP_MASK ? 1 + ((rep_mask & (bit)) ? 1 : 0) : 1)
#define PHM(k) asm volatile("; === PHASE %0" :: "i"(k))
#define SEAM(k) do { if (IN(k) && IN((k) + 1)) { xcd_barrier(bar); if constexpr ((REP_MASK & 256) != 0) xcd_barrier(bar); } } while (0)
    bf16_t* const Hb = (bf16_t*)(F.ws() + WS_H); bf16_t* const Gb = (bf16_t*)(F.ws() + WS_G); bf16_t* const Ob = (bf16_t*)(F.ws() + WS_O); bf16_t* const Yb = (bf16_t*)(F.ws() + WS_Y);

    if (IN(0)) { PHM(0); for (int rep = 0; rep < NREP(16); ++rep) p0_prologue(F); } SEAM(0);
    if (IN(1)) { PHM(1); if constexpr ((REP_MASK & 128) != 0) p_hpass0<true>(F); p_hpass0<false>(F); } SEAM(1);
    if (IN(2)) { PHM(2); if constexpr ((REP_MASK & 128) != 0) p_poolprep<true>(F); p_poolprep<false>(F); } SEAM(2);
    if (IN(3)) { PHM(3);
        int kpool = 256; asm volatile("" : "+s"(kpool));
        pg8::Gemm g{Ob, (const bf16_t*)(F.ws() + WS_POOLW), 4 * T, 256, kpool}; pg8::PoolOrder S{F.G, F.vcu};
        pg8::EpiPool E{Yb, D};
        for (int rep = 0; rep < NREP(32); ++rep) pg8::gemm_phase<pg8::EpiPool, pg8::PoolOrder, PG8_ALIGN, PG8_SP2>(F.lds, g, S, E);
    } SEAM(3);
    moe_layer<0, 4>(F, bar, lo, hi, rep_mask);
    if (IN(9)) { PHM(9);
        int kop = D; asm volatile("" : "+s"(kop));
        pg8::Gemm g{Hb, (const bf16_t*)(F.ws() + WS_GQKV), T, 1536, kop}; pg8::StaticOrder S; S.init(T, 1536, F.G, (int)blockIdx.x);
        pg8::EpiScaled E{Gb, 1536, 1.f / W8_SCALE};
        pg8::gemm_phase<pg8::EpiScaled, pg8::StaticOrder, PG8_ALIGN, PG8_SP2, 1>(F.lds, g, S, E);
    } SEAM(9);
    if (IN(10)) { PHM(10); if constexpr ((REP_MASK & 128) != 0) p_gqa_prep<true>(F); p_gqa_prep<false>(F); } SEAM(10);
    if (IN(11)) { PHM(11); if constexpr ((REP_MASK & 1) != 0) { p_gqa_attn<ATT_PROBE + 1>(F); refresh(F); } p_gqa_attn<0>(F); } SEAM(11);
    if (IN(12)) { PHM(12);
        int kop = D; asm volatile("" : "+s"(kop));
        pg8::Gemm g{Ob, (const bf16_t*)(F.ws() + WS_GO), T, D, kop}; pg8::StaticOrder S; S.init(T, D, F.G, (int)blockIdx.x);
        pg8::EpiScaled E{Yb, D, 1.f / (W8_SCALE * OS_GQA)};
        for (int rep = 0; rep < NREP(32); ++rep) pg8::gemm_phase<pg8::EpiScaled, pg8::StaticOrder, PG8_ALIGN, PG8_SP2, 1>(F.lds, g, S, E);
    } SEAM(12);
    moe_layer<1, 13>(F, bar, lo, hi, rep_mask);
    if (IN(18)) { PHM(18);
        int kop = D; asm volatile("" : "+s"(kop));
        pg8::Gemm g{Hb, (const bf16_t*)(F.ws() + WS_CIN), T, 3072, kop}; pg8::StaticOrder S; S.init(T, 3072, F.G, (int)blockIdx.x);
        pg8::EpiScaled E{Gb, 3072, 1.f / W8_SCALE};
        pg8::gemm_phase<pg8::EpiScaled, pg8::StaticOrder, PG8_ALIGN, PG8_SP2, 1>(F.lds, g, S, E);
    } SEAM(18);
    if (IN(19)) { PHM(19); if constexpr ((REP_MASK & 128) != 0) p_conv_prep<true>(F); p_conv_prep<false>(F); } SEAM(19);
    if (IN(20)) { PHM(20);
        int kop = D; asm volatile("" : "+s"(kop));
        pg8::Gemm g{Ob, (const bf16_t*)(F.ws() + WS_COUT), T, D, kop}; pg8::StaticOrder S; S.init(T, D, F.G, (int)blockIdx.x);
        pg8::EpiScaled E{Yb, D, 1.f / (W8_SCALE * OS_CONV)};
        for (int rep = 0; rep < NREP(32); ++rep) pg8::gemm_phase<pg8::EpiScaled, pg8::StaticOrder, PG8_ALIGN, PG8_SP2, 1>(F.lds, g, S, E);
    } SEAM(20);
    moe_layer<2, 21>(F, bar, lo, hi, rep_mask);
    if (IN(26)) { PHM(26);
        int kop = D; asm volatile("" : "+s"(kop));
        pg8::Gemm g{Hb, (const bf16_t*)(F.ws() + WS_DQKV), T, 3072, kop}; pg8::StaticOrder S; S.init(T, 3072, F.G, (int)blockIdx.x);
        pg8::EpiScaled E{Gb, 3072, 1.f / W8_SCALE};
        pg8::gemm_phase<pg8::EpiScaled, pg8::StaticOrder, PG8_ALIGN, PG8_SP2, 1>(F.lds, g, S, E);
    } SEAM(26);
    if (IN(27)) { PHM(27); if constexpr ((REP_MASK & 128) != 0) p_diff_prep<true>(F); p_diff_prep<false>(F); } SEAM(27);
    if (IN(28)) { PHM(28); for (int rep = 0; rep < NREP(2); ++rep) p_diff_attn(F); } if (IN(28) && IN(30)) xcd_barrier(bar);
    if (IN(30)) { PHM(30);
        int kop = D; asm volatile("" : "+s"(kop));
        pg8::Gemm g{Ob, (const bf16_t*)(F.ws() + WS_DO), T, D, kop}; pg8::LatentOrder S; S.init(D, F.G, (int)blockIdx.x);
        pg8::EpiScaled E{Yb, D, 1.f / (W8_SCALE * OS_DIFF)};
        for (int rep = 0; rep < NREP(32); ++rep) pg8::gemm_phase<pg8::EpiScaled, pg8::LatentOrder, PG8_ALIGN, PG8_SP2, 1>(F.lds, g, S, E);
    } SEAM(30);
    moe_layer<3, 31>(F, bar, lo, hi, rep_mask);
    if (args.dump) {
        if (!MK_MULTI) xcd_barrier(bar);
        const bf16_t* X = (const bf16_t*)(F.ws() + WS_X);
        for (int row = F.gw; row < T; row += F.NGW) { const int b = row >= SB ? 1 : 0, w = row - b * SB; if (w < NCTX) continue;
            f32x4 v[4]; ld_row_bf16(X + (size_t)row * D, F.lane, v); st_row_f32(F.out() + ((size_t)(b * SEQ + (w - NCTX))) * D, F.lane, v); }
    }
}
struct MoeDeal { int base, stride, limit, nun; };
__device__ __forceinline__ MoeDeal moe_deal(const Frame& F, int U) {
    MoeDeal d;
    if (F.G % 8 == 0) { const int per = F.G / 8, x = F.vcu / per, cl = F.vcu - x * per; d.base = (int)(((long)U * x) / 8) + cl; d.stride = per; d.limit = (int)(((long)U * (x + 1)) / 8); }
    else { d.base = F.vcu; d.stride = F.G; d.limit = U; }
    d.nun = (d.base < d.limit) ? (d.limit - d.base + d.stride - 1) / d.stride : 0;
    return d;
}
template <int L, int P0> __device__ __forceinline__ void moe_layer(Frame& F, const XcdBarrier& bar, int lo, int hi, int rep_mask) {
    if (IN(P0)) { PHM(P0); if constexpr ((REP_MASK & 512) != 0) { p_moe_a<L>(F, true); refresh(F); } p_moe_a<L>(F, false); } if (IN(P0) && IN(P0 + 2)) xcd_barrier(bar);
    if (IN(P0 + 2)) { PHM(P0 + 2);
        const int ntiles = moe_setup<L>(F); const MoeDeal dl = moe_deal(F, ntiles * 8);
        int kop = D; asm volatile("" : "+s"(kop));
        { LAS unsigned short* tk = (LAS unsigned short*)(F.lds + LC_TOK16); const LAS int* cnt = (const LAS int*)(F.lds + LC_CNT); const LAS int* tbase = (const LAS int*)(F.lds + LC_TBASE); const LAS int* tile_e = (const LAS int*)(F.lds + LC_TILEE);
          const int* list = (const int*)(F.ws() + WS_LIST); int nun = dl.nun; if (nun > MAXU) nun = MAXU;
          const int nent = nun * 256;
          for (int idx0 = F.tid; idx0 < nent; idx0 += 5 * NWAVES * 64) { int val[5]; bool ok[5];
#pragma unroll
              for (int k = 0; k < 5; ++k) { const int idx = min(idx0 + k * NWAVES * 64, nent - 1), i = idx >> 8, r = idx & 255, pm = (dl.base + i * dl.stride) >> 3, ee = tile_e[pm], pos = (pm - tbase[ee]) * 256 + r, c = cnt[ee];
                  ok[k] = pos < c; val[k] = list[(size_t)ee * T + min(pos, c - 1)]; }
#pragma unroll
              for (int k = 0; k < 5; ++k) { const int idx = idx0 + k * NWAVES * 64; if (idx < nent) tk[idx] = (unsigned short)(ok[k] ? (val[k] >> 2) : 0); } }
          __syncthreads(); }
        pg8::Gemm g{(const bf16_t*)(F.ws() + WS_H), (const bf16_t*)(F.ws() + WS_W1T + (size_t)L * NE * 2048 * D), T, 2048, kop};
        pg8::MoeOrder S{(const LAS int*)(F.lds + LC_TILEE), dl.limit, 8, dl.stride, dl.base};
        pg8::EpiSwiGLU E{F.ws() + WS_ACT, (const bf16_t*)(F.ws() + WS_B1H) + (size_t)L * NE * 2048, 1.f / W8_SCALE};
        if constexpr ((REP_MASK & 4) != 0) { pg8::EpiSwiGLUT<(G1_PROBE & 3)> E2{F.ws() + WS_HS, (const bf16_t*)(F.ws() + WS_B1H) + (size_t)L * NE * 2048, 1.f / W8_SCALE};
            pg8::gemm_phase<pg8::EpiSwiGLUT<(G1_PROBE & 3)>, pg8::MoeOrder, PG8_ALIGN, PG8_SP2, 1, true, (G1_PROBE >> 2)>(F.lds, g, S, E2, (const LAS unsigned short*)(F.lds + LC_TOK16)); }
        pg8::gemm_phase<pg8::EpiSwiGLU, pg8::MoeOrder, PG8_ALIGN, PG8_SP2, 1, true>(F.lds, g, S, E, (const LAS unsigned short*)(F.lds + LC_TOK16));
    } SEAM(P0 + 2);
    if (IN(P0 + 3)) { PHM(P0 + 3);
        const int ntiles = moe_setup<L>(F); const MoeDeal dl = moe_deal(F, ntiles * 4);
        int kop = D; asm volatile("" : "+s"(kop));
        pg8::Gemm g{(const bf16_t*)(F.ws() + WS_ACT), (const bf16_t*)(F.ws() + WS_W2T + (size_t)L * NE * D * D), CROWS, D, kop};
        pg8::MoeOrder S{(const LAS int*)(F.lds + LC_TILEE), dl.limit, 4, dl.stride, dl.base};
        { LAS int* st = (LAS int*)(F.lds + LC_TOK16); const LAS int* cnt = (const LAS int*)(F.lds + LC_CNT); const LAS int* tbase = (const LAS int*)(F.lds + LC_TBASE); const LAS int* tile_e = (const LAS int*)(F.lds + LC_TILEE);
          const int* list = (const int*)(F.ws() + WS_LIST); int nun = dl.nun; if (nun > MAXU / 2) nun = MAXU / 2;
          const int nent = nun * 256;
          for (int idx0 = F.tid; idx0 < nent; idx0 += 5 * NWAVES * 64) { int val[5]; bool ok[5];
#pragma unroll
              for (int k = 0; k < 5; ++k) { const int idx = min(idx0 + k * NWAVES * 64, nent - 1), i = idx >> 8, r = idx & 255, pm = (dl.base + i * dl.stride) >> 2, ee = tile_e[pm], pos = (pm - tbase[ee]) * 256 + r, c = cnt[ee];
                  ok[k] = pos < c; val[k] = list[(size_t)ee * T + min(pos, c - 1)]; }
#pragma unroll
              for (int k = 0; k < 5; ++k) { const int idx = idx0 + k * NWAVES * 64; if (idx < nent) st[idx] = ok[k] ? val[k] : -1; } }
          __syncthreads(); }
        pg8::EpiScatter E{F.ws() + WS_SLOT, (const LAS int*)(F.lds + LC_TOK16), dl.stride, dl.base, (const bf16_t*)(F.ws() + WS_B2H) + (size_t)L * NE * D, 1.f / W8_SCALE, 0, T * 4};
        pg8::gemm_phase<pg8::EpiScatter, pg8::MoeOrder, PG8_ALIGN, PG8_SP2, 1>(F.lds, g, S, E);
        if constexpr ((REP_MASK & 8) != 0) { pg8::EpiScatter E2{F.ws() + WS_HS, (const LAS int*)(F.lds + LC_TOK16), dl.stride, dl.base, (const bf16_t*)(F.ws() + WS_B2H) + (size_t)L * NE * D, 1.f / W8_SCALE, ((REP_MASK & 4096) ? 1 : 0), CROWS};
            pg8::gemm_phase<pg8::EpiScatter, pg8::MoeOrder, PG8_ALIGN, PG8_SP2, 1>(F.lds, g, S, E2); }
    } SEAM(P0 + 3);
    if (IN(P0 + 4)) { PHM(P0 + 4); if constexpr ((REP_MASK & 1024) != 0) p_moe_b<L, true>(F); p_moe_b<L, false>(F); } SEAM(P0 + 4);
}
#undef IN
#undef SEAM

extern "C" void kernel_launch(void* const* d_in, const int* in_sizes, int n_in, void* d_out, int out_size, void* d_ws, size_t ws_size, hipStream_t stream) {
    static int grid = 0;
    if (grid == 0) {
        if (n_in != N_IN || in_sizes[0] != NB * SEQ * D || out_size != NB * SEQ * D || ws_size < WS_END) {
            fprintf(stderr, "kernel_launch: shape mismatch (n_in %d, in0 %d, out %d, ws %zu, need %zu); nothing launched\n", n_in, n_in > 0 ? in_sizes[0] : -1, out_size, ws_size, (size_t)WS_END); grid = -1; return; }
        { const long long exp_sz[N_IN] = {(long long)NB * SEQ * D, NB * D, NB * NCTX * D, D, 4LL * D * 6 * D, 4 * 6 * D, 4 * 4 * D, 4 * 256 * 256, D, D * 1536, D * D, 128, 128, D * 3072, 3 * D, D * D, D * 3072, D * D, 4 * 64, 128,
                                             4 * D * NE, 4 * NE, 4LL * NE * D * 2048, 4 * NE * 2048, 4LL * NE * D * D, 4 * NE * D};
          for (int i = 0; i < N_IN; ++i) if ((long long)in_sizes[i] != exp_sz[i]) { fprintf(stderr, "kernel_launch: input %d has %d elements, expected %lld; nothing launched\n", i, in_sizes[i], exp_sz[i]); grid = -1; return; } }
        int dev = 0, cus = 0, per_cu = 0;
        if (hipGetDevice(&dev) != hipSuccess || hipDeviceGetAttribute(&cus, hipDeviceAttributeMultiprocessorCount, dev) != hipSuccess) { fprintf(stderr, "kernel_launch: device query failed\n"); grid = -1; return; }
        if (hipFuncSetAttribute((const void*)mk_fwd, hipFuncAttributeMaxDynamicSharedMemorySize, LDS_BYTES) != hipSuccess) { fprintf(stderr, "kernel_launch: hipFuncSetAttribute failed\n"); grid = -1; return; }
        if (hipOccupancyMaxActiveBlocksPerMultiprocessor(&per_cu, (const void*)mk_fwd, NWAVES * 64, LDS_BYTES) != hipSuccess || per_cu < 1)
            fprintf(stderr, "kernel_launch: note: occupancy query reports %d workgroups per CU\n", per_cu);
        (void)hipGetLastError();
        grid = cus;
    }
    if (grid < 0) return;
    if (hipMemsetAsync((char*)d_ws + WS_CTL, 0, CTL_ZERO_BYTES, stream) != hipSuccess) { fprintf(stderr, "kernel_launch: memset failed\n"); return; }
    Args a{};
    for (int i = 0; i < N_IN; ++i) a.in[i] = (const float*)d_in[i];
    a.out = (float*)d_out; a.ws = (unsigned char*)d_ws; a.pad = REP_MASK;
    constexpr int STOP = MK_STOP;
#if MK_MULTI
    for (int p = 0; p < STOP; ++p) { a.ph_lo = p; a.ph_hi = p + 1; a.dump = 0; hipLaunchKernelGGL(mk_fwd, dim3(grid), dim3(NWAVES * 64), LDS_BYTES, stream, a); }
    if (STOP < N_PHASES) { a.ph_lo = 0; a.ph_hi = 0; a.dump = 1; hipLaunchKernelGGL(mk_fwd, dim3(grid), dim3(NWAVES * 64), LDS_BYTES, stream, a); }
#else
    a.ph_lo = 0; a.ph_hi = STOP; a.dump = (STOP < N_PHASES) ? 1 : 0;
    hipLaunchKernelGGL(mk_fwd, dim3(grid), dim3(NWAVES * 64), LDS_BYTES, stream, a);
#endif
    const hipError_t le = hipPeekAtLastError();
    if (le != hipSuccess) fprintf(stderr, "kernel_launch: launch failed: %s\n", hipGetErrorName(le));
}
```

```cpp
#include <hip/hip_runtime.h>
#include <cstdio>
#include <cstdint>

#define GAS __attribute__((address_space(1)))
#define LAS __attribute__((address_space(3)))

constexpr int D = 1024, NB = 2, SEQ = 16384, NCTX = 256, SB = SEQ + NCTX  , T = NB * SB  ;
constexpr int NE = 32, TOPK = 4, DFF = 1024;
constexpr int MAXTILES = T * TOPK / 256 + NE;
constexpr int CROWS = MAXTILES * 256;
constexpr float RMS_EPS = 1e-6f;
constexpr float LAM_INIT = 0.55605818f;
constexpr float LOG2_THETA = 13.287712379549449f;
constexpr float INV_2PI = 0.15915494309189535f;
constexpr float GS_CONV = 8.f;
constexpr float OS_GQA = 32.f, OS_DIFF = 16.f, OS_CONV = 4.f;

enum { I_X = 0, I_C, I_CTX, I_CCTX, I_MODW, I_MODB, I_NORMG, I_POOLW, I_POOLS, I_GQKV, I_GO, I_GQG, I_GKG, I_CIN, I_CDW, I_COUT, I_DQKV, I_DO, I_DLAM, I_DSUB,
       I_RW, I_RB, I_W1, I_B1, I_W2, I_B2, N_IN };

constexpr size_t MiB = 1u << 20;
constexpr size_t WS_CTL = 0, CTL_ZERO_BYTES = 1 * MiB;
constexpr size_t WS_MOD = 1 * MiB;
constexpr size_t WS_POOLW = 2 * MiB;
constexpr size_t WS_GQKV = 3 * MiB;
constexpr size_t WS_GO = 6 * MiB;
constexpr size_t WS_CIN = 8 * MiB;
constexpr size_t WS_COUT = 14 * MiB;
constexpr size_t WS_DQKV = 16 * MiB;
constexpr size_t WS_DO = 22 * MiB;
constexpr size_t WS_GATE = 24 * MiB;
constexpr size_t WS_B1H = 25 * MiB;
constexpr size_t WS_B2H = WS_B1H + 512 * 1024;
constexpr size_t WS_LIST = 26 * MiB;
constexpr size_t WS_W1T = 32 * MiB;
constexpr size_t WS_W2T = WS_W1T + 512 * MiB;
constexpr size_t WS_X = WS_W2T + 256 * MiB;
constexpr size_t WS_H = WS_X + 130 * MiB;
constexpr size_t WS_G = WS_H + 65 * MiB;
constexpr size_t WS_O = WS_G + 195 * MiB;
constexpr size_t WS_OA = WS_O + 65 * MiB;
constexpr size_t WS_OB = WS_OA + 65 * MiB;
constexpr size_t WS_Y = WS_OB + 65 * MiB;
constexpr size_t WS_HS = WS_Y + 65 * MiB;
constexpr size_t WS_ACT = WS_HS + 276 * MiB;
constexpr size_t WS_SLOT = WS_ACT + 276 * MiB;
constexpr size_t WS_Q8 = WS_SLOT + 260 * MiB;
constexpr size_t WS_K8 = WS_Q8 + 33 * MiB;
constexpr size_t WS_VT8 = WS_K8 + 33 * MiB;
constexpr size_t WS_END = WS_VT8 + 33 * MiB;
static_assert(((size_t)T * 4 + 256) * 1024 <= 260 * MiB, "slot junk rows");
static_assert((size_t)T * 1024 <= 33 * MiB && (size_t)NB * 8 * 128 * SB <= 33 * MiB, "ws map fp8");
static_assert((size_t)T * D * 4 <= 130 * MiB && (size_t)T * D * 2 <= 65 * MiB && (size_t)T * 3072 * 2 <= 195 * MiB && (size_t)CROWS * D * 2 <= 276 * MiB && (size_t)T * 4 * D * 2 <= 260 * MiB, "ws map");
static_assert((size_t)NE * T * 4 <= 6 * MiB && (size_t)CROWS * 4 <= 1 * MiB && (size_t)T * 4 * 4 <= 1 * MiB && 4 * 3 * 6144 * 4 <= 1 * MiB, "ws map small");
constexpr int CW_CNT = 64;
constexpr int CW_BAR = 4096;

constexpr int RING_BYTES = 131072;
constexpr int LC_MISC = RING_BYTES;
constexpr int LC_CNT = LC_MISC + 64;
constexpr int LC_TBASE = LC_CNT + 128;
constexpr int LC_LCNT = LC_TBASE + 192;
constexpr int LC_GBASE = LC_LCNT + 128;
constexpr int LC_TILEE = LC_GBASE + 128;
constexpr int LC_TOK16 = LC_TILEE + MAXTILES * 4;
constexpr int MAXU = 26;
constexpr int LDS_BYTES = 147456;
static_assert(LC_TOK16 % 16 == 0 && LC_TOK16 + MAXU * 512 <= LDS_BYTES, "LDS map");

typedef unsigned short bf16_t;
typedef float f32x4 __attribute__((ext_vector_type(4)));
typedef float f32x2 __attribute__((ext_vector_type(2)));
typedef unsigned u32x2 __attribute__((ext_vector_type(2)));
typedef unsigned u32x4 __attribute__((ext_vector_type(4)));

__device__ __forceinline__ unsigned pkbf(float lo, float hi) { unsigned r; asm("v_cvt_pk_bf16_f32 %0, %1, %2" : "=v"(r) : "v"(lo), "v"(hi)); return r; }
__device__ __forceinline__ float bflo(unsigned w) { return __uint_as_float(w << 16); }
__device__ __forceinline__ float bfhi(unsigned w) { return __uint_as_float(w & 0xffff0000u); }
__device__ __forceinline__ float wave_sum(float v) {
#pragma unroll
    for (int o = 1; o < 64; o <<= 1) v += __shfl_xor(v, o);
    return v;
}
#define LDS_WAIT() asm volatile("s_waitcnt lgkmcnt(0)" ::: "memory")
#define VM_WAIT() asm volatile("s_waitcnt vmcnt(0)" ::: "memory")

namespace pg8 {
#define PG8_LAS __attribute__((address_space(3)))
typedef unsigned short bf16_t;
typedef short bf16x8 __attribute__((ext_vector_type(8)));
typedef float f32x4 __attribute__((ext_vector_type(4)));
typedef unsigned u32x4 __attribute__((ext_vector_type(4)));
typedef int i32x4 __attribute__((ext_vector_type(4)));
typedef int i32x8 __attribute__((ext_vector_type(8)));
typedef unsigned u32x2 __attribute__((ext_vector_type(2)));
constexpr int BM = 256, BK = 64, HALF = 128, HTB = HALF * BK * 2  , STAGE_BYTES = 8 * HTB, NXCD = 8, WGM = 8;

__host__ __device__ __forceinline__ int lds_byte(int r, int c) { const int st = (r >> 4) * 2 + (c >> 5), rr = r & 15, cc = c & 31, ob = rr * 64 + cc * 2; return st * 1024 + (ob ^ (((ob >> 9) & 1) << 5)); }
__host__ __device__ __forceinline__ void stage_rc(int b, int& R, int& C) { const int st = b / 1024, sb = b % 1024, swz = sb ^ (((sb >> 9) & 1) << 5); R = (st >> 1) * 16 + swz / 64; C = (st & 1) * 32 + (swz % 64) / 2; }
__host__ __device__ __forceinline__ int perm32(int rho) { const int n = rho >> 4, i = rho & 15; return 8 * (i >> 2) + 4 * n + (i & 3); }

struct Unit { int pm, pn; };
struct Gemm { const bf16_t* A; const bf16_t* Bt; int M, N, K; };

struct StaticOrder {
    int nM, nN, nwg, G, c;
    __host__ __device__ void init(int M, int N, int G_, int c_) { nM = M / BM; nN = N / BM; nwg = nM * nN; G = G_; c = c_; }
    __host__ __device__ bool next(int i, Unit& u) const {
        const long L = (long)i * G + c; if (L >= nwg) return false;
        int wgid = (int)L; { const int q = nwg / NXCD, r = nwg % NXCD, xcd = wgid % NXCD, off = wgid / NXCD; wgid = (xcd < r ? xcd * (q + 1) : r * (q + 1) + (xcd - r) * q) + off; }
        const int nig = WGM * nN, gid = wgid / nig, fm = gid * WGM, gsz = (nM - fm) < WGM ? (nM - fm) : WGM;
        u.pm = fm + ((wgid % nig) % gsz); u.pn = (wgid % nig) / gsz; return true;
    }
    __device__ __forceinline__ void a_ready(const Unit&) const {}
    __device__ __forceinline__ void done(const Unit&) const {}
};


struct PoolOrder {
    int G, c;
    __device__ __forceinline__ bool next(int i, Unit& u) const { const int L = i * G + c; if (L >= 4 * 130) return false; const int g = L & 3, pm = L >> 2; u.pm = g * 130 + pm; u.pn = g; return true; }
    __device__ __forceinline__ void a_ready(const Unit&) const {}
    __device__ __forceinline__ void done(const Unit&) const {}
};
struct LatentOrder {
    StaticOrder S;
    __device__ void init(int N, int G_, int c_) { S.init(NB * SEQ, N, G_, c_); }
    __device__ bool next(int i, Unit& u) const { if (!S.next(i, u)) return false; u.pm += (u.pm >= SEQ / 256) ? 2 : 1; return true; }
    __device__ __forceinline__ void a_ready(const Unit&) const {}
    __device__ __forceinline__ void done(const Unit&) const {}
};
struct MoeOrder {
    const PG8_LAS int* tile_e; int lim, nN, G, c;
    __device__ __forceinline__ bool next(int i, Unit& u) const { const int L = i * G + c; if (L >= lim) return false; const int pm = L / nN, pl = L - pm * nN; u.pm = pm; u.pn = tile_e[pm] * nN + pl; return true; }
    __device__ __forceinline__ void a_ready(const Unit&) const {}
    __device__ __forceinline__ void done(const Unit&) const {}
};

__device__ __forceinline__ unsigned cvt_pk_bf16(float lo, float hi) { unsigned r; asm volatile("v_cvt_pk_bf16_f32 %0, %1, %2" : "=v"(r) : "v"(lo), "v"(hi)); return r; }

template <bool POOL> struct EpiPlainT {
    static constexpr bool PERM = true, AFTER_DRAIN = false, HAS_PRE = false; struct Pre {}; static constexpr int NST = 16;
    bf16_t* O; int ldc;
    __device__ __forceinline__ void operator()(const f32x4 (&acc)[2][2][4][2], const Unit& u, int wr, int wc, int fr, int fq) const {
        const int rt = POOL ? (u.pm - 130 * u.pn) : u.pm;
        const int row0 = rt * BM + wr * 64 + fr, col0 = u.pn * BM + wc * 32 + 8 * fq;
#pragma unroll
        for (int ai = 0; ai < 2; ++ai)
#pragma unroll
            for (int m = 0; m < 4; ++m) { bf16_t* rowp = O + (size_t)(row0 + ai * HALF + m * 16) * ldc + col0;
#pragma unroll
                for (int bj = 0; bj < 2; ++bj) { const f32x4 v0 = acc[ai][bj][m][0], v1 = acc[ai][bj][m][1];
                    u32x4 w; w.x = cvt_pk_bf16(v0[0], v0[1]); w.y = cvt_pk_bf16(v0[2], v0[3]); w.z = cvt_pk_bf16(v1[0], v1[1]); w.w = cvt_pk_bf16(v1[2], v1[3]);
                    *(u32x4*)(rowp + bj * HALF) = w; } }
    }
};
struct EpiScaled {
    static constexpr bool PERM = true, AFTER_DRAIN = false, HAS_PRE = false; struct Pre {}; static constexpr int NST = 16;
    bf16_t* O; int ldc; float asc;
    __device__ __forceinline__ void operator()(const f32x4 (&acc)[2][2][4][2], const Unit& u, int wr, int wc, int fr, int fq) const {
        const int row0 = u.pm * BM + wr * 64 + fr, col0 = u.pn * BM + wc * 32 + 8 * fq;
#pragma unroll
        for (int ai = 0; ai < 2; ++ai)
#pragma unroll
            for (int m = 0; m < 4; ++m) { bf16_t* rowp = O + (size_t)(row0 + ai * HALF + m * 16) * ldc + col0;
#pragma unroll
                for (int bj = 0; bj < 2; ++bj) { const f32x4 v0 = acc[ai][bj][m][0] * asc, v1 = acc[ai][bj][m][1] * asc;
                    u32x4 w; w.x = cvt_pk_bf16(v0[0], v0[1]); w.y = cvt_pk_bf16(v0[2], v0[3]); w.z = cvt_pk_bf16(v1[0], v1[1]); w.w = cvt_pk_bf16(v1[2], v1[3]);
                    *(u32x4*)(rowp + bj * HALF) = w; } }
    }
};
struct EpiRows8 {
    static constexpr bool PERM = true, AFTER_DRAIN = false, HAS_PRE = false; struct Pre {}; static constexpr int NST = 8;
    unsigned char* O; int ldc; float asc;
    __device__ __forceinline__ void operator()(const f32x4 (&acc)[2][2][4][2], const Unit& u, int wr, int wc, int fr, int fq) const {
        const int col0 = u.pn * BM + wc * 32 + 8 * fq;
#pragma unroll
        for (int ai = 0; ai < 2; ++ai)
#pragma unroll
            for (int mp = 0; mp < 2; ++mp) {
                const int m = 2 * mp + (fq & 1), row = u.pm * BM + wr * 64 + fr + ai * HALF + m * 16;
#pragma unroll
                for (int bj = 0; bj < 2; ++bj) { unsigned w[2][2];
#pragma unroll
                    for (int mm = 0; mm < 2; ++mm) { const f32x4 v0 = acc[ai][bj][2 * mp + mm][0] * asc, v1 = acc[ai][bj][2 * mp + mm][1] * asc;
                        int w0 = 0, w1 = 0; w0 = __builtin_amdgcn_cvt_pk_fp8_f32(v0[0], v0[1], w0, false); w0 = __builtin_amdgcn_cvt_pk_fp8_f32(v0[2], v0[3], w0, true);
                        w1 = __builtin_amdgcn_cvt_pk_fp8_f32(v1[0], v1[1], w1, false); w1 = __builtin_amdgcn_cvt_pk_fp8_f32(v1[2], v1[3], w1, true);
                        w[mm][0] = (unsigned)w0; w[mm][1] = (unsigned)w1; }
                    const auto lo = __builtin_amdgcn_permlane16_swap(w[0][0], w[1][0], false, false), hi2 = __builtin_amdgcn_permlane16_swap(w[0][1], w[1][1], false, false);
                    *(u32x4*)(O + (size_t)row * ldc + (col0 & ~15) + bj * HALF) = (u32x4){lo[0], hi2[0], lo[1], hi2[1]}; }
            }
    }
};
typedef EpiPlainT<false> EpiPlain;
typedef EpiPlainT<true> EpiPool;
template <int CHEAP> struct EpiSwiGLUT {
    static constexpr bool PERM = true, AFTER_DRAIN = false; static constexpr int NST = (CHEAP == 2) ? 0 : 4;
    unsigned char* ACT; const bf16_t* b1h; float asc;
    static constexpr bool HAS_PRE = true; struct Pre { u32x4 bg, bu; };
    __device__ __forceinline__ void pre(const Unit& u, int wc, int fq, Pre& p) const {
        const int e = u.pn >> 3, pl = u.pn & 7, oc0 = pl * 128 + wc * 32 + 8 * fq;
        const bf16_t* a = b1h + e * 2048 + oc0;
        asm volatile("global_load_dwordx4 %0, %1, off" : "=v"(p.bg) : "v"(a) : "memory");
        asm volatile("global_load_dwordx4 %0, %1, off offset:2048" : "=v"(p.bu) : "v"(a) : "memory");
    }
    __device__ __forceinline__ void operator()(const f32x4 (&acc)[2][2][4][2], const Unit& u, int wr, int wc, int fr, int fq, const Pre& p) const {
        if constexpr (CHEAP == 2) return;
        const int pl = u.pn & 7;
        const int row0 = u.pm * BM + wr * 64 + fr, oc0 = pl * 128 + wc * 32 + 8 * fq;
        f32x4 bg[2], bu[2];
#pragma unroll
        for (int n = 0; n < 2; ++n) { bg[n] = (f32x4){__uint_as_float(p.bg[2 * n] << 16), __uint_as_float(p.bg[2 * n] & 0xffff0000u), __uint_as_float(p.bg[2 * n + 1] << 16), __uint_as_float(p.bg[2 * n + 1] & 0xffff0000u)};
            bu[n] = (f32x4){__uint_as_float(p.bu[2 * n] << 16), __uint_as_float(p.bu[2 * n] & 0xffff0000u), __uint_as_float(p.bu[2 * n + 1] << 16), __uint_as_float(p.bu[2 * n + 1] & 0xffff0000u)} + 1.0f; }
#pragma unroll
        for (int ai = 0; ai < 2; ++ai)
#pragma unroll
            for (int mp = 0; mp < 2; ++mp) {
                unsigned w[2][2];
#pragma unroll
                for (int mm = 0; mm < 2; ++mm) { const int m = 2 * mp + mm; float o[8];
#pragma unroll
                    for (int n = 0; n < 2; ++n) {
#pragma unroll
                        for (int jp = 0; jp < 2; ++jp) { typedef float f2e __attribute__((ext_vector_type(2)));
                            const f32x4 ag = acc[ai][0][m][n], au = acc[ai][1][m][n];
                            const f2e a2 = {asc, asc};
                            f2e gv = (f2e){ag[2 * jp], ag[2 * jp + 1]} * a2 + (f2e){bg[n][2 * jp], bg[n][2 * jp + 1]};
                            f2e uv = (f2e){au[2 * jp], au[2 * jp + 1]} * a2 + (f2e){bu[n][2 * jp], bu[n][2 * jp + 1]};
                            gv.x = fminf(gv.x, 7.0f); gv.y = fminf(gv.y, 7.0f);
                            uv.x = fminf(fmaxf(uv.x, -6.0f), 8.0f); uv.y = fminf(fmaxf(uv.y, -6.0f), 8.0f);
                            const f2e tt = gv * (f2e){-1.702f * 1.4426950408889634f, -1.702f * 1.4426950408889634f};
                            f2e dd = (f2e){(CHEAP != 0) ? 1.0f : __builtin_amdgcn_exp2f(tt.x), (CHEAP != 0) ? 1.0f : __builtin_amdgcn_exp2f(tt.y)} + (f2e){1.0f, 1.0f};
                            const f2e sg = {(CHEAP != 0) ? 0.5f : __builtin_amdgcn_rcpf(dd.x), (CHEAP != 0) ? 0.5f : __builtin_amdgcn_rcpf(dd.y)};
                            const f2e oo = (gv * sg) * uv;
                            o[4 * n + 2 * jp] = oo.x; o[4 * n + 2 * jp + 1] = oo.y; } }
                    int w0 = 0, w1 = 0; w0 = __builtin_amdgcn_cvt_pk_fp8_f32(o[0], o[1], w0, false); w0 = __builtin_amdgcn_cvt_pk_fp8_f32(o[2], o[3], w0, true);
                    w1 = __builtin_amdgcn_cvt_pk_fp8_f32(o[4], o[5], w1, false); w1 = __builtin_amdgcn_cvt_pk_fp8_f32(o[6], o[7], w1, true);
                    w[mm][0] = (unsigned)w0; w[mm][1] = (unsigned)w1; }
                const auto lo = __builtin_amdgcn_permlane16_swap(w[0][0], w[1][0], false, false), hi2 = __builtin_amdgcn_permlane16_swap(w[0][1], w[1][1], false, false);
                const int m = 2 * mp + (fq & 1);
                *(u32x4*)(ACT + (size_t)(row0 + ai * HALF + m * 16) * 1024 + (oc0 & ~15)) = (u32x4){lo[0], hi2[0], lo[1], hi2[1]}; }
    }
};
typedef EpiSwiGLUT<0> EpiSwiGLU;
struct EpiScatter {
    static constexpr bool PERM = true, AFTER_DRAIN = false;
    static constexpr int NST = 8;
    unsigned char* SLOT; const PG8_LAS int* slot_tab; int G, c; const bf16_t* b2h; float asc; int seq; int junk0;
    static constexpr bool HAS_PRE = true; struct Pre { u32x4 bv[2]; };
    __device__ __forceinline__ void pre(const Unit& u, int wc, int fq, Pre& p) const {
        const int e = u.pn >> 2, pl = u.pn & 3, col0 = pl * BM + wc * 32 + 8 * fq;
        const bf16_t* a = b2h + e * 1024 + col0;
        asm volatile("global_load_dwordx4 %0, %1, off" : "=v"(p.bv[0]) : "v"(a) : "memory");
        asm volatile("global_load_dwordx4 %0, %1, off offset:256" : "=v"(p.bv[1]) : "v"(a) : "memory");
    }
    __device__ __forceinline__ void operator()(const f32x4 (&acc)[2][2][4][2], const Unit& u, int wr, int wc, int fr, int fq, const Pre& p) const {
        const int pl = u.pn & 3, ui = (u.pm * 4 + pl - c) / G;
        const int col0 = pl * BM + wc * 32 + 8 * fq;
        f32x4 bv[2][2];
#pragma unroll
        for (int bj = 0; bj < 2; ++bj)
#pragma unroll
            for (int n = 0; n < 2; ++n) bv[bj][n] = (f32x4){__uint_as_float(p.bv[bj][2 * n] << 16), __uint_as_float(p.bv[bj][2 * n] & 0xffff0000u), __uint_as_float(p.bv[bj][2 * n + 1] << 16), __uint_as_float(p.bv[bj][2 * n + 1] & 0xffff0000u)};
#pragma unroll
        for (int ai = 0; ai < 2; ++ai)
#pragma unroll
            for (int mp = 0; mp < 2; ++mp) {
                const int m = 2 * mp + (fq & 1), rit = wr * 64 + fr + ai * HALF + m * 16;
                int slot = seq ? (u.pm * BM + rit) : slot_tab[ui * BM + rit];
                if (slot < 0) slot = junk0 + rit;
#pragma unroll
                for (int bj = 0; bj < 2; ++bj) { unsigned w[2][2];
#pragma unroll
                    for (int mm = 0; mm < 2; ++mm) { const f32x4 v0 = acc[ai][bj][2 * mp + mm][0] * asc + bv[bj][0], v1 = acc[ai][bj][2 * mp + mm][1] * asc + bv[bj][1];
                        int w0 = 0, w1 = 0; w0 = __builtin_amdgcn_cvt_pk_fp8_f32(v0[0], v0[1], w0, false); w0 = __builtin_amdgcn_cvt_pk_fp8_f32(v0[2], v0[3], w0, true);
                        w1 = __builtin_amdgcn_cvt_pk_fp8_f32(v1[0], v1[1], w1, false); w1 = __builtin_amdgcn_cvt_pk_fp8_f32(v1[2], v1[3], w1, true);
                        w[mm][0] = (unsigned)w0; w[mm][1] = (unsigned)w1; }
                    const auto lo = __builtin_amdgcn_permlane16_swap(w[0][0], w[1][0], false, false), hi2 = __builtin_amdgcn_permlane16_swap(w[0][1], w[1][1], false, false);
                    *(u32x4*)(SLOT + (size_t)slot * 1024 + (col0 & ~15) + bj * HALF) = (u32x4){lo[0], hi2[0], lo[1], hi2[1]}; }
            }
    }
};

template <class Epi, class Sched, bool ALIGN_EPI = false, bool SP2 = false, int ES = 2, bool GATHER = false, int PRB = 0>
__device__ __forceinline__ void gemm_phase(PG8_LAS unsigned char* lds, const Gemm g, const Sched& S, const Epi& E, const PG8_LAS unsigned short* tok16 = nullptr) {
    static_assert(SP2 || !GATHER, "GATHER is implemented for the SP2 loop");
    int tid_ = threadIdx.x; asm volatile("" : "+v"(tid_));
    const int tid = tid_, wid = __builtin_amdgcn_readfirstlane(tid >> 6), lane = tid & 63, wr = wid >> 2, wc = wid & 3, fr = lane & 15, fq = lane >> 4;
    const int K = g.K, nt = K * ES / (BK * 2);
    unsigned voffA[2], voffB[2]; int rowA[2]; unsigned colA[2];
#pragma unroll
    for (int i = 0; i < 2; ++i) { int R, C; stage_rc(tid * 16 + i * 8192, R, C); const int Rb = Epi::PERM ? ((R & ~31) + perm32(R & 31)) : R;
        voffA[i] = (unsigned)(R * K * ES + C * 2); voffB[i] = (unsigned)(Rb * K * ES + C * 2); rowA[i] = R; colA[i] = (unsigned)(C * 2); }
    const size_t kstep = (size_t)(BK * 2);
    const size_t hstep = (size_t)HALF * K * ES;
    const size_t hstepA = GATHER ? 0 : hstep;
    const size_t tstep = 2 * hstep;
    const unsigned ldsw = (unsigned)wid * 1024u;
    const int aoff = lds_byte(wr * 64 + fr, fq * 8), boff = lds_byte(wc * 32 + fr, fq * 8);
#define PG8_SA(b, h) (((b) * 2 + (h)) * HTB)
#define PG8_SB(b, h) ((4 + (b) * 2 + (h)) * HTB)
#define PG8_STAGE(bufoff, gbase, voff) do { _Pragma("unroll") for (int _i = 0; _i < 2; ++_i) \
        __builtin_amdgcn_global_load_lds((const unsigned*)((const char*)(gbase) + (voff)[_i]), (PG8_LAS unsigned*)(lds + (bufoff) + ldsw + _i * 8192), 16, 0, 0); } while (0)
#define PG8_GOFF(dst, ui_) do { _Pragma("unroll") for (int _h = 0; _h < 2; ++_h) _Pragma("unroll") for (int _i = 0; _i < 2; ++_i) dst[_h][_i] = (unsigned)tok16[(ui_) * 256 + _h * HALF + rowA[_i]] * (unsigned)(K * ES) + colA[_i]; } while (0)
#define PG8_STAGE_A(bufoff, gbase, h, usenext) do { if constexpr (GATHER) { _Pragma("unroll") for (int _i = 0; _i < 2; ++_i) { const unsigned vo_ = (usenext) ? goffN[h][_i] : goffC[h][_i]; \
        __builtin_amdgcn_global_load_lds((const unsigned*)((const char*)(gbase) + vo_), (PG8_LAS unsigned*)(lds + (bufoff) + ldsw + _i * 8192), 16, 0, 0); } } else PG8_STAGE(bufoff, gbase, voffA); } while (0)
#define PG8_LDA(dst, b, h) do { _Pragma("unroll") for (int m = 0; m < 4; ++m) _Pragma("unroll") for (int k = 0; k < 2; ++k) dst[m][k] = *(const PG8_LAS bf16x8*)(lds + PG8_SA(b, h) + aoff + m * 2048 + k * 1024); } while (0)
#define PG8_LDB(dst, b, h) do { _Pragma("unroll") for (int n = 0; n < 2; ++n) _Pragma("unroll") for (int k = 0; k < 2; ++k) dst[n][k] = *(const PG8_LAS bf16x8*)(lds + PG8_SB(b, h) + boff + n * 2048 + k * 1024); } while (0)
#define PG8_CAT8(lo, hi) __builtin_shufflevector(__builtin_bit_cast(i32x4, lo), __builtin_bit_cast(i32x4, hi), 0, 1, 2, 3, 4, 5, 6, 7)
#define PG8_MFMA8(accv, bv, av) asm volatile("v_mfma_scale_f32_16x16x128_f8f6f4 %0, %1, %2, %0, %3, %3 op_sel_hi:[0,0,0]" : "+v"(accv) : "v"(bv), "v"(av), "v"(sc1))
#define PG8_MMA(ai, bj, At, Bt) do { if constexpr (PRB == 1) break; __builtin_amdgcn_s_setprio(1); if constexpr (ES == 2) { _Pragma("unroll") for (int m = 0; m < 4; ++m) _Pragma("unroll") for (int n = 0; n < 2; ++n) _Pragma("unroll") for (int k = 0; k < 2; ++k) \
        acc[ai][bj][m][n] = __builtin_amdgcn_mfma_f32_16x16x32_bf16(Bt[n][k], At[m][k], acc[ai][bj][m][n], 0, 0, 0); } else { _Pragma("unroll") for (int m = 0; m < 4; ++m) _Pragma("unroll") for (int n = 0; n < 2; ++n) { \
        const i32x8 b8_ = PG8_CAT8(Bt[n][0], Bt[n][1]), a8_ = PG8_CAT8(At[m][0], At[m][1]); PG8_MFMA8(acc[ai][bj][m][n], b8_, a8_); } } __builtin_amdgcn_s_setprio(0); } while (0)
#define PG8_WAIT_V(n) asm volatile("s_waitcnt vmcnt(" #n ")" ::: "memory")
#define PG8_WAIT_L(n) asm volatile("s_waitcnt lgkmcnt(" #n ")" ::: "memory")
#define PG8_BAR __builtin_amdgcn_s_barrier()
#define PG8_SCHED __builtin_amdgcn_sched_barrier(0)
    Unit cur, nxt; int ui = 0; typename Epi::Pre epre;
    if (!S.next(0, cur)) return;
    int sc1 = 0x7f7f7f7f; asm volatile("" : "+v"(sc1));
    f32x4 acc[2][2][4][2];
#pragma unroll
    for (int a = 0; a < 2; ++a)
#pragma unroll
        for (int b = 0; b < 2; ++b)
#pragma unroll
            for (int m = 0; m < 4; ++m)
#pragma unroll
                for (int n = 0; n < 2; ++n) acc[a][b][m][n] = (f32x4){0.f, 0.f, 0.f, 0.f};
    bf16x8 At[4][2], B0[2][2], B1[2][2];
    const char* cA = (const char*)g.A + (GATHER ? (size_t)0 : (size_t)cur.pm * tstep); const char* cB = (const char*)g.Bt + (size_t)cur.pn * tstep;
    unsigned goffC[2][2] = {{0u, 0u}, {0u, 0u}}, goffN[2][2] = {{0u, 0u}, {0u, 0u}};
    if constexpr (GATHER) PG8_GOFF(goffC, 0);
    S.a_ready(cur);
    if constexpr (SP2) {
        PG8_STAGE(PG8_SB(0, 0), cB, voffB); PG8_STAGE(PG8_SB(0, 1), cB + hstep, voffB); PG8_STAGE_A(PG8_SA(0, 0), cA, 0, false); PG8_STAGE_A(PG8_SA(0, 1), cA + hstepA, 1, false);
        if (wr == 1) PG8_BAR;
        PG8_WAIT_V(2); PG8_BAR;
        PG8_STAGE(PG8_SB(1, 0), cB + kstep, voffB); PG8_STAGE_A(PG8_SA(1, 0), cA + kstep, 0, false); PG8_STAGE(PG8_SB(1, 1), cB + hstep + kstep, voffB);
        PG8_WAIT_V(6); PG8_BAR;
    } else {
        PG8_STAGE(PG8_SB(0, 0), cB, voffB); PG8_STAGE(PG8_SA(0, 0), cA, voffA); PG8_STAGE(PG8_SB(0, 1), cB + hstep, voffB); PG8_STAGE(PG8_SA(0, 1), cA + hstep, voffA);
        if (wr == 1) PG8_BAR;
        PG8_WAIT_V(4); PG8_BAR;
        PG8_STAGE(PG8_SB(1, 0), cB + kstep, voffB); PG8_STAGE(PG8_SA(1, 0), cA + kstep, voffA); PG8_STAGE(PG8_SB(1, 1), cB + hstep + kstep, voffB);
        PG8_WAIT_V(6); PG8_BAR;
    }
    bool seam = false;
#define PG8_WAIT_VX(rx_) asm volatile("v_cmp_ne_u32_e32 vcc, 0, %0\n\ts_cbranch_vccz 1f\n\ts_waitcnt vmcnt(%1)\n\ts_branch 2f\n1:\n\ts_waitcnt vmcnt(8)\n2:" :: "v"(rx_), "n"(8 + Epi::NST) : "memory", "vcc")
    for (;;) {
        const bool has_next = S.next(ui + 1, nxt);
        const char* nA = (has_next && !GATHER) ? (const char*)g.A + (size_t)nxt.pm * tstep : cA;
        const char* nB = has_next ? (const char*)g.Bt + (size_t)nxt.pn * tstep : cB;
        for (int t = 0; t < nt; t += 2) {
            const bool last = (t == nt - 2);
            const int rx = (SP2 && seam && t == 0) ? 1 : 0;
            const char* a1 = cA + (size_t)(t + 1) * kstep;
            const char* a2 = last ? nA : cA + (size_t)(t + 2) * kstep; const char* b2 = last ? nB : cB + (size_t)(t + 2) * kstep;
            const char* a3 = a2 + kstep; const char* b3 = b2 + kstep;
            if (last && has_next) S.a_ready(nxt);
            if constexpr (Epi::HAS_PRE) { if (last) E.pre(cur, wc, fq, epre); }
            if constexpr (GATHER) { if (last) { if (has_next) PG8_GOFF(goffN, ui + 1); else { _Pragma("unroll") for (int _h = 0; _h < 2; ++_h) _Pragma("unroll") for (int _i = 0; _i < 2; ++_i) goffN[_h][_i] = goffC[_h][_i]; } } }
            if constexpr (SP2) {
            PG8_LDB(B0, 0, 0); PG8_LDB(B1, 0, 1); PG8_SCHED; PG8_LDA(At, 0, 0); PG8_STAGE_A(PG8_SA(1, 1), a1 + hstepA, 1, false);
            PG8_WAIT_VX(rx); PG8_WAIT_L(0); PG8_BAR; PG8_MMA(0, 0, At, B0); PG8_MMA(0, 1, At, B1); PG8_BAR; PG8_SCHED;
            PG8_LDA(At, 0, 1); PG8_STAGE(PG8_SB(0, 0), b2, voffB); PG8_STAGE(PG8_SB(0, 1), b2 + hstep, voffB); PG8_STAGE_A(PG8_SA(0, 0), a2, 0, last);
            PG8_WAIT_VX(rx); PG8_WAIT_L(0); PG8_BAR; PG8_MMA(1, 0, At, B0); PG8_MMA(1, 1, At, B1); PG8_BAR; PG8_SCHED;
            PG8_LDB(B0, 1, 0); PG8_LDB(B1, 1, 1); PG8_SCHED; PG8_LDA(At, 1, 0); PG8_STAGE_A(PG8_SA(0, 1), a2 + hstepA, 1, last);
            PG8_WAIT_V(8); PG8_WAIT_L(0); PG8_BAR; PG8_MMA(0, 0, At, B0); PG8_MMA(0, 1, At, B1); PG8_BAR; PG8_SCHED;
            PG8_LDA(At, 1, 1); PG8_STAGE(PG8_SB(1, 0), b3, voffB); PG8_STAGE(PG8_SB(1, 1), b3 + hstep, voffB); PG8_STAGE_A(PG8_SA(1, 0), a3, 0, last);
            PG8_WAIT_V(8); PG8_WAIT_L(0); PG8_BAR; PG8_MMA(1, 0, At, B0); PG8_MMA(1, 1, At, B1); PG8_BAR; PG8_SCHED;
            } else {
            PG8_LDB(B0, 0, 0); PG8_SCHED; PG8_LDA(At, 0, 0); PG8_STAGE(PG8_SA(1, 1), a1 + hstep, voffA);
            PG8_WAIT_L(8); PG8_BAR; PG8_WAIT_L(0); PG8_MMA(0, 0, At, B0); PG8_BAR; PG8_SCHED;
            PG8_LDB(B1, 0, 1); PG8_STAGE(PG8_SB(0, 0), b2, voffB);
            PG8_BAR; PG8_WAIT_L(0); PG8_MMA(0, 1, At, B1); PG8_BAR;
            PG8_LDA(At, 0, 1); PG8_STAGE(PG8_SA(0, 0), a2, voffA);
            PG8_BAR; PG8_WAIT_L(0); PG8_MMA(1, 0, At, B0); PG8_BAR; PG8_SCHED;
            PG8_STAGE(PG8_SB(0, 1), b2 + hstep, voffB);
            PG8_WAIT_V(6); PG8_BAR; PG8_MMA(1, 1, At, B1); PG8_BAR;
            PG8_LDB(B0, 1, 0); PG8_SCHED; PG8_LDA(At, 1, 0); PG8_STAGE(PG8_SA(0, 1), a2 + hstep, voffA);
            PG8_WAIT_L(8); PG8_BAR; PG8_WAIT_L(0); PG8_MMA(0, 0, At, B0); PG8_BAR; PG8_SCHED;
            PG8_LDB(B1, 1, 1); PG8_STAGE(PG8_SB(1, 0), b3, voffB);
            PG8_BAR; PG8_WAIT_L(0); PG8_MMA(0, 1, At, B1); PG8_BAR;
            PG8_LDA(At, 1, 1); PG8_STAGE(PG8_SA(1, 0), a3, voffA);
            PG8_BAR; PG8_WAIT_L(0); PG8_MMA(1, 0, At, B0); PG8_BAR; PG8_SCHED;
            PG8_STAGE(PG8_SB(1, 1), b3 + hstep, voffB);
            PG8_WAIT_V(6); PG8_BAR; PG8_MMA(1, 1, At, B1); PG8_BAR;
            }
        }
        if constexpr (ES == 1) { PG8_SCHED; asm volatile("s_nop 15\n\ts_nop 15" ::: "memory"); PG8_SCHED; }
        if constexpr (ALIGN_EPI) { if (wr == 0) PG8_BAR; }
        if constexpr (!Epi::AFTER_DRAIN) { if constexpr (Epi::HAS_PRE) E(acc, cur, wr, wc, fr, fq, epre); else E(acc, cur, wr, wc, fr, fq); S.done(cur); }
        if (!has_next) break;
#pragma unroll
        for (int a = 0; a < 2; ++a)
#pragma unroll
            for (int b = 0; b < 2; ++b)
#pragma unroll
                for (int m = 0; m < 4; ++m)
#pragma unroll
                    for (int n = 0; n < 2; ++n) acc[a][b][m][n] = (f32x4){0.f, 0.f, 0.f, 0.f};
        cur = nxt; cA = nA; cB = nB; ++ui; seam = SP2;
        if constexpr (GATHER) { _Pragma("unroll") for (int _h = 0; _h < 2; ++_h) _Pragma("unroll") for (int _i = 0; _i < 2; ++_i) goffC[_h][_i] = goffN[_h][_i]; }
        if constexpr (ALIGN_EPI) { if (wr == 1) PG8_BAR; }
    }
    PG8_WAIT_V(0);
    if constexpr (!ALIGN_EPI) { if (wr == 0) PG8_BAR; }
    PG8_BAR;
    if constexpr (Epi::AFTER_DRAIN) { E.fused(acc, cur, wr, wc, fr, fq, lds, wid, lane); S.done(cur); }
#undef PG8_SA
#undef PG8_SB
#undef PG8_STAGE
#undef PG8_STAGE_A
#undef PG8_GOFF
#undef PG8_LDA
#undef PG8_LDB
#undef PG8_MMA
#undef PG8_CAT8
#undef PG8_MFMA8
#undef PG8_WAIT_V
#undef PG8_WAIT_VX
#undef PG8_WAIT_L
#undef PG8_BAR
#undef PG8_SCHED
}
}

namespace att {
using f32x16 = __attribute__((ext_vector_type(16))) float;
__device__ __forceinline__ int crow(int r, int hi) { return (r & 3) + 8 * (r >> 2) + 4 * hi; }
__device__ __forceinline__ unsigned cvtpk(float lo, float hi) { unsigned r; asm volatile("v_cvt_pk_bf16_f32 %0, %1, %2" : "=v"(r) : "v"(lo), "v"(hi)); return r; }
}

namespace att8 {
using att::f32x16; using att::crow;
typedef int i32x4 __attribute__((ext_vector_type(4)));
typedef int i32x8 __attribute__((ext_vector_type(8)));
constexpr int NW = 8, QBLK = 32, KVBLK = 64;
#define SBAR() __builtin_amdgcn_sched_barrier(0)
template <int OFF> __device__ __forceinline__ i32x4 rd128(int a) { i32x4 r; asm volatile("ds_read_b128 %0, %1 offset:%2" : "=&v"(r) : "v"(a), "i"(OFF) : "memory"); return r; }
__device__ __forceinline__ i32x8 cat8(i32x4 lo, i32x4 hi) { return __builtin_shufflevector(lo, hi, 0, 1, 2, 3, 4, 5, 6, 7); }
__device__ __forceinline__ float mx3(float a, float b, float c) { float r; asm("v_max3_f32 %0, %1, %2, %3" : "=v"(r) : "v"(a), "v"(b), "v"(c)); return r; }
constexpr float CSC = 1.f / 65536.f;
template <bool FIRST>
__device__ __forceinline__ void softmax8(f32x16& p0, f32x16& p1, float& M_run, float& alpha, i32x8& pf) {
  constexpr float CTHR = (56.f + 8.f * (5.f * 1.4426950408889634f)) * CSC;
  float a0 = mx3(p0[0], p0[1], p0[2]), a1 = mx3(p0[8], p0[9], p0[10]), a2 = mx3(p1[0], p1[1], p1[2]), a3 = mx3(p1[8], p1[9], p1[10]);
  a0 = mx3(a0, p0[3], p0[4]); a1 = mx3(a1, p0[11], p0[12]); a2 = mx3(a2, p1[3], p1[4]); a3 = mx3(a3, p1[11], p1[12]);
  a0 = mx3(a0, p0[5], p0[6]); a1 = mx3(a1, p0[13], p0[14]); a2 = mx3(a2, p1[5], p1[6]); a3 = mx3(a3, p1[13], p1[14]);
  a0 = mx3(a0, p0[7], a1); a2 = mx3(a2, p1[7], a3);
  float cmax = mx3(a0, p0[15], a2); cmax = mx3(cmax, p1[15], cmax);
  { auto rr = __builtin_amdgcn_permlane32_swap(__float_as_uint(cmax), __float_as_uint(cmax), false, false); cmax = mx3(__uint_as_float(rr[0]), __uint_as_float(rr[1]), __uint_as_float(rr[1])); }
  alpha = 1.f;
  if (FIRST || !__builtin_expect(__all(cmax <= CTHR), 1)) {
    const float tmax = (cmax * 65536.f - 56.f) * 0.125f, d = FIRST ? tmax : fmaxf(tmax, 0.f), d8 = 8.f * d * CSC;
    alpha = __builtin_amdgcn_exp2f(-d); M_run += d;
#pragma unroll
    for (int r = 0; r < 16; ++r) { p0[r] -= d8; p1[r] -= d8; }
  }
  typedef unsigned short us2 __attribute__((ext_vector_type(2)));
#pragma unroll
  for (int w = 0; w < 4; ++w) { const unsigned A = __builtin_bit_cast(unsigned, __builtin_amdgcn_cvt_pknorm_u16(p0[4 * w], p0[4 * w + 1])), B = __builtin_bit_cast(unsigned, __builtin_amdgcn_cvt_pknorm_u16(p0[4 * w + 2], p0[4 * w + 3]));
    pf[w] = (int)__builtin_amdgcn_perm(B, A, 0x06040200u); }
#pragma unroll
  for (int w = 0; w < 4; ++w) { const unsigned A = __builtin_bit_cast(unsigned, __builtin_amdgcn_cvt_pknorm_u16(p1[4 * w], p1[4 * w + 1])), B = __builtin_bit_cast(unsigned, __builtin_amdgcn_cvt_pknorm_u16(p1[4 * w + 2], p1[4 * w + 3]));
    pf[4 + w] = (int)__builtin_amdgcn_perm(B, A, 0x06040200u); }
}

template <int DQK, int LDQ, int LDK, int LDO, bool DIFF, int PROBE = 0>
__device__ __forceinline__ void attn_body8(const unsigned char* __restrict__ Qb, const unsigned char* __restrict__ Kh, const unsigned char* __restrict__ VT, unsigned char* __restrict__ Ob, int seq, char* lds,
                                           int dmode, float lam, const float* __restrict__ subg) {
  constexpr int SHM_V = 128 * 64, SHM_K = 64 * DQK, SLOT = SHM_V + SHM_K, NS = DQK / 64;
  int tid_ = threadIdx.x; asm volatile("" : "+v"(tid_));
  const int tid = tid_, wid = __builtin_amdgcn_readfirstlane(tid >> 6), lane = tid & 63, r32 = lane & 31, hi = lane >> 5, half = wid >> 2;
  constexpr int RD = 4;
  float* ws = (float*)(lds + RD * SLOT) + wid * 64; float* al_l = ws + 32;
  int sc1 = 0x7f7f7f7f; asm volatile("" : "+v"(sc1));
  int scq = 0x6f6f6f6f; asm volatile("" : "+v"(scq));
  float M_run = 0.f; asm volatile("" : "+v"(M_run));
  f32x16 o[4] = {};
  typedef float f32x4_ __attribute__((ext_vector_type(4)));
  f32x4_ osum = {0.f, 0.f, 0.f, 0.f};
  i32x8 sel8;
  { const int onv = (((lane & 15) == 0 && ((lane >> 4) & 1) == 0) || ((lane & 15) == 1 && ((lane >> 4) & 1) == 1)) ? 0x38383838 : 0;
#pragma unroll
    for (int i = 0; i < 8; ++i) { int t_; asm volatile("v_mov_b32 %0, %1" : "=v"(t_) : "v"(onv)); sel8[i] = t_; } }
#define MFMA16S(acc4, a8, b8) asm volatile("v_mfma_scale_f32_16x16x128_f8f6f4 %0, %1, %2, %0, %3, %3 op_sel_hi:[0,0,0]" : "+v"(acc4) : "v"(a8), "v"(b8), "v"(sc1))
  i32x8 qf[NS];
  { const unsigned char* Qw = Qb + (long)(wid * QBLK + r32) * LDQ + hi * 32;
#pragma unroll
    for (int s = 0; s < NS; ++s) qf[s] = cat8(*reinterpret_cast<const i32x4*>(Qw + s * 64), *reinterpret_cast<const i32x4*>(Qw + s * 64 + 16)); }
  const int vrow = 16 * wid + (lane >> 2), vpc = lane & 3;
  const int krow = 8 * wid + ((DQK == 128) ? (lane >> 3) : ((lane >> 2) & 7)), kpc = (DQK == 128) ? (lane & 7) : (lane & 3);
  const unsigned char* vsrc = VT + (long)vrow * SB + ((vpc ^ ((vrow >> 2) & 3)) << 4);
  const unsigned char* ksrc = Kh + (long)krow * LDK + ((DQK == 128) ? ((kpc ^ ((krow >> 1) & 7)) << 4) : ((kpc ^ ((krow >> 2) & 3)) << 4));
  const bool kact = (DQK == 128) || (lane < 32);
  const unsigned ldv = (unsigned)__builtin_amdgcn_readfirstlane((int)(uintptr_t)lds + wid * 1024), ldk = (unsigned)__builtin_amdgcn_readfirstlane((int)(uintptr_t)lds + SHM_V + wid * (DQK == 128 ? 1024 : 512));
#define GLDS16(gsrc, ldst) do { unsigned keep_; asm volatile("s_mov_b32 %0, m0\n\ts_mov_b32 m0, %2\n\ts_nop 0\n\tglobal_load_lds_dwordx4 %1, off\n\ts_mov_b32 m0, %0" : "=&s"(keep_) : "v"(gsrc), "s"(ldst) : "memory"); } while (0)
#define SDMA8(t_, sl_) do { GLDS16(vsrc + (t_) * KVBLK, ldv + (unsigned)((sl_) * SLOT)); if (kact) GLDS16(ksrc + (long)((t_) * KVBLK) * LDK, ldk + (unsigned)((sl_) * SLOT)); } while (0)
#define VMWAIT8(n) asm volatile("s_waitcnt vmcnt(" #n ")" ::: "memory")
#define BARL8() do { SBAR(); asm volatile("s_waitcnt lgkmcnt(0)\n\ts_barrier" ::: "memory"); SBAR(); } while (0)
#define LWAIT8(n) do { asm volatile("s_waitcnt lgkmcnt(" #n ")" ::: "memory"); SBAR(); } while (0)
#define RESC8(a) do { if (__any((a) < 1.f)) { if (hi == 0) al_l[r32] = (a); asm volatile("s_waitcnt lgkmcnt(0)" ::: "memory"); \
    _Pragma("unroll") for (int g = 0; g < 4; ++g) { const f32x4 a4_ = *(const f32x4*)(al_l + 8 * g + 4 * hi);      \
      _Pragma("unroll") for (int i = 0; i < 4; ++i) { _Pragma("unroll") for (int d = 0; d < 4; ++d) o[d][4 * g + i] *= a4_[i]; } SBAR(); } \
    { const f32x4 a4_ = *(const f32x4*)(al_l + (lane & 1) * 16 + 4 * (lane >> 4)); _Pragma("unroll") for (int i = 0; i < 4; ++i) osum[i] *= a4_[i]; }     \
    CIN_SET8(); } } while (0)
#define MFMA8(acc, a8, b8) asm volatile("v_mfma_scale_f32_32x32x64_f8f6f4 %0, %1, %2, %0, %3, %3 op_sel_hi:[0,0,0]" : "+v"(acc) : "v"(a8), "v"(b8), "v"(sc1))
#define MFMA8QC(acc, a8, b8, cin_) asm volatile("v_mfma_scale_f32_32x32x64_f8f6f4 %0, %1, %2, %3, %4, %5 op_sel_hi:[0,0,0]" : "=&v"(acc) : "v"(a8), "v"(b8), "v"(cin_), "v"(scq), "v"(sc1))
#define MFMA8Q(acc, a8, b8) asm volatile("v_mfma_scale_f32_32x32x64_f8f6f4 %0, %1, %2, %0, %3, %4 op_sel_hi:[0,0,0]" : "+v"(acc) : "v"(a8), "v"(b8), "v"(scq), "v"(sc1))
  const int lb = (int)(uintptr_t)lds;
  const int va0 = lb + r32 * 64 + (((2 * hi) ^ ((r32 >> 2) & 3)) << 4), va1 = lb + r32 * 64 + (((2 * hi + 1) ^ ((r32 >> 2) & 3)) << 4);
  const int kz = (DQK == 128) ? ((r32 >> 1) & 7) : ((r32 >> 2) & 3), krb = lb + SHM_V + r32 * DQK;
  const int ka00 = krb + (((2 * hi) ^ kz) << 4), ka01 = krb + (((2 * hi + 1) ^ kz) << 4), ka10 = krb + (((4 + 2 * hi) ^ kz) << 4), ka11 = krb + (((5 + 2 * hi) ^ kz) << 4);
#define KREAD8(so) do { k00 = rd128<0>(ka00 + (so)); k01 = rd128<0>(ka01 + (so)); k10 = rd128<32 * DQK>(ka00 + (so)); k11 = rd128<32 * DQK>(ka01 + (so)); \
    if constexpr (NS == 2) { k20 = rd128<0>(ka10 + (so)); k21 = rd128<0>(ka11 + (so)); k30 = rd128<32 * DQK>(ka10 + (so)); k31 = rd128<32 * DQK>(ka11 + (so)); } } while (0)
#define KREAD8C(SO) do { k00 = rd128<(SO)>(ka00); k01 = rd128<(SO)>(ka01); k10 = rd128<(SO) + 32 * DQK>(ka00); k11 = rd128<(SO) + 32 * DQK>(ka01); \
    if constexpr (NS == 2) { k20 = rd128<(SO)>(ka10); k21 = rd128<(SO)>(ka11); k30 = rd128<(SO) + 32 * DQK>(ka10); k31 = rd128<(SO) + 32 * DQK>(ka11); } } while (0)
#define VREAD8AC(SO) do { v00 = rd128<(SO)>(va0); v01 = rd128<(SO)>(va1); v10 = rd128<(SO) + 2048>(va0); v11 = rd128<(SO) + 2048>(va1); } while (0)
#define VREAD8BC(SO) do { if constexpr (NS == 2) { k00 = rd128<(SO) + 4096>(va0); k01 = rd128<(SO) + 4096>(va1); k10 = rd128<(SO) + 6144>(va0); k11 = rd128<(SO) + 6144>(va1); } \
    else { k20 = rd128<(SO) + 4096>(va0); k21 = rd128<(SO) + 4096>(va1); k30 = rd128<(SO) + 6144>(va0); k31 = rd128<(SO) + 6144>(va1); } } while (0)
#define VREAD8A(so) do { v00 = rd128<0>(va0 + (so)); v01 = rd128<0>(va1 + (so)); v10 = rd128<2048>(va0 + (so)); v11 = rd128<2048>(va1 + (so)); } while (0)
#define VREAD8B(so) do { if constexpr (NS == 2) { k00 = rd128<4096>(va0 + (so)); k01 = rd128<4096>(va1 + (so)); k10 = rd128<6144>(va0 + (so)); k11 = rd128<6144>(va1 + (so)); } \
    else { k20 = rd128<4096>(va0 + (so)); k21 = rd128<4096>(va1 + (so)); k30 = rd128<6144>(va0 + (so)); k31 = rd128<6144>(va1 + (so)); } } while (0)
#define QK8(NV) do { if constexpr (NS == 2) { LWAIT8_(NV + 6); MFMA8QC(p0, cat8(k00, k01), qf[0], cin); LWAIT8_(NV + 4); MFMA8QC(p1, cat8(k10, k11), qf[0], cin); LWAIT8_(NV + 2); MFMA8Q(p0, cat8(k20, k21), qf[NS - 1]); LWAIT8_(NV); MFMA8Q(p1, cat8(k30, k31), qf[NS - 1]); } \
    else { LWAIT8_(NV + 2); MFMA8QC(p0, cat8(k00, k01), qf[0], cin); LWAIT8_(NV); MFMA8QC(p1, cat8(k10, k11), qf[0], cin); } } while (0)
#define LWAIT8_(n) do { asm volatile("s_waitcnt lgkmcnt(%0)" :: "n"(n) : "memory"); SBAR(); } while (0)
#define PV8() do { MFMA16S(osum, pf, sel8); LWAIT8(6); MFMA8(o[0], pf, cat8(v00, v01)); LWAIT8(4); MFMA8(o[1], pf, cat8(v10, v11)); \
    if constexpr (NS == 2) { LWAIT8(2); MFMA8(o[2], pf, cat8(k00, k01)); LWAIT8(0); MFMA8(o[3], pf, cat8(k10, k11)); } else { LWAIT8(2); MFMA8(o[2], pf, cat8(k20, k21)); LWAIT8(0); MFMA8(o[3], pf, cat8(k30, k31)); } } while (0)
  f32x16 p0, p1; float al; i32x8 pf; const int NT = seq / KVBLK;
  f32x16 cin;
#define CIN_SET8() do { const float nm_ = (56.f - 8.f * M_run) * CSC; _Pragma("unroll") for (int r = 0; r < 16; ++r) cin[r] = nm_; asm volatile("" : "+v"(cin)); SBAR(); } while (0)
  i32x4 k00, k01, k10, k11, k20, k21, k30, k31, v00, v01, v10, v11;
#define ACC_INIT8() do { const float nm = (56.f - 8.f * M_run) * CSC; typedef float f2_ __attribute__((ext_vector_type(2))); f2_ n2 = {nm, nm}; asm volatile("" : "+v"(n2)); \
      f2_ q_[16]; _Pragma("unroll") for (int i = 0; i < 16; ++i) asm volatile("v_mov_b64 %0, %1" : "=v"(q_[i]) : "v"(n2)); \
      typedef float f4_ __attribute__((ext_vector_type(4))); typedef float f8_ __attribute__((ext_vector_type(8))); \
      { const f4_ a = __builtin_shufflevector(q_[0], q_[1], 0, 1, 2, 3), b = __builtin_shufflevector(q_[2], q_[3], 0, 1, 2, 3), c = __builtin_shufflevector(q_[4], q_[5], 0, 1, 2, 3), d = __builtin_shufflevector(q_[6], q_[7], 0, 1, 2, 3); \
        const f8_ ab = __builtin_shufflevector(a, b, 0, 1, 2, 3, 4, 5, 6, 7), cd = __builtin_shufflevector(c, d, 0, 1, 2, 3, 4, 5, 6, 7); p0 = __builtin_shufflevector(ab, cd, 0, 1, 2, 3, 4, 5, 6, 7, 8, 9, 10, 11, 12, 13, 14, 15); } \
      { const f4_ a = __builtin_shufflevector(q_[8], q_[9], 0, 1, 2, 3), b = __builtin_shufflevector(q_[10], q_[11], 0, 1, 2, 3), c = __builtin_shufflevector(q_[12], q_[13], 0, 1, 2, 3), d = __builtin_shufflevector(q_[14], q_[15], 0, 1, 2, 3); \
        const f8_ ab = __builtin_shufflevector(a, b, 0, 1, 2, 3, 4, 5, 6, 7), cd = __builtin_shufflevector(c, d, 0, 1, 2, 3, 4, 5, 6, 7); p1 = __builtin_shufflevector(ab, cd, 0, 1, 2, 3, 4, 5, 6, 7, 8, 9, 10, 11, 12, 13, 14, 15); } \
      asm volatile("" : "+v"(p0), "+v"(p1)); SBAR(); } while (0)
  SDMA8(0, 0); SDMA8(1, 1); SDMA8(2, 2); if (half) SDMA8(3, 3);
  VMWAIT8(0); BARL8();
  CIN_SET8();
  KREAD8(0); QK8(0);
  SBAR(); asm volatile("s_nop 15\n\ts_nop 15\n\ts_nop 15\n\ts_nop 15\n\ts_nop 15\n\ts_nop 15" ::: "memory"); SBAR();
  softmax8<true>(p0, p1, M_run, al, pf);
  CIN_SET8();
  if (half) BARL8();
  int sw = (3 + half) & 3;
#define MSEG8(KO, VO) do { \
    if constexpr (NS == 2) { \
      k00 = rd128<(KO)>(ka00); k01 = rd128<(KO)>(ka01); k10 = rd128<(KO) + 32 * DQK>(ka00); k11 = rd128<(KO) + 32 * DQK>(ka01); k20 = rd128<(KO)>(ka10); k21 = rd128<(KO)>(ka11); \
      LWAIT8(4); MFMA8QC(p0, cat8(k00, k01), qf[0], cin); k30 = rd128<(KO) + 32 * DQK>(ka10); k31 = rd128<(KO) + 32 * DQK>(ka11); \
      LWAIT8(4); MFMA8QC(p1, cat8(k10, k11), qf[0], cin); v00 = rd128<(VO)>(va0); v01 = rd128<(VO)>(va1); \
      LWAIT8(4); MFMA8Q(p0, cat8(k20, k21), qf[NS - 1]); v10 = rd128<(VO) + 2048>(va0); v11 = rd128<(VO) + 2048>(va1); \
      LWAIT8(4); MFMA8Q(p1, cat8(k30, k31), qf[NS - 1]); k00 = rd128<(VO) + 4096>(va0); k01 = rd128<(VO) + 4096>(va1); \
      MFMA16S(osum, pf, sel8); k10 = rd128<(VO) + 6144>(va0); k11 = rd128<(VO) + 6144>(va1); \
      LWAIT8(6); MFMA8(o[0], pf, cat8(v00, v01)); LWAIT8(4); MFMA8(o[1], pf, cat8(v10, v11)); LWAIT8(2); MFMA8(o[2], pf, cat8(k00, k01)); LWAIT8(0); MFMA8(o[3], pf, cat8(k10, k11)); \
    } else { \
      k00 = rd128<(KO)>(ka00); k01 = rd128<(KO)>(ka01); k10 = rd128<(KO) + 32 * DQK>(ka00); k11 = rd128<(KO) + 32 * DQK>(ka01); v00 = rd128<(VO)>(va0); v01 = rd128<(VO)>(va1); \
      LWAIT8(4); MFMA8QC(p0, cat8(k00, k01), qf[0], cin); v10 = rd128<(VO) + 2048>(va0); v11 = rd128<(VO) + 2048>(va1); \
      LWAIT8(4); MFMA8QC(p1, cat8(k10, k11), qf[0], cin); k20 = rd128<(VO) + 4096>(va0); k21 = rd128<(VO) + 4096>(va1); \
      MFMA16S(osum, pf, sel8); k30 = rd128<(VO) + 6144>(va0); k31 = rd128<(VO) + 6144>(va1); \
      LWAIT8(6); MFMA8(o[0], pf, cat8(v00, v01)); LWAIT8(4); MFMA8(o[1], pf, cat8(v10, v11)); LWAIT8(2); MFMA8(o[2], pf, cat8(k20, k21)); LWAIT8(0); MFMA8(o[3], pf, cat8(k30, k31)); } } while (0)
#define STEP8(KS, VS, jj) do { \
    MSEG8((KS) * SLOT, (VS) * SLOT); \
    BARL8(); \
    softmax8<false>(p0, p1, M_run, al, pf); RESC8(al); \
    { const int t = (jj) + 3 + half; if (t < NT) { SDMA8(t, sw); VMWAIT8(2); } else VMWAIT8(0); } \
    BARL8(); \
    sw = (sw + 1) & 3; } while (0)
  int j = 0;
  for (; j + 4 < NT; j += 4) { STEP8(1, 0, j); STEP8(2, 1, j + 1); STEP8(3, 2, j + 2); STEP8(0, 3, j + 3); }
  if (j + 1 < NT) { STEP8(1, 0, j); ++j; }
  if (j + 1 < NT) { STEP8(2, 1, j); ++j; }
  if (j + 1 < NT) { STEP8(3, 2, j); ++j; }
  const int sv = j & 3;
#undef STEP8
#undef MSEG8
#undef ACC_INIT8
#undef CIN_SET8
  VREAD8A(sv * SLOT); VREAD8B(sv * SLOT); PV8();
  SBAR(); asm volatile("s_nop 15\n\ts_nop 15\n\ts_nop 15\n\ts_nop 15\n\ts_nop 15\n\ts_nop 15" ::: "memory"); SBAR();
  if (!half) BARL8();
  float rli[16];
  { if ((lane & 15) < 2) *(f32x4*)(al_l + (lane & 15) * 16 + 4 * (lane >> 4)) = (f32x4){osum[0], osum[1], osum[2], osum[3]};
    asm volatile("s_waitcnt lgkmcnt(0)" ::: "memory");
#pragma unroll
    for (int g = 0; g < 4; ++g) { const f32x4 a4 = *(const f32x4*)(al_l + 8 * g + 4 * hi);
#pragma unroll
      for (int i = 0; i < 4; ++i) rli[4 * g + i] = __builtin_amdgcn_rcpf(a4[i]); } }
  unsigned char* Ow = Ob + (long)(wid * QBLK) * LDO;
  if constexpr (!DIFF) {
#pragma unroll
    for (int r = 0; r < 16; ++r) { int orow = crow(r, hi);
#pragma unroll
      for (int d0 = 0; d0 < 4; ++d0) { const float v_ = o[d0][r] * (rli[r] * OS_GQA); Ow[(long)orow * LDO + d0 * 32 + r32] = (unsigned char)__builtin_amdgcn_cvt_pk_fp8_f32(v_, v_, 0, false); } }
  } else {
    char* stash = lds + RD * SLOT + 2048 + wid * 8192 + lane * 16;
    if (dmode == 0) {
#pragma unroll
      for (int q = 0; q < 8; ++q) { const int d0 = q >> 1, r0 = (q & 1) * 8; i32x4 w;
#pragma unroll
        for (int i = 0; i < 4; ++i) w[i] = (int)att::cvtpk(o[d0][r0 + 2 * i] * rli[r0 + 2 * i], o[d0][r0 + 2 * i + 1] * rli[r0 + 2 * i + 1]);
        *(i32x4*)(stash + q * 1024) = w; }
    } else {
      float ss[16];
#pragma unroll
      for (int r = 0; r < 16; ++r) ss[r] = 0.f;
#pragma unroll
      for (int q = 0; q < 8; ++q) { const int d0 = q >> 1, r0 = (q & 1) * 8; const i32x4 w = *(const i32x4*)(stash + q * 1024);
#pragma unroll
        for (int i = 0; i < 4; ++i) { const int r = r0 + 2 * i;
          const float a = bflo((unsigned)w[i]) - lam * (o[d0][r] * rli[r]), b = bfhi((unsigned)w[i]) - lam * (o[d0][r + 1] * rli[r + 1]);
          o[d0][r] = a; o[d0][r + 1] = b; ss[r] += a * a; ss[r + 1] += b * b; } }
      float sg[4];
#pragma unroll
      for (int d0 = 0; d0 < 4; ++d0) sg[d0] = subg[d0 * 32 + r32] * ((1.f - LAM_INIT) * OS_DIFF);
#pragma unroll
      for (int r = 0; r < 16; ++r) { float s = ss[r];
#pragma unroll
        for (int x = 1; x < 32; x <<= 1) s += __shfl_xor(s, x);
        const float rs = rsqrtf(s * (1.f / 128.f) + RMS_EPS); const int orow = crow(r, hi);
#pragma unroll
        for (int d0 = 0; d0 < 4; ++d0) { const float v_ = o[d0][r] * rs * sg[d0]; Ow[(long)orow * LDO + d0 * 32 + r32] = (unsigned char)__builtin_amdgcn_cvt_pk_fp8_f32(v_, v_, 0, false); } }
    }
  }
  BARL8();
#undef GLDS16
#undef SDMA8
#undef VMWAIT8
#undef BARL8
#undef LWAIT8
#undef LWAIT8_
#undef RESC8
#undef MFMA8
#undef MFMA8Q
#undef MFMA16S
#undef KREAD8
#undef VREAD8A
#undef VREAD8B
#undef KREAD8C
#undef VREAD8AC
#undef VREAD8BC
#undef QK8
#undef PV8
}
#undef SBAR
}
#define XB_TMO      128
#define XB_XCNT(j)  (256  + 64 * (j))
#define XB_XSUB(j)  (1280 + 64 * (j))
#define XB_XGEN(j)  (2304 + 64 * (j))
#define XB_TOP      3328
#define XB_TOPGEN   3392
#define XCD_BAR_WORDS 3456
#define XB_SPIN_CAP (1u << 18)

__device__ __forceinline__ unsigned xb_ld(unsigned* p)              { return __hip_atomic_load(p, __ATOMIC_RELAXED, __HIP_MEMORY_SCOPE_AGENT); }
__device__ __forceinline__ unsigned xb_add(unsigned* p, unsigned v) { return __hip_atomic_fetch_add(p, v, __ATOMIC_RELAXED, __HIP_MEMORY_SCOPE_AGENT); }
__device__ __forceinline__ unsigned xb_xcc_id() { return (unsigned)__builtin_amdgcn_s_getreg((3 << 11) | 20) & 0xFu; }
#define XB_SPIN(cond, bar) do { unsigned _sp = 0; while (cond) { __builtin_amdgcn_s_sleep(1); \
    if ((++_sp & 255u) == 0u) { if (xb_ld(&(bar)[XB_TMO])) break; if (_sp > XB_SPIN_CAP) { atomicAdd(&(bar)[XB_TMO], 1u); break; } } } } while (0)

struct XcdBarrier {
    unsigned* bar; unsigned x;
    volatile LAS unsigned* st;
};

__device__ __forceinline__ XcdBarrier xcd_barrier_post(unsigned* bar, volatile LAS unsigned* st) {
    XcdBarrier b; b.bar = bar; b.x = xb_xcc_id(); b.st = st;
    if (threadIdx.x == 0) (void)xb_add(&bar[XB_XCNT(b.x)], 1u);
    return b;
}
__device__ __forceinline__ void xcd_barrier_complete(unsigned* bar, unsigned x, unsigned& nloc, unsigned& nx) {
    const unsigned G = gridDim.x * gridDim.y * gridDim.z;
    unsigned sum, cnt, mine, sp = 0u;
    for (;;) {
        sum = 0u; cnt = 0u; mine = 0u;
#pragma unroll
        for (unsigned j = 0; j < 16; ++j) { const unsigned c = xb_ld(&bar[XB_XCNT(j)]); sum += c; cnt += (c > 0u) ? 1u : 0u; mine = (j == x) ? c : mine; }
        if (sum == G) break;
        __builtin_amdgcn_s_sleep(1);
        if ((++sp & 255u) == 0u) { if (xb_ld(&bar[XB_TMO])) break; if (sp > XB_SPIN_CAP) { atomicAdd(&bar[XB_TMO], 1u); break; } }
    }
    nloc = mine > 0u ? mine : 1u; nx = cnt > 0u ? cnt : 1u;
}

__device__ __forceinline__ void xcd_barrier(const XcdBarrier& b) {
    asm volatile("s_waitcnt vmcnt(0)" ::: "memory");
    __syncthreads();
    if (threadIdx.x == 0) {
        unsigned* bar = b.bar;
        __builtin_amdgcn_s_waitcnt(0);
        unsigned nloc = b.st[0], nx = b.st[1];
        if (nloc == 0u) { xcd_barrier_complete(bar, b.x, nloc, nx); b.st[0] = nloc; b.st[1] = nx; }
        const unsigned old = xb_add(&bar[XB_XSUB(b.x)], 1u);
        const unsigned gen = old / nloc;
        if (old + 1u == (gen + 1u) * nloc) {
            __builtin_amdgcn_fence(__ATOMIC_RELEASE, "agent");
            asm volatile("s_waitcnt vmcnt(0)" ::: "memory");
            const unsigned og = xb_add(&bar[XB_TOP], 1u);
            const unsigned tg = og / nx;
            if (og + 1u == (tg + 1u) * nx) xb_add(&bar[XB_TOPGEN], 1u);
            else XB_SPIN(xb_ld(&bar[XB_TOPGEN]) == tg, bar);
            __builtin_amdgcn_fence(__ATOMIC_ACQUIRE, "agent");
            xb_add(&bar[XB_XGEN(b.x)], 1u);
            asm volatile("s_waitcnt vmcnt(0)" ::: "memory");
        } else {
            XB_SPIN(xb_ld(&bar[XB_XGEN(b.x)]) == gen, bar);
            __builtin_amdgcn_fence(__ATOMIC_ACQUIRE, "agent");
            asm volatile("s_waitcnt vmcnt(0)" ::: "memory");
        }
    }
    __syncthreads();
}

constexpr int NWAVES = 8;
constexpr int N_PHASES = 36;
#ifndef MK_STOP
#define MK_STOP N_PHASES
#endif
#ifndef ATT_SDEPTH
#define ATT_SDEPTH 1
#endif
#ifndef G1_PROBE
#define G1_PROBE 0
#endif
#ifndef ATT_PROBE
#define ATT_PROBE 0
#endif
#ifndef REP_MASK
#define REP_MASK 0
#endif
constexpr size_t WS_JUNK = WS_END - WS_GATE;
constexpr float W8_SCALE = 32.f;
constexpr float QSCALE128 = 8.f * 0.088388347648318440f * 1.4426950408889634f, QSCALE64 = 8.f * 0.125f * 1.4426950408889634f;
#ifndef SM_MASK
#define SM_MASK 127
#endif
#ifndef PRO_PARTS
#define PRO_PARTS 15
#endif
#ifndef MK_MULTI
#define MK_MULTI 0
#endif

struct Args { const float* in[N_IN]; float* out; unsigned char* ws; int ph_lo, ph_hi, dump, pad; };
static_assert(sizeof(Args) == N_IN * 8 + 8 + 8 + 16, "Args has no padding");
typedef const __attribute__((address_space(4))) Args* KArgs;
struct Frame {
    LAS unsigned char* lds;
    char* ldsg;
    int tid, lane, wave, vcu, G, gw, NGW;
    KArgs kp;
    __device__ __forceinline__ const float* in(int i) const { return kp->in[i]; }
    __device__ __forceinline__ float* out() const { return kp->out; }
    __device__ __forceinline__ unsigned char* ws() const { return kp->ws; }
    __device__ __forceinline__ unsigned* ctl() const { return (unsigned*)(kp->ws + WS_CTL); }
};
__device__ __forceinline__ bool refresh(Frame& F) { int t = threadIdx.x; asm volatile("" : "+v"(t)); F.tid = t; F.lane = t & 63; KArgs k = (KArgs)__builtin_amdgcn_kernarg_segment_ptr(); asm volatile("" : "+s"(k)); F.kp = k; return true; }
__device__ __forceinline__ const float* input_row(const Frame& F, int row) {
    const int b = row >= SB ? 1 : 0, w = row - b * SB;
    return (w < NCTX) ? F.in(I_CTX) + ((size_t)(b * NCTX + w)) * D : F.in(I_X) + ((size_t)(b * SEQ + (w - NCTX))) * D;
}
__device__ __forceinline__ int stream_of(int row) { const int b = row >= SB ? 1 : 0, w = row - b * SB; return (w < NCTX) ? 2 : b; }
__device__ __forceinline__ const float* modp(const Frame& F, int layer, int s, int chunk) { return (const float*)(F.ws() + WS_MOD) + ((size_t)(layer * 3 + s) * 6 + chunk) * D; }
__device__ __forceinline__ const float* normg(const Frame& F, int layer, int k) { return F.in(I_NORMG) + (size_t)(layer * 4 + k) * D; }

__device__ __forceinline__ void ld_row_f32(const float* p, int lane, f32x4 (&v)[4]) {
#pragma unroll
    for (int j = 0; j < 4; ++j) v[j] = *(const f32x4*)(p + 256 * j + 4 * lane);
}
__device__ __forceinline__ void st_row_f32(float* p, int lane, const f32x4 (&v)[4]) {
#pragma unroll
    for (int j = 0; j < 4; ++j) *(f32x4*)(p + 256 * j + 4 * lane) = v[j];
}
__device__ __forceinline__ void ld_row_bf16(const bf16_t* p, int lane, f32x4 (&v)[4]) {
#pragma unroll
    for (int j = 0; j < 4; ++j) { const u32x2 w = *(const u32x2*)(p + 256 * j + 4 * lane); v[j] = (f32x4){bflo(w.x), bfhi(w.x), bflo(w.y), bfhi(w.y)}; }
}
__device__ __forceinline__ void ld_row_fp8(const unsigned char* p, int lane, f32x4 (&v)[4]) {
#pragma unroll
    for (int j = 0; j < 4; ++j) { const int w = *(const int*)(p + 256 * j + 4 * lane);
        v[j] = (f32x4){__builtin_amdgcn_cvt_f32_fp8(w, 0), __builtin_amdgcn_cvt_f32_fp8(w, 1), __builtin_amdgcn_cvt_f32_fp8(w, 2), __builtin_amdgcn_cvt_f32_fp8(w, 3)}; }
}
__device__ __forceinline__ void st_row_bf16(bf16_t* p, int lane, const f32x4 (&v)[4]) {
#pragma unroll
    for (int j = 0; j < 4; ++j) { u32x2 w; w.x = pkbf(v[j].x, v[j].y); w.y = pkbf(v[j].z, v[j].w); *(u32x2*)(p + 256 * j + 4 * lane) = w; }
}
__device__ __forceinline__ float row_ss(const f32x4 (&v)[4]) {
    float s = 0.f;
#pragma unroll
    for (int j = 0; j < 4; ++j) s += (v[j].x * v[j].x + v[j].y * v[j].y) + (v[j].z * v[j].z + v[j].w * v[j].w);
    return wave_sum(s);
}
__device__ __forceinline__ void modnorm(const f32x4 (&v)[4], const float* g, const float* m1, const float* m0, int lane, f32x4 (&h)[4]) {
    const float r = rsqrtf(row_ss(v) * (1.f / D) + RMS_EPS);
#pragma unroll
    for (int j = 0; j < 4; ++j) { const f32x4 gv = *(const f32x4*)(g + 256 * j + 4 * lane), a = *(const f32x4*)(m1 + 256 * j + 4 * lane), b = *(const f32x4*)(m0 + 256 * j + 4 * lane);
        h[j] = (v[j] * r) * gv * (a + 1.f) + b; }
}

__device__ __forceinline__ void tr_item(const float* W, int K, int N, bf16_t* WT, int k0, int n0, int dst_row0, LAS float* scr, int lane, const float* colscale = nullptr) {
    float tmp[32]; const float csv = colscale ? colscale[lane & 31] : 1.f;
#pragma unroll
    for (int i = 0; i < 32; ++i) { const int kk = 2 * i + (lane >> 5); tmp[i] = W[(size_t)(k0 + kk) * N + n0 + (lane & 31)]; }
#pragma unroll
    for (int i = 0; i < 32; ++i) { const int kk = 2 * i + (lane >> 5); scr[kk * 33 + (lane & 31)] = tmp[i] * csv; }
    LDS_WAIT(); asm volatile("" ::: "memory");
    const int c = lane & 7;
#pragma unroll
    for (int j = 0; j < 4; ++j) { const int n = (lane >> 3) + 8 * j; const LAS float* s = scr + (8 * c) * 33 + n;
        u32x4 o; o.x = pkbf(s[0 * 33], s[1 * 33]); o.y = pkbf(s[2 * 33], s[3 * 33]); o.z = pkbf(s[4 * 33], s[5 * 33]); o.w = pkbf(s[6 * 33], s[7 * 33]);
        *(u32x4*)(WT + (size_t)(dst_row0 + n) * K + k0 + 8 * c) = o; }
    LDS_WAIT(); asm volatile("" ::: "memory");
}
__device__ __forceinline__ void tr_item8(const float* W, int K, int N, unsigned char* WT, int k0, int n0, int dst_row0, LAS float* scr, int lane, float wscale) {
    float tmp[32];
#pragma unroll
    for (int i = 0; i < 32; ++i) { const int kk = 2 * i + (lane >> 5); tmp[i] = W[(size_t)(k0 + kk) * N + n0 + (lane & 31)]; }
#pragma unroll
    for (int i = 0; i < 32; ++i) { const int kk = 2 * i + (lane >> 5); scr[kk * 33 + (lane & 31)] = tmp[i] * wscale; }
    LDS_WAIT(); asm volatile("" ::: "memory");
    const int c = lane & 7;
#pragma unroll
    for (int j = 0; j < 4; ++j) { const int n = (lane >> 3) + 8 * j; const LAS float* s = scr + (8 * c) * 33 + n;
        int w0 = 0, w1 = 0; w0 = __builtin_amdgcn_cvt_pk_fp8_f32(s[0 * 33], s[1 * 33], w0, false); w0 = __builtin_amdgcn_cvt_pk_fp8_f32(s[2 * 33], s[3 * 33], w0, true);
        w1 = __builtin_amdgcn_cvt_pk_fp8_f32(s[4 * 33], s[5 * 33], w1, false); w1 = __builtin_amdgcn_cvt_pk_fp8_f32(s[6 * 33], s[7 * 33], w1, true);
        *(u32x2*)(WT + (size_t)(dst_row0 + n) * K + k0 + 8 * c) = (u32x2){(unsigned)w0, (unsigned)w1}; }
    LDS_WAIT(); asm volatile("" ::: "memory");
}
__device__ __forceinline__ void tr_plain(const float* W, int K, int N, bf16_t* WT, int row_off, LAS float* scr, int item, int lane, const float* colscale = nullptr) {
    const int nblk = N / 32, kb = item / nblk, nb = item - kb * nblk;
    tr_item(W, K, N, WT, 64 * kb, 32 * nb, row_off + 32 * nb, scr, lane, colscale ? colscale + 32 * nb : nullptr);
}
__device__ __forceinline__ void tr_plain8(const float* W, int K, int N, unsigned char* WT, LAS float* scr, int item, int lane) {
    const int nblk = N / 32, kb = item / nblk, nb = item - kb * nblk;
    tr_item8(W, K, N, WT, 64 * kb, 32 * nb, 32 * nb, scr, lane, W8_SCALE);
}
__device__ __forceinline__ void p0_prologue(Frame& F) {
    {
        LAS float* sv = (LAS float*)(F.lds);
        LAS float* red = (LAS float*)(F.lds + 16384);
        if ((PRO_PARTS & 1) && F.vcu < 192) {
            for (int i = F.tid; i < 3 * D; i += 512) { const int s = i >> 10, k = i & 1023; const float c = (s < 2) ? F.in(I_C)[s * D + k] : F.in(I_CCTX)[k]; sv[i] = c / (1.f + __expf(-c)); }
            __syncthreads();
            for (int task = F.vcu; task < 192; task += F.G) {
                const int layer = task / 48, n0 = (task % 48) * 128;
                const int tx = F.tid & 31, ty = F.tid >> 5;
                const float* wp = F.in(I_MODW) + ((size_t)layer * D + ty * 64) * 6144 + n0 + 4 * tx;
                f32x4 a0 = {0, 0, 0, 0}, a1 = a0, a2 = a0;
#pragma unroll 8
                for (int k = 0; k < 64; ++k) { const f32x4 w = *(const f32x4*)(wp + (size_t)k * 6144); const int kk = ty * 64 + k;
                    a0 += w * sv[kk]; a1 += w * sv[D + kk]; a2 += w * sv[2 * D + kk]; }
                *(LAS f32x4*)(red + (ty * 3 + 0) * 128 + 4 * tx) = a0; *(LAS f32x4*)(red + (ty * 3 + 1) * 128 + 4 * tx) = a1; *(LAS f32x4*)(red + (ty * 3 + 2) * 128 + 4 * tx) = a2;
                __syncthreads();
                if (F.tid < 384) { const int s = F.tid >> 7, n = F.tid & 127; float acc = F.in(I_MODB)[layer * 6144 + n0 + n];
#pragma unroll
                    for (int y = 0; y < 16; ++y) acc += red[(y * 3 + s) * 128 + n];
                    ((float*)(F.ws() + WS_MOD))[((size_t)(layer * 3 + s)) * 6144 + n0 + n] = acc; }
                __syncthreads();
            }
        }
        __syncthreads();
    }
    { bf16_t* b1h = (bf16_t*)(F.ws() + WS_B1H); bf16_t* b2h = (bf16_t*)(F.ws() + WS_B2H); const float* b1 = F.in(I_B1); const float* b2 = F.in(I_B2);
      const int gt = F.vcu * (NWAVES * 64) + F.tid, ngt = F.G * NWAVES * 64;
      for (int i = gt; i < 4 * NE * 2048 / 2; i += ngt) ((unsigned*)b1h)[i] = pkbf(b1[2 * i], b1[2 * i + 1]);
      for (int i = gt; i < 4 * NE * 1024 / 2; i += ngt) ((unsigned*)b2h)[i] = pkbf(b2[2 * i], b2[2 * i + 1]); }
    LAS float* scr = (LAS float*)(F.lds + F.wave * 16384);
    if (PRO_PARTS & 2) {
        constexpr int I_POOL = 4 * (256 / 64) * (256 / 32);
        constexpr int I_GQ = 16 * 48, I_SQ = 16 * 32, I_W3 = 16 * 96;
        constexpr int NSMALL = I_POOL + I_GQ + I_SQ + I_W3 + I_SQ + I_W3 + I_SQ;
        for (int it = F.gw; it < NSMALL; it += F.NGW) {
            int r = it;
            if (r < I_POOL) { if (!(SM_MASK & 1)) continue; const int g = r >> 5; tr_plain(F.in(I_POOLW) + (size_t)g * 65536, 256, 256, (bf16_t*)(F.ws() + WS_POOLW), g * 256, scr, r & 31, F.lane, F.in(I_POOLS) + g * 256); continue; } r -= I_POOL;
            if (r < I_GQ) { if (!(SM_MASK & 2)) continue; tr_plain8(F.in(I_GQKV), D, 1536, F.ws() + WS_GQKV, scr, r, F.lane); continue; } r -= I_GQ;
            if (r < I_SQ) { if (!(SM_MASK & 4)) continue; tr_plain8(F.in(I_GO), D, D, F.ws() + WS_GO, scr, r, F.lane); continue; } r -= I_SQ;
            if (r < I_W3) { if (!(SM_MASK & 8)) continue; tr_plain8(F.in(I_CIN), D, 3072, F.ws() + WS_CIN, scr, r, F.lane); continue; } r -= I_W3;
            if (r < I_SQ) { if (!(SM_MASK & 16)) continue; tr_plain8(F.in(I_COUT), D, D, F.ws() + WS_COUT, scr, r, F.lane); continue; } r -= I_SQ;
            if (r < I_W3) { if (!(SM_MASK & 32)) continue; tr_plain8(F.in(I_DQKV), D, 3072, F.ws() + WS_DQKV, scr, r, F.lane); continue; } r -= I_W3;
            if (!(SM_MASK & 64)) continue; tr_plain8(F.in(I_DO), D, D, F.ws() + WS_DO, scr, r, F.lane);
        }
    }
    if (PRO_PARTS & 12) {
        constexpr int NI1 = 128 * 1024, NIT = NI1 + 128 * 512;
        float cur[32], nxt[32];
#define XW_DECODE(it_) const bool w1_ = (it_) < NI1; const int r2_ = w1_ ? (it_) : (it_) - NI1; const int mat_ = w1_ ? (r2_ >> 10) : (r2_ >> 9), rr_ = w1_ ? (r2_ & 1023) : (r2_ & 511), kb_ = w1_ ? (rr_ >> 7) : (rr_ >> 6), n0_ = 16 * (w1_ ? (rr_ & 127) : (rr_ & 63)), N_ = w1_ ? 2048 : 1024; \
        const float* W_ = w1_ ? F.in(I_W1) + (size_t)mat_ * D * 2048 : F.in(I_W2) + (size_t)mat_ * D * D;
#define XW_LOAD(it_, buf) do { XW_DECODE(it_) _Pragma("unroll") for (int i = 0; i < 32; ++i) { const int kk = 4 * i + (F.lane >> 4); buf[i] = W_[(size_t)(128 * kb_ + kk) * N_ + n0_ + (F.lane & 15)]; } } while (0)
        int it = F.gw;
        if (it < NIT) XW_LOAD(it, cur);
        for (; it < NIT; it += F.NGW) {
            const int itn = it + F.NGW;
            if (itn < NIT) XW_LOAD(itn, nxt);
            XW_DECODE(it)
            const int drow = w1_ ? (mat_ * 2048 + ((n0_ & 1023) >> 7) * 256 + (n0_ >> 10) * 128 + (n0_ & 127)) : (mat_ * 1024 + n0_);
            unsigned char* WT = F.ws() + (w1_ ? WS_W1T : WS_W2T);
#pragma unroll
            for (int i = 0; i < 32; ++i) { const int kk = 4 * i + (F.lane >> 4); scr[kk * 17 + (F.lane & 15)] = cur[i] * W8_SCALE; }
            LDS_WAIT(); asm volatile("" ::: "memory");
            { const int n = F.lane >> 2, c = F.lane & 3; const LAS float* s = scr + (32 * c) * 17 + n; unsigned o8[8];
#pragma unroll
              for (int q = 0; q < 8; ++q) { int w0 = 0; w0 = __builtin_amdgcn_cvt_pk_fp8_f32(s[(4 * q) * 17], s[(4 * q + 1) * 17], w0, false); w0 = __builtin_amdgcn_cvt_pk_fp8_f32(s[(4 * q + 2) * 17], s[(4 * q + 3) * 17], w0, true); o8[q] = (unsigned)w0; }
              unsigned char* d = WT + (size_t)(drow + n) * D + 128 * kb_ + 32 * c;
              *(u32x4*)d = (u32x4){o8[0], o8[1], o8[2], o8[3]}; *(u32x4*)(d + 16) = (u32x4){o8[4], o8[5], o8[6], o8[7]}; }
            LDS_WAIT(); asm volatile("" ::: "memory");
#pragma unroll
            for (int i = 0; i < 32; ++i) cur[i] = nxt[i];
        }
#undef XW_DECODE
#undef XW_LOAD
    }
    __syncthreads();
}

template <bool DRY> __device__ __forceinline__ void p_hpass0(Frame& F) {
    bf16_t* H = (bf16_t*)(F.ws() + WS_H + (DRY ? WS_JUNK : 0));
    int cs = -1; f32x4 pg[4], p0v[4];
    for (int rr = F.gw; rr < T; rr += 2 * F.NGW) {
        const int r0 = rr, r1 = min(rr + F.NGW, T - 1);
        f32x4 v0[4], v1[4], h[4]; ld_row_f32(input_row(F, r0), F.lane, v0); ld_row_f32(input_row(F, r1), F.lane, v1);
#define HP_ROW(v_, r_) do { const int s = stream_of(r_); if (s != cs) { cs = s; const float* gn = normg(F, 0, 0); const float* m1n = modp(F, 0, s, 1); const float* m0n = modp(F, 0, s, 0); \
            _Pragma("unroll") for (int j = 0; j < 4; ++j) { const int o = 256 * j + 4 * F.lane; pg[j] = *(const f32x4*)(gn + o) * (*(const f32x4*)(m1n + o) + 1.f); p0v[j] = *(const f32x4*)(m0n + o); } } \
          const float rx = rsqrtf(row_ss(v_) * (1.f / D) + RMS_EPS); _Pragma("unroll") for (int j = 0; j < 4; ++j) h[j] = (v_[j] * rx) * pg[j] + p0v[j]; st_row_bf16(H + (size_t)(r_) * D, F.lane, h); } while (0)
        HP_ROW(v0, r0); HP_ROW(v1, r1);
#undef HP_ROW
    }
}
template <bool DRY> __device__ __forceinline__ void p_poolprep(Frame& F) {
    const bf16_t* H = (const bf16_t*)(F.ws() + WS_H); bf16_t* Dp = (bf16_t*)(F.ws() + WS_O + (DRY ? WS_JUNK : 0));
    for (int row = F.gw; row < T; row += F.NGW) {
        const int b = row >= SB ? 1 : 0, w = row - b * SB;
        const int s0 = (w < NCTX) ? b * SB : b * SB + NCTX, s1 = (w < NCTX) ? b * SB + NCTX : (b + 1) * SB;
#pragma unroll
        for (int j = 0; j < 4; ++j) {
            constexpr int dummy = 0; (void)dummy;
            const int half = 1 << j;
            const int lo = max(row - half, s0), hi = min(row + half, s1);
            u32x2 q[16];
#pragma unroll
            for (int i = 0; i < 2 * half; ++i) { const int rr = row - half + i; const int rc = (rr >= lo && rr < hi) ? rr : row; q[i] = *(const u32x2*)(H + (size_t)rc * D + 256 * j + 4 * F.lane); }
            const u32x2 qs = *(const u32x2*)(H + (size_t)row * D + 256 * j + 4 * F.lane);
            f32x4 acc = {0, 0, 0, 0};
#pragma unroll
            for (int i = 0; i < 2 * half; ++i) { const int rr = row - half + i; const float wgt = (rr >= lo && rr < hi) ? 1.f : 0.f; acc += (f32x4){bflo(q[i].x), bfhi(q[i].x), bflo(q[i].y), bfhi(q[i].y)} * wgt; }
            const f32x4 self = {bflo(qs.x), bfhi(qs.x), bflo(qs.y), bfhi(qs.y)};
            const f32x4 d = acc * (1.f / (float)(hi - lo)) - self;
            u32x2 o; o.x = pkbf(d.x, d.y); o.y = pkbf(d.z, d.w);
            *(u32x2*)(Dp + ((size_t)j * T + row) * 256 + 4 * F.lane) = o;
        }
    }
}

template <int L>
__device__ __forceinline__ void p_moe_a(Frame& F, const bool DRY) {
    const bf16_t* Y = (const bf16_t*)(F.ws() + WS_Y); const bf16_t* X = (const bf16_t*)(F.ws() + WS_X); bf16_t* Xo = (bf16_t*)(F.ws() + WS_X + (DRY ? WS_JUNK : 0)); unsigned char* H8 = F.ws() + WS_H + (DRY ? WS_JUNK : 0);
    float* gate = (float*)(F.ws() + WS_GATE + (DRY ? WS_JUNK : 0)); int* list = (int*)(F.ws() + WS_LIST);
    LAS float* hbuf = (LAS float*)(F.lds);
    LAS float* part = (LAS float*)(F.lds + 65536);
    LAS int* sel = (LAS int*)(F.lds + 83968);
    LAS int* lcnt = (LAS int*)(F.lds + LC_LCNT); LAS int* gbase = (LAS int*)(F.lds + LC_GBASE);
    const float* g1 = normg(F, L, 1); const float* g2 = normg(F, L, 2);
    const float* rw = F.in(I_RW) + (size_t)L * D * NE; const float* rb = F.in(I_RB) + L * NE;
    const int e = F.lane & 31, kh = F.lane >> 5;
    typedef short rbf16x8 __attribute__((ext_vector_type(8)));
    rbf16x8 wh[4][2], wl[4][2];
#pragma unroll
    for (int s = 0; s < 4; ++s)
#pragma unroll
        for (int n = 0; n < 2; ++n) { unsigned hw[4], lw[4];
#pragma unroll
            for (int q = 0; q < 4; ++q) { const int k = 128 * F.wave + 32 * s + 8 * (F.lane >> 4) + 2 * q; const float w0 = rw[(size_t)k * NE + 16 * n + (F.lane & 15)], w1 = rw[(size_t)(k + 1) * NE + 16 * n + (F.lane & 15)];
                hw[q] = pkbf(w0, w1); lw[q] = pkbf(w0 - bflo(hw[q]), w1 - bfhi(hw[q])); }
            const u32x4 hv = {hw[0], hw[1], hw[2], hw[3]}, lv = {lw[0], lw[1], lw[2], lw[3]}; wh[s][n] = __builtin_bit_cast(rbf16x8, hv); wl[s][n] = __builtin_bit_cast(rbf16x8, lv); }
    const float bias = rb[e];
    if (F.tid < 32) lcnt[F.tid] = 0;
    __syncthreads();
    constexpr int NRA = (L == 3) ? NB * SEQ : T;
#define MA_ROW(n_) ((L == 3) ? (((n_) >> 14) * SB + NCTX + ((n_) & (SEQ - 1))) : (n_))
    const int chunk = (NRA + F.G - 1) / F.G, tok0 = min(NRA, (int)blockIdx.x * chunk), tok1 = min(NRA, tok0 + chunk);
    int cs = -1; f32x4 qm[4], qg[4], q0v[4];
    f32x4 y[2][4], x[2][4];
#define MA_LOAD(base_) do { _Pragma("unroll") for (int tt = 0; tt < 2; ++tt) { const int tok_ = (base_) + F.wave * 2 + tt; if (tok_ < tok1) { \
        const int row_ = MA_ROW(tok_); ld_row_bf16(Y + (size_t)row_ * D, F.lane, y[tt]); if constexpr (L == 0) ld_row_f32(input_row(F, row_), F.lane, x[tt]); else ld_row_bf16(X + (size_t)row_ * D, F.lane, x[tt]); } } } while (0)
    MA_LOAD(tok0);
    for (int base = tok0; base < tok1; base += 16) {
#pragma unroll
        for (int tt = 0; tt < 2; ++tt) {
            const int tl = F.wave * 2 + tt, tok = base + tl;
            if (tok < tok1) {
                const int row = MA_ROW(tok), s = stream_of(row);
                f32x4 h[4];
                if (s != cs) { cs = s; const float* m2 = modp(F, L, s, 2); const float* m4 = modp(F, L, s, 4); const float* m3 = modp(F, L, s, 3);
#pragma unroll
                    for (int j = 0; j < 4; ++j) { const int o = 256 * j + 4 * F.lane; qm[j] = *(const f32x4*)(m2 + o) * *(const f32x4*)(g1 + o); qg[j] = *(const f32x4*)(g2 + o) * (*(const f32x4*)(m4 + o) + 1.f); q0v[j] = *(const f32x4*)(m3 + o); } }
                const float ry = rsqrtf(row_ss(y[tt]) * (1.f / D) + RMS_EPS);
#pragma unroll
                for (int j = 0; j < 4; ++j) x[tt][j] = x[tt][j] + qm[j] * (y[tt][j] * ry);
                st_row_bf16(Xo + (size_t)row * D, F.lane, x[tt]);
                { const float rx = rsqrtf(row_ss(x[tt]) * (1.f / D) + RMS_EPS);
#pragma unroll
                  for (int j = 0; j < 4; ++j) h[j] = (x[tt][j] * rx) * qg[j] + q0v[j]; }
#pragma unroll
                for (int j = 0; j < 4; ++j) { int w = 0; w = __builtin_amdgcn_cvt_pk_fp8_f32(h[j].x, h[j].y, w, false); w = __builtin_amdgcn_cvt_pk_fp8_f32(h[j].z, h[j].w, w, true); *(int*)(H8 + (size_t)row * D + 256 * j + 4 * F.lane) = w; }
#pragma unroll
                for (int j = 0; j < 4; ++j) *(LAS f32x4*)(hbuf + tl * D + 256 * j + 4 * F.lane) = h[j];
            }
        }
        __syncthreads();
        if (base + 16 < tok1) MA_LOAD(base + 16);
        {
            f32x4 lg0 = {0.f, 0.f, 0.f, 0.f}, lg1 = {0.f, 0.f, 0.f, 0.f};
#pragma unroll
            for (int s = 0; s < 4; ++s) {
                const LAS float* hp = hbuf + (F.lane & 15) * D + 128 * F.wave + 32 * s + 8 * (F.lane >> 4);
                const f32x4 x0 = *(const LAS f32x4*)hp, x1 = *(const LAS f32x4*)(hp + 4);
                const unsigned h0 = pkbf(x0.x, x0.y), h1 = pkbf(x0.z, x0.w), h2 = pkbf(x1.x, x1.y), h3 = pkbf(x1.z, x1.w);
                const unsigned l0 = pkbf(x0.x - bflo(h0), x0.y - bfhi(h0)), l1 = pkbf(x0.z - bflo(h1), x0.w - bfhi(h1)), l2 = pkbf(x1.x - bflo(h2), x1.y - bfhi(h2)), l3 = pkbf(x1.z - bflo(h3), x1.w - bfhi(h3));
                const u32x4 hv = {h0, h1, h2, h3}, lv = {l0, l1, l2, l3};
                const rbf16x8 ah = __builtin_bit_cast(rbf16x8, hv), al = __builtin_bit_cast(rbf16x8, lv);
                lg0 = __builtin_amdgcn_mfma_f32_16x16x32_bf16(ah, wh[s][0], lg0, 0, 0, 0); lg1 = __builtin_amdgcn_mfma_f32_16x16x32_bf16(ah, wh[s][1], lg1, 0, 0, 0);
                lg0 = __builtin_amdgcn_mfma_f32_16x16x32_bf16(ah, wl[s][0], lg0, 0, 0, 0); lg1 = __builtin_amdgcn_mfma_f32_16x16x32_bf16(ah, wl[s][1], lg1, 0, 0, 0);
                lg0 = __builtin_amdgcn_mfma_f32_16x16x32_bf16(al, wh[s][0], lg0, 0, 0, 0); lg1 = __builtin_amdgcn_mfma_f32_16x16x32_bf16(al, wh[s][1], lg1, 0, 0, 0);
            }
#pragma unroll
            for (int r = 0; r < 4; ++r) { const int tl = 4 * (F.lane >> 4) + r; part[(F.wave * 16 + tl) * 32 + (F.lane & 15)] = lg0[r]; part[(F.wave * 16 + tl) * 32 + 16 + (F.lane & 15)] = lg1[r]; }
        }
        __syncthreads();
        {
            const int tl = F.wave * 2 + kh, tok = base + tl;
            float v = bias;
#pragma unroll
            for (int w = 0; w < 8; ++w) v += part[(w * 16 + tl) * 32 + e];
            float tv[4]; int ti[4];
#pragma unroll
            for (int k = 0; k < 4; ++k) {
                float cv = v; int ci = e;
#pragma unroll
                for (int o = 1; o < 32; o <<= 1) { const float ov = __shfl_xor(cv, o); const int oi = __shfl_xor(ci, o); if (ov > cv || (ov == cv && oi < ci)) { cv = ov; ci = oi; } }
                tv[k] = cv; ti[k] = ci; if (e == ci) v = -3.0e38f;
            }
            if (tok < tok1) {
                const float e1 = __expf(tv[1] - tv[0]), e2 = __expf(tv[2] - tv[0]), e3 = __expf(tv[3] - tv[0]); const float inv = 1.f / (1.f + e1 + e2 + e3);
                if (e == 0) *(f32x4*)(gate + (size_t)MA_ROW(tok) * 4) = (f32x4){inv, e1 * inv, e2 * inv, e3 * inv};
                if (!DRY && e < 4) { const int ex = (e == 0) ? ti[0] : (e == 1) ? ti[1] : (e == 2) ? ti[2] : ti[3];
                    const int rank = __hip_atomic_fetch_add(lcnt + ex, 1, __ATOMIC_RELAXED, __HIP_MEMORY_SCOPE_WORKGROUP); sel[(tok - tok0) * 4 + e] = ex | (rank << 8); }
            }
        }
    }
#undef MA_LOAD
    __syncthreads();
    if (DRY) return;
    if (F.tid < 32) gbase[F.tid] = (int)__hip_atomic_fetch_add(F.ctl() + CW_CNT + L * 32 + F.tid, (unsigned)lcnt[F.tid], __ATOMIC_RELAXED, __HIP_MEMORY_SCOPE_AGENT);
    __syncthreads();
    for (int i = F.tid; i < (tok1 - tok0) * 4; i += 512) { const int v = sel[i], ee = v & 255, rank = v >> 8; list[(size_t)ee * T + gbase[ee] + rank] = MA_ROW(tok0 + (i >> 2)) * 4 + (i & 3); }
    __syncthreads();
#undef MA_ROW
}
template <int L>
__device__ __forceinline__ int moe_setup(Frame& F) {
    LAS int* cnt = (LAS int*)(F.lds + LC_CNT); LAS int* tbase = (LAS int*)(F.lds + LC_TBASE); LAS int* tile_e = (LAS int*)(F.lds + LC_TILEE);
    __syncthreads();
    if (F.tid < 64) {
        const int c = (F.lane < 32) ? (int)__hip_atomic_load(F.ctl() + CW_CNT + L * 32 + F.lane, __ATOMIC_RELAXED, __HIP_MEMORY_SCOPE_AGENT) : 0;
        const int nt = (c + 255) >> 8;
        int incl = nt;
#pragma unroll
        for (int o = 1; o < 32; o <<= 1) { const int t = __shfl_up(incl, o); if (F.lane >= o) incl += t; }
        const int excl = incl - nt;
        if (F.lane < 32) { cnt[F.lane] = c; tbase[F.lane] = excl; for (int t = 0; t < nt; ++t) tile_e[excl + t] = F.lane; }
        if (F.lane == 31) tbase[32] = incl;
    }
    __syncthreads();
    return tbase[32];
}
template <int L, bool DRY>
__device__ __forceinline__ void p_moe_b(Frame& F) {
    const unsigned char* SLOT = F.ws() + WS_SLOT; const bf16_t* X = (const bf16_t*)(F.ws() + WS_X); bf16_t* Xo = (bf16_t*)(F.ws() + WS_X + (DRY ? WS_JUNK : 0)); unsigned char* H8 = F.ws() + WS_H + (DRY ? WS_JUNK : 0); const float* gate = (const float*)(F.ws() + WS_GATE);
    const float* g3 = normg(F, L, 3);
    constexpr int NR = (L == 3) ? NB * SEQ : T;
    int sl[4][4], sn[4][4]; f32x4 xc[4], xn[4], gc, gn;
#define MB_ROW(n_) ((L == 3) ? (((n_) >> 14) * SB + NCTX + ((n_) & (SEQ - 1))) : (n_))
#define MB_LOAD(n_, S_, X_, G_) do { const int r_ = MB_ROW(n_); G_ = *(const f32x4*)(gate + (size_t)r_ * 4); \
        _Pragma("unroll") for (int k = 0; k < 4; ++k) _Pragma("unroll") for (int j = 0; j < 4; ++j) S_[k][j] = *(const int*)(SLOT + ((size_t)r_ * 4 + k) * D + 256 * j + 4 * F.lane); \
        ld_row_bf16(X + (size_t)r_ * D, F.lane, X_); } while (0)
    int cs = -1; f32x4 pm[4], pg[4], p0v[4];
    int n = F.gw;
    if (n < NR) MB_LOAD(n, sl, xc, gc);
    for (; n < NR; n += F.NGW) {
        const int nn = n + F.NGW;
        if (nn < NR) MB_LOAD(nn, sn, xn, gn);
        const int row = MB_ROW(n), b = row >= SB ? 1 : 0, w = row - b * SB, s = (w < NCTX) ? 2 : b;
        f32x4 y[4], x[4];
#pragma unroll
        for (int j = 0; j < 4; ++j) { y[j] = (f32x4){0, 0, 0, 0}; x[j] = xc[j];
#pragma unroll
            for (int k = 0; k < 4; ++k) { const int q = sl[k][j]; y[j] += (f32x4){__builtin_amdgcn_cvt_f32_fp8(q, 0), __builtin_amdgcn_cvt_f32_fp8(q, 1), __builtin_amdgcn_cvt_f32_fp8(q, 2), __builtin_amdgcn_cvt_f32_fp8(q, 3)} * gc[k]; } }
        if (s != cs) { cs = s; constexpr int LN_ = (L < 3) ? L + 1 : 3; const float* m5 = modp(F, L, s, 5); const float* gn = normg(F, LN_, 0); const float* m1n = modp(F, LN_, s, 1); const float* m0n = modp(F, LN_, s, 0);
#pragma unroll
            for (int j = 0; j < 4; ++j) { const int o = 256 * j + 4 * F.lane; pm[j] = *(const f32x4*)(m5 + o) * *(const f32x4*)(g3 + o); pg[j] = *(const f32x4*)(gn + o) * (*(const f32x4*)(m1n + o) + 1.f); p0v[j] = *(const f32x4*)(m0n + o); } }
        const float ry = rsqrtf(row_ss(y) * (1.f / D) + RMS_EPS);
#pragma unroll
        for (int j = 0; j < 4; ++j) x[j] = x[j] + pm[j] * (y[j] * ry);
        if (L == 3) { st_row_f32((DRY ? (float*)Xo : F.out()) + ((size_t)(b * SEQ + (w - NCTX))) * D, F.lane, x); }
        else {
            st_row_bf16(Xo + (size_t)row * D, F.lane, x);
            f32x4 h[4]; const float rx = rsqrtf(row_ss(x) * (1.f / D) + RMS_EPS);
#pragma unroll
            for (int j = 0; j < 4; ++j) h[j] = (x[j] * rx) * pg[j] + p0v[j];
#pragma unroll
            for (int j = 0; j < 4; ++j) { int w8 = 0; w8 = __builtin_amdgcn_cvt_pk_fp8_f32(h[j].x, h[j].y, w8, false); w8 = __builtin_amdgcn_cvt_pk_fp8_f32(h[j].z, h[j].w, w8, true); *(int*)(H8 + (size_t)row * D + 256 * j + 4 * F.lane) = w8; }
        }
#pragma unroll
        for (int k = 0; k < 4; ++k)
#pragma unroll
            for (int j = 0; j < 4; ++j) sl[k][j] = sn[k][j];
#pragma unroll
        for (int j = 0; j < 4; ++j) xc[j] = xn[j];
        gc = gn;
    }
#undef MB_ROW
#undef MB_LOAD
}
template <int LDG, int VCOL0, int NH>
__device__ __forceinline__ void vt_prep(Frame& F, const bf16_t* G, unsigned char* VT8) {
    LAS unsigned char* scr = F.lds + F.wave * 4096;
    constexpr int NTI = SB / 64;
    const int dvl = F.lane >> 1, hf = F.lane & 1;
    for (int it = F.gw; it < NB * NH * NTI; it += F.NGW) {
        const int tile = it % NTI, bh = it / NTI, b = bh / NH, hd = bh - b * NH;
        const bf16_t* src = G + (size_t)(b * SB + tile * 64 + F.lane) * LDG + VCOL0 + hd * 128;
        unsigned char* dst = VT8 + (size_t)(bh * 128) * SB + tile * 64 + hf * 32;
#pragma unroll 1
        for (int c = 0; c < 4; ++c) {
            u32x4 a[4];
#pragma unroll
            for (int i = 0; i < 4; ++i) a[i] = *(const u32x4*)(src + c * 32 + i * 8);
#pragma unroll
            for (int i = 0; i < 4; ++i) {
                int w0 = 0, w1 = 0;
                w0 = __builtin_amdgcn_cvt_pk_fp8_f32(bflo(a[i].x), bfhi(a[i].x), w0, false); w0 = __builtin_amdgcn_cvt_pk_fp8_f32(bflo(a[i].y), bfhi(a[i].y), w0, true);
                w1 = __builtin_amdgcn_cvt_pk_fp8_f32(bflo(a[i].z), bfhi(a[i].z), w1, false); w1 = __builtin_amdgcn_cvt_pk_fp8_f32(bflo(a[i].w), bfhi(a[i].w), w1, true);
                *(LAS int*)(scr + F.lane * 36 + 8 * i) = w0; *(LAS int*)(scr + F.lane * 36 + 8 * i + 4) = w1;
            }
            LDS_WAIT(); asm volatile("" ::: "memory");
            unsigned o8[8];
#pragma unroll
            for (int q = 0; q < 8; ++q) { const int kb = 32 * (q >> 2) + 8 * (q & 3) + 4 * hf; const LAS unsigned char* p = scr + kb * 36 + dvl;
                o8[q] = (unsigned)p[0] | ((unsigned)p[36] << 8) | ((unsigned)p[72] << 16) | ((unsigned)p[108] << 24); }
            unsigned char* d = dst + (size_t)(c * 32 + dvl) * SB;
            *(u32x4*)d = (u32x4){o8[0], o8[1], o8[2], o8[3]}; *(u32x4*)(d + 16) = (u32x4){o8[4], o8[5], o8[6], o8[7]};
            LDS_WAIT(); asm volatile("" ::: "memory");
        }
    }
}
template <bool DRY> __device__ __forceinline__ void p_gqa_prep(Frame& F) {
    const bf16_t* G = (const bf16_t*)(F.ws() + WS_G); unsigned char* Q8 = F.ws() + WS_Q8; unsigned char* K8 = F.ws() + WS_K8; const float* qg = F.in(I_GQG); const float* kg = F.in(I_GKG);
    const int hi = F.lane >> 5, jl = (F.lane & 31) * 2, c0 = hi * 64 + jl;
    const float f0 = __builtin_amdgcn_exp2f(-(float)(jl & 31) * (LOG2_THETA / 32.f)), f1 = __builtin_amdgcn_exp2f(-(float)((jl + 1) & 31) * (LOG2_THETA / 32.f));
    const float qg0 = qg[c0], qg1 = qg[c0 + 1], kg0 = kg[c0], kg1 = kg[c0 + 1];
    for (int rr = F.gw; rr < T; rr += 2 * F.NGW) {
        unsigned qw[2][10];
#pragma unroll
        for (int u = 0; u < 2; ++u) { const int row = min(rr + u * F.NGW, T - 1); const bf16_t* gr = G + (size_t)row * 1536 + c0;
#pragma unroll
            for (int h = 0; h < 10; ++h) qw[u][h] = *(const unsigned*)(gr + h * 128); }
#pragma unroll
        for (int u = 0; u < 2; ++u) {
            const int row = min(rr + u * F.NGW, T - 1);
            const int b = row >= SB ? 1 : 0, w = row - b * SB; const bool lat = w >= NCTX; const int t = w - NCTX;
            const float pos = lat ? ((jl < 32) ? (float)(t >> 6) : (float)(t & 63)) : 0.f; const float a0 = pos * f0, a1 = pos * f1;
            const float cs0 = __cosf(a0), sn0 = __sinf(a0), cs1 = __cosf(a1), sn1 = __sinf(a1);
#pragma unroll
            for (int h = 0; h < 10; ++h) {
                const unsigned q = qw[u][h];
                const float x0 = bflo(q), x1 = bfhi(q);
                const float r = rsqrtf(wave_sum(x0 * x0 + x1 * x1) * (1.f / 128.f) + RMS_EPS);
                const float n0 = x0 * r * (h < 8 ? qg0 : kg0), n1 = x1 * r * (h < 8 ? qg1 : kg1);
                const float p0 = __shfl_xor(n0, 32), p1 = __shfl_xor(n1, 32);
                const float o0 = hi ? (n0 * cs0 + p0 * sn0) : (n0 * cs0 - p0 * sn0), o1 = hi ? (n1 * cs1 + p1 * sn1) : (n1 * cs1 - p1 * sn1);
                const float qs = (h < 8) ? QSCALE128 : 1.f;
                const unsigned short w8 = (unsigned short)__builtin_amdgcn_cvt_pk_fp8_f32(o0 * qs, o1 * qs, 0, false);
                if (h < 8) *(unsigned short*)(Q8 + (size_t)row * 1024 + h * 128 + c0) = w8; else *(unsigned short*)(K8 + (size_t)row * 256 + (h - 8) * 128 + c0) = w8;
            }
        }
    }
    vt_prep<1536, 1280, 2>(F, G, F.ws() + WS_VT8);
}
template <bool DRY> __device__ __forceinline__ void p_diff_prep(Frame& F) {
    const bf16_t* G = (const bf16_t*)(F.ws() + WS_G); unsigned char* Q8 = F.ws() + WS_Q8; unsigned char* K8 = F.ws() + WS_K8;
    const int l31 = F.lane & 31, j0 = 2 * l31; const bool first = l31 < 16; const int jj = j0 & 31;
    const float f0 = __builtin_amdgcn_exp2f(-(float)(jj & 15) * (LOG2_THETA / 16.f)), f1 = __builtin_amdgcn_exp2f(-(float)((jj + 1) & 15) * (LOG2_THETA / 16.f));
    for (int rr = F.gw; rr < T; rr += 2 * F.NGW) {
        unsigned qw[2][16];
#pragma unroll
        for (int u = 0; u < 2; ++u) { const int row = min(rr + u * F.NGW, T - 1); const bf16_t* gr = G + (size_t)row * 3072 + 2 * F.lane;
#pragma unroll
            for (int ch = 0; ch < 16; ++ch) qw[u][ch] = *(const unsigned*)(gr + ch * 128); }
#pragma unroll
        for (int u = 0; u < 2; ++u) {
            const int row = min(rr + u * F.NGW, T - 1);
            const int b = row >= SB ? 1 : 0, w = row - b * SB; const int t = w - NCTX;
            const float pos = (w >= NCTX) ? ((jj < 16) ? (float)(t >> 6) : (float)(t & 63)) : 0.f; const float a0 = pos * f0, a1 = pos * f1;
            const float cs0 = __cosf(a0), sn0 = __sinf(a0), cs1 = __cosf(a1), sn1 = __sinf(a1);
#pragma unroll
            for (int ch = 0; ch < 16; ++ch) {
                const unsigned q = qw[u][ch];
                const float x0 = bflo(q), x1 = bfhi(q);
                const float p0 = __shfl_xor(x0, 16), p1 = __shfl_xor(x1, 16);
                const float o0 = first ? (x0 * cs0 - p0 * sn0) : (x0 * cs0 + p0 * sn0), o1 = first ? (x1 * cs1 - p1 * sn1) : (x1 * cs1 + p1 * sn1);
                const float qs = (ch < 8) ? QSCALE64 : 1.f;
                const unsigned short w8 = (unsigned short)__builtin_amdgcn_cvt_pk_fp8_f32(o0 * qs, o1 * qs, 0, false);
                if (ch < 8) *(unsigned short*)(Q8 + (size_t)row * 1024 + ch * 128 + 2 * F.lane) = w8; else *(unsigned short*)(K8 + (size_t)row * 1024 + (ch - 8) * 128 + 2 * F.lane) = w8;
            }
        }
    }
    vt_prep<3072, 2048, 8>(F, G, F.ws() + WS_VT8);
}
template <bool DRY> __device__ __forceinline__ void p_conv_prep(Frame& F) {
    const unsigned char* G = F.ws() + WS_G; unsigned char* Z = F.ws() + WS_O + (DRY ? WS_JUNK : 0); const float* wd = F.in(I_CDW);
    for (int rr = F.gw; rr < T; rr += 2 * F.NGW) {
        int qc[2][3][4], qx[2][3][4], qb[2][4]; float wm[2][3];
#pragma unroll
        for (int u = 0; u < 2; ++u) {
            const int row = min(rr + u * F.NGW, T - 1); const int b = row >= SB ? 1 : 0, w = row - b * SB;
            const int s0 = (w < NCTX) ? b * SB : b * SB + NCTX, s1 = (w < NCTX) ? b * SB + NCTX : (b + 1) * SB;
            const bool hasp = row - 1 >= s0, hasn = row + 1 < s1;
            const int rws[3] = {hasp ? row - 1 : row, row, hasn ? row + 1 : row}; wm[u][0] = hasp ? 1.f : 0.f; wm[u][1] = 1.f; wm[u][2] = hasn ? 1.f : 0.f;
#pragma unroll
            for (int j = 0; j < 4; ++j) { const int c = 256 * j + 4 * F.lane; qb[u][j] = *(const int*)(G + (size_t)row * 3072 + c);
#pragma unroll
                for (int d = 0; d < 3; ++d) { const unsigned char* gp = G + (size_t)rws[d] * 3072 + c; qc[u][d][j] = *(const int*)(gp + 1024); qx[u][d][j] = *(const int*)(gp + 2048); } }
        }
#pragma unroll
        for (int u = 0; u < 2; ++u) {
            const int row = min(rr + u * F.NGW, T - 1);
#pragma unroll
            for (int j = 0; j < 4; ++j) { const int c = 256 * j + 4 * F.lane; f32x4 acc = {0, 0, 0, 0};
#pragma unroll
                for (int d = 0; d < 3; ++d) { const int a = qc[u][d][j], x = qx[u][d][j];
                    const f32x4 uu = (f32x4){__builtin_amdgcn_cvt_f32_fp8(a, 0), __builtin_amdgcn_cvt_f32_fp8(a, 1), __builtin_amdgcn_cvt_f32_fp8(a, 2), __builtin_amdgcn_cvt_f32_fp8(a, 3)}
                                   * (f32x4){__builtin_amdgcn_cvt_f32_fp8(x, 0), __builtin_amdgcn_cvt_f32_fp8(x, 1), __builtin_amdgcn_cvt_f32_fp8(x, 2), __builtin_amdgcn_cvt_f32_fp8(x, 3)};
                    acc += uu * (*(const f32x4*)(wd + d * D + c) * wm[u][d]); }
                const int g = qb[u][j]; constexpr float ZS = OS_CONV / (GS_CONV * GS_CONV * GS_CONV);
                const f32x4 z = acc * (f32x4){__builtin_amdgcn_cvt_f32_fp8(g, 0), __builtin_amdgcn_cvt_f32_fp8(g, 1), __builtin_amdgcn_cvt_f32_fp8(g, 2), __builtin_amdgcn_cvt_f32_fp8(g, 3)};
                int w8 = 0; w8 = __builtin_amdgcn_cvt_pk_fp8_f32(z.x * ZS, z.y * ZS, w8, false); w8 = __builtin_amdgcn_cvt_pk_fp8_f32(z.z * ZS, z.w * ZS, w8, true);
                *(int*)(Z + (size_t)row * D + c) = w8; }
        }
    }
}
template <int PV> __device__ __forceinline__ void p_gqa_attn(Frame& F) {
    const unsigned char* Q8 = F.ws() + WS_Q8; const unsigned char* K8 = F.ws() + WS_K8; const unsigned char* VT8 = F.ws() + WS_VT8; unsigned char* O = F.ws() + WS_O + (PV ? WS_JUNK : 0);
    for (int idx = F.vcu; idx < 1024 + 16; idx += F.G) {
        int b, hq, qrow, seq;
        if (idx < 1024) { const int r = idx >> 8, wi = idx & 255; b = r >> 1; hq = (r & 1) * 4 + (wi >> 6); qrow = b * SB + NCTX + (wi & 63) * 256; seq = SB; }
        else { const int j = idx - 1024; b = j >> 3; hq = j & 7; qrow = b * SB; seq = NCTX; }
        const int kvh = hq >> 2;
        att8::attn_body8<128, 1024, 256, 1024, false, (PV > 0 ? PV - 1 : 0)>(Q8 + (size_t)qrow * 1024 + hq * 128, K8 + (size_t)(b * SB) * 256 + kvh * 128, VT8 + (size_t)((b * 2 + kvh) * 128) * SB,
                                                      O + (size_t)qrow * D + hq * 128, seq, F.ldsg, 0, 0.f, nullptr);
    }
}
__device__ __forceinline__ void p_diff_attn(Frame& F) {
    const unsigned char* Q8 = F.ws() + WS_Q8; const unsigned char* K8 = F.ws() + WS_K8; const unsigned char* VT8 = F.ws() + WS_VT8; unsigned char* O = F.ws() + WS_O;
    const float* lv = F.in(I_DLAM);
    const float lam = __expf(wave_sum(lv[F.lane] * lv[64 + F.lane])) - __expf(wave_sum(lv[128 + F.lane] * lv[192 + F.lane])) + LAM_INIT;
    for (int idx = F.vcu; idx < 1024; idx += F.G) {
#pragma unroll 1
        for (int s = 0; s < 2; ++s) {
            int ix = idx; asm volatile("" : "+s"(ix));
            const int r = ix >> 6, b = r >> 3, h = r & 7, qrow = b * SB + NCTX + (ix & 63) * 256;
            att8::attn_body8<64, 1024, 1024, 1024, true>(Q8 + (size_t)qrow * 1024 + h * 128 + s * 64, K8 + (size_t)(b * SB) * 1024 + h * 128 + s * 64, VT8 + (size_t)((b * 8 + h) * 128) * SB,
                                                         O + (size_t)qrow * D + h * 128, SB, F.ldsg, s, lam, F.in(I_DSUB));
        }
    }
}


#define PG8_ALIGN true
#define PG8_SP2 true

template <int L, int P0> __device__ __forceinline__ void moe_layer(Frame& F, const XcdBarrier& bar, int lo, int hi, int rep_mask);

__global__ void __launch_bounds__(NWAVES * 64, 2) mk_fwd(Args args) {
    extern __shared__ __attribute__((aligned(16))) unsigned char lds[];
    Frame F;
    F.lds = (LAS unsigned char*)lds; F.ldsg = (char*)lds;
    F.tid = threadIdx.x; F.lane = F.tid & 63; F.wave = __builtin_amdgcn_readfirstlane(F.tid >> 6);
    F.G = gridDim.x; { const int bx = blockIdx.x; F.vcu = (F.G % 8 == 0) ? (bx % 8) * (F.G / 8) + bx / 8 : bx; }
    F.gw = F.vcu * NWAVES + F.wave; F.NGW = F.G * NWAVES;
    refresh(F);
    for (int u = F.tid; u < (LDS_BYTES - RING_BYTES) / 4; u += NWAVES * 64) ((LAS unsigned*)(F.lds + RING_BYTES))[u] = 0u;
    __syncthreads();
    XcdBarrier bar; bar.bar = F.ctl() + CW_BAR; bar.x = 0; bar.st = nullptr;
    if (!MK_MULTI) bar = xcd_barrier_post(F.ctl() + CW_BAR, (volatile LAS unsigned*)(F.lds + LC_MISC));
    const int lo = args.ph_lo, hi = args.ph_hi; const int rep_mask = args.pad;
#define IN(k) (lo <= (k) && (k) < hi && refresh(F))
#define NREP(bit) (REP_MASK ? 1 + ((rep_mask & (bit)) ? 1 : 0) : 1)
#define PHM(k) asm volatile("; === PHASE %0" :: "i"(k))
#define SEAM(k) do { if (IN(k) && IN((k) + 1)) { xcd_barrier(bar); if constexpr ((REP_MASK & 256) != 0) xcd_barrier(bar); } } while (0)
    bf16_t* const Hb = (bf16_t*)(F.ws() + WS_H); bf16_t* const Gb = (bf16_t*)(F.ws() + WS_G); bf16_t* const Ob = (bf16_t*)(F.ws() + WS_O); bf16_t* const Yb = (bf16_t*)(F.ws() + WS_Y);

    if (IN(0)) { PHM(0); for (int rep = 0; rep < NREP(16); ++rep) p0_prologue(F); } SEAM(0);
    if (IN(1)) { PHM(1); if constexpr ((REP_MASK & 128) != 0) p_hpass0<true>(F); p_hpass0<false>(F); } SEAM(1);
    if (IN(2)) { PHM(2); if constexpr ((REP_MASK & 128) != 0) p_poolprep<true>(F); p_poolprep<false>(F); } SEAM(2);
    if (IN(3)) { PHM(3);
        int kpool = 256; asm volatile("" : "+s"(kpool));
        pg8::Gemm g{Ob, (const bf16_t*)(F.ws() + WS_POOLW), 4 * T, 256, kpool}; pg8::PoolOrder S{F.G, F.vcu};
        pg8::EpiPool E{Yb, D};
        for (int rep = 0; rep < NREP(32); ++rep) pg8::gemm_phase<pg8::EpiPool, pg8::PoolOrder, PG8_ALIGN, PG8_SP2>(F.lds, g, S, E);
    } SEAM(3);
    moe_layer<0, 4>(F, bar, lo, hi, rep_mask);
    if (IN(9)) { PHM(9);
        int kop = D; asm volatile("" : "+s"(kop));
        pg8::Gemm g{Hb, (const bf16_t*)(F.ws() + WS_GQKV), T, 1536, kop}; pg8::StaticOrder S; S.init(T, 1536, F.G, (int)blockIdx.x);
        pg8::EpiScaled E{Gb, 1536, 1.f / W8_SCALE};
        pg8::gemm_phase<pg8::EpiScaled, pg8::StaticOrder, PG8_ALIGN, PG8_SP2, 1>(F.lds, g, S, E);
    } SEAM(9);
    if (IN(10)) { PHM(10); if constexpr ((REP_MASK & 128) != 0) p_gqa_prep<true>(F); p_gqa_prep<false>(F); } SEAM(10);
    if (IN(11)) { PHM(11); if constexpr ((REP_MASK & 1) != 0) { p_gqa_attn<ATT_PROBE + 1>(F); refresh(F); } p_gqa_attn<0>(F); } SEAM(11);
    if (IN(12)) { PHM(12);
        int kop = D; asm volatile("" : "+s"(kop));
        pg8::Gemm g{Ob, (const bf16_t*)(F.ws() + WS_GO), T, D, kop}; pg8::StaticOrder S; S.init(T, D, F.G, (int)blockIdx.x);
        pg8::EpiScaled E{Yb, D, 1.f / (W8_SCALE * OS_GQA)};
        for (int rep = 0; rep < NREP(32); ++rep) pg8::gemm_phase<pg8::EpiScaled, pg8::StaticOrder, PG8_ALIGN, PG8_SP2, 1>(F.lds, g, S, E);
    } SEAM(12);
    moe_layer<1, 13>(F, bar, lo, hi, rep_mask);
    if (IN(18)) { PHM(18);
        int kop = D; asm volatile("" : "+s"(kop));
        pg8::Gemm g{Hb, (const bf16_t*)(F.ws() + WS_CIN), T, 3072, kop}; pg8::StaticOrder S; S.init(T, 3072, F.G, (int)blockIdx.x);
        pg8::EpiRows8 E{F.ws() + WS_G, 3072, GS_CONV / W8_SCALE};
        pg8::gemm_phase<pg8::EpiRows8, pg8::StaticOrder, PG8_ALIGN, PG8_SP2, 1>(F.lds, g, S, E);
    } SEAM(18);
    if (IN(19)) { PHM(19); if constexpr ((REP_MASK & 128) != 0) p_conv_prep<true>(F); p_conv_prep<false>(F); } SEAM(19);
    if (IN(20)) { PHM(20);
        int kop = D; asm volatile("" : "+s"(kop));
        pg8::Gemm g{Ob, (const bf16_t*)(F.ws() + WS_COUT), T, D, kop}; pg8::StaticOrder S; S.init(T, D, F.G, (int)blockIdx.x);
        pg8::EpiScaled E{Yb, D, 1.f / (W8_SCALE * OS_CONV)};
        for (int rep = 0; rep < NREP(32); ++rep) pg8::gemm_phase<pg8::EpiScaled, pg8::StaticOrder, PG8_ALIGN, PG8_SP2, 1>(F.lds, g, S, E);
    } SEAM(20);
    moe_layer<2, 21>(F, bar, lo, hi, rep_mask);
    if (IN(26)) { PHM(26);
        int kop = D; asm volatile("" : "+s"(kop));
        pg8::Gemm g{Hb, (const bf16_t*)(F.ws() + WS_DQKV), T, 3072, kop}; pg8::StaticOrder S; S.init(T, 3072, F.G, (int)blockIdx.x);
        pg8::EpiScaled E{Gb, 3072, 1.f / W8_SCALE};
        pg8::gemm_phase<pg8::EpiScaled, pg8::StaticOrder, PG8_ALIGN, PG8_SP2, 1>(F.lds, g, S, E);
    } SEAM(26);
    if (IN(27)) { PHM(27); if constexpr ((REP_MASK & 128) != 0) p_diff_prep<true>(F); p_diff_prep<false>(F); } SEAM(27);
    if (IN(28)) { PHM(28); for (int rep = 0; rep < NREP(2); ++rep) p_diff_attn(F); } if (IN(28) && IN(30)) xcd_barrier(bar);
    if (IN(30)) { PHM(30);
        int kop = D; asm volatile("" : "+s"(kop));
        pg8::Gemm g{Ob, (const bf16_t*)(F.ws() + WS_DO), T, D, kop}; pg8::LatentOrder S; S.init(D, F.G, (int)blockIdx.x);
        pg8::EpiScaled E{Yb, D, 1.f / (W8_SCALE * OS_DIFF)};
        for (int rep = 0; rep < NREP(32); ++rep) pg8::gemm_phase<pg8::EpiScaled, pg8::LatentOrder, PG8_ALIGN, PG8_SP2, 1>(F.lds, g, S, E);
    } SEAM(30);
    moe_layer<3, 31>(F, bar, lo, hi, rep_mask);
    if (args.dump) {
        if (!MK_MULTI) xcd_barrier(bar);
        const bf16_t* X = (const bf16_t*)(F.ws() + WS_X);
        for (int row = F.gw; row < T; row += F.NGW) { const int b = row >= SB ? 1 : 0, w = row - b * SB; if (w < NCTX) continue;
            f32x4 v[4]; ld_row_bf16(X + (size_t)row * D, F.lane, v); st_row_f32(F.out() + ((size_t)(b * SEQ + (w - NCTX))) * D, F.lane, v); }
    }
}
struct MoeDeal { int base, stride, limit, nun; };
__device__ __forceinline__ MoeDeal moe_deal(const Frame& F, int U) {
    MoeDeal d;
    if (F.G % 8 == 0) { const int per = F.G / 8, x = F.vcu / per, cl = F.vcu - x * per; d.base = (int)(((long)U * x) / 8) + cl; d.stride = per; d.limit = (int)(((long)U * (x + 1)) / 8); }
    else { d.base = F.vcu; d.stride = F.G; d.limit = U; }
    d.nun = (d.base < d.limit) ? (d.limit - d.base + d.stride - 1) / d.stride : 0;
    return d;
}
template <int L, int P0> __device__ __forceinline__ void moe_layer(Frame& F, const XcdBarrier& bar, int lo, int hi, int rep_mask) {
    if (IN(P0)) { PHM(P0); if constexpr ((REP_MASK & 512) != 0) { p_moe_a<L>(F, true); refresh(F); } p_moe_a<L>(F, false); } if (IN(P0) && IN(P0 + 2)) xcd_barrier(bar);
    if (IN(P0 + 2)) { PHM(P0 + 2);
        const int ntiles = moe_setup<L>(F); const MoeDeal dl = moe_deal(F, ntiles * 8);
        int kop = D; asm volatile("" : "+s"(kop));
        { LAS unsigned short* tk = (LAS unsigned short*)(F.lds + LC_TOK16); const LAS int* cnt = (const LAS int*)(F.lds + LC_CNT); const LAS int* tbase = (const LAS int*)(F.lds + LC_TBASE); const LAS int* tile_e = (const LAS int*)(F.lds + LC_TILEE);
          const int* list = (const int*)(F.ws() + WS_LIST); int nun = dl.nun; if (nun > MAXU) nun = MAXU;
          const int nent = nun * 256;
          for (int idx0 = F.tid; idx0 < nent; idx0 += 5 * NWAVES * 64) { int val[5]; bool ok[5];
#pragma unroll
              for (int k = 0; k < 5; ++k) { const int idx = min(idx0 + k * NWAVES * 64, nent - 1), i = idx >> 8, r = idx & 255, pm = (dl.base + i * dl.stride) >> 3, ee = tile_e[pm], pos = (pm - tbase[ee]) * 256 + r, c = cnt[ee];
                  ok[k] = pos < c; val[k] = list[(size_t)ee * T + min(pos, c - 1)]; }
#pragma unroll
              for (int k = 0; k < 5; ++k) { const int idx = idx0 + k * NWAVES * 64; if (idx < nent) tk[idx] = (unsigned short)(ok[k] ? (val[k] >> 2) : 0); } }
          __syncthreads(); }
        pg8::Gemm g{(const bf16_t*)(F.ws() + WS_H), (const bf16_t*)(F.ws() + WS_W1T + (size_t)L * NE * 2048 * D), T, 2048, kop};
        pg8::MoeOrder S{(const LAS int*)(F.lds + LC_TILEE), dl.limit, 8, dl.stride, dl.base};
        pg8::EpiSwiGLU E{F.ws() + WS_ACT, (const bf16_t*)(F.ws() + WS_B1H) + (size_t)L * NE * 2048, 1.f / W8_SCALE};
        if constexpr ((REP_MASK & 4) != 0) { pg8::EpiSwiGLUT<(G1_PROBE & 3)> E2{F.ws() + WS_HS, (const bf16_t*)(F.ws() + WS_B1H) + (size_t)L * NE * 2048, 1.f / W8_SCALE};
            pg8::gemm_phase<pg8::EpiSwiGLUT<(G1_PROBE & 3)>, pg8::MoeOrder, PG8_ALIGN, PG8_SP2, 1, true, (G1_PROBE >> 2)>(F.lds, g, S, E2, (const LAS unsigned short*)(F.lds + LC_TOK16)); }
        pg8::gemm_phase<pg8::EpiSwiGLU, pg8::MoeOrder, PG8_ALIGN, PG8_SP2, 1, true>(F.lds, g, S, E, (const LAS unsigned short*)(F.lds + LC_TOK16));
    } SEAM(P0 + 2);
    if (IN(P0 + 3)) { PHM(P0 + 3);
        const int ntiles = moe_setup<L>(F); const MoeDeal dl = moe_deal(F, ntiles * 4);
        int kop = D; asm volatile("" : "+s"(kop));
        pg8::Gemm g{(const bf16_t*)(F.ws() + WS_ACT), (const bf16_t*)(F.ws() + WS_W2T + (size_t)L * NE * D * D), CROWS, D, kop};
        pg8::MoeOrder S{(const LAS int*)(F.lds + LC_TILEE), dl.limit, 4, dl.stride, dl.base};
        { LAS int* st = (LAS int*)(F.lds + LC_TOK16); const LAS int* cnt = (const LAS int*)(F.lds + LC_CNT); const LAS int* tbase = (const LAS int*)(F.lds + LC_TBASE); const LAS int* tile_e = (const LAS int*)(F.lds + LC_TILEE);
          const int* list = (const int*)(F.ws() + WS_LIST); int nun = dl.nun; if (nun > MAXU / 2) nun = MAXU / 2;
          const int nent = nun * 256;
          for (int idx0 = F.tid; idx0 < nent; idx0 += 5 * NWAVES * 64) { int val[5]; bool ok[5];
#pragma unroll
              for (int k = 0; k < 5; ++k) { const int idx = min(idx0 + k * NWAVES * 64, nent - 1), i = idx >> 8, r = idx & 255, pm = (dl.base + i * dl.stride) >> 2, ee = tile_e[pm], pos = (pm - tbase[ee]) * 256 + r, c = cnt[ee];
                  ok[k] = pos < c; val[k] = list[(size_t)ee * T + min(pos, c - 1)]; }
#pragma unroll
              for (int k = 0; k < 5; ++k) { const int idx = idx0 + k * NWAVES * 64; if (idx < nent) st[idx] = ok[k] ? val[k] : -1; } }
          __syncthreads(); }
        pg8::EpiScatter E{F.ws() + WS_SLOT, (const LAS int*)(F.lds + LC_TOK16), dl.stride, dl.base, (const bf16_t*)(F.ws() + WS_B2H) + (size_t)L * NE * D, 1.f / W8_SCALE, 0, T * 4};
        pg8::gemm_phase<pg8::EpiScatter, pg8::MoeOrder, PG8_ALIGN, PG8_SP2, 1>(F.lds, g, S, E);
        if constexpr ((REP_MASK & 8) != 0) { pg8::EpiScatter E2{F.ws() + WS_HS, (const LAS int*)(F.lds + LC_TOK16), dl.stride, dl.base, (const bf16_t*)(F.ws() + WS_B2H) + (size_t)L * NE * D, 1.f / W8_SCALE, ((REP_MASK & 4096) ? 1 : 0), CROWS};
            pg8::gemm_phase<pg8::EpiScatter, pg8::MoeOrder, PG8_ALIGN, PG8_SP2, 1>(F.lds, g, S, E2); }
    } SEAM(P0 + 3);
    if (IN(P0 + 4)) { PHM(P0 + 4); if constexpr ((REP_MASK & 1024) != 0) p_moe_b<L, true>(F); p_moe_b<L, false>(F); } SEAM(P0 + 4);
}
#undef IN
#undef SEAM

extern "C" void kernel_launch(void* const* d_in, const int* in_sizes, int n_in, void* d_out, int out_size, void* d_ws, size_t ws_size, hipStream_t stream) {
    static int grid = 0;
    if (grid == 0) {
        if (n_in != N_IN || in_sizes[0] != NB * SEQ * D || out_size != NB * SEQ * D || ws_size < WS_END) {
            fprintf(stderr, "kernel_launch: shape mismatch (n_in %d, in0 %d, out %d, ws %zu, need %zu); nothing launched\n", n_in, n_in > 0 ? in_sizes[0] : -1, out_size, ws_size, (size_t)WS_END); grid = -1; return; }
        { const long long exp_sz[N_IN] = {(long long)NB * SEQ * D, NB * D, NB * NCTX * D, D, 4LL * D * 6 * D, 4 * 6 * D, 4 * 4 * D, 4 * 256 * 256, D, D * 1536, D * D, 128, 128, D * 3072, 3 * D, D * D, D * 3072, D * D, 4 * 64, 128,
                                             4 * D * NE, 4 * NE, 4LL * NE * D * 2048, 4 * NE * 2048, 4LL * NE * D * D, 4 * NE * D};
          for (int i = 0; i < N_IN; ++i) if ((long long)in_sizes[i] != exp_sz[i]) { fprintf(stderr, "kernel_launch: input %d has %d elements, expected %lld; nothing launched\n", i, in_sizes[i], exp_sz[i]); grid = -1; return; } }
        int dev = 0, cus = 0, per_cu = 0;
        if (hipGetDevice(&dev) != hipSuccess || hipDeviceGetAttribute(&cus, hipDeviceAttributeMultiprocessorCount, dev) != hipSuccess) { fprintf(stderr, "kernel_launch: device query failed\n"); grid = -1; return; }
        if (hipFuncSetAttribute((const void*)mk_fwd, hipFuncAttributeMaxDynamicSharedMemorySize, LDS_BYTES) != hipSuccess) { fprintf(stderr, "kernel_launch: hipFuncSetAttribute failed\n"); grid = -1; return; }
        if (hipOccupancyMaxActiveBlocksPerMultiprocessor(&per_cu, (const void*)mk_fwd, NWAVES * 64, LDS_BYTES) != hipSuccess || per_cu < 1)
            fprintf(stderr, "kernel_launch: note: occupancy query reports %d workgroups per CU\n", per_cu);
        (void)hipGetLastError();
        grid = cus;
    }
    if (grid < 0) return;
    if (hipMemsetAsync((char*)d_ws + WS_CTL, 0, CTL_ZERO_BYTES, stream) != hipSuccess) { fprintf(stderr, "kernel_launch: memset failed\n"); return; }
    Args a{};
    for (int i = 0; i < N_IN; ++i) a.in[i] = (const float*)d_in[i];
    a.out = (float*)d_out; a.ws = (unsigned char*)d_ws; a.pad = REP_MASK;
    constexpr int STOP = MK_STOP;
#if MK_MULTI
    for (int p = 0; p < STOP; ++p) { a.ph_lo = p; a.ph_hi = p + 1; a.dump = 0; hipLaunchKernelGGL(mk_fwd, dim3(grid), dim3(NWAVES * 64), LDS_BYTES, stream, a); }
    if (STOP < N_PHASES) { a.ph_lo = 0; a.ph_hi = 0; a.dump = 1; hipLaunchKernelGGL(mk_fwd, dim3(grid), dim3(NWAVES * 64), LDS_BYTES, stream, a); }
#else
    a.ph_lo = 0; a.ph_hi = STOP; a.dump = (STOP < N_PHASES) ? 1 : 0;
    hipLaunchKernelGGL(mk_fwd, dim3(grid), dim3(NWAVES * 64), LDS_BYTES, stream, a);
#endif
    const hipError_t le = hipPeekAtLastError();
    if (le != hipSuccess) fprintf(stderr, "kernel_launch: launch failed: %s\n", hipGetErrorName(le));
}
```

```cpp
#include <hip/hip_runtime.h>
#include <cstdio>
#include <cstdint>

#define GAS __attribute__((address_space(1)))
#define LAS __attribute__((address_space(3)))

constexpr int D = 1024, NB = 2, SEQ = 16384, NCTX = 256, SB = SEQ + NCTX  , T = NB * SB  ;
constexpr int NE = 32, TOPK = 4, DFF = 1024;
constexpr int MAXTILES = T * TOPK / 256 + NE;
constexpr int CROWS = MAXTILES * 256;
constexpr float RMS_EPS = 1e-6f;
constexpr float LAM_INIT = 0.55605818f;
constexpr float LOG2_THETA = 13.287712379549449f;
constexpr float INV_2PI = 0.15915494309189535f;
constexpr float GS_CONV = 8.f, GS_DIFF = 8.f;
constexpr float OS_GQA = 32.f, OS_DIFF = 16.f, OS_CONV = 4.f;

enum { I_X = 0, I_C, I_CTX, I_CCTX, I_MODW, I_MODB, I_NORMG, I_POOLW, I_POOLS, I_GQKV, I_GO, I_GQG, I_GKG, I_CIN, I_CDW, I_COUT, I_DQKV, I_DO, I_DLAM, I_DSUB,
       I_RW, I_RB, I_W1, I_B1, I_W2, I_B2, N_IN };

constexpr size_t MiB = 1u << 20;
constexpr size_t WS_CTL = 0, CTL_ZERO_BYTES = 1 * MiB;
constexpr size_t WS_MOD = 1 * MiB;
constexpr size_t WS_POOLW = 2 * MiB;
constexpr size_t WS_GQKV = 3 * MiB;
constexpr size_t WS_GO = 6 * MiB;
constexpr size_t WS_CIN = 8 * MiB;
constexpr size_t WS_COUT = 14 * MiB;
constexpr size_t WS_DQKV = 16 * MiB;
constexpr size_t WS_DO = 22 * MiB;
constexpr size_t WS_GATE = 24 * MiB;
constexpr size_t WS_B1H = 25 * MiB;
constexpr size_t WS_B2H = WS_B1H + 512 * 1024;
constexpr size_t WS_LIST = 26 * MiB;
constexpr size_t WS_W1T = 32 * MiB;
constexpr size_t WS_W2T = WS_W1T + 512 * MiB;
constexpr size_t WS_X = WS_W2T + 256 * MiB;
constexpr size_t WS_H = WS_X + 130 * MiB;
constexpr size_t WS_G = WS_H + 65 * MiB;
constexpr size_t WS_O = WS_G + 195 * MiB;
constexpr size_t WS_OA = WS_O + 65 * MiB;
constexpr size_t WS_OB = WS_OA + 65 * MiB;
constexpr size_t WS_Y = WS_OB + 65 * MiB;
constexpr size_t WS_HS = WS_Y + 65 * MiB;
constexpr size_t WS_ACT = WS_HS + 276 * MiB;
constexpr size_t WS_SLOT = WS_ACT + 276 * MiB;
constexpr size_t WS_Q8 = WS_SLOT + 260 * MiB;
constexpr size_t WS_K8 = WS_Q8 + 33 * MiB;
constexpr size_t WS_VT8 = WS_K8 + 33 * MiB;
constexpr size_t WS_END = WS_VT8 + 33 * MiB;
static_assert(((size_t)T * 4 + 256) * 1024 <= 260 * MiB, "slot junk rows");
static_assert((size_t)T * 1024 <= 33 * MiB && (size_t)NB * 8 * 128 * SB <= 33 * MiB, "ws map fp8");
static_assert((size_t)T * D * 4 <= 130 * MiB && (size_t)T * D * 2 <= 65 * MiB && (size_t)T * 3072 * 2 <= 195 * MiB && (size_t)CROWS * D * 2 <= 276 * MiB && (size_t)T * 4 * D * 2 <= 260 * MiB, "ws map");
static_assert((size_t)NE * T * 4 <= 6 * MiB && (size_t)CROWS * 4 <= 1 * MiB && (size_t)T * 4 * 4 <= 1 * MiB && 4 * 3 * 6144 * 4 <= 1 * MiB, "ws map small");
constexpr int CW_CNT = 64;
constexpr int CW_BAR = 4096;

constexpr int RING_BYTES = 131072;
constexpr int LC_MISC = RING_BYTES;
constexpr int LC_CNT = LC_MISC + 64;
constexpr int LC_TBASE = LC_CNT + 128;
constexpr int LC_LCNT = LC_TBASE + 192;
constexpr int LC_GBASE = LC_LCNT + 128;
constexpr int LC_TILEE = LC_GBASE + 128;
constexpr int LC_TOK16 = LC_TILEE + MAXTILES * 4;
constexpr int MAXU = 26;
constexpr int LDS_BYTES = 147456;
static_assert(LC_TOK16 % 16 == 0 && LC_TOK16 + MAXU * 512 <= LDS_BYTES, "LDS map");

typedef unsigned short bf16_t;
typedef float f32x4 __attribute__((ext_vector_type(4)));
typedef float f32x2 __attribute__((ext_vector_type(2)));
typedef unsigned u32x2 __attribute__((ext_vector_type(2)));
typedef unsigned u32x4 __attribute__((ext_vector_type(4)));

__device__ __forceinline__ unsigned pkbf(float lo, float hi) { unsigned r; asm("v_cvt_pk_bf16_f32 %0, %1, %2" : "=v"(r) : "v"(lo), "v"(hi)); return r; }
__device__ __forceinline__ float bflo(unsigned w) { return __uint_as_float(w << 16); }
__device__ __forceinline__ float bfhi(unsigned w) { return __uint_as_float(w & 0xffff0000u); }
__device__ __forceinline__ float wave_sum(float v) {
#pragma unroll
    for (int o = 1; o < 64; o <<= 1) v += __shfl_xor(v, o);
    return v;
}
#define LDS_WAIT() asm volatile("s_waitcnt lgkmcnt(0)" ::: "memory")
#define VM_WAIT() asm volatile("s_waitcnt vmcnt(0)" ::: "memory")

namespace pg8 {
#define PG8_LAS __attribute__((address_space(3)))
typedef unsigned short bf16_t;
typedef short bf16x8 __attribute__((ext_vector_type(8)));
typedef float f32x4 __attribute__((ext_vector_type(4)));
typedef unsigned u32x4 __attribute__((ext_vector_type(4)));
typedef int i32x4 __attribute__((ext_vector_type(4)));
typedef int i32x8 __attribute__((ext_vector_type(8)));
typedef unsigned u32x2 __attribute__((ext_vector_type(2)));
constexpr int BM = 256, BK = 64, HALF = 128, HTB = HALF * BK * 2  , STAGE_BYTES = 8 * HTB, NXCD = 8, WGM = 8;

__host__ __device__ __forceinline__ int lds_byte(int r, int c) { const int st = (r >> 4) * 2 + (c >> 5), rr = r & 15, cc = c & 31, ob = rr * 64 + cc * 2; return st * 1024 + (ob ^ (((ob >> 9) & 1) << 5)); }
__host__ __device__ __forceinline__ void stage_rc(int b, int& R, int& C) { const int st = b / 1024, sb = b % 1024, swz = sb ^ (((sb >> 9) & 1) << 5); R = (st >> 1) * 16 + swz / 64; C = (st & 1) * 32 + (swz % 64) / 2; }
__host__ __device__ __forceinline__ int perm32(int rho) { const int n = rho >> 4, i = rho & 15; return 8 * (i >> 2) + 4 * n + (i & 3); }

struct Unit { int pm, pn; };
struct Gemm { const bf16_t* A; const bf16_t* Bt; int M, N, K; };

struct StaticOrder {
    int nM, nN, nwg, G, c;
    __host__ __device__ void init(int M, int N, int G_, int c_) { nM = M / BM; nN = N / BM; nwg = nM * nN; G = G_; c = c_; }
    __host__ __device__ bool next(int i, Unit& u) const {
        const long L = (long)i * G + c; if (L >= nwg) return false;
        int wgid = (int)L; { const int q = nwg / NXCD, r = nwg % NXCD, xcd = wgid % NXCD, off = wgid / NXCD; wgid = (xcd < r ? xcd * (q + 1) : r * (q + 1) + (xcd - r) * q) + off; }
        const int nig = WGM * nN, gid = wgid / nig, fm = gid * WGM, gsz = (nM - fm) < WGM ? (nM - fm) : WGM;
        u.pm = fm + ((wgid % nig) % gsz); u.pn = (wgid % nig) / gsz; return true;
    }
    __device__ __forceinline__ void a_ready(const Unit&) const {}
    __device__ __forceinline__ void done(const Unit&) const {}
};


struct PoolOrder {
    int G, c;
    __device__ __forceinline__ bool next(int i, Unit& u) const { const int L = i * G + c; if (L >= 4 * 130) return false; const int g = L & 3, pm = L >> 2; u.pm = g * 130 + pm; u.pn = g; return true; }
    __device__ __forceinline__ void a_ready(const Unit&) const {}
    __device__ __forceinline__ void done(const Unit&) const {}
};
struct LatentOrder {
    StaticOrder S;
    __device__ void init(int N, int G_, int c_) { S.init(NB * SEQ, N, G_, c_); }
    __device__ bool next(int i, Unit& u) const { if (!S.next(i, u)) return false; u.pm += (u.pm >= SEQ / 256) ? 2 : 1; return true; }
    __device__ __forceinline__ void a_ready(const Unit&) const {}
    __device__ __forceinline__ void done(const Unit&) const {}
};
struct MoeOrder {
    const PG8_LAS int* tile_e; int lim, nN, G, c;
    __device__ __forceinline__ bool next(int i, Unit& u) const { const int L = i * G + c; if (L >= lim) return false; const int pm = L / nN, pl = L - pm * nN; u.pm = pm; u.pn = tile_e[pm] * nN + pl; return true; }
    __device__ __forceinline__ void a_ready(const Unit&) const {}
    __device__ __forceinline__ void done(const Unit&) const {}
};

__device__ __forceinline__ unsigned cvt_pk_bf16(float lo, float hi) { unsigned r; asm volatile("v_cvt_pk_bf16_f32 %0, %1, %2" : "=v"(r) : "v"(lo), "v"(hi)); return r; }

template <bool POOL> struct EpiPlainT {
    static constexpr bool PERM = true, AFTER_DRAIN = false, HAS_PRE = false; struct Pre {}; static constexpr int NST = 16;
    bf16_t* O; int ldc;
    __device__ __forceinline__ void operator()(const f32x4 (&acc)[2][2][4][2], const Unit& u, int wr, int wc, int fr, int fq) const {
        const int rt = POOL ? (u.pm - 130 * u.pn) : u.pm;
        const int row0 = rt * BM + wr * 64 + fr, col0 = u.pn * BM + wc * 32 + 8 * fq;
#pragma unroll
        for (int ai = 0; ai < 2; ++ai)
#pragma unroll
            for (int m = 0; m < 4; ++m) { bf16_t* rowp = O + (size_t)(row0 + ai * HALF + m * 16) * ldc + col0;
#pragma unroll
                for (int bj = 0; bj < 2; ++bj) { const f32x4 v0 = acc[ai][bj][m][0], v1 = acc[ai][bj][m][1];
                    u32x4 w; w.x = cvt_pk_bf16(v0[0], v0[1]); w.y = cvt_pk_bf16(v0[2], v0[3]); w.z = cvt_pk_bf16(v1[0], v1[1]); w.w = cvt_pk_bf16(v1[2], v1[3]);
                    *(u32x4*)(rowp + bj * HALF) = w; } }
    }
};
struct EpiScaled {
    static constexpr bool PERM = true, AFTER_DRAIN = false, HAS_PRE = false; struct Pre {}; static constexpr int NST = 16;
    bf16_t* O; int ldc; float asc;
    __device__ __forceinline__ void operator()(const f32x4 (&acc)[2][2][4][2], const Unit& u, int wr, int wc, int fr, int fq) const {
        const int row0 = u.pm * BM + wr * 64 + fr, col0 = u.pn * BM + wc * 32 + 8 * fq;
#pragma unroll
        for (int ai = 0; ai < 2; ++ai)
#pragma unroll
            for (int m = 0; m < 4; ++m) { bf16_t* rowp = O + (size_t)(row0 + ai * HALF + m * 16) * ldc + col0;
#pragma unroll
                for (int bj = 0; bj < 2; ++bj) { const f32x4 v0 = acc[ai][bj][m][0] * asc, v1 = acc[ai][bj][m][1] * asc;
                    u32x4 w; w.x = cvt_pk_bf16(v0[0], v0[1]); w.y = cvt_pk_bf16(v0[2], v0[3]); w.z = cvt_pk_bf16(v1[0], v1[1]); w.w = cvt_pk_bf16(v1[2], v1[3]);
                    *(u32x4*)(rowp + bj * HALF) = w; } }
    }
};
struct EpiRows8 {
    static constexpr bool PERM = true, AFTER_DRAIN = false, HAS_PRE = false; struct Pre {}; static constexpr int NST = 8;
    unsigned char* O; int ldc; float asc;
    __device__ __forceinline__ void operator()(const f32x4 (&acc)[2][2][4][2], const Unit& u, int wr, int wc, int fr, int fq) const {
        const int col0 = u.pn * BM + wc * 32 + 8 * fq;
#pragma unroll
        for (int ai = 0; ai < 2; ++ai)
#pragma unroll
            for (int mp = 0; mp < 2; ++mp) {
                const int m = 2 * mp + (fq & 1), row = u.pm * BM + wr * 64 + fr + ai * HALF + m * 16;
#pragma unroll
                for (int bj = 0; bj < 2; ++bj) { unsigned w[2][2];
#pragma unroll
                    for (int mm = 0; mm < 2; ++mm) { const f32x4 v0 = acc[ai][bj][2 * mp + mm][0] * asc, v1 = acc[ai][bj][2 * mp + mm][1] * asc;
                        int w0 = 0, w1 = 0; w0 = __builtin_amdgcn_cvt_pk_fp8_f32(v0[0], v0[1], w0, false); w0 = __builtin_amdgcn_cvt_pk_fp8_f32(v0[2], v0[3], w0, true);
                        w1 = __builtin_amdgcn_cvt_pk_fp8_f32(v1[0], v1[1], w1, false); w1 = __builtin_amdgcn_cvt_pk_fp8_f32(v1[2], v1[3], w1, true);
                        w[mm][0] = (unsigned)w0; w[mm][1] = (unsigned)w1; }
                    const auto lo = __builtin_amdgcn_permlane16_swap(w[0][0], w[1][0], false, false), hi2 = __builtin_amdgcn_permlane16_swap(w[0][1], w[1][1], false, false);
                    *(u32x4*)(O + (size_t)row * ldc + (col0 & ~15) + bj * HALF) = (u32x4){lo[0], hi2[0], lo[1], hi2[1]}; }
            }
    }
};
typedef EpiPlainT<false> EpiPlain;
typedef EpiPlainT<true> EpiPool;
template <int CHEAP> struct EpiSwiGLUT {
    static constexpr bool PERM = true, AFTER_DRAIN = false; static constexpr int NST = (CHEAP == 2) ? 0 : 4;
    unsigned char* ACT; const bf16_t* b1h; float asc;
    static constexpr bool HAS_PRE = true; struct Pre { u32x4 bg, bu; };
    __device__ __forceinline__ void pre(const Unit& u, int wc, int fq, Pre& p) const {
        const int e = u.pn >> 3, pl = u.pn & 7, oc0 = pl * 128 + wc * 32 + 8 * fq;
        const bf16_t* a = b1h + e * 2048 + oc0;
        asm volatile("global_load_dwordx4 %0, %1, off" : "=v"(p.bg) : "v"(a) : "memory");
        asm volatile("global_load_dwordx4 %0, %1, off offset:2048" : "=v"(p.bu) : "v"(a) : "memory");
    }
    __device__ __forceinline__ void operator()(const f32x4 (&acc)[2][2][4][2], const Unit& u, int wr, int wc, int fr, int fq, const Pre& p) const {
        if constexpr (CHEAP == 2) return;
        const int pl = u.pn & 7;
        const int row0 = u.pm * BM + wr * 64 + fr, oc0 = pl * 128 + wc * 32 + 8 * fq;
        f32x4 bg[2], bu[2];
#pragma unroll
        for (int n = 0; n < 2; ++n) { bg[n] = (f32x4){__uint_as_float(p.bg[2 * n] << 16), __uint_as_float(p.bg[2 * n] & 0xffff0000u), __uint_as_float(p.bg[2 * n + 1] << 16), __uint_as_float(p.bg[2 * n + 1] & 0xffff0000u)};
            bu[n] = (f32x4){__uint_as_float(p.bu[2 * n] << 16), __uint_as_float(p.bu[2 * n] & 0xffff0000u), __uint_as_float(p.bu[2 * n + 1] << 16), __uint_as_float(p.bu[2 * n + 1] & 0xffff0000u)} + 1.0f; }
#pragma unroll
        for (int ai = 0; ai < 2; ++ai)
#pragma unroll
            for (int mp = 0; mp < 2; ++mp) {
                unsigned w[2][2];
#pragma unroll
                for (int mm = 0; mm < 2; ++mm) { const int m = 2 * mp + mm; float o[8];
#pragma unroll
                    for (int n = 0; n < 2; ++n) {
#pragma unroll
                        for (int jp = 0; jp < 2; ++jp) { typedef float f2e __attribute__((ext_vector_type(2)));
                            const f32x4 ag = acc[ai][0][m][n], au = acc[ai][1][m][n];
                            const f2e a2 = {asc, asc};
                            f2e gv = (f2e){ag[2 * jp], ag[2 * jp + 1]} * a2 + (f2e){bg[n][2 * jp], bg[n][2 * jp + 1]};
                            f2e uv = (f2e){au[2 * jp], au[2 * jp + 1]} * a2 + (f2e){bu[n][2 * jp], bu[n][2 * jp + 1]};
                            gv.x = fminf(gv.x, 7.0f); gv.y = fminf(gv.y, 7.0f);
                            uv.x = fminf(fmaxf(uv.x, -6.0f), 8.0f); uv.y = fminf(fmaxf(uv.y, -6.0f), 8.0f);
                            const f2e tt = gv * (f2e){-1.702f * 1.4426950408889634f, -1.702f * 1.4426950408889634f};
                            f2e dd = (f2e){(CHEAP != 0) ? 1.0f : __builtin_amdgcn_exp2f(tt.x), (CHEAP != 0) ? 1.0f : __builtin_amdgcn_exp2f(tt.y)} + (f2e){1.0f, 1.0f};
                            const f2e sg = {(CHEAP != 0) ? 0.5f : __builtin_amdgcn_rcpf(dd.x), (CHEAP != 0) ? 0.5f : __builtin_amdgcn_rcpf(dd.y)};
                            const f2e oo = (gv * sg) * uv;
                            o[4 * n + 2 * jp] = oo.x; o[4 * n + 2 * jp + 1] = oo.y; } }
                    int w0 = 0, w1 = 0; w0 = __builtin_amdgcn_cvt_pk_fp8_f32(o[0], o[1], w0, false); w0 = __builtin_amdgcn_cvt_pk_fp8_f32(o[2], o[3], w0, true);
                    w1 = __builtin_amdgcn_cvt_pk_fp8_f32(o[4], o[5], w1, false); w1 = __builtin_amdgcn_cvt_pk_fp8_f32(o[6], o[7], w1, true);
                    w[mm][0] = (unsigned)w0; w[mm][1] = (unsigned)w1; }
                const auto lo = __builtin_amdgcn_permlane16_swap(w[0][0], w[1][0], false, false), hi2 = __builtin_amdgcn_permlane16_swap(w[0][1], w[1][1], false, false);
                const int m = 2 * mp + (fq & 1);
                *(u32x4*)(ACT + (size_t)(row0 + ai * HALF + m * 16) * 1024 + (oc0 & ~15)) = (u32x4){lo[0], hi2[0], lo[1], hi2[1]}; }
    }
};
typedef EpiSwiGLUT<0> EpiSwiGLU;
struct EpiScatter {
    static constexpr bool PERM = true, AFTER_DRAIN = false;
    static constexpr int NST = 8;
    unsigned char* SLOT; const PG8_LAS int* slot_tab; int G, c; const bf16_t* b2h; float asc; int seq; int junk0;
    static constexpr bool HAS_PRE = true; struct Pre { u32x4 bv[2]; };
    __device__ __forceinline__ void pre(const Unit& u, int wc, int fq, Pre& p) const {
        const int e = u.pn >> 2, pl = u.pn & 3, col0 = pl * BM + wc * 32 + 8 * fq;
        const bf16_t* a = b2h + e * 1024 + col0;
        asm volatile("global_load_dwordx4 %0, %1, off" : "=v"(p.bv[0]) : "v"(a) : "memory");
        asm volatile("global_load_dwordx4 %0, %1, off offset:256" : "=v"(p.bv[1]) : "v"(a) : "memory");
    }
    __device__ __forceinline__ void operator()(const f32x4 (&acc)[2][2][4][2], const Unit& u, int wr, int wc, int fr, int fq, const Pre& p) const {
        const int pl = u.pn & 3, ui = (u.pm * 4 + pl - c) / G;
        const int col0 = pl * BM + wc * 32 + 8 * fq;
        f32x4 bv[2][2];
#pragma unroll
        for (int bj = 0; bj < 2; ++bj)
#pragma unroll
            for (int n = 0; n < 2; ++n) bv[bj][n] = (f32x4){__uint_as_float(p.bv[bj][2 * n] << 16), __uint_as_float(p.bv[bj][2 * n] & 0xffff0000u), __uint_as_float(p.bv[bj][2 * n + 1] << 16), __uint_as_float(p.bv[bj][2 * n + 1] & 0xffff0000u)};
#pragma unroll
        for (int ai = 0; ai < 2; ++ai)
#pragma unroll
            for (int mp = 0; mp < 2; ++mp) {
                const int m = 2 * mp + (fq & 1), rit = wr * 64 + fr + ai * HALF + m * 16;
                int slot = seq ? (u.pm * BM + rit) : slot_tab[ui * BM + rit];
                if (slot < 0) slot = junk0 + rit;
#pragma unroll
                for (int bj = 0; bj < 2; ++bj) { unsigned w[2][2];
#pragma unroll
                    for (int mm = 0; mm < 2; ++mm) { const f32x4 v0 = acc[ai][bj][2 * mp + mm][0] * asc + bv[bj][0], v1 = acc[ai][bj][2 * mp + mm][1] * asc + bv[bj][1];
                        int w0 = 0, w1 = 0; w0 = __builtin_amdgcn_cvt_pk_fp8_f32(v0[0], v0[1], w0, false); w0 = __builtin_amdgcn_cvt_pk_fp8_f32(v0[2], v0[3], w0, true);
                        w1 = __builtin_amdgcn_cvt_pk_fp8_f32(v1[0], v1[1], w1, false); w1 = __builtin_amdgcn_cvt_pk_fp8_f32(v1[2], v1[3], w1, true);
                        w[mm][0] = (unsigned)w0; w[mm][1] = (unsigned)w1; }
                    const auto lo = __builtin_amdgcn_permlane16_swap(w[0][0], w[1][0], false, false), hi2 = __builtin_amdgcn_permlane16_swap(w[0][1], w[1][1], false, false);
                    *(u32x4*)(SLOT + (size_t)slot * 1024 + (col0 & ~15) + bj * HALF) = (u32x4){lo[0], hi2[0], lo[1], hi2[1]}; }
            }
    }
};

template <class Epi, class Sched, bool ALIGN_EPI = false, bool SP2 = false, int ES = 2, bool GATHER = false, int PRB = 0>
__device__ __forceinline__ void gemm_phase(PG8_LAS unsigned char* lds, const Gemm g, const Sched& S, const Epi& E, const PG8_LAS unsigned short* tok16 = nullptr) {
    static_assert(SP2 || !GATHER, "GATHER is implemented for the SP2 loop");
    int tid_ = threadIdx.x; asm volatile("" : "+v"(tid_));
    const int tid = tid_, wid = __builtin_amdgcn_readfirstlane(tid >> 6), lane = tid & 63, wr = wid >> 2, wc = wid & 3, fr = lane & 15, fq = lane >> 4;
    const int K = g.K, nt = K * ES / (BK * 2);
    unsigned voffA[2], voffB[2]; int rowA[2]; unsigned colA[2];
#pragma unroll
    for (int i = 0; i < 2; ++i) { int R, C; stage_rc(tid * 16 + i * 8192, R, C); const int Rb = Epi::PERM ? ((R & ~31) + perm32(R & 31)) : R;
        voffA[i] = (unsigned)(R * K * ES + C * 2); voffB[i] = (unsigned)(Rb * K * ES + C * 2); rowA[i] = R; colA[i] = (unsigned)(C * 2); }
    const size_t kstep = (size_t)(BK * 2);
    const size_t hstep = (size_t)HALF * K * ES;
    const size_t hstepA = GATHER ? 0 : hstep;
    const size_t tstep = 2 * hstep;
    const unsigned ldsw = (unsigned)wid * 1024u;
    const int aoff = lds_byte(wr * 64 + fr, fq * 8), boff = lds_byte(wc * 32 + fr, fq * 8);
#define PG8_SA(b, h) (((b) * 2 + (h)) * HTB)
#define PG8_SB(b, h) ((4 + (b) * 2 + (h)) * HTB)
#define PG8_STAGE(bufoff, gbase, voff) do { _Pragma("unroll") for (int _i = 0; _i < 2; ++_i) \
        __builtin_amdgcn_global_load_lds((const unsigned*)((const char*)(gbase) + (voff)[_i]), (PG8_LAS unsigned*)(lds + (bufoff) + ldsw + _i * 8192), 16, 0, 0); } while (0)
#define PG8_GOFF(dst, ui_) do { _Pragma("unroll") for (int _h = 0; _h < 2; ++_h) _Pragma("unroll") for (int _i = 0; _i < 2; ++_i) dst[_h][_i] = (unsigned)tok16[(ui_) * 256 + _h * HALF + rowA[_i]] * (unsigned)(K * ES) + colA[_i]; } while (0)
#define PG8_STAGE_A(bufoff, gbase, h, usenext) do { if constexpr (GATHER) { _Pragma("unroll") for (int _i = 0; _i < 2; ++_i) { const unsigned vo_ = (usenext) ? goffN[h][_i] : goffC[h][_i]; \
        __builtin_amdgcn_global_load_lds((const unsigned*)((const char*)(gbase) + vo_), (PG8_LAS unsigned*)(lds + (bufoff) + ldsw + _i * 8192), 16, 0, 0); } } else PG8_STAGE(bufoff, gbase, voffA); } while (0)
#define PG8_LDA(dst, b, h) do { _Pragma("unroll") for (int m = 0; m < 4; ++m) _Pragma("unroll") for (int k = 0; k < 2; ++k) dst[m][k] = *(const PG8_LAS bf16x8*)(lds + PG8_SA(b, h) + aoff + m * 2048 + k * 1024); } while (0)
#define PG8_LDB(dst, b, h) do { _Pragma("unroll") for (int n = 0; n < 2; ++n) _Pragma("unroll") for (int k = 0; k < 2; ++k) dst[n][k] = *(const PG8_LAS bf16x8*)(lds + PG8_SB(b, h) + boff + n * 2048 + k * 1024); } while (0)
#define PG8_CAT8(lo, hi) __builtin_shufflevector(__builtin_bit_cast(i32x4, lo), __builtin_bit_cast(i32x4, hi), 0, 1, 2, 3, 4, 5, 6, 7)
#define PG8_MFMA8(accv, bv, av) asm volatile("v_mfma_scale_f32_16x16x128_f8f6f4 %0, %1, %2, %0, %3, %3 op_sel_hi:[0,0,0]" : "+v"(accv) : "v"(bv), "v"(av), "v"(sc1))
#define PG8_MMA(ai, bj, At, Bt) do { if constexpr (PRB == 1) break; __builtin_amdgcn_s_setprio(1); if constexpr (ES == 2) { _Pragma("unroll") for (int m = 0; m < 4; ++m) _Pragma("unroll") for (int n = 0; n < 2; ++n) _Pragma("unroll") for (int k = 0; k < 2; ++k) \
        acc[ai][bj][m][n] = __builtin_amdgcn_mfma_f32_16x16x32_bf16(Bt[n][k], At[m][k], acc[ai][bj][m][n], 0, 0, 0); } else { _Pragma("unroll") for (int m = 0; m < 4; ++m) _Pragma("unroll") for (int n = 0; n < 2; ++n) { \
        const i32x8 b8_ = PG8_CAT8(Bt[n][0], Bt[n][1]), a8_ = PG8_CAT8(At[m][0], At[m][1]); PG8_MFMA8(acc[ai][bj][m][n], b8_, a8_); } } __builtin_amdgcn_s_setprio(0); } while (0)
#define PG8_WAIT_V(n) asm volatile("s_waitcnt vmcnt(" #n ")" ::: "memory")
#define PG8_WAIT_L(n) asm volatile("s_waitcnt lgkmcnt(" #n ")" ::: "memory")
#define PG8_BAR __builtin_amdgcn_s_barrier()
#define PG8_SCHED __builtin_amdgcn_sched_barrier(0)
    Unit cur, nxt; int ui = 0; typename Epi::Pre epre;
    if (!S.next(0, cur)) return;
    int sc1 = 0x7f7f7f7f; asm volatile("" : "+v"(sc1));
    f32x4 acc[2][2][4][2];
#pragma unroll
    for (int a = 0; a < 2; ++a)
#pragma unroll
        for (int b = 0; b < 2; ++b)
#pragma unroll
            for (int m = 0; m < 4; ++m)
#pragma unroll
                for (int n = 0; n < 2; ++n) acc[a][b][m][n] = (f32x4){0.f, 0.f, 0.f, 0.f};
    bf16x8 At[4][2], B0[2][2], B1[2][2];
    const char* cA = (const char*)g.A + (GATHER ? (size_t)0 : (size_t)cur.pm * tstep); const char* cB = (const char*)g.Bt + (size_t)cur.pn * tstep;
    unsigned goffC[2][2] = {{0u, 0u}, {0u, 0u}}, goffN[2][2] = {{0u, 0u}, {0u, 0u}};
    if constexpr (GATHER) PG8_GOFF(goffC, 0);
    S.a_ready(cur);
    if constexpr (SP2) {
        PG8_STAGE(PG8_SB(0, 0), cB, voffB); PG8_STAGE(PG8_SB(0, 1), cB + hstep, voffB); PG8_STAGE_A(PG8_SA(0, 0), cA, 0, false); PG8_STAGE_A(PG8_SA(0, 1), cA + hstepA, 1, false);
        if (wr == 1) PG8_BAR;
        PG8_WAIT_V(2); PG8_BAR;
        PG8_STAGE(PG8_SB(1, 0), cB + kstep, voffB); PG8_STAGE_A(PG8_SA(1, 0), cA + kstep, 0, false); PG8_STAGE(PG8_SB(1, 1), cB + hstep + kstep, voffB);
        PG8_WAIT_V(6); PG8_BAR;
    } else {
        PG8_STAGE(PG8_SB(0, 0), cB, voffB); PG8_STAGE(PG8_SA(0, 0), cA, voffA); PG8_STAGE(PG8_SB(0, 1), cB + hstep, voffB); PG8_STAGE(PG8_SA(0, 1), cA + hstep, voffA);
        if (wr == 1) PG8_BAR;
        PG8_WAIT_V(4); PG8_BAR;
        PG8_STAGE(PG8_SB(1, 0), cB + kstep, voffB); PG8_STAGE(PG8_SA(1, 0), cA + kstep, voffA); PG8_STAGE(PG8_SB(1, 1), cB + hstep + kstep, voffB);
        PG8_WAIT_V(6); PG8_BAR;
    }
    bool seam = false;
#define PG8_WAIT_VX(rx_) asm volatile("v_cmp_ne_u32_e32 vcc, 0, %0\n\ts_cbranch_vccz 1f\n\ts_waitcnt vmcnt(%1)\n\ts_branch 2f\n1:\n\ts_waitcnt vmcnt(8)\n2:" :: "v"(rx_), "n"(8 + Epi::NST) : "memory", "vcc")
    for (;;) {
        const bool has_next = S.next(ui + 1, nxt);
        const char* nA = (has_next && !GATHER) ? (const char*)g.A + (size_t)nxt.pm * tstep : cA;
        const char* nB = has_next ? (const char*)g.Bt + (size_t)nxt.pn * tstep : cB;
        for (int t = 0; t < nt; t += 2) {
            const bool last = (t == nt - 2);
            const int rx = (SP2 && seam && t == 0) ? 1 : 0;
            const char* a1 = cA + (size_t)(t + 1) * kstep;
            const char* a2 = last ? nA : cA + (size_t)(t + 2) * kstep; const char* b2 = last ? nB : cB + (size_t)(t + 2) * kstep;
            const char* a3 = a2 + kstep; const char* b3 = b2 + kstep;
            if (last && has_next) S.a_ready(nxt);
            if constexpr (Epi::HAS_PRE) { if (last) E.pre(cur, wc, fq, epre); }
            if constexpr (GATHER) { if (last) { if (has_next) PG8_GOFF(goffN, ui + 1); else { _Pragma("unroll") for (int _h = 0; _h < 2; ++_h) _Pragma("unroll") for (int _i = 0; _i < 2; ++_i) goffN[_h][_i] = goffC[_h][_i]; } } }
            if constexpr (SP2) {
            PG8_LDB(B0, 0, 0); PG8_LDB(B1, 0, 1); PG8_SCHED; PG8_LDA(At, 0, 0); PG8_STAGE_A(PG8_SA(1, 1), a1 + hstepA, 1, false);
            PG8_WAIT_VX(rx); PG8_WAIT_L(0); PG8_BAR; PG8_MMA(0, 0, At, B0); PG8_MMA(0, 1, At, B1); PG8_BAR; PG8_SCHED;
            PG8_LDA(At, 0, 1); PG8_STAGE(PG8_SB(0, 0), b2, voffB); PG8_STAGE(PG8_SB(0, 1), b2 + hstep, voffB); PG8_STAGE_A(PG8_SA(0, 0), a2, 0, last);
            PG8_WAIT_VX(rx); PG8_WAIT_L(0); PG8_BAR; PG8_MMA(1, 0, At, B0); PG8_MMA(1, 1, At, B1); PG8_BAR; PG8_SCHED;
            PG8_LDB(B0, 1, 0); PG8_LDB(B1, 1, 1); PG8_SCHED; PG8_LDA(At, 1, 0); PG8_STAGE_A(PG8_SA(0, 1), a2 + hstepA, 1, last);
            PG8_WAIT_V(8); PG8_WAIT_L(0); PG8_BAR; PG8_MMA(0, 0, At, B0); PG8_MMA(0, 1, At, B1); PG8_BAR; PG8_SCHED;
            PG8_LDA(At, 1, 1); PG8_STAGE(PG8_SB(1, 0), b3, voffB); PG8_STAGE(PG8_SB(1, 1), b3 + hstep, voffB); PG8_STAGE_A(PG8_SA(1, 0), a3, 0, last);
            PG8_WAIT_V(8); PG8_WAIT_L(0); PG8_BAR; PG8_MMA(1, 0, At, B0); PG8_MMA(1, 1, At, B1); PG8_BAR; PG8_SCHED;
            } else {
            PG8_LDB(B0, 0, 0); PG8_SCHED; PG8_LDA(At, 0, 0); PG8_STAGE(PG8_SA(1, 1), a1 + hstep, voffA);
            PG8_WAIT_L(8); PG8_BAR; PG8_WAIT_L(0); PG8_MMA(0, 0, At, B0); PG8_BAR; PG8_SCHED;
            PG8_LDB(B1, 0, 1); PG8_STAGE(PG8_SB(0, 0), b2, voffB);
            PG8_BAR; PG8_WAIT_L(0); PG8_MMA(0, 1, At, B1); PG8_BAR;
            PG8_LDA(At, 0, 1); PG8_STAGE(PG8_SA(0, 0), a2, voffA);
            PG8_BAR; PG8_WAIT_L(0); PG8_MMA(1, 0, At, B0); PG8_BAR; PG8_SCHED;
            PG8_STAGE(PG8_SB(0, 1), b2 + hstep, voffB);
            PG8_WAIT_V(6); PG8_BAR; PG8_MMA(1, 1, At, B1); PG8_BAR;
            PG8_LDB(B0, 1, 0); PG8_SCHED; PG8_LDA(At, 1, 0); PG8_STAGE(PG8_SA(0, 1), a2 + hstep, voffA);
            PG8_WAIT_L(8); PG8_BAR; PG8_WAIT_L(0); PG8_MMA(0, 0, At, B0); PG8_BAR; PG8_SCHED;
            PG8_LDB(B1, 1, 1); PG8_STAGE(PG8_SB(1, 0), b3, voffB);
            PG8_BAR; PG8_WAIT_L(0); PG8_MMA(0, 1, At, B1); PG8_BAR;
            PG8_LDA(At, 1, 1); PG8_STAGE(PG8_SA(1, 0), a3, voffA);
            PG8_BAR; PG8_WAIT_L(0); PG8_MMA(1, 0, At, B0); PG8_BAR; PG8_SCHED;
            PG8_STAGE(PG8_SB(1, 1), b3 + hstep, voffB);
            PG8_WAIT_V(6); PG8_BAR; PG8_MMA(1, 1, At, B1); PG8_BAR;
            }
        }
        if constexpr (ES == 1) { PG8_SCHED; asm volatile("s_nop 15\n\ts_nop 15" ::: "memory"); PG8_SCHED; }
        if constexpr (ALIGN_EPI) { if (wr == 0) PG8_BAR; }
        if constexpr (!Epi::AFTER_DRAIN) { if constexpr (Epi::HAS_PRE) E(acc, cur, wr, wc, fr, fq, epre); else E(acc, cur, wr, wc, fr, fq); S.done(cur); }
        if (!has_next) break;
#pragma unroll
        for (int a = 0; a < 2; ++a)
#pragma unroll
            for (int b = 0; b < 2; ++b)
#pragma unroll
                for (int m = 0; m < 4; ++m)
#pragma unroll
                    for (int n = 0; n < 2; ++n) acc[a][b][m][n] = (f32x4){0.f, 0.f, 0.f, 0.f};
        cur = nxt; cA = nA; cB = nB; ++ui; seam = SP2;
        if constexpr (GATHER) { _Pragma("unroll") for (int _h = 0; _h < 2; ++_h) _Pragma("unroll") for (int _i = 0; _i < 2; ++_i) goffC[_h][_i] = goffN[_h][_i]; }
        if constexpr (ALIGN_EPI) { if (wr == 1) PG8_BAR; }
    }
    PG8_WAIT_V(0);
    if constexpr (!ALIGN_EPI) { if (wr == 0) PG8_BAR; }
    PG8_BAR;
    if constexpr (Epi::AFTER_DRAIN) { E.fused(acc, cur, wr, wc, fr, fq, lds, wid, lane); S.done(cur); }
#undef PG8_SA
#undef PG8_SB
#undef PG8_STAGE
#undef PG8_STAGE_A
#undef PG8_GOFF
#undef PG8_LDA
#undef PG8_LDB
#undef PG8_MMA
#undef PG8_CAT8
#undef PG8_MFMA8
#undef PG8_WAIT_V
#undef PG8_WAIT_VX
#undef PG8_WAIT_L
#undef PG8_BAR
#undef PG8_SCHED
}
}

namespace att {
using f32x16 = __attribute__((ext_vector_type(16))) float;
__device__ __forceinline__ int crow(int r, int hi) { return (r & 3) + 8 * (r >> 2) + 4 * hi; }
__device__ __forceinline__ unsigned cvtpk(float lo, float hi) { unsigned r; asm volatile("v_cvt_pk_bf16_f32 %0, %1, %2" : "=v"(r) : "v"(lo), "v"(hi)); return r; }
}

namespace att8 {
using att::f32x16; using att::crow;
typedef int i32x4 __attribute__((ext_vector_type(4)));
typedef int i32x8 __attribute__((ext_vector_type(8)));
constexpr int NW = 8, QBLK = 32, KVBLK = 64;
#define SBAR() __builtin_amdgcn_sched_barrier(0)
template <int OFF> __device__ __forceinline__ i32x4 rd128(int a) { i32x4 r; asm volatile("ds_read_b128 %0, %1 offset:%2" : "=&v"(r) : "v"(a), "i"(OFF) : "memory"); return r; }
__device__ __forceinline__ i32x8 cat8(i32x4 lo, i32x4 hi) { return __builtin_shufflevector(lo, hi, 0, 1, 2, 3, 4, 5, 6, 7); }
__device__ __forceinline__ float mx3(float a, float b, float c) { float r; asm("v_max3_f32 %0, %1, %2, %3" : "=v"(r) : "v"(a), "v"(b), "v"(c)); return r; }
constexpr float CSC = 1.f / 65536.f;
template <bool FIRST>
__device__ __forceinline__ void softmax8(f32x16& p0, f32x16& p1, float& M_run, float& alpha, i32x8& pf) {
  constexpr float CTHR = (56.f + 8.f * (5.f * 1.4426950408889634f)) * CSC;
  float a0 = mx3(p0[0], p0[1], p0[2]), a1 = mx3(p0[8], p0[9], p0[10]), a2 = mx3(p1[0], p1[1], p1[2]), a3 = mx3(p1[8], p1[9], p1[10]);
  a0 = mx3(a0, p0[3], p0[4]); a1 = mx3(a1, p0[11], p0[12]); a2 = mx3(a2, p1[3], p1[4]); a3 = mx3(a3, p1[11], p1[12]);
  a0 = mx3(a0, p0[5], p0[6]); a1 = mx3(a1, p0[13], p0[14]); a2 = mx3(a2, p1[5], p1[6]); a3 = mx3(a3, p1[13], p1[14]);
  a0 = mx3(a0, p0[7], a1); a2 = mx3(a2, p1[7], a3);
  float cmax = mx3(a0, p0[15], a2); cmax = mx3(cmax, p1[15], cmax);
  { auto rr = __builtin_amdgcn_permlane32_swap(__float_as_uint(cmax), __float_as_uint(cmax), false, false); cmax = mx3(__uint_as_float(rr[0]), __uint_as_float(rr[1]), __uint_as_float(rr[1])); }
  alpha = 1.f;
  if (FIRST || !__builtin_expect(__all(cmax <= CTHR), 1)) {
    const float tmax = (cmax * 65536.f - 56.f) * 0.125f, d = FIRST ? tmax : fmaxf(tmax, 0.f), d8 = 8.f * d * CSC;
    alpha = __builtin_amdgcn_exp2f(-d); M_run += d;
#pragma unroll
    for (int r = 0; r < 16; ++r) { p0[r] -= d8; p1[r] -= d8; }
  }
  typedef unsigned short us2 __attribute__((ext_vector_type(2)));
#pragma unroll
  for (int w = 0; w < 4; ++w) { const unsigned A = __builtin_bit_cast(unsigned, __builtin_amdgcn_cvt_pknorm_u16(p0[4 * w], p0[4 * w + 1])), B = __builtin_bit_cast(unsigned, __builtin_amdgcn_cvt_pknorm_u16(p0[4 * w + 2], p0[4 * w + 3]));
    pf[w] = (int)__builtin_amdgcn_perm(B, A, 0x06040200u); }
#pragma unroll
  for (int w = 0; w < 4; ++w) { const unsigned A = __builtin_bit_cast(unsigned, __builtin_amdgcn_cvt_pknorm_u16(p1[4 * w], p1[4 * w + 1])), B = __builtin_bit_cast(unsigned, __builtin_amdgcn_cvt_pknorm_u16(p1[4 * w + 2], p1[4 * w + 3]));
    pf[4 + w] = (int)__builtin_amdgcn_perm(B, A, 0x06040200u); }
}

template <int DQK, int LDQ, int LDK, int LDO, bool DIFF, int PROBE = 0>
__device__ __forceinline__ void attn_body8(const unsigned char* __restrict__ Qb, const unsigned char* __restrict__ Kh, const unsigned char* __restrict__ VT, unsigned char* __restrict__ Ob, int seq, char* lds,
                                           int dmode, float lam, const float* __restrict__ subg) {
  constexpr int SHM_V = 128 * 64, SHM_K = 64 * DQK, SLOT = SHM_V + SHM_K, NS = DQK / 64;
  int tid_ = threadIdx.x; asm volatile("" : "+v"(tid_));
  const int tid = tid_, wid = __builtin_amdgcn_readfirstlane(tid >> 6), lane = tid & 63, r32 = lane & 31, hi = lane >> 5, half = wid >> 2;
  constexpr int RD = 4;
  float* ws = (float*)(lds + RD * SLOT) + wid * 64; float* al_l = ws + 32;
  int sc1 = 0x7f7f7f7f; asm volatile("" : "+v"(sc1));
  int scq = 0x6f6f6f6f; asm volatile("" : "+v"(scq));
  float M_run = 0.f; asm volatile("" : "+v"(M_run));
  f32x16 o[4] = {};
  typedef float f32x4_ __attribute__((ext_vector_type(4)));
  f32x4_ osum = {0.f, 0.f, 0.f, 0.f};
  i32x8 sel8;
  { const int onv = (((lane & 15) == 0 && ((lane >> 4) & 1) == 0) || ((lane & 15) == 1 && ((lane >> 4) & 1) == 1)) ? 0x38383838 : 0;
#pragma unroll
    for (int i = 0; i < 8; ++i) { int t_; asm volatile("v_mov_b32 %0, %1" : "=v"(t_) : "v"(onv)); sel8[i] = t_; } }
#define MFMA16S(acc4, a8, b8) asm volatile("v_mfma_scale_f32_16x16x128_f8f6f4 %0, %1, %2, %0, %3, %3 op_sel_hi:[0,0,0]" : "+v"(acc4) : "v"(a8), "v"(b8), "v"(sc1))
  i32x8 qf[NS];
  { const unsigned char* Qw = Qb + (long)(wid * QBLK + r32) * LDQ + hi * 32;
#pragma unroll
    for (int s = 0; s < NS; ++s) qf[s] = cat8(*reinterpret_cast<const i32x4*>(Qw + s * 64), *reinterpret_cast<const i32x4*>(Qw + s * 64 + 16)); }
  const int vrow = 16 * wid + (lane >> 2), vpc = lane & 3;
  const int krow = 8 * wid + ((DQK == 128) ? (lane >> 3) : ((lane >> 2) & 7)), kpc = (DQK == 128) ? (lane & 7) : (lane & 3);
  const unsigned char* vsrc = VT + (long)vrow * SB + ((vpc ^ ((vrow >> 2) & 3)) << 4);
  const unsigned char* ksrc = Kh + (long)krow * LDK + ((DQK == 128) ? ((kpc ^ ((krow >> 1) & 7)) << 4) : ((kpc ^ ((krow >> 2) & 3)) << 4));
  const bool kact = (DQK == 128) || (lane < 32);
  const unsigned ldv = (unsigned)__builtin_amdgcn_readfirstlane((int)(uintptr_t)lds + wid * 1024), ldk = (unsigned)__builtin_amdgcn_readfirstlane((int)(uintptr_t)lds + SHM_V + wid * (DQK == 128 ? 1024 : 512));
#define GLDS16(gsrc, ldst) do { unsigned keep_; asm volatile("s_mov_b32 %0, m0\n\ts_mov_b32 m0, %2\n\ts_nop 0\n\tglobal_load_lds_dwordx4 %1, off\n\ts_mov_b32 m0, %0" : "=&s"(keep_) : "v"(gsrc), "s"(ldst) : "memory"); } while (0)
#define SDMA8(t_, sl_) do { GLDS16(vsrc + (t_) * KVBLK, ldv + (unsigned)((sl_) * SLOT)); if (kact) GLDS16(ksrc + (long)((t_) * KVBLK) * LDK, ldk + (unsigned)((sl_) * SLOT)); } while (0)
#define VMWAIT8(n) asm volatile("s_waitcnt vmcnt(" #n ")" ::: "memory")
#define BARL8() do { SBAR(); asm volatile("s_waitcnt lgkmcnt(0)\n\ts_barrier" ::: "memory"); SBAR(); } while (0)
#define LWAIT8(n) do { asm volatile("s_waitcnt lgkmcnt(" #n ")" ::: "memory"); SBAR(); } while (0)
#define RESC8(a) do { if (__any((a) < 1.f)) { if (hi == 0) al_l[r32] = (a); asm volatile("s_waitcnt lgkmcnt(0)" ::: "memory"); \
    _Pragma("unroll") for (int g = 0; g < 4; ++g) { const f32x4 a4_ = *(const f32x4*)(al_l + 8 * g + 4 * hi);      \
      _Pragma("unroll") for (int i = 0; i < 4; ++i) { _Pragma("unroll") for (int d = 0; d < 4; ++d) o[d][4 * g + i] *= a4_[i]; } SBAR(); } \
    { const f32x4 a4_ = *(const f32x4*)(al_l + (lane & 1) * 16 + 4 * (lane >> 4)); _Pragma("unroll") for (int i = 0; i < 4; ++i) osum[i] *= a4_[i]; }     \
    CIN_SET8(); } } while (0)
#define MFMA8(acc, a8, b8) asm volatile("v_mfma_scale_f32_32x32x64_f8f6f4 %0, %1, %2, %0, %3, %3 op_sel_hi:[0,0,0]" : "+v"(acc) : "v"(a8), "v"(b8), "v"(sc1))
#define MFMA8QC(acc, a8, b8, cin_) asm volatile("v_mfma_scale_f32_32x32x64_f8f6f4 %0, %1, %2, %3, %4, %5 op_sel_hi:[0,0,0]" : "=&v"(acc) : "v"(a8), "v"(b8), "v"(cin_), "v"(scq), "v"(sc1))
#define MFMA8Q(acc, a8, b8) asm volatile("v_mfma_scale_f32_32x32x64_f8f6f4 %0, %1, %2, %0, %3, %4 op_sel_hi:[0,0,0]" : "+v"(acc) : "v"(a8), "v"(b8), "v"(scq), "v"(sc1))
  const int lb = (int)(uintptr_t)lds;
  const int va0 = lb + r32 * 64 + (((2 * hi) ^ ((r32 >> 2) & 3)) << 4), va1 = lb + r32 * 64 + (((2 * hi + 1) ^ ((r32 >> 2) & 3)) << 4);
  const int kz = (DQK == 128) ? ((r32 >> 1) & 7) : ((r32 >> 2) & 3), krb = lb + SHM_V + r32 * DQK;
  const int ka00 = krb + (((2 * hi) ^ kz) << 4), ka01 = krb + (((2 * hi + 1) ^ kz) << 4), ka10 = krb + (((4 + 2 * hi) ^ kz) << 4), ka11 = krb + (((5 + 2 * hi) ^ kz) << 4);
#define KREAD8(so) do { k00 = rd128<0>(ka00 + (so)); k01 = rd128<0>(ka01 + (so)); k10 = rd128<32 * DQK>(ka00 + (so)); k11 = rd128<32 * DQK>(ka01 + (so)); \
    if constexpr (NS == 2) { k20 = rd128<0>(ka10 + (so)); k21 = rd128<0>(ka11 + (so)); k30 = rd128<32 * DQK>(ka10 + (so)); k31 = rd128<32 * DQK>(ka11 + (so)); } } while (0)
#define KREAD8C(SO) do { k00 = rd128<(SO)>(ka00); k01 = rd128<(SO)>(ka01); k10 = rd128<(SO) + 32 * DQK>(ka00); k11 = rd128<(SO) + 32 * DQK>(ka01); \
    if constexpr (NS == 2) { k20 = rd128<(SO)>(ka10); k21 = rd128<(SO)>(ka11); k30 = rd128<(SO) + 32 * DQK>(ka10); k31 = rd128<(SO) + 32 * DQK>(ka11); } } while (0)
#define VREAD8AC(SO) do { v00 = rd128<(SO)>(va0); v01 = rd128<(SO)>(va1); v10 = rd128<(SO) + 2048>(va0); v11 = rd128<(SO) + 2048>(va1); } while (0)
#define VREAD8BC(SO) do { if constexpr (NS == 2) { k00 = rd128<(SO) + 4096>(va0); k01 = rd128<(SO) + 4096>(va1); k10 = rd128<(SO) + 6144>(va0); k11 = rd128<(SO) + 6144>(va1); } \
    else { k20 = rd128<(SO) + 4096>(va0); k21 = rd128<(SO) + 4096>(va1); k30 = rd128<(SO) + 6144>(va0); k31 = rd128<(SO) + 6144>(va1); } } while (0)
#define VREAD8A(so) do { v00 = rd128<0>(va0 + (so)); v01 = rd128<0>(va1 + (so)); v10 = rd128<2048>(va0 + (so)); v11 = rd128<2048>(va1 + (so)); } while (0)
#define VREAD8B(so) do { if constexpr (NS == 2) { k00 = rd128<4096>(va0 + (so)); k01 = rd128<4096>(va1 + (so)); k10 = rd128<6144>(va0 + (so)); k11 = rd128<6144>(va1 + (so)); } \
    else { k20 = rd128<4096>(va0 + (so)); k21 = rd128<4096>(va1 + (so)); k30 = rd128<6144>(va0 + (so)); k31 = rd128<6144>(va1 + (so)); } } while (0)
#define QK8(NV) do { if constexpr (NS == 2) { LWAIT8_(NV + 6); MFMA8QC(p0, cat8(k00, k01), qf[0], cin); LWAIT8_(NV + 4); MFMA8QC(p1, cat8(k10, k11), qf[0], cin); LWAIT8_(NV + 2); MFMA8Q(p0, cat8(k20, k21), qf[NS - 1]); LWAIT8_(NV); MFMA8Q(p1, cat8(k30, k31), qf[NS - 1]); } \
    else { LWAIT8_(NV + 2); MFMA8QC(p0, cat8(k00, k01), qf[0], cin); LWAIT8_(NV); MFMA8QC(p1, cat8(k10, k11), qf[0], cin); } } while (0)
#define LWAIT8_(n) do { asm volatile("s_waitcnt lgkmcnt(%0)" :: "n"(n) : "memory"); SBAR(); } while (0)
#define PV8() do { MFMA16S(osum, pf, sel8); LWAIT8(6); MFMA8(o[0], pf, cat8(v00, v01)); LWAIT8(4); MFMA8(o[1], pf, cat8(v10, v11)); \
    if constexpr (NS == 2) { LWAIT8(2); MFMA8(o[2], pf, cat8(k00, k01)); LWAIT8(0); MFMA8(o[3], pf, cat8(k10, k11)); } else { LWAIT8(2); MFMA8(o[2], pf, cat8(k20, k21)); LWAIT8(0); MFMA8(o[3], pf, cat8(k30, k31)); } } while (0)
  f32x16 p0, p1; float al; i32x8 pf; const int NT = seq / KVBLK;
  f32x16 cin;
#define CIN_SET8() do { const float nm_ = (56.f - 8.f * M_run) * CSC; _Pragma("unroll") for (int r = 0; r < 16; ++r) cin[r] = nm_; asm volatile("" : "+v"(cin)); SBAR(); } while (0)
  i32x4 k00, k01, k10, k11, k20, k21, k30, k31, v00, v01, v10, v11;
#define ACC_INIT8() do { const float nm = (56.f - 8.f * M_run) * CSC; typedef float f2_ __attribute__((ext_vector_type(2))); f2_ n2 = {nm, nm}; asm volatile("" : "+v"(n2)); \
      f2_ q_[16]; _Pragma("unroll") for (int i = 0; i < 16; ++i) asm volatile("v_mov_b64 %0, %1" : "=v"(q_[i]) : "v"(n2)); \
      typedef float f4_ __attribute__((ext_vector_type(4))); typedef float f8_ __attribute__((ext_vector_type(8))); \
      { const f4_ a = __builtin_shufflevector(q_[0], q_[1], 0, 1, 2, 3), b = __builtin_shufflevector(q_[2], q_[3], 0, 1, 2, 3), c = __builtin_shufflevector(q_[4], q_[5], 0, 1, 2, 3), d = __builtin_shufflevector(q_[6], q_[7], 0, 1, 2, 3); \
        const f8_ ab = __builtin_shufflevector(a, b, 0, 1, 2, 3, 4, 5, 6, 7), cd = __builtin_shufflevector(c, d, 0, 1, 2, 3, 4, 5, 6, 7); p0 = __builtin_shufflevector(ab, cd, 0, 1, 2, 3, 4, 5, 6, 7, 8, 9, 10, 11, 12, 13, 14, 15); } \
      { const f4_ a = __builtin_shufflevector(q_[8], q_[9], 0, 1, 2, 3), b = __builtin_shufflevector(q_[10], q_[11], 0, 1, 2, 3), c = __builtin_shufflevector(q_[12], q_[13], 0, 1, 2, 3), d = __builtin_shufflevector(q_[14], q_[15], 0, 1, 2, 3); \
        const f8_ ab = __builtin_shufflevector(a, b, 0, 1, 2, 3, 4, 5, 6, 7), cd = __builtin_shufflevector(c, d, 0, 1, 2, 3, 4, 5, 6, 7); p1 = __builtin_shufflevector(ab, cd, 0, 1, 2, 3, 4, 5, 6, 7, 8, 9, 10, 11, 12, 13, 14, 15); } \
      asm volatile("" : "+v"(p0), "+v"(p1)); SBAR(); } while (0)
  SDMA8(0, 0); SDMA8(1, 1); SDMA8(2, 2); if (half) SDMA8(3, 3);
  VMWAIT8(0); BARL8();
  CIN_SET8();
  KREAD8(0); QK8(0);
  SBAR(); asm volatile("s_nop 15\n\ts_nop 15\n\ts_nop 15\n\ts_nop 15\n\ts_nop 15\n\ts_nop 15" ::: "memory"); SBAR();
  softmax8<true>(p0, p1, M_run, al, pf);
  CIN_SET8();
  if (half) BARL8();
  int sw = (3 + half) & 3;
#define MSEG8(KO, VO) do { \
    if constexpr (NS == 2) { \
      k00 = rd128<(KO)>(ka00); k01 = rd128<(KO)>(ka01); k10 = rd128<(KO) + 32 * DQK>(ka00); k11 = rd128<(KO) + 32 * DQK>(ka01); k20 = rd128<(KO)>(ka10); k21 = rd128<(KO)>(ka11); \
      LWAIT8(4); MFMA8QC(p0, cat8(k00, k01), qf[0], cin); k30 = rd128<(KO) + 32 * DQK>(ka10); k31 = rd128<(KO) + 32 * DQK>(ka11); \
      LWAIT8(4); MFMA8QC(p1, cat8(k10, k11), qf[0], cin); v00 = rd128<(VO)>(va0); v01 = rd128<(VO)>(va1); \
      LWAIT8(4); MFMA8Q(p0, cat8(k20, k21), qf[NS - 1]); v10 = rd128<(VO) + 2048>(va0); v11 = rd128<(VO) + 2048>(va1); \
      LWAIT8(4); MFMA8Q(p1, cat8(k30, k31), qf[NS - 1]); k00 = rd128<(VO) + 4096>(va0); k01 = rd128<(VO) + 4096>(va1); \
      MFMA16S(osum, pf, sel8); k10 = rd128<(VO) + 6144>(va0); k11 = rd128<(VO) + 6144>(va1); \
      LWAIT8(6); MFMA8(o[0], pf, cat8(v00, v01)); LWAIT8(4); MFMA8(o[1], pf, cat8(v10, v11)); LWAIT8(2); MFMA8(o[2], pf, cat8(k00, k01)); LWAIT8(0); MFMA8(o[3], pf, cat8(k10, k11)); \
    } else { \
      k00 = rd128<(KO)>(ka00); k01 = rd128<(KO)>(ka01); k10 = rd128<(KO) + 32 * DQK>(ka00); k11 = rd128<(KO) + 32 * DQK>(ka01); v00 = rd128<(VO)>(va0); v01 = rd128<(VO)>(va1); \
      LWAIT8(4); MFMA8QC(p0, cat8(k00, k01), qf[0], cin); v10 = rd128<(VO) + 2048>(va0); v11 = rd128<(VO) + 2048>(va1); \
      LWAIT8(4); MFMA8QC(p1, cat8(k10, k11), qf[0], cin); k20 = rd128<(VO) + 4096>(va0); k21 = rd128<(VO) + 4096>(va1); \
      MFMA16S(osum, pf, sel8); k30 = rd128<(VO) + 6144>(va0); k31 = rd128<(VO) + 6144>(va1); \
      LWAIT8(6); MFMA8(o[0], pf, cat8(v00, v01)); LWAIT8(4); MFMA8(o[1], pf, cat8(v10, v11)); LWAIT8(2); MFMA8(o[2], pf, cat8(k20, k21)); LWAIT8(0); MFMA8(o[3], pf, cat8(k30, k31)); } } while (0)
#define STEP8(KS, VS, jj) do { \
    MSEG8((KS) * SLOT, (VS) * SLOT); \
    BARL8(); \
    softmax8<false>(p0, p1, M_run, al, pf); RESC8(al); \
    { const int t = (jj) + 3 + half; if (t < NT) { SDMA8(t, sw); VMWAIT8(2); } else VMWAIT8(0); } \
    BARL8(); \
    sw = (sw + 1) & 3; } while (0)
  int j = 0;
  for (; j + 4 < NT; j += 4) { STEP8(1, 0, j); STEP8(2, 1, j + 1); STEP8(3, 2, j + 2); STEP8(0, 3, j + 3); }
  if (j + 1 < NT) { STEP8(1, 0, j); ++j; }
  if (j + 1 < NT) { STEP8(2, 1, j); ++j; }
  if (j + 1 < NT) { STEP8(3, 2, j); ++j; }
  const int sv = j & 3;
#undef STEP8
#undef MSEG8
#undef ACC_INIT8
#undef CIN_SET8
  VREAD8A(sv * SLOT); VREAD8B(sv * SLOT); PV8();
  SBAR(); asm volatile("s_nop 15\n\ts_nop 15\n\ts_nop 15\n\ts_nop 15\n\ts_nop 15\n\ts_nop 15" ::: "memory"); SBAR();
  if (!half) BARL8();
  float rli[16];
  { if ((lane & 15) < 2) *(f32x4*)(al_l + (lane & 15) * 16 + 4 * (lane >> 4)) = (f32x4){osum[0], osum[1], osum[2], osum[3]};
    asm volatile("s_waitcnt lgkmcnt(0)" ::: "memory");
#pragma unroll
    for (int g = 0; g < 4; ++g) { const f32x4 a4 = *(const f32x4*)(al_l + 8 * g + 4 * hi);
#pragma unroll
      for (int i = 0; i < 4; ++i) rli[4 * g + i] = __builtin_amdgcn_rcpf(a4[i]); } }
  unsigned char* Ow = Ob + (long)(wid * QBLK) * LDO;
  if constexpr (!DIFF) {
#pragma unroll
    for (int r = 0; r < 16; ++r) { int orow = crow(r, hi);
#pragma unroll
      for (int d0 = 0; d0 < 4; ++d0) { const float v_ = o[d0][r] * (rli[r] * OS_GQA); Ow[(long)orow * LDO + d0 * 32 + r32] = (unsigned char)__builtin_amdgcn_cvt_pk_fp8_f32(v_, v_, 0, false); } }
  } else {
    char* stash = lds + RD * SLOT + 2048 + wid * 8192 + lane * 16;
    if (dmode == 0) {
#pragma unroll
      for (int q = 0; q < 8; ++q) { const int d0 = q >> 1, r0 = (q & 1) * 8; i32x4 w;
#pragma unroll
        for (int i = 0; i < 4; ++i) w[i] = (int)att::cvtpk(o[d0][r0 + 2 * i] * rli[r0 + 2 * i], o[d0][r0 + 2 * i + 1] * rli[r0 + 2 * i + 1]);
        *(i32x4*)(stash + q * 1024) = w; }
    } else {
      float ss[16];
#pragma unroll
      for (int r = 0; r < 16; ++r) ss[r] = 0.f;
#pragma unroll
      for (int q = 0; q < 8; ++q) { const int d0 = q >> 1, r0 = (q & 1) * 8; const i32x4 w = *(const i32x4*)(stash + q * 1024);
#pragma unroll
        for (int i = 0; i < 4; ++i) { const int r = r0 + 2 * i;
          const float a = bflo((unsigned)w[i]) - lam * (o[d0][r] * rli[r]), b = bfhi((unsigned)w[i]) - lam * (o[d0][r + 1] * rli[r + 1]);
          o[d0][r] = a; o[d0][r + 1] = b; ss[r] += a * a; ss[r + 1] += b * b; } }
      float sg[4];
#pragma unroll
      for (int d0 = 0; d0 < 4; ++d0) sg[d0] = subg[d0 * 32 + r32] * ((1.f - LAM_INIT) * OS_DIFF);
#pragma unroll
      for (int r = 0; r < 16; ++r) { float s = ss[r];
#pragma unroll
        for (int x = 1; x < 32; x <<= 1) s += __shfl_xor(s, x);
        const float rs = rsqrtf(s * (1.f / 128.f) + RMS_EPS * (GS_DIFF * GS_DIFF)); const int orow = crow(r, hi);
#pragma unroll
        for (int d0 = 0; d0 < 4; ++d0) { const float v_ = o[d0][r] * rs * sg[d0]; Ow[(long)orow * LDO + d0 * 32 + r32] = (unsigned char)__builtin_amdgcn_cvt_pk_fp8_f32(v_, v_, 0, false); } }
    }
  }
  BARL8();
#undef GLDS16
#undef SDMA8
#undef VMWAIT8
#undef BARL8
#undef LWAIT8
#undef LWAIT8_
#undef RESC8
#undef MFMA8
#undef MFMA8Q
#undef MFMA16S
#undef KREAD8
#undef VREAD8A
#undef VREAD8B
#undef KREAD8C
#undef VREAD8AC
#undef VREAD8BC
#undef QK8
#undef PV8
}
#undef SBAR
}
#define XB_TMO      128
#define XB_XCNT(j)  (256  + 64 * (j))
#define XB_XSUB(j)  (1280 + 64 * (j))
#define XB_XGEN(j)  (2304 + 64 * (j))
#define XB_TOP      3328
#define XB_TOPGEN   3392
#define XCD_BAR_WORDS 3456
#define XB_SPIN_CAP (1u << 18)

__device__ __forceinline__ unsigned xb_ld(unsigned* p)              { return __hip_atomic_load(p, __ATOMIC_RELAXED, __HIP_MEMORY_SCOPE_AGENT); }
__device__ __forceinline__ unsigned xb_add(unsigned* p, unsigned v) { return __hip_atomic_fetch_add(p, v, __ATOMIC_RELAXED, __HIP_MEMORY_SCOPE_AGENT); }
__device__ __forceinline__ unsigned xb_xcc_id() { return (unsigned)__builtin_amdgcn_s_getreg((3 << 11) | 20) & 0xFu; }
#define XB_SPIN(cond, bar) do { unsigned _sp = 0; while (cond) { __builtin_amdgcn_s_sleep(1); \
    if ((++_sp & 255u) == 0u) { if (xb_ld(&(bar)[XB_TMO])) break; if (_sp > XB_SPIN_CAP) { atomicAdd(&(bar)[XB_TMO], 1u); break; } } } } while (0)

struct XcdBarrier {
    unsigned* bar; unsigned x;
    volatile LAS unsigned* st;
};

__device__ __forceinline__ XcdBarrier xcd_barrier_post(unsigned* bar, volatile LAS unsigned* st) {
    XcdBarrier b; b.bar = bar; b.x = xb_xcc_id(); b.st = st;
    if (threadIdx.x == 0) (void)xb_add(&bar[XB_XCNT(b.x)], 1u);
    return b;
}
__device__ __forceinline__ void xcd_barrier_complete(unsigned* bar, unsigned x, unsigned& nloc, unsigned& nx) {
    const unsigned G = gridDim.x * gridDim.y * gridDim.z;
    unsigned sum, cnt, mine, sp = 0u;
    for (;;) {
        sum = 0u; cnt = 0u; mine = 0u;
#pragma unroll
        for (unsigned j = 0; j < 16; ++j) { const unsigned c = xb_ld(&bar[XB_XCNT(j)]); sum += c; cnt += (c > 0u) ? 1u : 0u; mine = (j == x) ? c : mine; }
        if (sum == G) break;
        __builtin_amdgcn_s_sleep(1);
        if ((++sp & 255u) == 0u) { if (xb_ld(&bar[XB_TMO])) break; if (sp > XB_SPIN_CAP) { atomicAdd(&bar[XB_TMO], 1u); break; } }
    }
    nloc = mine > 0u ? mine : 1u; nx = cnt > 0u ? cnt : 1u;
}

__device__ __forceinline__ void xcd_barrier(const XcdBarrier& b) {
    asm volatile("s_waitcnt vmcnt(0)" ::: "memory");
    __syncthreads();
    if (threadIdx.x == 0) {
        unsigned* bar = b.bar;
        __builtin_amdgcn_s_waitcnt(0);
        unsigned nloc = b.st[0], nx = b.st[1];
        if (nloc == 0u) { xcd_barrier_complete(bar, b.x, nloc, nx); b.st[0] = nloc; b.st[1] = nx; }
        const unsigned old = xb_add(&bar[XB_XSUB(b.x)], 1u);
        const unsigned gen = old / nloc;
        if (old + 1u == (gen + 1u) * nloc) {
            __builtin_amdgcn_fence(__ATOMIC_RELEASE, "agent");
            asm volatile("s_waitcnt vmcnt(0)" ::: "memory");
            const unsigned og = xb_add(&bar[XB_TOP], 1u);
            const unsigned tg = og / nx;
            if (og + 1u == (tg + 1u) * nx) xb_add(&bar[XB_TOPGEN], 1u);
            else XB_SPIN(xb_ld(&bar[XB_TOPGEN]) == tg, bar);
            __builtin_amdgcn_fence(__ATOMIC_ACQUIRE, "agent");
            xb_add(&bar[XB_XGEN(b.x)], 1u);
            asm volatile("s_waitcnt vmcnt(0)" ::: "memory");
        } else {
            XB_SPIN(xb_ld(&bar[XB_XGEN(b.x)]) == gen, bar);
            __builtin_amdgcn_fence(__ATOMIC_ACQUIRE, "agent");
            asm volatile("s_waitcnt vmcnt(0)" ::: "memory");
        }
    }
    __syncthreads();
}

constexpr int NWAVES = 8;
constexpr int N_PHASES = 36;
#ifndef MK_STOP
#define MK_STOP N_PHASES
#endif
#ifndef ATT_SDEPTH
#define ATT_SDEPTH 1
#endif
#ifndef G1_PROBE
#define G1_PROBE 0
#endif
#ifndef ATT_PROBE
#define ATT_PROBE 0
#endif
#ifndef REP_MASK
#define REP_MASK 0
#endif
constexpr size_t WS_JUNK = WS_END - WS_GATE;
constexpr float W8_SCALE = 32.f;
constexpr float QSCALE128 = 8.f * 0.088388347648318440f * 1.4426950408889634f, QSCALE64 = 8.f * 0.125f * 1.4426950408889634f;
#ifndef SM_MASK
#define SM_MASK 127
#endif
#ifndef PRO_PARTS
#define PRO_PARTS 15
#endif
#ifndef MK_MULTI
#define MK_MULTI 0
#endif

struct Args { const float* in[N_IN]; float* out; unsigned char* ws; int ph_lo, ph_hi, dump, pad; };
static_assert(sizeof(Args) == N_IN * 8 + 8 + 8 + 16, "Args has no padding");
typedef const __attribute__((address_space(4))) Args* KArgs;
struct Frame {
    LAS unsigned char* lds;
    char* ldsg;
    int tid, lane, wave, vcu, G, gw, NGW;
    KArgs kp;
    __device__ __forceinline__ const float* in(int i) const { return kp->in[i]; }
    __device__ __forceinline__ float* out() const { return kp->out; }
    __device__ __forceinline__ unsigned char* ws() const { return kp->ws; }
    __device__ __forceinline__ unsigned* ctl() const { return (unsigned*)(kp->ws + WS_CTL); }
};
__device__ __forceinline__ bool refresh(Frame& F) { int t = threadIdx.x; asm volatile("" : "+v"(t)); F.tid = t; F.lane = t & 63; KArgs k = (KArgs)__builtin_amdgcn_kernarg_segment_ptr(); asm volatile("" : "+s"(k)); F.kp = k; return true; }
__device__ __forceinline__ const float* input_row(const Frame& F, int row) {
    const int b = row >= SB ? 1 : 0, w = row - b * SB;
    return (w < NCTX) ? F.in(I_CTX) + ((size_t)(b * NCTX + w)) * D : F.in(I_X) + ((size_t)(b * SEQ + (w - NCTX))) * D;
}
__device__ __forceinline__ int stream_of(int row) { const int b = row >= SB ? 1 : 0, w = row - b * SB; return (w < NCTX) ? 2 : b; }
__device__ __forceinline__ const float* modp(const Frame& F, int layer, int s, int chunk) { return (const float*)(F.ws() + WS_MOD) + ((size_t)(layer * 3 + s) * 6 + chunk) * D; }
__device__ __forceinline__ const float* normg(const Frame& F, int layer, int k) { return F.in(I_NORMG) + (size_t)(layer * 4 + k) * D; }

__device__ __forceinline__ void ld_row_f32(const float* p, int lane, f32x4 (&v)[4]) {
#pragma unroll
    for (int j = 0; j < 4; ++j) v[j] = *(const f32x4*)(p + 256 * j + 4 * lane);
}
__device__ __forceinline__ void st_row_f32(float* p, int lane, const f32x4 (&v)[4]) {
#pragma unroll
    for (int j = 0; j < 4; ++j) *(f32x4*)(p + 256 * j + 4 * lane) = v[j];
}
__device__ __forceinline__ void ld_row_bf16(const bf16_t* p, int lane, f32x4 (&v)[4]) {
#pragma unroll
    for (int j = 0; j < 4; ++j) { const u32x2 w = *(const u32x2*)(p + 256 * j + 4 * lane); v[j] = (f32x4){bflo(w.x), bfhi(w.x), bflo(w.y), bfhi(w.y)}; }
}
__device__ __forceinline__ void ld_row_fp8(const unsigned char* p, int lane, f32x4 (&v)[4]) {
#pragma unroll
    for (int j = 0; j < 4; ++j) { const int w = *(const int*)(p + 256 * j + 4 * lane);
        v[j] = (f32x4){__builtin_amdgcn_cvt_f32_fp8(w, 0), __builtin_amdgcn_cvt_f32_fp8(w, 1), __builtin_amdgcn_cvt_f32_fp8(w, 2), __builtin_amdgcn_cvt_f32_fp8(w, 3)}; }
}
__device__ __forceinline__ void st_row_bf16(bf16_t* p, int lane, const f32x4 (&v)[4]) {
#pragma unroll
    for (int j = 0; j < 4; ++j) { u32x2 w; w.x = pkbf(v[j].x, v[j].y); w.y = pkbf(v[j].z, v[j].w); *(u32x2*)(p + 256 * j + 4 * lane) = w; }
}
__device__ __forceinline__ float row_ss(const f32x4 (&v)[4]) {
    float s = 0.f;
#pragma unroll
    for (int j = 0; j < 4; ++j) s += (v[j].x * v[j].x + v[j].y * v[j].y) + (v[j].z * v[j].z + v[j].w * v[j].w);
    return wave_sum(s);
}
__device__ __forceinline__ void modnorm(const f32x4 (&v)[4], const float* g, const float* m1, const float* m0, int lane, f32x4 (&h)[4]) {
    const float r = rsqrtf(row_ss(v) * (1.f / D) + RMS_EPS);
#pragma unroll
    for (int j = 0; j < 4; ++j) { const f32x4 gv = *(const f32x4*)(g + 256 * j + 4 * lane), a = *(const f32x4*)(m1 + 256 * j + 4 * lane), b = *(const f32x4*)(m0 + 256 * j + 4 * lane);
        h[j] = (v[j] * r) * gv * (a + 1.f) + b; }
}

__device__ __forceinline__ void tr_item(const float* W, int K, int N, bf16_t* WT, int k0, int n0, int dst_row0, LAS float* scr, int lane, const float* colscale = nullptr) {
    float tmp[32]; const float csv = colscale ? colscale[lane & 31] : 1.f;
#pragma unroll
    for (int i = 0; i < 32; ++i) { const int kk = 2 * i + (lane >> 5); tmp[i] = W[(size_t)(k0 + kk) * N + n0 + (lane & 31)]; }
#pragma unroll
    for (int i = 0; i < 32; ++i) { const int kk = 2 * i + (lane >> 5); scr[kk * 33 + (lane & 31)] = tmp[i] * csv; }
    LDS_WAIT(); asm volatile("" ::: "memory");
    const int c = lane & 7;
#pragma unroll
    for (int j = 0; j < 4; ++j) { const int n = (lane >> 3) + 8 * j; const LAS float* s = scr + (8 * c) * 33 + n;
        u32x4 o; o.x = pkbf(s[0 * 33], s[1 * 33]); o.y = pkbf(s[2 * 33], s[3 * 33]); o.z = pkbf(s[4 * 33], s[5 * 33]); o.w = pkbf(s[6 * 33], s[7 * 33]);
        *(u32x4*)(WT + (size_t)(dst_row0 + n) * K + k0 + 8 * c) = o; }
    LDS_WAIT(); asm volatile("" ::: "memory");
}
__device__ __forceinline__ void tr_item8(const float* W, int K, int N, unsigned char* WT, int k0, int n0, int dst_row0, LAS float* scr, int lane, float wscale) {
    float tmp[32];
#pragma unroll
    for (int i = 0; i < 32; ++i) { const int kk = 2 * i + (lane >> 5); tmp[i] = W[(size_t)(k0 + kk) * N + n0 + (lane & 31)]; }
#pragma unroll
    for (int i = 0; i < 32; ++i) { const int kk = 2 * i + (lane >> 5); scr[kk * 33 + (lane & 31)] = tmp[i] * wscale; }
    LDS_WAIT(); asm volatile("" ::: "memory");
    const int c = lane & 7;
#pragma unroll
    for (int j = 0; j < 4; ++j) { const int n = (lane >> 3) + 8 * j; const LAS float* s = scr + (8 * c) * 33 + n;
        int w0 = 0, w1 = 0; w0 = __builtin_amdgcn_cvt_pk_fp8_f32(s[0 * 33], s[1 * 33], w0, false); w0 = __builtin_amdgcn_cvt_pk_fp8_f32(s[2 * 33], s[3 * 33], w0, true);
        w1 = __builtin_amdgcn_cvt_pk_fp8_f32(s[4 * 33], s[5 * 33], w1, false); w1 = __builtin_amdgcn_cvt_pk_fp8_f32(s[6 * 33], s[7 * 33], w1, true);
        *(u32x2*)(WT + (size_t)(dst_row0 + n) * K + k0 + 8 * c) = (u32x2){(unsigned)w0, (unsigned)w1}; }
    LDS_WAIT(); asm volatile("" ::: "memory");
}
__device__ __forceinline__ void tr_plain(const float* W, int K, int N, bf16_t* WT, int row_off, LAS float* scr, int item, int lane, const float* colscale = nullptr) {
    const int nblk = N / 32, kb = item / nblk, nb = item - kb * nblk;
    tr_item(W, K, N, WT, 64 * kb, 32 * nb, row_off + 32 * nb, scr, lane, colscale ? colscale + 32 * nb : nullptr);
}
__device__ __forceinline__ void tr_plain8(const float* W, int K, int N, unsigned char* WT, LAS float* scr, int item, int lane) {
    const int nblk = N / 32, kb = item / nblk, nb = item - kb * nblk;
    tr_item8(W, K, N, WT, 64 * kb, 32 * nb, 32 * nb, scr, lane, W8_SCALE);
}
__device__ __forceinline__ void p0_prologue(Frame& F) {
    {
        LAS float* sv = (LAS float*)(F.lds);
        LAS float* red = (LAS float*)(F.lds + 16384);
        if ((PRO_PARTS & 1) && F.vcu < 192) {
            for (int i = F.tid; i < 3 * D; i += 512) { const int s = i >> 10, k = i & 1023; const float c = (s < 2) ? F.in(I_C)[s * D + k] : F.in(I_CCTX)[k]; sv[i] = c / (1.f + __expf(-c)); }
            __syncthreads();
            for (int task = F.vcu; task < 192; task += F.G) {
                const int layer = task / 48, n0 = (task % 48) * 128;
                const int tx = F.tid & 31, ty = F.tid >> 5;
                const float* wp = F.in(I_MODW) + ((size_t)layer * D + ty * 64) * 6144 + n0 + 4 * tx;
                f32x4 a0 = {0, 0, 0, 0}, a1 = a0, a2 = a0;
#pragma unroll 8
                for (int k = 0; k < 64; ++k) { const f32x4 w = *(const f32x4*)(wp + (size_t)k * 6144); const int kk = ty * 64 + k;
                    a0 += w * sv[kk]; a1 += w * sv[D + kk]; a2 += w * sv[2 * D + kk]; }
                *(LAS f32x4*)(red + (ty * 3 + 0) * 128 + 4 * tx) = a0; *(LAS f32x4*)(red + (ty * 3 + 1) * 128 + 4 * tx) = a1; *(LAS f32x4*)(red + (ty * 3 + 2) * 128 + 4 * tx) = a2;
                __syncthreads();
                if (F.tid < 384) { const int s = F.tid >> 7, n = F.tid & 127; float acc = F.in(I_MODB)[layer * 6144 + n0 + n];
#pragma unroll
                    for (int y = 0; y < 16; ++y) acc += red[(y * 3 + s) * 128 + n];
                    ((float*)(F.ws() + WS_MOD))[((size_t)(layer * 3 + s)) * 6144 + n0 + n] = acc; }
                __syncthreads();
            }
        }
        __syncthreads();
    }
    { bf16_t* b1h = (bf16_t*)(F.ws() + WS_B1H); bf16_t* b2h = (bf16_t*)(F.ws() + WS_B2H); const float* b1 = F.in(I_B1); const float* b2 = F.in(I_B2);
      const int gt = F.vcu * (NWAVES * 64) + F.tid, ngt = F.G * NWAVES * 64;
      for (int i = gt; i < 4 * NE * 2048 / 2; i += ngt) ((unsigned*)b1h)[i] = pkbf(b1[2 * i], b1[2 * i + 1]);
      for (int i = gt; i < 4 * NE * 1024 / 2; i += ngt) ((unsigned*)b2h)[i] = pkbf(b2[2 * i], b2[2 * i + 1]); }
    LAS float* scr = (LAS float*)(F.lds + F.wave * 16384);
    if (PRO_PARTS & 2) {
        constexpr int I_POOL = 4 * (256 / 64) * (256 / 32);
        constexpr int I_GQ = 16 * 48, I_SQ = 16 * 32, I_W3 = 16 * 96;
        constexpr int NSMALL = I_POOL + I_GQ + I_SQ + I_W3 + I_SQ + I_W3 + I_SQ;
        for (int it = F.gw; it < NSMALL; it += F.NGW) {
            int r = it;
            if (r < I_POOL) { if (!(SM_MASK & 1)) continue; const int g = r >> 5; tr_plain(F.in(I_POOLW) + (size_t)g * 65536, 256, 256, (bf16_t*)(F.ws() + WS_POOLW), g * 256, scr, r & 31, F.lane, F.in(I_POOLS) + g * 256); continue; } r -= I_POOL;
            if (r < I_GQ) { if (!(SM_MASK & 2)) continue; tr_plain8(F.in(I_GQKV), D, 1536, F.ws() + WS_GQKV, scr, r, F.lane); continue; } r -= I_GQ;
            if (r < I_SQ) { if (!(SM_MASK & 4)) continue; tr_plain8(F.in(I_GO), D, D, F.ws() + WS_GO, scr, r, F.lane); continue; } r -= I_SQ;
            if (r < I_W3) { if (!(SM_MASK & 8)) continue; tr_plain8(F.in(I_CIN), D, 3072, F.ws() + WS_CIN, scr, r, F.lane); continue; } r -= I_W3;
            if (r < I_SQ) { if (!(SM_MASK & 16)) continue; tr_plain8(F.in(I_COUT), D, D, F.ws() + WS_COUT, scr, r, F.lane); continue; } r -= I_SQ;
            if (r < I_W3) { if (!(SM_MASK & 32)) continue; tr_plain8(F.in(I_DQKV), D, 3072, F.ws() + WS_DQKV, scr, r, F.lane); continue; } r -= I_W3;
            if (!(SM_MASK & 64)) continue; tr_plain8(F.in(I_DO), D, D, F.ws() + WS_DO, scr, r, F.lane);
        }
    }
    if (PRO_PARTS & 12) {
        constexpr int NI1 = 128 * 1024, NIT = NI1 + 128 * 512;
        float cur[32], nxt[32];
#define XW_DECODE(it_) const bool w1_ = (it_) < NI1; const int r2_ = w1_ ? (it_) : (it_) - NI1; const int mat_ = w1_ ? (r2_ >> 10) : (r2_ >> 9), rr_ = w1_ ? (r2_ & 1023) : (r2_ & 511), kb_ = w1_ ? (rr_ >> 7) : (rr_ >> 6), n0_ = 16 * (w1_ ? (rr_ & 127) : (rr_ & 63)), N_ = w1_ ? 2048 : 1024; \
        const float* W_ = w1_ ? F.in(I_W1) + (size_t)mat_ * D * 2048 : F.in(I_W2) + (size_t)mat_ * D * D;
#define XW_LOAD(it_, buf) do { XW_DECODE(it_) _Pragma("unroll") for (int i = 0; i < 32; ++i) { const int kk = 4 * i + (F.lane >> 4); buf[i] = W_[(size_t)(128 * kb_ + kk) * N_ + n0_ + (F.lane & 15)]; } } while (0)
        int it = F.gw;
        if (it < NIT) XW_LOAD(it, cur);
        for (; it < NIT; it += F.NGW) {
            const int itn = it + F.NGW;
            if (itn < NIT) XW_LOAD(itn, nxt);
            XW_DECODE(it)
            const int drow = w1_ ? (mat_ * 2048 + ((n0_ & 1023) >> 7) * 256 + (n0_ >> 10) * 128 + (n0_ & 127)) : (mat_ * 1024 + n0_);
            unsigned char* WT = F.ws() + (w1_ ? WS_W1T : WS_W2T);
#pragma unroll
            for (int i = 0; i < 32; ++i) { const int kk = 4 * i + (F.lane >> 4); scr[kk * 17 + (F.lane & 15)] = cur[i] * W8_SCALE; }
            LDS_WAIT(); asm volatile("" ::: "memory");
            { const int n = F.lane >> 2, c = F.lane & 3; const LAS float* s = scr + (32 * c) * 17 + n; unsigned o8[8];
#pragma unroll
              for (int q = 0; q < 8; ++q) { int w0 = 0; w0 = __builtin_amdgcn_cvt_pk_fp8_f32(s[(4 * q) * 17], s[(4 * q + 1) * 17], w0, false); w0 = __builtin_amdgcn_cvt_pk_fp8_f32(s[(4 * q + 2) * 17], s[(4 * q + 3) * 17], w0, true); o8[q] = (unsigned)w0; }
              unsigned char* d = WT + (size_t)(drow + n) * D + 128 * kb_ + 32 * c;
              *(u32x4*)d = (u32x4){o8[0], o8[1], o8[2], o8[3]}; *(u32x4*)(d + 16) = (u32x4){o8[4], o8[5], o8[6], o8[7]}; }
            LDS_WAIT(); asm volatile("" ::: "memory");
#pragma unroll
            for (int i = 0; i < 32; ++i) cur[i] = nxt[i];
        }
#undef XW_DECODE
#undef XW_LOAD
    }
    __syncthreads();
}

template <bool DRY> __device__ __forceinline__ void p_hpass0(Frame& F) {
    bf16_t* H = (bf16_t*)(F.ws() + WS_H + (DRY ? WS_JUNK : 0));
    int cs = -1; f32x4 pg[4], p0v[4];
    for (int rr = F.gw; rr < T; rr += 2 * F.NGW) {
        const int r0 = rr, r1 = min(rr + F.NGW, T - 1);
        f32x4 v0[4], v1[4], h[4]; ld_row_f32(input_row(F, r0), F.lane, v0); ld_row_f32(input_row(F, r1), F.lane, v1);
#define HP_ROW(v_, r_) do { const int s = stream_of(r_); if (s != cs) { cs = s; const float* gn = normg(F, 0, 0); const float* m1n = modp(F, 0, s, 1); const float* m0n = modp(F, 0, s, 0); \
            _Pragma("unroll") for (int j = 0; j < 4; ++j) { const int o = 256 * j + 4 * F.lane; pg[j] = *(const f32x4*)(gn + o) * (*(const f32x4*)(m1n + o) + 1.f); p0v[j] = *(const f32x4*)(m0n + o); } } \
          const float rx = rsqrtf(row_ss(v_) * (1.f / D) + RMS_EPS); _Pragma("unroll") for (int j = 0; j < 4; ++j) h[j] = (v_[j] * rx) * pg[j] + p0v[j]; st_row_bf16(H + (size_t)(r_) * D, F.lane, h); } while (0)
        HP_ROW(v0, r0); HP_ROW(v1, r1);
#undef HP_ROW
    }
}
template <bool DRY> __device__ __forceinline__ void p_poolprep(Frame& F) {
    const bf16_t* H = (const bf16_t*)(F.ws() + WS_H); bf16_t* Dp = (bf16_t*)(F.ws() + WS_O + (DRY ? WS_JUNK : 0));
    for (int row = F.gw; row < T; row += F.NGW) {
        const int b = row >= SB ? 1 : 0, w = row - b * SB;
        const int s0 = (w < NCTX) ? b * SB : b * SB + NCTX, s1 = (w < NCTX) ? b * SB + NCTX : (b + 1) * SB;
#pragma unroll
        for (int j = 0; j < 4; ++j) {
            constexpr int dummy = 0; (void)dummy;
            const int half = 1 << j;
            const int lo = max(row - half, s0), hi = min(row + half, s1);
            u32x2 q[16];
#pragma unroll
            for (int i = 0; i < 2 * half; ++i) { const int rr = row - half + i; const int rc = (rr >= lo && rr < hi) ? rr : row; q[i] = *(const u32x2*)(H + (size_t)rc * D + 256 * j + 4 * F.lane); }
            const u32x2 qs = *(const u32x2*)(H + (size_t)row * D + 256 * j + 4 * F.lane);
            f32x4 acc = {0, 0, 0, 0};
#pragma unroll
            for (int i = 0; i < 2 * half; ++i) { const int rr = row - half + i; const float wgt = (rr >= lo && rr < hi) ? 1.f : 0.f; acc += (f32x4){bflo(q[i].x), bfhi(q[i].x), bflo(q[i].y), bfhi(q[i].y)} * wgt; }
            const f32x4 self = {bflo(qs.x), bfhi(qs.x), bflo(qs.y), bfhi(qs.y)};
            const f32x4 d = acc * (1.f / (float)(hi - lo)) - self;
            u32x2 o; o.x = pkbf(d.x, d.y); o.y = pkbf(d.z, d.w);
            *(u32x2*)(Dp + ((size_t)j * T + row) * 256 + 4 * F.lane) = o;
        }
    }
}

template <int L>
__device__ __forceinline__ void p_moe_a(Frame& F, const bool DRY) {
    const bf16_t* Y = (const bf16_t*)(F.ws() + WS_Y); const bf16_t* X = (const bf16_t*)(F.ws() + WS_X); bf16_t* Xo = (bf16_t*)(F.ws() + WS_X + (DRY ? WS_JUNK : 0)); unsigned char* H8 = F.ws() + WS_H + (DRY ? WS_JUNK : 0);
    float* gate = (float*)(F.ws() + WS_GATE + (DRY ? WS_JUNK : 0)); int* list = (int*)(F.ws() + WS_LIST);
    LAS float* hbuf = (LAS float*)(F.lds);
    LAS float* part = (LAS float*)(F.lds + 65536);
    LAS int* sel = (LAS int*)(F.lds + 83968);
    LAS int* lcnt = (LAS int*)(F.lds + LC_LCNT); LAS int* gbase = (LAS int*)(F.lds + LC_GBASE);
    const float* g1 = normg(F, L, 1); const float* g2 = normg(F, L, 2);
    const float* rw = F.in(I_RW) + (size_t)L * D * NE; const float* rb = F.in(I_RB) + L * NE;
    const int e = F.lane & 31, kh = F.lane >> 5;
    typedef short rbf16x8 __attribute__((ext_vector_type(8)));
    rbf16x8 wh[4][2], wl[4][2];
#pragma unroll
    for (int s = 0; s < 4; ++s)
#pragma unroll
        for (int n = 0; n < 2; ++n) { unsigned hw[4], lw[4];
#pragma unroll
            for (int q = 0; q < 4; ++q) { const int k = 128 * F.wave + 32 * s + 8 * (F.lane >> 4) + 2 * q; const float w0 = rw[(size_t)k * NE + 16 * n + (F.lane & 15)], w1 = rw[(size_t)(k + 1) * NE + 16 * n + (F.lane & 15)];
                hw[q] = pkbf(w0, w1); lw[q] = pkbf(w0 - bflo(hw[q]), w1 - bfhi(hw[q])); }
            const u32x4 hv = {hw[0], hw[1], hw[2], hw[3]}, lv = {lw[0], lw[1], lw[2], lw[3]}; wh[s][n] = __builtin_bit_cast(rbf16x8, hv); wl[s][n] = __builtin_bit_cast(rbf16x8, lv); }
    const float bias = rb[e];
    if (F.tid < 32) lcnt[F.tid] = 0;
    __syncthreads();
    constexpr int NRA = (L == 3) ? NB * SEQ : T;
#define MA_ROW(n_) ((L == 3) ? (((n_) >> 14) * SB + NCTX + ((n_) & (SEQ - 1))) : (n_))
    const int chunk = (NRA + F.G - 1) / F.G, tok0 = min(NRA, (int)blockIdx.x * chunk), tok1 = min(NRA, tok0 + chunk);
    int cs = -1; f32x4 qm[4], qg[4], q0v[4];
    f32x4 y[2][4], x[2][4];
#define MA_LOAD(base_) do { _Pragma("unroll") for (int tt = 0; tt < 2; ++tt) { const int tok_ = (base_) + F.wave * 2 + tt; if (tok_ < tok1) { \
        const int row_ = MA_ROW(tok_); ld_row_bf16(Y + (size_t)row_ * D, F.lane, y[tt]); if constexpr (L == 0) ld_row_f32(input_row(F, row_), F.lane, x[tt]); else ld_row_bf16(X + (size_t)row_ * D, F.lane, x[tt]); } } } while (0)
    MA_LOAD(tok0);
    for (int base = tok0; base < tok1; base += 16) {
#pragma unroll
        for (int tt = 0; tt < 2; ++tt) {
            const int tl = F.wave * 2 + tt, tok = base + tl;
            if (tok < tok1) {
                const int row = MA_ROW(tok), s = stream_of(row);
                f32x4 h[4];
                if (s != cs) { cs = s; const float* m2 = modp(F, L, s, 2); const float* m4 = modp(F, L, s, 4); const float* m3 = modp(F, L, s, 3);
#pragma unroll
                    for (int j = 0; j < 4; ++j) { const int o = 256 * j + 4 * F.lane; qm[j] = *(const f32x4*)(m2 + o) * *(const f32x4*)(g1 + o); qg[j] = *(const f32x4*)(g2 + o) * (*(const f32x4*)(m4 + o) + 1.f); q0v[j] = *(const f32x4*)(m3 + o); } }
                const float ry = rsqrtf(row_ss(y[tt]) * (1.f / D) + RMS_EPS);
#pragma unroll
                for (int j = 0; j < 4; ++j) x[tt][j] = x[tt][j] + qm[j] * (y[tt][j] * ry);
                st_row_bf16(Xo + (size_t)row * D, F.lane, x[tt]);
                { const float rx = rsqrtf(row_ss(x[tt]) * (1.f / D) + RMS_EPS);
#pragma unroll
                  for (int j = 0; j < 4; ++j) h[j] = (x[tt][j] * rx) * qg[j] + q0v[j]; }
#pragma unroll
                for (int j = 0; j < 4; ++j) { int w = 0; w = __builtin_amdgcn_cvt_pk_fp8_f32(h[j].x, h[j].y, w, false); w = __builtin_amdgcn_cvt_pk_fp8_f32(h[j].z, h[j].w, w, true); *(int*)(H8 + (size_t)row * D + 256 * j + 4 * F.lane) = w; }
#pragma unroll
                for (int j = 0; j < 4; ++j) *(LAS f32x4*)(hbuf + tl * D + 256 * j + 4 * F.lane) = h[j];
            }
        }
        __syncthreads();
        if (base + 16 < tok1) MA_LOAD(base + 16);
        {
            f32x4 lg0 = {0.f, 0.f, 0.f, 0.f}, lg1 = {0.f, 0.f, 0.f, 0.f};
#pragma unroll
            for (int s = 0; s < 4; ++s) {
                const LAS float* hp = hbuf + (F.lane & 15) * D + 128 * F.wave + 32 * s + 8 * (F.lane >> 4);
                const f32x4 x0 = *(const LAS f32x4*)hp, x1 = *(const LAS f32x4*)(hp + 4);
                const unsigned h0 = pkbf(x0.x, x0.y), h1 = pkbf(x0.z, x0.w), h2 = pkbf(x1.x, x1.y), h3 = pkbf(x1.z, x1.w);
                const unsigned l0 = pkbf(x0.x - bflo(h0), x0.y - bfhi(h0)), l1 = pkbf(x0.z - bflo(h1), x0.w - bfhi(h1)), l2 = pkbf(x1.x - bflo(h2), x1.y - bfhi(h2)), l3 = pkbf(x1.z - bflo(h3), x1.w - bfhi(h3));
                const u32x4 hv = {h0, h1, h2, h3}, lv = {l0, l1, l2, l3};
                const rbf16x8 ah = __builtin_bit_cast(rbf16x8, hv), al = __builtin_bit_cast(rbf16x8, lv);
                lg0 = __builtin_amdgcn_mfma_f32_16x16x32_bf16(ah, wh[s][0], lg0, 0, 0, 0); lg1 = __builtin_amdgcn_mfma_f32_16x16x32_bf16(ah, wh[s][1], lg1, 0, 0, 0);
                lg0 = __builtin_amdgcn_mfma_f32_16x16x32_bf16(ah, wl[s][0], lg0, 0, 0, 0); lg1 = __builtin_amdgcn_mfma_f32_16x16x32_bf16(ah, wl[s][1], lg1, 0, 0, 0);
                lg0 = __builtin_amdgcn_mfma_f32_16x16x32_bf16(al, wh[s][0], lg0, 0, 0, 0); lg1 = __builtin_amdgcn_mfma_f32_16x16x32_bf16(al, wh[s][1], lg1, 0, 0, 0);
            }
#pragma unroll
            for (int r = 0; r < 4; ++r) { const int tl = 4 * (F.lane >> 4) + r; part[(F.wave * 16 + tl) * 32 + (F.lane & 15)] = lg0[r]; part[(F.wave * 16 + tl) * 32 + 16 + (F.lane & 15)] = lg1[r]; }
        }
        __syncthreads();
        {
            const int tl = F.wave * 2 + kh, tok = base + tl;
            float v = bias;
#pragma unroll
            for (int w = 0; w < 8; ++w) v += part[(w * 16 + tl) * 32 + e];
            float tv[4]; int ti[4];
#pragma unroll
            for (int k = 0; k < 4; ++k) {
                float cv = v; int ci = e;
#pragma unroll
                for (int o = 1; o < 32; o <<= 1) { const float ov = __shfl_xor(cv, o); const int oi = __shfl_xor(ci, o); if (ov > cv || (ov == cv && oi < ci)) { cv = ov; ci = oi; } }
                tv[k] = cv; ti[k] = ci; if (e == ci) v = -3.0e38f;
            }
            if (tok < tok1) {
                const float e1 = __expf(tv[1] - tv[0]), e2 = __expf(tv[2] - tv[0]), e3 = __expf(tv[3] - tv[0]); const float inv = 1.f / (1.f + e1 + e2 + e3);
                if (e == 0) *(f32x4*)(gate + (size_t)MA_ROW(tok) * 4) = (f32x4){inv, e1 * inv, e2 * inv, e3 * inv};
                if (!DRY && e < 4) { const int ex = (e == 0) ? ti[0] : (e == 1) ? ti[1] : (e == 2) ? ti[2] : ti[3];
                    const int rank = __hip_atomic_fetch_add(lcnt + ex, 1, __ATOMIC_RELAXED, __HIP_MEMORY_SCOPE_WORKGROUP); sel[(tok - tok0) * 4 + e] = ex | (rank << 8); }
            }
        }
    }
#undef MA_LOAD
    __syncthreads();
    if (DRY) return;
    if (F.tid < 32) gbase[F.tid] = (int)__hip_atomic_fetch_add(F.ctl() + CW_CNT + L * 32 + F.tid, (unsigned)lcnt[F.tid], __ATOMIC_RELAXED, __HIP_MEMORY_SCOPE_AGENT);
    __syncthreads();
    for (int i = F.tid; i < (tok1 - tok0) * 4; i += 512) { const int v = sel[i], ee = v & 255, rank = v >> 8; list[(size_t)ee * T + gbase[ee] + rank] = MA_ROW(tok0 + (i >> 2)) * 4 + (i & 3); }
    __syncthreads();
#undef MA_ROW
}
template <int L>
__device__ __forceinline__ int moe_setup(Frame& F) {
    LAS int* cnt = (LAS int*)(F.lds + LC_CNT); LAS int* tbase = (LAS int*)(F.lds + LC_TBASE); LAS int* tile_e = (LAS int*)(F.lds + LC_TILEE);
    __syncthreads();
    if (F.tid < 64) {
        const int c = (F.lane < 32) ? (int)__hip_atomic_load(F.ctl() + CW_CNT + L * 32 + F.lane, __ATOMIC_RELAXED, __HIP_MEMORY_SCOPE_AGENT) : 0;
        const int nt = (c + 255) >> 8;
        int incl = nt;
#pragma unroll
        for (int o = 1; o < 32; o <<= 1) { const int t = __shfl_up(incl, o); if (F.lane >= o) incl += t; }
        const int excl = incl - nt;
        if (F.lane < 32) { cnt[F.lane] = c; tbase[F.lane] = excl; for (int t = 0; t < nt; ++t) tile_e[excl + t] = F.lane; }
        if (F.lane == 31) tbase[32] = incl;
    }
    __syncthreads();
    return tbase[32];
}
template <int L, bool DRY>
__device__ __forceinline__ void p_moe_b(Frame& F) {
    const unsigned char* SLOT = F.ws() + WS_SLOT; const bf16_t* X = (const bf16_t*)(F.ws() + WS_X); bf16_t* Xo = (bf16_t*)(F.ws() + WS_X + (DRY ? WS_JUNK : 0)); unsigned char* H8 = F.ws() + WS_H + (DRY ? WS_JUNK : 0); const float* gate = (const float*)(F.ws() + WS_GATE);
    const float* g3 = normg(F, L, 3);
    constexpr int NR = (L == 3) ? NB * SEQ : T;
    int sl[4][4], sn[4][4]; f32x4 xc[4], xn[4], gc, gn;
#define MB_ROW(n_) ((L == 3) ? (((n_) >> 14) * SB + NCTX + ((n_) & (SEQ - 1))) : (n_))
#define MB_LOAD(n_, S_, X_, G_) do { const int r_ = MB_ROW(n_); G_ = *(const f32x4*)(gate + (size_t)r_ * 4); \
        _Pragma("unroll") for (int k = 0; k < 4; ++k) _Pragma("unroll") for (int j = 0; j < 4; ++j) S_[k][j] = *(const int*)(SLOT + ((size_t)r_ * 4 + k) * D + 256 * j + 4 * F.lane); \
        ld_row_bf16(X + (size_t)r_ * D, F.lane, X_); } while (0)
    int cs = -1; f32x4 pm[4], pg[4], p0v[4];
    int n = F.gw;
    if (n < NR) MB_LOAD(n, sl, xc, gc);
    for (; n < NR; n += F.NGW) {
        const int nn = n + F.NGW;
        if (nn < NR) MB_LOAD(nn, sn, xn, gn);
        const int row = MB_ROW(n), b = row >= SB ? 1 : 0, w = row - b * SB, s = (w < NCTX) ? 2 : b;
        f32x4 y[4], x[4];
#pragma unroll
        for (int j = 0; j < 4; ++j) { y[j] = (f32x4){0, 0, 0, 0}; x[j] = xc[j];
#pragma unroll
            for (int k = 0; k < 4; ++k) { const int q = sl[k][j]; y[j] += (f32x4){__builtin_amdgcn_cvt_f32_fp8(q, 0), __builtin_amdgcn_cvt_f32_fp8(q, 1), __builtin_amdgcn_cvt_f32_fp8(q, 2), __builtin_amdgcn_cvt_f32_fp8(q, 3)} * gc[k]; } }
        if (s != cs) { cs = s; constexpr int LN_ = (L < 3) ? L + 1 : 3; const float* m5 = modp(F, L, s, 5); const float* gn = normg(F, LN_, 0); const float* m1n = modp(F, LN_, s, 1); const float* m0n = modp(F, LN_, s, 0);
#pragma unroll
            for (int j = 0; j < 4; ++j) { const int o = 256 * j + 4 * F.lane; pm[j] = *(const f32x4*)(m5 + o) * *(const f32x4*)(g3 + o); pg[j] = *(const f32x4*)(gn + o) * (*(const f32x4*)(m1n + o) + 1.f); p0v[j] = *(const f32x4*)(m0n + o); } }
        const float ry = rsqrtf(row_ss(y) * (1.f / D) + RMS_EPS);
#pragma unroll
        for (int j = 0; j < 4; ++j) x[j] = x[j] + pm[j] * (y[j] * ry);
        if (L == 3) { st_row_f32((DRY ? (float*)Xo : F.out()) + ((size_t)(b * SEQ + (w - NCTX))) * D, F.lane, x); }
        else {
            st_row_bf16(Xo + (size_t)row * D, F.lane, x);
            f32x4 h[4]; const float rx = rsqrtf(row_ss(x) * (1.f / D) + RMS_EPS);
#pragma unroll
            for (int j = 0; j < 4; ++j) h[j] = (x[j] * rx) * pg[j] + p0v[j];
#pragma unroll
            for (int j = 0; j < 4; ++j) { int w8 = 0; w8 = __builtin_amdgcn_cvt_pk_fp8_f32(h[j].x, h[j].y, w8, false); w8 = __builtin_amdgcn_cvt_pk_fp8_f32(h[j].z, h[j].w, w8, true); *(int*)(H8 + (size_t)row * D + 256 * j + 4 * F.lane) = w8; }
        }
#pragma unroll
        for (int k = 0; k < 4; ++k)
#pragma unroll
            for (int j = 0; j < 4; ++j) sl[k][j] = sn[k][j];
#pragma unroll
        for (int j = 0; j < 4; ++j) xc[j] = xn[j];
        gc = gn;
    }
#undef MB_ROW
#undef MB_LOAD
}
template <int LDG, int VCOL0, int NH>
__device__ __forceinline__ void vt_prep(Frame& F, const bf16_t* G, unsigned char* VT8) {
    LAS unsigned char* scr = F.lds + F.wave * 4096;
    constexpr int NTI = SB / 64;
    const int dvl = F.lane >> 1, hf = F.lane & 1;
    for (int it = F.gw; it < NB * NH * NTI; it += F.NGW) {
        const int tile = it % NTI, bh = it / NTI, b = bh / NH, hd = bh - b * NH;
        const bf16_t* src = G + (size_t)(b * SB + tile * 64 + F.lane) * LDG + VCOL0 + hd * 128;
        unsigned char* dst = VT8 + (size_t)(bh * 128) * SB + tile * 64 + hf * 32;
#pragma unroll 1
        for (int c = 0; c < 4; ++c) {
            u32x4 a[4];
#pragma unroll
            for (int i = 0; i < 4; ++i) a[i] = *(const u32x4*)(src + c * 32 + i * 8);
#pragma unroll
            for (int i = 0; i < 4; ++i) {
                int w0 = 0, w1 = 0;
                w0 = __builtin_amdgcn_cvt_pk_fp8_f32(bflo(a[i].x), bfhi(a[i].x), w0, false); w0 = __builtin_amdgcn_cvt_pk_fp8_f32(bflo(a[i].y), bfhi(a[i].y), w0, true);
                w1 = __builtin_amdgcn_cvt_pk_fp8_f32(bflo(a[i].z), bfhi(a[i].z), w1, false); w1 = __builtin_amdgcn_cvt_pk_fp8_f32(bflo(a[i].w), bfhi(a[i].w), w1, true);
                *(LAS int*)(scr + F.lane * 36 + 8 * i) = w0; *(LAS int*)(scr + F.lane * 36 + 8 * i + 4) = w1;
            }
            LDS_WAIT(); asm volatile("" ::: "memory");
            unsigned o8[8];
#pragma unroll
            for (int q = 0; q < 8; ++q) { const int kb = 32 * (q >> 2) + 8 * (q & 3) + 4 * hf; const LAS unsigned char* p = scr + kb * 36 + dvl;
                o8[q] = (unsigned)p[0] | ((unsigned)p[36] << 8) | ((unsigned)p[72] << 16) | ((unsigned)p[108] << 24); }
            unsigned char* d = dst + (size_t)(c * 32 + dvl) * SB;
            *(u32x4*)d = (u32x4){o8[0], o8[1], o8[2], o8[3]}; *(u32x4*)(d + 16) = (u32x4){o8[4], o8[5], o8[6], o8[7]};
            LDS_WAIT(); asm volatile("" ::: "memory");
        }
    }
}
template <int LDG, int VCOL0, int NH>
__device__ __forceinline__ void vt_prep8(Frame& F, const unsigned char* G, unsigned char* VT8) {
    LAS unsigned char* scr = F.lds + F.wave * 4096;
    constexpr int NTI = SB / 64;
    const int dvl = F.lane >> 1, hf = F.lane & 1;
    for (int it = F.gw; it < NB * NH * NTI; it += F.NGW) {
        const int tile = it % NTI, bh = it / NTI, b = bh / NH, hd = bh - b * NH;
        const unsigned char* src = G + (size_t)(b * SB + tile * 64 + F.lane) * LDG + VCOL0 + hd * 128;
        unsigned char* dst = VT8 + (size_t)(bh * 128) * SB + tile * 64 + hf * 32;
#pragma unroll 1
        for (int c = 0; c < 4; ++c) {
            const u32x4 a0 = *(const u32x4*)(src + c * 32), a1 = *(const u32x4*)(src + c * 32 + 16);
#pragma unroll
            for (int i = 0; i < 4; ++i) { *(LAS unsigned*)(scr + F.lane * 36 + 4 * i) = a0[i]; *(LAS unsigned*)(scr + F.lane * 36 + 16 + 4 * i) = a1[i]; }
            LDS_WAIT(); asm volatile("" ::: "memory");
            unsigned o8[8];
#pragma unroll
            for (int q = 0; q < 8; ++q) { const int kb = 32 * (q >> 2) + 8 * (q & 3) + 4 * hf; const LAS unsigned char* p = scr + kb * 36 + dvl;
                o8[q] = (unsigned)p[0] | ((unsigned)p[36] << 8) | ((unsigned)p[72] << 16) | ((unsigned)p[108] << 24); }
            unsigned char* d = dst + (size_t)(c * 32 + dvl) * SB;
            *(u32x4*)d = (u32x4){o8[0], o8[1], o8[2], o8[3]}; *(u32x4*)(d + 16) = (u32x4){o8[4], o8[5], o8[6], o8[7]};
            LDS_WAIT(); asm volatile("" ::: "memory");
        }
    }
}
template <bool DRY> __device__ __forceinline__ void p_gqa_prep(Frame& F) {
    const bf16_t* G = (const bf16_t*)(F.ws() + WS_G); unsigned char* Q8 = F.ws() + WS_Q8; unsigned char* K8 = F.ws() + WS_K8; const float* qg = F.in(I_GQG); const float* kg = F.in(I_GKG);
    const int hi = F.lane >> 5, jl = (F.lane & 31) * 2, c0 = hi * 64 + jl;
    const float f0 = __builtin_amdgcn_exp2f(-(float)(jl & 31) * (LOG2_THETA / 32.f)), f1 = __builtin_amdgcn_exp2f(-(float)((jl + 1) & 31) * (LOG2_THETA / 32.f));
    const float qg0 = qg[c0], qg1 = qg[c0 + 1], kg0 = kg[c0], kg1 = kg[c0 + 1];
    for (int rr = F.gw; rr < T; rr += 2 * F.NGW) {
        unsigned qw[2][10];
#pragma unroll
        for (int u = 0; u < 2; ++u) { const int row = min(rr + u * F.NGW, T - 1); const bf16_t* gr = G + (size_t)row * 1536 + c0;
#pragma unroll
            for (int h = 0; h < 10; ++h) qw[u][h] = *(const unsigned*)(gr + h * 128); }
#pragma unroll
        for (int u = 0; u < 2; ++u) {
            const int row = min(rr + u * F.NGW, T - 1);
            const int b = row >= SB ? 1 : 0, w = row - b * SB; const bool lat = w >= NCTX; const int t = w - NCTX;
            const float pos = lat ? ((jl < 32) ? (float)(t >> 6) : (float)(t & 63)) : 0.f; const float a0 = pos * f0, a1 = pos * f1;
            const float cs0 = __cosf(a0), sn0 = __sinf(a0), cs1 = __cosf(a1), sn1 = __sinf(a1);
#pragma unroll
            for (int h = 0; h < 10; ++h) {
                const unsigned q = qw[u][h];
                const float x0 = bflo(q), x1 = bfhi(q);
                const float r = rsqrtf(wave_sum(x0 * x0 + x1 * x1) * (1.f / 128.f) + RMS_EPS);
                const float n0 = x0 * r * (h < 8 ? qg0 : kg0), n1 = x1 * r * (h < 8 ? qg1 : kg1);
                const float p0 = __shfl_xor(n0, 32), p1 = __shfl_xor(n1, 32);
                const float o0 = hi ? (n0 * cs0 + p0 * sn0) : (n0 * cs0 - p0 * sn0), o1 = hi ? (n1 * cs1 + p1 * sn1) : (n1 * cs1 - p1 * sn1);
                const float qs = (h < 8) ? QSCALE128 : 1.f;
                const unsigned short w8 = (unsigned short)__builtin_amdgcn_cvt_pk_fp8_f32(o0 * qs, o1 * qs, 0, false);
                if (h < 8) *(unsigned short*)(Q8 + (size_t)row * 1024 + h * 128 + c0) = w8; else *(unsigned short*)(K8 + (size_t)row * 256 + (h - 8) * 128 + c0) = w8;
            }
        }
    }
    vt_prep<1536, 1280, 2>(F, G, F.ws() + WS_VT8);
}
template <bool DRY> __device__ __forceinline__ void p_diff_prep(Frame& F) {
    const unsigned char* G = F.ws() + WS_G; unsigned char* Q8 = F.ws() + WS_Q8; unsigned char* K8 = F.ws() + WS_K8;
    const int l31 = F.lane & 31, j0 = 2 * l31; const bool first = l31 < 16; const int jj = j0 & 31;
    const float f0 = __builtin_amdgcn_exp2f(-(float)(jj & 15) * (LOG2_THETA / 16.f)), f1 = __builtin_amdgcn_exp2f(-(float)((jj + 1) & 15) * (LOG2_THETA / 16.f));
    for (int rr = F.gw; rr < T; rr += 2 * F.NGW) {
        unsigned qw[2][16];
#pragma unroll
        for (int u = 0; u < 2; ++u) { const int row = min(rr + u * F.NGW, T - 1); const unsigned char* gr = G + (size_t)row * 3072 + 2 * F.lane;
#pragma unroll
            for (int ch = 0; ch < 16; ++ch) qw[u][ch] = *(const unsigned short*)(gr + ch * 128); }
#pragma unroll
        for (int u = 0; u < 2; ++u) {
            const int row = min(rr + u * F.NGW, T - 1);
            const int b = row >= SB ? 1 : 0, w = row - b * SB; const int t = w - NCTX;
            const float pos = (w >= NCTX) ? ((jj < 16) ? (float)(t >> 6) : (float)(t & 63)) : 0.f; const float a0 = pos * f0, a1 = pos * f1;
            const float cs0 = __cosf(a0), sn0 = __sinf(a0), cs1 = __cosf(a1), sn1 = __sinf(a1);
#pragma unroll
            for (int ch = 0; ch < 16; ++ch) {
                const unsigned q = qw[u][ch];
                const float x0 = __builtin_amdgcn_cvt_f32_fp8((int)q, 0), x1 = __builtin_amdgcn_cvt_f32_fp8((int)q, 1);
                const float p0 = __shfl_xor(x0, 16), p1 = __shfl_xor(x1, 16);
                const float o0 = first ? (x0 * cs0 - p0 * sn0) : (x0 * cs0 + p0 * sn0), o1 = first ? (x1 * cs1 - p1 * sn1) : (x1 * cs1 + p1 * sn1);
                const float qs = (ch < 8) ? QSCALE64 / GS_DIFF : 1.f / GS_DIFF;
                const unsigned short w8 = (unsigned short)__builtin_amdgcn_cvt_pk_fp8_f32(o0 * qs, o1 * qs, 0, false);
                if (ch < 8) *(unsigned short*)(Q8 + (size_t)row * 1024 + ch * 128 + 2 * F.lane) = w8; else *(unsigned short*)(K8 + (size_t)row * 1024 + (ch - 8) * 128 + 2 * F.lane) = w8;
            }
        }
    }
    vt_prep8<3072, 2048, 8>(F, G, F.ws() + WS_VT8);
}
template <bool DRY> __device__ __forceinline__ void p_conv_prep(Frame& F) {
    const unsigned char* G = F.ws() + WS_G; unsigned char* Z = F.ws() + WS_O + (DRY ? WS_JUNK : 0); const float* wd = F.in(I_CDW);
    for (int rr = F.gw; rr < T; rr += 2 * F.NGW) {
        int qc[2][3][4], qx[2][3][4], qb[2][4]; float wm[2][3];
#pragma unroll
        for (int u = 0; u < 2; ++u) {
            const int row = min(rr + u * F.NGW, T - 1); const int b = row >= SB ? 1 : 0, w = row - b * SB;
            const int s0 = (w < NCTX) ? b * SB : b * SB + NCTX, s1 = (w < NCTX) ? b * SB + NCTX : (b + 1) * SB;
            const bool hasp = row - 1 >= s0, hasn = row + 1 < s1;
            const int rws[3] = {hasp ? row - 1 : row, row, hasn ? row + 1 : row}; wm[u][0] = hasp ? 1.f : 0.f; wm[u][1] = 1.f; wm[u][2] = hasn ? 1.f : 0.f;
#pragma unroll
            for (int j = 0; j < 4; ++j) { const int c = 256 * j + 4 * F.lane; qb[u][j] = *(const int*)(G + (size_t)row * 3072 + c);
#pragma unroll
                for (int d = 0; d < 3; ++d) { const unsigned char* gp = G + (size_t)rws[d] * 3072 + c; qc[u][d][j] = *(const int*)(gp + 1024); qx[u][d][j] = *(const int*)(gp + 2048); } }
        }
#pragma unroll
        for (int u = 0; u < 2; ++u) {
            const int row = min(rr + u * F.NGW, T - 1);
#pragma unroll
            for (int j = 0; j < 4; ++j) { const int c = 256 * j + 4 * F.lane; f32x4 acc = {0, 0, 0, 0};
#pragma unroll
                for (int d = 0; d < 3; ++d) { const int a = qc[u][d][j], x = qx[u][d][j];
                    const f32x4 uu = (f32x4){__builtin_amdgcn_cvt_f32_fp8(a, 0), __builtin_amdgcn_cvt_f32_fp8(a, 1), __builtin_amdgcn_cvt_f32_fp8(a, 2), __builtin_amdgcn_cvt_f32_fp8(a, 3)}
                                   * (f32x4){__builtin_amdgcn_cvt_f32_fp8(x, 0), __builtin_amdgcn_cvt_f32_fp8(x, 1), __builtin_amdgcn_cvt_f32_fp8(x, 2), __builtin_amdgcn_cvt_f32_fp8(x, 3)};
                    acc += uu * (*(const f32x4*)(wd + d * D + c) * wm[u][d]); }
                const int g = qb[u][j]; constexpr float ZS = OS_CONV / (GS_CONV * GS_CONV * GS_CONV);
                const f32x4 z = acc * (f32x4){__builtin_amdgcn_cvt_f32_fp8(g, 0), __builtin_amdgcn_cvt_f32_fp8(g, 1), __builtin_amdgcn_cvt_f32_fp8(g, 2), __builtin_amdgcn_cvt_f32_fp8(g, 3)};
                int w8 = 0; w8 = __builtin_amdgcn_cvt_pk_fp8_f32(z.x * ZS, z.y * ZS, w8, false); w8 = __builtin_amdgcn_cvt_pk_fp8_f32(z.z * ZS, z.w * ZS, w8, true);
                *(int*)(Z + (size_t)row * D + c) = w8; }
        }
    }
}
template <int PV> __device__ __forceinline__ void p_gqa_attn(Frame& F) {
    const unsigned char* Q8 = F.ws() + WS_Q8; const unsigned char* K8 = F.ws() + WS_K8; const unsigned char* VT8 = F.ws() + WS_VT8; unsigned char* O = F.ws() + WS_O + (PV ? WS_JUNK : 0);
    for (int idx = F.vcu; idx < 1024 + 16; idx += F.G) {
        int b, hq, qrow, seq;
        if (idx < 1024) { const int r = idx >> 8, wi = idx & 255; b = r >> 1; hq = (r & 1) * 4 + (wi >> 6); qrow = b * SB + NCTX + (wi & 63) * 256; seq = SB; }
        else { const int j = idx - 1024; b = j >> 3; hq = j & 7; qrow = b * SB; seq = NCTX; }
        const int kvh = hq >> 2;
        att8::attn_body8<128, 1024, 256, 1024, false, (PV > 0 ? PV - 1 : 0)>(Q8 + (size_t)qrow * 1024 + hq * 128, K8 + (size_t)(b * SB) * 256 + kvh * 128, VT8 + (size_t)((b * 2 + kvh) * 128) * SB,
                                                      O + (size_t)qrow * D + hq * 128, seq, F.ldsg, 0, 0.f, nullptr);
    }
}
__device__ __forceinline__ void p_diff_attn(Frame& F) {
    const unsigned char* Q8 = F.ws() + WS_Q8; const unsigned char* K8 = F.ws() + WS_K8; const unsigned char* VT8 = F.ws() + WS_VT8; unsigned char* O = F.ws() + WS_O;
    const float* lv = F.in(I_DLAM);
    const float lam = __expf(wave_sum(lv[F.lane] * lv[64 + F.lane])) - __expf(wave_sum(lv[128 + F.lane] * lv[192 + F.lane])) + LAM_INIT;
    for (int idx = F.vcu; idx < 1024; idx += F.G) {
#pragma unroll 1
        for (int s = 0; s < 2; ++s) {
            int ix = idx; asm volatile("" : "+s"(ix));
            const int r = ix >> 6, b = r >> 3, h = r & 7, qrow = b * SB + NCTX + (ix & 63) * 256;
            att8::attn_body8<64, 1024, 1024, 1024, true>(Q8 + (size_t)qrow * 1024 + h * 128 + s * 64, K8 + (size_t)(b * SB) * 1024 + h * 128 + s * 64, VT8 + (size_t)((b * 8 + h) * 128) * SB,
                                                         O + (size_t)qrow * D + h * 128, SB, F.ldsg, s, lam, F.in(I_DSUB));
        }
    }
}


#define PG8_ALIGN true
#define PG8_SP2 true

template <int L, int P0> __device__ __forceinline__ void moe_layer(Frame& F, const XcdBarrier& bar, int lo, int hi, int rep_mask);

__global__ void __launch_bounds__(NWAVES * 64, 2) mk_fwd(Args args) {
    extern __shared__ __attribute__((aligned(16))) unsigned char lds[];
    Frame F;
    F.lds = (LAS unsigned char*)lds; F.ldsg = (char*)lds;
    F.tid = threadIdx.x; F.lane = F.tid & 63; F.wave = __builtin_amdgcn_readfirstlane(F.tid >> 6);
    F.G = gridDim.x; { const int bx = blockIdx.x; F.vcu = (F.G % 8 == 0) ? (bx % 8) * (F.G / 8) + bx / 8 : bx; }
    F.gw = F.vcu * NWAVES + F.wave; F.NGW = F.G * NWAVES;
    refresh(F);
    for (int u = F.tid; u < (LDS_BYTES - RING_BYTES) / 4; u += NWAVES * 64) ((LAS unsigned*)(F.lds + RING_BYTES))[u] = 0u;
    __syncthreads();
    XcdBarrier bar; bar.bar = F.ctl() + CW_BAR; bar.x = 0; bar.st = nullptr;
    if (!MK_MULTI) bar = xcd_barrier_post(F.ctl() + CW_BAR, (volatile LAS unsigned*)(F.lds + LC_MISC));
    const int lo = args.ph_lo, hi = args.ph_hi; const int rep_mask = args.pad;
#define IN(k) (lo <= (k) && (k) < hi && refresh(F))
#define NREP(bit) (REP_MASK ? 1 + ((rep_mask & (bit)) ? 1 : 0) : 1)
#define PHM(k) asm volatile("; === PHASE %0" :: "i"(k))
#define SEAM(k) do { if (IN(k) && IN((k) + 1)) { xcd_barrier(bar); if constexpr ((REP_MASK & 256) != 0) xcd_barrier(bar); } } while (0)
    bf16_t* const Hb = (bf16_t*)(F.ws() + WS_H); bf16_t* const Gb = (bf16_t*)(F.ws() + WS_G); bf16_t* const Ob = (bf16_t*)(F.ws() + WS_O); bf16_t* const Yb = (bf16_t*)(F.ws() + WS_Y);

    if (IN(0)) { PHM(0); for (int rep = 0; rep < NREP(16); ++rep) p0_prologue(F); } SEAM(0);
    if (IN(1)) { PHM(1); if constexpr ((REP_MASK & 128) != 0) p_hpass0<true>(F); p_hpass0<false>(F); } SEAM(1);
    if (IN(2)) { PHM(2); if constexpr ((REP_MASK & 128) != 0) p_poolprep<true>(F); p_poolprep<false>(F); } SEAM(2);
    if (IN(3)) { PHM(3);
        int kpool = 256; asm volatile("" : "+s"(kpool));
        pg8::Gemm g{Ob, (const bf16_t*)(F.ws() + WS_POOLW), 4 * T, 256, kpool}; pg8::PoolOrder S{F.G, F.vcu};
        pg8::EpiPool E{Yb, D};
        for (int rep = 0; rep < NREP(32); ++rep) pg8::gemm_phase<pg8::EpiPool, pg8::PoolOrder, PG8_ALIGN, PG8_SP2>(F.lds, g, S, E);
    } SEAM(3);
    moe_layer<0, 4>(F, bar, lo, hi, rep_mask);
    if (IN(9)) { PHM(9);
        int kop = D; asm volatile("" : "+s"(kop));
        pg8::Gemm g{Hb, (const bf16_t*)(F.ws() + WS_GQKV), T, 1536, kop}; pg8::StaticOrder S; S.init(T, 1536, F.G, (int)blockIdx.x);
        pg8::EpiScaled E{Gb, 1536, 1.f / W8_SCALE};
        pg8::gemm_phase<pg8::EpiScaled, pg8::StaticOrder, PG8_ALIGN, PG8_SP2, 1>(F.lds, g, S, E);
    } SEAM(9);
    if (IN(10)) { PHM(10); if constexpr ((REP_MASK & 128) != 0) p_gqa_prep<true>(F); p_gqa_prep<false>(F); } SEAM(10);
    if (IN(11)) { PHM(11); if constexpr ((REP_MASK & 1) != 0) { p_gqa_attn<ATT_PROBE + 1>(F); refresh(F); } p_gqa_attn<0>(F); } SEAM(11);
    if (IN(12)) { PHM(12);
        int kop = D; asm volatile("" : "+s"(kop));
        pg8::Gemm g{Ob, (const bf16_t*)(F.ws() + WS_GO), T, D, kop}; pg8::StaticOrder S; S.init(T, D, F.G, (int)blockIdx.x);
        pg8::EpiScaled E{Yb, D, 1.f / (W8_SCALE * OS_GQA)};
        for (int rep = 0; rep < NREP(32); ++rep) pg8::gemm_phase<pg8::EpiScaled, pg8::StaticOrder, PG8_ALIGN, PG8_SP2, 1>(F.lds, g, S, E);
    } SEAM(12);
    moe_layer<1, 13>(F, bar, lo, hi, rep_mask);
    if (IN(18)) { PHM(18);
        int kop = D; asm volatile("" : "+s"(kop));
        pg8::Gemm g{Hb, (const bf16_t*)(F.ws() + WS_CIN), T, 3072, kop}; pg8::StaticOrder S; S.init(T, 3072, F.G, (int)blockIdx.x);
        pg8::EpiRows8 E{F.ws() + WS_G, 3072, GS_CONV / W8_SCALE};
        pg8::gemm_phase<pg8::EpiRows8, pg8::StaticOrder, PG8_ALIGN, PG8_SP2, 1>(F.lds, g, S, E);
    } SEAM(18);
    if (IN(19)) { PHM(19); if constexpr ((REP_MASK & 128) != 0) p_conv_prep<true>(F); p_conv_prep<false>(F); } SEAM(19);
    if (IN(20)) { PHM(20);
        int kop = D; asm volatile("" : "+s"(kop));
        pg8::Gemm g{Ob, (const bf16_t*)(F.ws() + WS_COUT), T, D, kop}; pg8::StaticOrder S; S.init(T, D, F.G, (int)blockIdx.x);
        pg8::EpiScaled E{Yb, D, 1.f / (W8_SCALE * OS_CONV)};
        for (int rep = 0; rep < NREP(32); ++rep) pg8::gemm_phase<pg8::EpiScaled, pg8::StaticOrder, PG8_ALIGN, PG8_SP2, 1>(F.lds, g, S, E);
    } SEAM(20);
    moe_layer<2, 21>(F, bar, lo, hi, rep_mask);
    if (IN(26)) { PHM(26);
        int kop = D; asm volatile("" : "+s"(kop));
        pg8::Gemm g{Hb, (const bf16_t*)(F.ws() + WS_DQKV), T, 3072, kop}; pg8::StaticOrder S; S.init(T, 3072, F.G, (int)blockIdx.x);
        pg8::EpiRows8 E{F.ws() + WS_G, 3072, GS_DIFF / W8_SCALE};
        pg8::gemm_phase<pg8::EpiRows8, pg8::StaticOrder, PG8_ALIGN, PG8_SP2, 1>(F.lds, g, S, E);
    } SEAM(26);
    if (IN(27)) { PHM(27); if constexpr ((REP_MASK & 128) != 0) p_diff_prep<true>(F); p_diff_prep<false>(F); } SEAM(27);
    if (IN(28)) { PHM(28); for (int rep = 0; rep < NREP(2); ++rep) p_diff_attn(F); } if (IN(28) && IN(30)) xcd_barrier(bar);
    if (IN(30)) { PHM(30);
        int kop = D; asm volatile("" : "+s"(kop));
        pg8::Gemm g{Ob, (const bf16_t*)(F.ws() + WS_DO), T, D, kop}; pg8::LatentOrder S; S.init(D, F.G, (int)blockIdx.x);
        pg8::EpiScaled E{Yb, D, 1.f / (W8_SCALE * OS_DIFF)};
        for (int rep = 0; rep < NREP(32); ++rep) pg8::gemm_phase<pg8::EpiScaled, pg8::LatentOrder, PG8_ALIGN, PG8_SP2, 1>(F.lds, g, S, E);
    } SEAM(30);
    moe_layer<3, 31>(F, bar, lo, hi, rep_mask);
    if (args.dump) {
        if (!MK_MULTI) xcd_barrier(bar);
        const bf16_t* X = (const bf16_t*)(F.ws() + WS_X);
        for (int row = F.gw; row < T; row += F.NGW) { const int b = row >= SB ? 1 : 0, w = row - b * SB; if (w < NCTX) continue;
            f32x4 v[4]; ld_row_bf16(X + (size_t)row * D, F.lane, v); st_row_f32(F.out() + ((size_t)(b * SEQ + (w - NCTX))) * D, F.lane, v); }
    }
}
struct MoeDeal { int base, stride, limit, nun; };
__device__ __forceinline__ MoeDeal moe_deal(const Frame& F, int U) {
    MoeDeal d;
    if (F.G % 8 == 0) { const int per = F.G / 8, x = F.vcu / per, cl = F.vcu - x * per; d.base = (int)(((long)U * x) / 8) + cl; d.stride = per; d.limit = (int)(((long)U * (x + 1)) / 8); }
    else { d.base = F.vcu; d.stride = F.G; d.limit = U; }
    d.nun = (d.base < d.limit) ? (d.limit - d.base + d.stride - 1) / d.stride : 0;
    return d;
}
template <int L, int P0> __device__ __forceinline__ void moe_layer(Frame& F, const XcdBarrier& bar, int lo, int hi, int rep_mask) {
    if (IN(P0)) { PHM(P0); if constexpr ((REP_MASK & 512) != 0) { p_moe_a<L>(F, true); refresh(F); } p_moe_a<L>(F, false); } if (IN(P0) && IN(P0 + 2)) xcd_barrier(bar);
    if (IN(P0 + 2)) { PHM(P0 + 2);
        const int ntiles = moe_setup<L>(F); const MoeDeal dl = moe_deal(F, ntiles * 8);
        int kop = D; asm volatile("" : "+s"(kop));
        { LAS unsigned short* tk = (LAS unsigned short*)(F.lds + LC_TOK16); const LAS int* cnt = (const LAS int*)(F.lds + LC_CNT); const LAS int* tbase = (const LAS int*)(F.lds + LC_TBASE); const LAS int* tile_e = (const LAS int*)(F.lds + LC_TILEE);
          const int* list = (const int*)(F.ws() + WS_LIST); int nun = dl.nun; if (nun > MAXU) nun = MAXU;
          const int nent = nun * 256;
          for (int idx0 = F.tid; idx0 < nent; idx0 += 5 * NWAVES * 64) { int val[5]; bool ok[5];
#pragma unroll
              for (int k = 0; k < 5; ++k) { const int idx = min(idx0 + k * NWAVES * 64, nent - 1), i = idx >> 8, r = idx & 255, pm = (dl.base + i * dl.stride) >> 3, ee = tile_e[pm], pos = (pm - tbase[ee]) * 256 + r, c = cnt[ee];
                  ok[k] = pos < c; val[k] = list[(size_t)ee * T + min(pos, c - 1)]; }
#pragma unroll
              for (int k = 0; k < 5; ++k) { const int idx = idx0 + k * NWAVES * 64; if (idx < nent) tk[idx] = (unsigned short)(ok[k] ? (val[k] >> 2) : 0); } }
          __syncthreads(); }
        pg8::Gemm g{(const bf16_t*)(F.ws() + WS_H), (const bf16_t*)(F.ws() + WS_W1T + (size_t)L * NE * 2048 * D), T, 2048, kop};
        pg8::MoeOrder S{(const LAS int*)(F.lds + LC_TILEE), dl.limit, 8, dl.stride, dl.base};
        pg8::EpiSwiGLU E{F.ws() + WS_ACT, (const bf16_t*)(F.ws() + WS_B1H) + (size_t)L * NE * 2048, 1.f / W8_SCALE};
        if constexpr ((REP_MASK & 4) != 0) { pg8::EpiSwiGLUT<(G1_PROBE & 3)> E2{F.ws() + WS_HS, (const bf16_t*)(F.ws() + WS_B1H) + (size_t)L * NE * 2048, 1.f / W8_SCALE};
            pg8::gemm_phase<pg8::EpiSwiGLUT<(G1_PROBE & 3)>, pg8::MoeOrder, PG8_ALIGN, PG8_SP2, 1, true, (G1_PROBE >> 2)>(F.lds, g, S, E2, (const LAS unsigned short*)(F.lds + LC_TOK16)); }
        pg8::gemm_phase<pg8::EpiSwiGLU, pg8::MoeOrder, PG8_ALIGN, PG8_SP2, 1, true>(F.lds, g, S, E, (const LAS unsigned short*)(F.lds + LC_TOK16));
    } SEAM(P0 + 2);
    if (IN(P0 + 3)) { PHM(P0 + 3);
        const int ntiles = moe_setup<L>(F); const MoeDeal dl = moe_deal(F, ntiles * 4);
        int kop = D; asm volatile("" : "+s"(kop));
        pg8::Gemm g{(const bf16_t*)(F.ws() + WS_ACT), (const bf16_t*)(F.ws() + WS_W2T + (size_t)L * NE * D * D), CROWS, D, kop};
        pg8::MoeOrder S{(const LAS int*)(F.lds + LC_TILEE), dl.limit, 4, dl.stride, dl.base};
        { LAS int* st = (LAS int*)(F.lds + LC_TOK16); const LAS int* cnt = (const LAS int*)(F.lds + LC_CNT); const LAS int* tbase = (const LAS int*)(F.lds + LC_TBASE); const LAS int* tile_e = (const LAS int*)(F.lds + LC_TILEE);
          const int* list = (const int*)(F.ws() + WS_LIST); int nun = dl.nun; if (nun > MAXU / 2) nun = MAXU / 2;
          const int nent = nun * 256;
          for (int idx0 = F.tid; idx0 < nent; idx0 += 5 * NWAVES * 64) { int val[5]; bool ok[5];
#pragma unroll
              for (int k = 0; k < 5; ++k) { const int idx = min(idx0 + k * NWAVES * 64, nent - 1), i = idx >> 8, r = idx & 255, pm = (dl.base + i * dl.stride) >> 2, ee = tile_e[pm], pos = (pm - tbase[ee]) * 256 + r, c = cnt[ee];
                  ok[k] = pos < c; val[k] = list[(size_t)ee * T + min(pos, c - 1)]; }
#pragma unroll
              for (int k = 0; k < 5; ++k) { const int idx = idx0 + k * NWAVES * 64; if (idx < nent) st[idx] = ok[k] ? val[k] : -1; } }
          __syncthreads(); }
        pg8::EpiScatter E{F.ws() + WS_SLOT, (const LAS int*)(F.lds + LC_TOK16), dl.stride, dl.base, (const bf16_t*)(F.ws() + WS_B2H) + (size_t)L * NE * D, 1.f / W8_SCALE, 0, T * 4};
        pg8::gemm_phase<pg8::EpiScatter, pg8::MoeOrder, PG8_ALIGN, PG8_SP2, 1>(F.lds, g, S, E);
        if constexpr ((REP_MASK & 8) != 0) { pg8::EpiScatter E2{F.ws() + WS_HS, (const LAS int*)(F.lds + LC_TOK16), dl.stride, dl.base, (const bf16_t*)(F.ws() + WS_B2H) + (size_t)L * NE * D, 1.f / W8_SCALE, ((REP_MASK & 4096) ? 1 : 0), CROWS};
            pg8::gemm_phase<pg8::EpiScatter, pg8::MoeOrder, PG8_ALIGN, PG8_SP2, 1>(F.lds, g, S, E2); }
    } SEAM(P0 + 3);
    if (IN(P0 + 4)) { PHM(P0 + 4); if constexpr ((REP_MASK & 1024) != 0) p_moe_b<L, true>(F); p_moe_b<L, false>(F); } SEAM(P0 + 4);
}
#undef IN
#undef SEAM

extern "C" void kernel_launch(void* const* d_in, const int* in_sizes, int n_in, void* d_out, int out_size, void* d_ws, size_t ws_size, hipStream_t stream) {
    static int grid = 0;
    if (grid == 0) {
        if (n_in != N_IN || in_sizes[0] != NB * SEQ * D || out_size != NB * SEQ * D || ws_size < WS_END) {
            fprintf(stderr, "kernel_launch: shape mismatch (n_in %d, in0 %d, out %d, ws %zu, need %zu); nothing launched\n", n_in, n_in > 0 ? in_sizes[0] : -1, out_size, ws_size, (size_t)WS_END); grid = -1; return; }
        { const long long exp_sz[N_IN] = {(long long)NB * SEQ * D, NB * D, NB * NCTX * D, D, 4LL * D * 6 * D, 4 * 6 * D, 4 * 4 * D, 4 * 256 * 256, D, D * 1536, D * D, 128, 128, D * 3072, 3 * D, D * D, D * 3072, D * D, 4 * 64, 128,
                                             4 * D * NE, 4 * NE, 4LL * NE * D * 2048, 4 * NE * 2048, 4LL * NE * D * D, 4 * NE * D};
          for (int i = 0; i < N_IN; ++i) if ((long long)in_sizes[i] != exp_sz[i]) { fprintf(stderr, "kernel_launch: input %d has %d elements, expected %lld; nothing launched\n", i, in_sizes[i], exp_sz[i]); grid = -1; return; } }
        int dev = 0, cus = 0, per_cu = 0;
        if (hipGetDevice(&dev) != hipSuccess || hipDeviceGetAttribute(&cus, hipDeviceAttributeMultiprocessorCount, dev) != hipSuccess) { fprintf(stderr, "kernel_launch: device query failed\n"); grid = -1; return; }
        if (hipFuncSetAttribute((const void*)mk_fwd, hipFuncAttributeMaxDynamicSharedMemorySize, LDS_BYTES) != hipSuccess) { fprintf(stderr, "kernel_launch: hipFuncSetAttribute failed\n"); grid = -1; return; }
        if (hipOccupancyMaxActiveBlocksPerMultiprocessor(&per_cu, (const void*)mk_fwd, NWAVES * 64, LDS_BYTES) != hipSuccess || per_cu < 1)
            fprintf(stderr, "kernel_launch: note: occupancy query reports %d workgroups per CU\n", per_cu);
        (void)hipGetLastError();
        grid = cus;
    }
    if (grid < 0) return;
    if (hipMemsetAsync((char*)d_ws + WS_CTL, 0, CTL_ZERO_BYTES, stream) != hipSuccess) { fprintf(stderr, "kernel_launch: memset failed\n"); return; }
    Args a{};
    for (int i = 0; i < N_IN; ++i) a.in[i] = (const float*)d_in[i];
    a.out = (float*)d_out; a.ws = (unsigned char*)d_ws; a.pad = REP_MASK;
    constexpr int STOP = MK_STOP;
#if MK_MULTI
    for (int p = 0; p < STOP; ++p) { a.ph_lo = p; a.ph_hi = p + 1; a.dump = 0; hipLaunchKernelGGL(mk_fwd, dim3(grid), dim3(NWAVES * 64), LDS_BYTES, stream, a); }
    if (STOP < N_PHASES) { a.ph_lo = 0; a.ph_hi = 0; a.dump = 1; hipLaunchKernelGGL(mk_fwd, dim3(grid), dim3(NWAVES * 64), LDS_BYTES, stream, a); }
#else
    a.ph_lo = 0; a.ph_hi = STOP; a.dump = (STOP < N_PHASES) ? 1 : 0;
    hipLaunchKernelGGL(mk_fwd, dim3(grid), dim3(NWAVES * 64), LDS_BYTES, stream, a);
#endif
    const hipError_t le = hipPeekAtLastError();
    if (le != hipSuccess) fprintf(stderr, "kernel_launch: launch failed: %s\n", hipGetErrorName(le));
}
```

```cpp
#include <hip/hip_runtime.h>
#include <cstdio>
#include <cstdint>

#define GAS __attribute__((address_space(1)))
#define LAS __attribute__((address_space(3)))

constexpr int D = 1024, NB = 2, SEQ = 16384, NCTX = 256, SB = SEQ + NCTX  , T = NB * SB  ;
constexpr int NE = 32, TOPK = 4, DFF = 1024;
constexpr int MAXTILES = T * TOPK / 256 + NE;
constexpr int CROWS = MAXTILES * 256;
constexpr float RMS_EPS = 1e-6f;
constexpr float LAM_INIT = 0.55605818f;
constexpr float LOG2_THETA = 13.287712379549449f;
constexpr float INV_2PI = 0.15915494309189535f;
constexpr float GS_CONV = 8.f, GS_DIFF = 8.f, GS_GQA = 8.f;
constexpr float OS_GQA = 32.f, OS_DIFF = 16.f, OS_CONV = 4.f;

enum { I_X = 0, I_C, I_CTX, I_CCTX, I_MODW, I_MODB, I_NORMG, I_POOLW, I_POOLS, I_GQKV, I_GO, I_GQG, I_GKG, I_CIN, I_CDW, I_COUT, I_DQKV, I_DO, I_DLAM, I_DSUB,
       I_RW, I_RB, I_W1, I_B1, I_W2, I_B2, N_IN };

constexpr size_t MiB = 1u << 20;
constexpr size_t WS_CTL = 0, CTL_ZERO_BYTES = 1 * MiB;
constexpr size_t WS_MOD = 1 * MiB;
constexpr size_t WS_POOLW = 2 * MiB;
constexpr size_t WS_GQKV = 3 * MiB;
constexpr size_t WS_GO = 6 * MiB;
constexpr size_t WS_CIN = 8 * MiB;
constexpr size_t WS_COUT = 14 * MiB;
constexpr size_t WS_DQKV = 16 * MiB;
constexpr size_t WS_DO = 22 * MiB;
constexpr size_t WS_GATE = 24 * MiB;
constexpr size_t WS_B1H = 25 * MiB;
constexpr size_t WS_B2H = WS_B1H + 512 * 1024;
constexpr size_t WS_LIST = 26 * MiB;
constexpr size_t WS_W1T = 32 * MiB;
constexpr size_t WS_W2T = WS_W1T + 512 * MiB;
constexpr size_t WS_X = WS_W2T + 256 * MiB;
constexpr size_t WS_H = WS_X + 130 * MiB;
constexpr size_t WS_G = WS_H + 65 * MiB;
constexpr size_t WS_O = WS_G + 195 * MiB;
constexpr size_t WS_OA = WS_O + 65 * MiB;
constexpr size_t WS_OB = WS_OA + 65 * MiB;
constexpr size_t WS_Y = WS_OB + 65 * MiB;
constexpr size_t WS_HS = WS_Y + 65 * MiB;
constexpr size_t WS_ACT = WS_HS + 276 * MiB;
constexpr size_t WS_SLOT = WS_ACT + 276 * MiB;
constexpr size_t WS_Q8 = WS_SLOT + 260 * MiB;
constexpr size_t WS_K8 = WS_Q8 + 33 * MiB;
constexpr size_t WS_VT8 = WS_K8 + 33 * MiB;
constexpr size_t WS_END = WS_VT8 + 33 * MiB;
static_assert(((size_t)T * 4 + 256) * 1024 <= 260 * MiB, "slot junk rows");
static_assert((size_t)T * 1024 <= 33 * MiB && (size_t)NB * 8 * 128 * SB <= 33 * MiB, "ws map fp8");
static_assert((size_t)T * D * 4 <= 130 * MiB && (size_t)T * D * 2 <= 65 * MiB && (size_t)T * 3072 * 2 <= 195 * MiB && (size_t)CROWS * D * 2 <= 276 * MiB && (size_t)T * 4 * D * 2 <= 260 * MiB, "ws map");
static_assert((size_t)NE * T * 4 <= 6 * MiB && (size_t)CROWS * 4 <= 1 * MiB && (size_t)T * 4 * 4 <= 1 * MiB && 4 * 3 * 6144 * 4 <= 1 * MiB, "ws map small");
constexpr int CW_CNT = 64;
constexpr int CW_BAR = 4096;

constexpr int RING_BYTES = 131072;
constexpr int LC_MISC = RING_BYTES;
constexpr int LC_CNT = LC_MISC + 64;
constexpr int LC_TBASE = LC_CNT + 128;
constexpr int LC_LCNT = LC_TBASE + 192;
constexpr int LC_GBASE = LC_LCNT + 128;
constexpr int LC_TILEE = LC_GBASE + 128;
constexpr int LC_TOK16 = LC_TILEE + MAXTILES * 4;
constexpr int MAXU = 26;
constexpr int LDS_BYTES = 147456;
static_assert(LC_TOK16 % 16 == 0 && LC_TOK16 + MAXU * 512 <= LDS_BYTES, "LDS map");

typedef unsigned short bf16_t;
typedef float f32x4 __attribute__((ext_vector_type(4)));
typedef float f32x2 __attribute__((ext_vector_type(2)));
typedef unsigned u32x2 __attribute__((ext_vector_type(2)));
typedef unsigned u32x4 __attribute__((ext_vector_type(4)));

__device__ __forceinline__ unsigned pkbf(float lo, float hi) { unsigned r; asm("v_cvt_pk_bf16_f32 %0, %1, %2" : "=v"(r) : "v"(lo), "v"(hi)); return r; }
__device__ __forceinline__ float bflo(unsigned w) { return __uint_as_float(w << 16); }
__device__ __forceinline__ float bfhi(unsigned w) { return __uint_as_float(w & 0xffff0000u); }
__device__ __forceinline__ float wave_sum(float v) {
#pragma unroll
    for (int o = 1; o < 64; o <<= 1) v += __shfl_xor(v, o);
    return v;
}
#define LDS_WAIT() asm volatile("s_waitcnt lgkmcnt(0)" ::: "memory")
#define VM_WAIT() asm volatile("s_waitcnt vmcnt(0)" ::: "memory")

namespace pg8 {
#define PG8_LAS __attribute__((address_space(3)))
typedef unsigned short bf16_t;
typedef short bf16x8 __attribute__((ext_vector_type(8)));
typedef float f32x4 __attribute__((ext_vector_type(4)));
typedef unsigned u32x4 __attribute__((ext_vector_type(4)));
typedef int i32x4 __attribute__((ext_vector_type(4)));
typedef int i32x8 __attribute__((ext_vector_type(8)));
typedef unsigned u32x2 __attribute__((ext_vector_type(2)));
constexpr int BM = 256, BK = 64, HALF = 128, HTB = HALF * BK * 2  , STAGE_BYTES = 8 * HTB, NXCD = 8, WGM = 8;

__host__ __device__ __forceinline__ int lds_byte(int r, int c) { const int st = (r >> 4) * 2 + (c >> 5), rr = r & 15, cc = c & 31, ob = rr * 64 + cc * 2; return st * 1024 + (ob ^ (((ob >> 9) & 1) << 5)); }
__host__ __device__ __forceinline__ void stage_rc(int b, int& R, int& C) { const int st = b / 1024, sb = b % 1024, swz = sb ^ (((sb >> 9) & 1) << 5); R = (st >> 1) * 16 + swz / 64; C = (st & 1) * 32 + (swz % 64) / 2; }
__host__ __device__ __forceinline__ int perm32(int rho) { const int n = rho >> 4, i = rho & 15; return 8 * (i >> 2) + 4 * n + (i & 3); }

struct Unit { int pm, pn; };
struct Gemm { const bf16_t* A; const bf16_t* Bt; int M, N, K; };

struct StaticOrder {
    int nM, nN, nwg, G, c;
    __host__ __device__ void init(int M, int N, int G_, int c_) { nM = M / BM; nN = N / BM; nwg = nM * nN; G = G_; c = c_; }
    __host__ __device__ bool next(int i, Unit& u) const {
        const long L = (long)i * G + c; if (L >= nwg) return false;
        int wgid = (int)L; { const int q = nwg / NXCD, r = nwg % NXCD, xcd = wgid % NXCD, off = wgid / NXCD; wgid = (xcd < r ? xcd * (q + 1) : r * (q + 1) + (xcd - r) * q) + off; }
        const int nig = WGM * nN, gid = wgid / nig, fm = gid * WGM, gsz = (nM - fm) < WGM ? (nM - fm) : WGM;
        u.pm = fm + ((wgid % nig) % gsz); u.pn = (wgid % nig) / gsz; return true;
    }
    __device__ __forceinline__ void a_ready(const Unit&) const {}
    __device__ __forceinline__ void done(const Unit&) const {}
};


struct PoolOrder {
    int G, c;
    __device__ __forceinline__ bool next(int i, Unit& u) const { const int L = i * G + c; if (L >= 4 * 130) return false; const int g = L & 3, pm = L >> 2; u.pm = g * 130 + pm; u.pn = g; return true; }
    __device__ __forceinline__ void a_ready(const Unit&) const {}
    __device__ __forceinline__ void done(const Unit&) const {}
};
struct LatentOrder {
    StaticOrder S;
    __device__ void init(int N, int G_, int c_) { S.init(NB * SEQ, N, G_, c_); }
    __device__ bool next(int i, Unit& u) const { if (!S.next(i, u)) return false; u.pm += (u.pm >= SEQ / 256) ? 2 : 1; return true; }
    __device__ __forceinline__ void a_ready(const Unit&) const {}
    __device__ __forceinline__ void done(const Unit&) const {}
};
struct MoeOrder {
    const PG8_LAS int* tile_e; int lim, nN, G, c;
    __device__ __forceinline__ bool next(int i, Unit& u) const { const int L = i * G + c; if (L >= lim) return false; const int pm = L / nN, pl = L - pm * nN; u.pm = pm; u.pn = tile_e[pm] * nN + pl; return true; }
    __device__ __forceinline__ void a_ready(const Unit&) const {}
    __device__ __forceinline__ void done(const Unit&) const {}
};

__device__ __forceinline__ unsigned cvt_pk_bf16(float lo, float hi) { unsigned r; asm volatile("v_cvt_pk_bf16_f32 %0, %1, %2" : "=v"(r) : "v"(lo), "v"(hi)); return r; }

template <bool POOL> struct EpiPlainT {
    static constexpr bool PERM = true, AFTER_DRAIN = false, HAS_PRE = false; struct Pre {}; static constexpr int NST = 16;
    bf16_t* O; int ldc;
    __device__ __forceinline__ void operator()(const f32x4 (&acc)[2][2][4][2], const Unit& u, int wr, int wc, int fr, int fq) const {
        const int rt = POOL ? (u.pm - 130 * u.pn) : u.pm;
        const int row0 = rt * BM + wr * 64 + fr, col0 = u.pn * BM + wc * 32 + 8 * fq;
#pragma unroll
        for (int ai = 0; ai < 2; ++ai)
#pragma unroll
            for (int m = 0; m < 4; ++m) { bf16_t* rowp = O + (size_t)(row0 + ai * HALF + m * 16) * ldc + col0;
#pragma unroll
                for (int bj = 0; bj < 2; ++bj) { const f32x4 v0 = acc[ai][bj][m][0], v1 = acc[ai][bj][m][1];
                    u32x4 w; w.x = cvt_pk_bf16(v0[0], v0[1]); w.y = cvt_pk_bf16(v0[2], v0[3]); w.z = cvt_pk_bf16(v1[0], v1[1]); w.w = cvt_pk_bf16(v1[2], v1[3]);
                    *(u32x4*)(rowp + bj * HALF) = w; } }
    }
};
struct EpiScaled {
    static constexpr bool PERM = true, AFTER_DRAIN = false, HAS_PRE = false; struct Pre {}; static constexpr int NST = 16;
    bf16_t* O; int ldc; float asc;
    __device__ __forceinline__ void operator()(const f32x4 (&acc)[2][2][4][2], const Unit& u, int wr, int wc, int fr, int fq) const {
        const int row0 = u.pm * BM + wr * 64 + fr, col0 = u.pn * BM + wc * 32 + 8 * fq;
#pragma unroll
        for (int ai = 0; ai < 2; ++ai)
#pragma unroll
            for (int m = 0; m < 4; ++m) { bf16_t* rowp = O + (size_t)(row0 + ai * HALF + m * 16) * ldc + col0;
#pragma unroll
                for (int bj = 0; bj < 2; ++bj) { const f32x4 v0 = acc[ai][bj][m][0] * asc, v1 = acc[ai][bj][m][1] * asc;
                    u32x4 w; w.x = cvt_pk_bf16(v0[0], v0[1]); w.y = cvt_pk_bf16(v0[2], v0[3]); w.z = cvt_pk_bf16(v1[0], v1[1]); w.w = cvt_pk_bf16(v1[2], v1[3]);
                    *(u32x4*)(rowp + bj * HALF) = w; } }
    }
};
struct EpiRows8 {
    static constexpr bool PERM = true, AFTER_DRAIN = false, HAS_PRE = false; struct Pre {}; static constexpr int NST = 8;
    unsigned char* O; int ldc; float asc;
    __device__ __forceinline__ void operator()(const f32x4 (&acc)[2][2][4][2], const Unit& u, int wr, int wc, int fr, int fq) const {
        const int col0 = u.pn * BM + wc * 32 + 8 * fq;
#pragma unroll
        for (int ai = 0; ai < 2; ++ai)
#pragma unroll
            for (int mp = 0; mp < 2; ++mp) {
                const int m = 2 * mp + (fq & 1), row = u.pm * BM + wr * 64 + fr + ai * HALF + m * 16;
#pragma unroll
                for (int bj = 0; bj < 2; ++bj) { unsigned w[2][2];
#pragma unroll
                    for (int mm = 0; mm < 2; ++mm) { const f32x4 v0 = acc[ai][bj][2 * mp + mm][0] * asc, v1 = acc[ai][bj][2 * mp + mm][1] * asc;
                        int w0 = 0, w1 = 0; w0 = __builtin_amdgcn_cvt_pk_fp8_f32(v0[0], v0[1], w0, false); w0 = __builtin_amdgcn_cvt_pk_fp8_f32(v0[2], v0[3], w0, true);
                        w1 = __builtin_amdgcn_cvt_pk_fp8_f32(v1[0], v1[1], w1, false); w1 = __builtin_amdgcn_cvt_pk_fp8_f32(v1[2], v1[3], w1, true);
                        w[mm][0] = (unsigned)w0; w[mm][1] = (unsigned)w1; }
                    const auto lo = __builtin_amdgcn_permlane16_swap(w[0][0], w[1][0], false, false), hi2 = __builtin_amdgcn_permlane16_swap(w[0][1], w[1][1], false, false);
                    *(u32x4*)(O + (size_t)row * ldc + (col0 & ~15) + bj * HALF) = (u32x4){lo[0], hi2[0], lo[1], hi2[1]}; }
            }
    }
};
typedef EpiPlainT<false> EpiPlain;
typedef EpiPlainT<true> EpiPool;
template <int CHEAP> struct EpiSwiGLUT {
    static constexpr bool PERM = true, AFTER_DRAIN = false; static constexpr int NST = (CHEAP == 2) ? 0 : 4;
    unsigned char* ACT; const bf16_t* b1h; float asc;
    static constexpr bool HAS_PRE = true; struct Pre { u32x4 bg, bu; };
    __device__ __forceinline__ void pre(const Unit& u, int wc, int fq, Pre& p) const {
        const int e = u.pn >> 3, pl = u.pn & 7, oc0 = pl * 128 + wc * 32 + 8 * fq;
        const bf16_t* a = b1h + e * 2048 + oc0;
        asm volatile("global_load_dwordx4 %0, %1, off" : "=v"(p.bg) : "v"(a) : "memory");
        asm volatile("global_load_dwordx4 %0, %1, off offset:2048" : "=v"(p.bu) : "v"(a) : "memory");
    }
    __device__ __forceinline__ void operator()(const f32x4 (&acc)[2][2][4][2], const Unit& u, int wr, int wc, int fr, int fq, const Pre& p) const {
        if constexpr (CHEAP == 2) return;
        const int pl = u.pn & 7;
        const int row0 = u.pm * BM + wr * 64 + fr, oc0 = pl * 128 + wc * 32 + 8 * fq;
        f32x4 bg[2], bu[2];
#pragma unroll
        for (int n = 0; n < 2; ++n) { bg[n] = (f32x4){__uint_as_float(p.bg[2 * n] << 16), __uint_as_float(p.bg[2 * n] & 0xffff0000u), __uint_as_float(p.bg[2 * n + 1] << 16), __uint_as_float(p.bg[2 * n + 1] & 0xffff0000u)};
            bu[n] = (f32x4){__uint_as_float(p.bu[2 * n] << 16), __uint_as_float(p.bu[2 * n] & 0xffff0000u), __uint_as_float(p.bu[2 * n + 1] << 16), __uint_as_float(p.bu[2 * n + 1] & 0xffff0000u)} + 1.0f; }
#pragma unroll
        for (int ai = 0; ai < 2; ++ai)
#pragma unroll
            for (int mp = 0; mp < 2; ++mp) {
                unsigned w[2][2];
#pragma unroll
                for (int mm = 0; mm < 2; ++mm) { const int m = 2 * mp + mm; float o[8];
#pragma unroll
                    for (int n = 0; n < 2; ++n) {
#pragma unroll
                        for (int jp = 0; jp < 2; ++jp) { typedef float f2e __attribute__((ext_vector_type(2)));
                            const f32x4 ag = acc[ai][0][m][n], au = acc[ai][1][m][n];
                            const f2e a2 = {asc, asc};
                            f2e gv = (f2e){ag[2 * jp], ag[2 * jp + 1]} * a2 + (f2e){bg[n][2 * jp], bg[n][2 * jp + 1]};
                            f2e uv = (f2e){au[2 * jp], au[2 * jp + 1]} * a2 + (f2e){bu[n][2 * jp], bu[n][2 * jp + 1]};
                            gv.x = fminf(gv.x, 7.0f); gv.y = fminf(gv.y, 7.0f);
                            uv.x = fminf(fmaxf(uv.x, -6.0f), 8.0f); uv.y = fminf(fmaxf(uv.y, -6.0f), 8.0f);
                            const f2e tt = gv * (f2e){-1.702f * 1.4426950408889634f, -1.702f * 1.4426950408889634f};
                            f2e dd = (f2e){(CHEAP != 0) ? 1.0f : __builtin_amdgcn_exp2f(tt.x), (CHEAP != 0) ? 1.0f : __builtin_amdgcn_exp2f(tt.y)} + (f2e){1.0f, 1.0f};
                            const f2e sg = {(CHEAP != 0) ? 0.5f : __builtin_amdgcn_rcpf(dd.x), (CHEAP != 0) ? 0.5f : __builtin_amdgcn_rcpf(dd.y)};
                            const f2e oo = (gv * sg) * uv;
                            o[4 * n + 2 * jp] = oo.x; o[4 * n + 2 * jp + 1] = oo.y; } }
                    int w0 = 0, w1 = 0; w0 = __builtin_amdgcn_cvt_pk_fp8_f32(o[0], o[1], w0, false); w0 = __builtin_amdgcn_cvt_pk_fp8_f32(o[2], o[3], w0, true);
                    w1 = __builtin_amdgcn_cvt_pk_fp8_f32(o[4], o[5], w1, false); w1 = __builtin_amdgcn_cvt_pk_fp8_f32(o[6], o[7], w1, true);
                    w[mm][0] = (unsigned)w0; w[mm][1] = (unsigned)w1; }
                const auto lo = __builtin_amdgcn_permlane16_swap(w[0][0], w[1][0], false, false), hi2 = __builtin_amdgcn_permlane16_swap(w[0][1], w[1][1], false, false);
                const int m = 2 * mp + (fq & 1);
                *(u32x4*)(ACT + (size_t)(row0 + ai * HALF + m * 16) * 1024 + (oc0 & ~15)) = (u32x4){lo[0], hi2[0], lo[1], hi2[1]}; }
    }
};
typedef EpiSwiGLUT<0> EpiSwiGLU;
struct EpiScatter {
    static constexpr bool PERM = true, AFTER_DRAIN = false;
    static constexpr int NST = 8;
    unsigned char* SLOT; const PG8_LAS int* slot_tab; int G, c; const bf16_t* b2h; float asc; int seq; int junk0;
    static constexpr bool HAS_PRE = true; struct Pre { u32x4 bv[2]; };
    __device__ __forceinline__ void pre(const Unit& u, int wc, int fq, Pre& p) const {
        const int e = u.pn >> 2, pl = u.pn & 3, col0 = pl * BM + wc * 32 + 8 * fq;
        const bf16_t* a = b2h + e * 1024 + col0;
        asm volatile("global_load_dwordx4 %0, %1, off" : "=v"(p.bv[0]) : "v"(a) : "memory");
        asm volatile("global_load_dwordx4 %0, %1, off offset:256" : "=v"(p.bv[1]) : "v"(a) : "memory");
    }
    __device__ __forceinline__ void operator()(const f32x4 (&acc)[2][2][4][2], const Unit& u, int wr, int wc, int fr, int fq, const Pre& p) const {
        const int pl = u.pn & 3, ui = (u.pm * 4 + pl - c) / G;
        const int col0 = pl * BM + wc * 32 + 8 * fq;
        f32x4 bv[2][2];
#pragma unroll
        for (int bj = 0; bj < 2; ++bj)
#pragma unroll
            for (int n = 0; n < 2; ++n) bv[bj][n] = (f32x4){__uint_as_float(p.bv[bj][2 * n] << 16), __uint_as_float(p.bv[bj][2 * n] & 0xffff0000u), __uint_as_float(p.bv[bj][2 * n + 1] << 16), __uint_as_float(p.bv[bj][2 * n + 1] & 0xffff0000u)};
#pragma unroll
        for (int ai = 0; ai < 2; ++ai)
#pragma unroll
            for (int mp = 0; mp < 2; ++mp) {
                const int m = 2 * mp + (fq & 1), rit = wr * 64 + fr + ai * HALF + m * 16;
                int slot = seq ? (u.pm * BM + rit) : slot_tab[ui * BM + rit];
                if (slot < 0) slot = junk0 + rit;
#pragma unroll
                for (int bj = 0; bj < 2; ++bj) { unsigned w[2][2];
#pragma unroll
                    for (int mm = 0; mm < 2; ++mm) { const f32x4 v0 = acc[ai][bj][2 * mp + mm][0] * asc + bv[bj][0], v1 = acc[ai][bj][2 * mp + mm][1] * asc + bv[bj][1];
                        int w0 = 0, w1 = 0; w0 = __builtin_amdgcn_cvt_pk_fp8_f32(v0[0], v0[1], w0, false); w0 = __builtin_amdgcn_cvt_pk_fp8_f32(v0[2], v0[3], w0, true);
                        w1 = __builtin_amdgcn_cvt_pk_fp8_f32(v1[0], v1[1], w1, false); w1 = __builtin_amdgcn_cvt_pk_fp8_f32(v1[2], v1[3], w1, true);
                        w[mm][0] = (unsigned)w0; w[mm][1] = (unsigned)w1; }
                    const auto lo = __builtin_amdgcn_permlane16_swap(w[0][0], w[1][0], false, false), hi2 = __builtin_amdgcn_permlane16_swap(w[0][1], w[1][1], false, false);
                    *(u32x4*)(SLOT + (size_t)slot * 1024 + (col0 & ~15) + bj * HALF) = (u32x4){lo[0], hi2[0], lo[1], hi2[1]}; }
            }
    }
};

template <class Epi, class Sched, bool ALIGN_EPI = false, bool SP2 = false, int ES = 2, bool GATHER = false, int PRB = 0>
__device__ __forceinline__ void gemm_phase(PG8_LAS unsigned char* lds, const Gemm g, const Sched& S, const Epi& E, const PG8_LAS unsigned short* tok16 = nullptr) {
    static_assert(SP2 || !GATHER, "GATHER is implemented for the SP2 loop");
    int tid_ = threadIdx.x; asm volatile("" : "+v"(tid_));
    const int tid = tid_, wid = __builtin_amdgcn_readfirstlane(tid >> 6), lane = tid & 63, wr = wid >> 2, wc = wid & 3, fr = lane & 15, fq = lane >> 4;
    const int K = g.K, nt = K * ES / (BK * 2);
    unsigned voffA[2], voffB[2]; int rowA[2]; unsigned colA[2];
#pragma unroll
    for (int i = 0; i < 2; ++i) { int R, C; stage_rc(tid * 16 + i * 8192, R, C); const int Rb = Epi::PERM ? ((R & ~31) + perm32(R & 31)) : R;
        voffA[i] = (unsigned)(R * K * ES + C * 2); voffB[i] = (unsigned)(Rb * K * ES + C * 2); rowA[i] = R; colA[i] = (unsigned)(C * 2); }
    const size_t kstep = (size_t)(BK * 2);
    const size_t hstep = (size_t)HALF * K * ES;
    const size_t hstepA = GATHER ? 0 : hstep;
    const size_t tstep = 2 * hstep;
    const unsigned ldsw = (unsigned)wid * 1024u;
    const int aoff = lds_byte(wr * 64 + fr, fq * 8), boff = lds_byte(wc * 32 + fr, fq * 8);
#define PG8_SA(b, h) (((b) * 2 + (h)) * HTB)
#define PG8_SB(b, h) ((4 + (b) * 2 + (h)) * HTB)
#define PG8_STAGE(bufoff, gbase, voff) do { _Pragma("unroll") for (int _i = 0; _i < 2; ++_i) \
        __builtin_amdgcn_global_load_lds((const unsigned*)((const char*)(gbase) + (voff)[_i]), (PG8_LAS unsigned*)(lds + (bufoff) + ldsw + _i * 8192), 16, 0, 0); } while (0)
#define PG8_GOFF(dst, ui_) do { _Pragma("unroll") for (int _h = 0; _h < 2; ++_h) _Pragma("unroll") for (int _i = 0; _i < 2; ++_i) dst[_h][_i] = (unsigned)tok16[(ui_) * 256 + _h * HALF + rowA[_i]] * (unsigned)(K * ES) + colA[_i]; } while (0)
#define PG8_STAGE_A(bufoff, gbase, h, usenext) do { if constexpr (GATHER) { _Pragma("unroll") for (int _i = 0; _i < 2; ++_i) { const unsigned vo_ = (usenext) ? goffN[h][_i] : goffC[h][_i]; \
        __builtin_amdgcn_global_load_lds((const unsigned*)((const char*)(gbase) + vo_), (PG8_LAS unsigned*)(lds + (bufoff) + ldsw + _i * 8192), 16, 0, 0); } } else PG8_STAGE(bufoff, gbase, voffA); } while (0)
#define PG8_LDA(dst, b, h) do { _Pragma("unroll") for (int m = 0; m < 4; ++m) _Pragma("unroll") for (int k = 0; k < 2; ++k) dst[m][k] = *(const PG8_LAS bf16x8*)(lds + PG8_SA(b, h) + aoff + m * 2048 + k * 1024); } while (0)
#define PG8_LDB(dst, b, h) do { _Pragma("unroll") for (int n = 0; n < 2; ++n) _Pragma("unroll") for (int k = 0; k < 2; ++k) dst[n][k] = *(const PG8_LAS bf16x8*)(lds + PG8_SB(b, h) + boff + n * 2048 + k * 1024); } while (0)
#define PG8_CAT8(lo, hi) __builtin_shufflevector(__builtin_bit_cast(i32x4, lo), __builtin_bit_cast(i32x4, hi), 0, 1, 2, 3, 4, 5, 6, 7)
#define PG8_MFMA8(accv, bv, av) asm volatile("v_mfma_scale_f32_16x16x128_f8f6f4 %0, %1, %2, %0, %3, %3 op_sel_hi:[0,0,0]" : "+v"(accv) : "v"(bv), "v"(av), "v"(sc1))
#define PG8_MMA(ai, bj, At, Bt) do { if constexpr (PRB == 1) break; __builtin_amdgcn_s_setprio(1); if constexpr (ES == 2) { _Pragma("unroll") for (int m = 0; m < 4; ++m) _Pragma("unroll") for (int n = 0; n < 2; ++n) _Pragma("unroll") for (int k = 0; k < 2; ++k) \
        acc[ai][bj][m][n] = __builtin_amdgcn_mfma_f32_16x16x32_bf16(Bt[n][k], At[m][k], acc[ai][bj][m][n], 0, 0, 0); } else { _Pragma("unroll") for (int m = 0; m < 4; ++m) _Pragma("unroll") for (int n = 0; n < 2; ++n) { \
        const i32x8 b8_ = PG8_CAT8(Bt[n][0], Bt[n][1]), a8_ = PG8_CAT8(At[m][0], At[m][1]); PG8_MFMA8(acc[ai][bj][m][n], b8_, a8_); } } __builtin_amdgcn_s_setprio(0); } while (0)
#define PG8_WAIT_V(n) asm volatile("s_waitcnt vmcnt(" #n ")" ::: "memory")
#define PG8_WAIT_L(n) asm volatile("s_waitcnt lgkmcnt(" #n ")" ::: "memory")
#define PG8_BAR __builtin_amdgcn_s_barrier()
#define PG8_SCHED __builtin_amdgcn_sched_barrier(0)
    Unit cur, nxt; int ui = 0; typename Epi::Pre epre;
    if (!S.next(0, cur)) return;
    int sc1 = 0x7f7f7f7f; asm volatile("" : "+v"(sc1));
    f32x4 acc[2][2][4][2];
#pragma unroll
    for (int a = 0; a < 2; ++a)
#pragma unroll
        for (int b = 0; b < 2; ++b)
#pragma unroll
            for (int m = 0; m < 4; ++m)
#pragma unroll
                for (int n = 0; n < 2; ++n) acc[a][b][m][n] = (f32x4){0.f, 0.f, 0.f, 0.f};
    bf16x8 At[4][2], B0[2][2], B1[2][2];
    const char* cA = (const char*)g.A + (GATHER ? (size_t)0 : (size_t)cur.pm * tstep); const char* cB = (const char*)g.Bt + (size_t)cur.pn * tstep;
    unsigned goffC[2][2] = {{0u, 0u}, {0u, 0u}}, goffN[2][2] = {{0u, 0u}, {0u, 0u}};
    if constexpr (GATHER) PG8_GOFF(goffC, 0);
    S.a_ready(cur);
    if constexpr (SP2) {
        PG8_STAGE(PG8_SB(0, 0), cB, voffB); PG8_STAGE(PG8_SB(0, 1), cB + hstep, voffB); PG8_STAGE_A(PG8_SA(0, 0), cA, 0, false); PG8_STAGE_A(PG8_SA(0, 1), cA + hstepA, 1, false);
        if (wr == 1) PG8_BAR;
        PG8_WAIT_V(2); PG8_BAR;
        PG8_STAGE(PG8_SB(1, 0), cB + kstep, voffB); PG8_STAGE_A(PG8_SA(1, 0), cA + kstep, 0, false); PG8_STAGE(PG8_SB(1, 1), cB + hstep + kstep, voffB);
        PG8_WAIT_V(6); PG8_BAR;
    } else {
        PG8_STAGE(PG8_SB(0, 0), cB, voffB); PG8_STAGE(PG8_SA(0, 0), cA, voffA); PG8_STAGE(PG8_SB(0, 1), cB + hstep, voffB); PG8_STAGE(PG8_SA(0, 1), cA + hstep, voffA);
        if (wr == 1) PG8_BAR;
        PG8_WAIT_V(4); PG8_BAR;
        PG8_STAGE(PG8_SB(1, 0), cB + kstep, voffB); PG8_STAGE(PG8_SA(1, 0), cA + kstep, voffA); PG8_STAGE(PG8_SB(1, 1), cB + hstep + kstep, voffB);
        PG8_WAIT_V(6); PG8_BAR;
    }
    bool seam = false;
#define PG8_WAIT_VX(rx_) asm volatile("v_cmp_ne_u32_e32 vcc, 0, %0\n\ts_cbranch_vccz 1f\n\ts_waitcnt vmcnt(%1)\n\ts_branch 2f\n1:\n\ts_waitcnt vmcnt(8)\n2:" :: "v"(rx_), "n"(8 + Epi::NST) : "memory", "vcc")
    for (;;) {
        const bool has_next = S.next(ui + 1, nxt);
        const char* nA = (has_next && !GATHER) ? (const char*)g.A + (size_t)nxt.pm * tstep : cA;
        const char* nB = has_next ? (const char*)g.Bt + (size_t)nxt.pn * tstep : cB;
        for (int t = 0; t < nt; t += 2) {
            const bool last = (t == nt - 2);
            const int rx = (SP2 && seam && t == 0) ? 1 : 0;
            const char* a1 = cA + (size_t)(t + 1) * kstep;
            const char* a2 = last ? nA : cA + (size_t)(t + 2) * kstep; const char* b2 = last ? nB : cB + (size_t)(t + 2) * kstep;
            const char* a3 = a2 + kstep; const char* b3 = b2 + kstep;
            if (last && has_next) S.a_ready(nxt);
            if constexpr (Epi::HAS_PRE) { if (last) E.pre(cur, wc, fq, epre); }
            if constexpr (GATHER) { if (last) { if (has_next) PG8_GOFF(goffN, ui + 1); else { _Pragma("unroll") for (int _h = 0; _h < 2; ++_h) _Pragma("unroll") for (int _i = 0; _i < 2; ++_i) goffN[_h][_i] = goffC[_h][_i]; } } }
            if constexpr (SP2) {
            PG8_LDB(B0, 0, 0); PG8_LDB(B1, 0, 1); PG8_SCHED; PG8_LDA(At, 0, 0); PG8_STAGE_A(PG8_SA(1, 1), a1 + hstepA, 1, false);
            PG8_WAIT_VX(rx); PG8_WAIT_L(0); PG8_BAR; PG8_MMA(0, 0, At, B0); PG8_MMA(0, 1, At, B1); PG8_BAR; PG8_SCHED;
            PG8_LDA(At, 0, 1); PG8_STAGE(PG8_SB(0, 0), b2, voffB); PG8_STAGE(PG8_SB(0, 1), b2 + hstep, voffB); PG8_STAGE_A(PG8_SA(0, 0), a2, 0, last);
            PG8_WAIT_VX(rx); PG8_WAIT_L(0); PG8_BAR; PG8_MMA(1, 0, At, B0); PG8_MMA(1, 1, At, B1); PG8_BAR; PG8_SCHED;
            PG8_LDB(B0, 1, 0); PG8_LDB(B1, 1, 1); PG8_SCHED; PG8_LDA(At, 1, 0); PG8_STAGE_A(PG8_SA(0, 1), a2 + hstepA, 1, last);
            PG8_WAIT_V(8); PG8_WAIT_L(0); PG8_BAR; PG8_MMA(0, 0, At, B0); PG8_MMA(0, 1, At, B1); PG8_BAR; PG8_SCHED;
            PG8_LDA(At, 1, 1); PG8_STAGE(PG8_SB(1, 0), b3, voffB); PG8_STAGE(PG8_SB(1, 1), b3 + hstep, voffB); PG8_STAGE_A(PG8_SA(1, 0), a3, 0, last);
            PG8_WAIT_V(8); PG8_WAIT_L(0); PG8_BAR; PG8_MMA(1, 0, At, B0); PG8_MMA(1, 1, At, B1); PG8_BAR; PG8_SCHED;
            } else {
            PG8_LDB(B0, 0, 0); PG8_SCHED; PG8_LDA(At, 0, 0); PG8_STAGE(PG8_SA(1, 1), a1 + hstep, voffA);
            PG8_WAIT_L(8); PG8_BAR; PG8_WAIT_L(0); PG8_MMA(0, 0, At, B0); PG8_BAR; PG8_SCHED;
            PG8_LDB(B1, 0, 1); PG8_STAGE(PG8_SB(0, 0), b2, voffB);
            PG8_BAR; PG8_WAIT_L(0); PG8_MMA(0, 1, At, B1); PG8_BAR;
            PG8_LDA(At, 0, 1); PG8_STAGE(PG8_SA(0, 0), a2, voffA);
            PG8_BAR; PG8_WAIT_L(0); PG8_MMA(1, 0, At, B0); PG8_BAR; PG8_SCHED;
            PG8_STAGE(PG8_SB(0, 1), b2 + hstep, voffB);
            PG8_WAIT_V(6); PG8_BAR; PG8_MMA(1, 1, At, B1); PG8_BAR;
            PG8_LDB(B0, 1, 0); PG8_SCHED; PG8_LDA(At, 1, 0); PG8_STAGE(PG8_SA(0, 1), a2 + hstep, voffA);
            PG8_WAIT_L(8); PG8_BAR; PG8_WAIT_L(0); PG8_MMA(0, 0, At, B0); PG8_BAR; PG8_SCHED;
            PG8_LDB(B1, 1, 1); PG8_STAGE(PG8_SB(1, 0), b3, voffB);
            PG8_BAR; PG8_WAIT_L(0); PG8_MMA(0, 1, At, B1); PG8_BAR;
            PG8_LDA(At, 1, 1); PG8_STAGE(PG8_SA(1, 0), a3, voffA);
            PG8_BAR; PG8_WAIT_L(0); PG8_MMA(1, 0, At, B0); PG8_BAR; PG8_SCHED;
            PG8_STAGE(PG8_SB(1, 1), b3 + hstep, voffB);
            PG8_WAIT_V(6); PG8_BAR; PG8_MMA(1, 1, At, B1); PG8_BAR;
            }
        }
        if constexpr (ES == 1) { PG8_SCHED; asm volatile("s_nop 15\n\ts_nop 15" ::: "memory"); PG8_SCHED; }
        if constexpr (ALIGN_EPI) { if (wr == 0) PG8_BAR; }
        if constexpr (!Epi::AFTER_DRAIN) { if constexpr (Epi::HAS_PRE) E(acc, cur, wr, wc, fr, fq, epre); else E(acc, cur, wr, wc, fr, fq); S.done(cur); }
        if (!has_next) break;
#pragma unroll
        for (int a = 0; a < 2; ++a)
#pragma unroll
            for (int b = 0; b < 2; ++b)
#pragma unroll
                for (int m = 0; m < 4; ++m)
#pragma unroll
                    for (int n = 0; n < 2; ++n) acc[a][b][m][n] = (f32x4){0.f, 0.f, 0.f, 0.f};
        cur = nxt; cA = nA; cB = nB; ++ui; seam = SP2;
        if constexpr (GATHER) { _Pragma("unroll") for (int _h = 0; _h < 2; ++_h) _Pragma("unroll") for (int _i = 0; _i < 2; ++_i) goffC[_h][_i] = goffN[_h][_i]; }
        if constexpr (ALIGN_EPI) { if (wr == 1) PG8_BAR; }
    }
    PG8_WAIT_V(0);
    if constexpr (!ALIGN_EPI) { if (wr == 0) PG8_BAR; }
    PG8_BAR;
    if constexpr (Epi::AFTER_DRAIN) { E.fused(acc, cur, wr, wc, fr, fq, lds, wid, lane); S.done(cur); }
#undef PG8_SA
#undef PG8_SB
#undef PG8_STAGE
#undef PG8_STAGE_A
#undef PG8_GOFF
#undef PG8_LDA
#undef PG8_LDB
#undef PG8_MMA
#undef PG8_CAT8
#undef PG8_MFMA8
#undef PG8_WAIT_V
#undef PG8_WAIT_VX
#undef PG8_WAIT_L
#undef PG8_BAR
#undef PG8_SCHED
}
}

namespace att {
using f32x16 = __attribute__((ext_vector_type(16))) float;
__device__ __forceinline__ int crow(int r, int hi) { return (r & 3) + 8 * (r >> 2) + 4 * hi; }
__device__ __forceinline__ unsigned cvtpk(float lo, float hi) { unsigned r; asm volatile("v_cvt_pk_bf16_f32 %0, %1, %2" : "=v"(r) : "v"(lo), "v"(hi)); return r; }
}

namespace att8 {
using att::f32x16; using att::crow;
typedef int i32x4 __attribute__((ext_vector_type(4)));
typedef int i32x8 __attribute__((ext_vector_type(8)));
constexpr int NW = 8, QBLK = 32, KVBLK = 64;
#define SBAR() __builtin_amdgcn_sched_barrier(0)
template <int OFF> __device__ __forceinline__ i32x4 rd128(int a) { i32x4 r; asm volatile("ds_read_b128 %0, %1 offset:%2" : "=&v"(r) : "v"(a), "i"(OFF) : "memory"); return r; }
__device__ __forceinline__ i32x8 cat8(i32x4 lo, i32x4 hi) { return __builtin_shufflevector(lo, hi, 0, 1, 2, 3, 4, 5, 6, 7); }
__device__ __forceinline__ float mx3(float a, float b, float c) { float r; asm("v_max3_f32 %0, %1, %2, %3" : "=v"(r) : "v"(a), "v"(b), "v"(c)); return r; }
constexpr float CSC = 1.f / 65536.f;
template <bool FIRST>
__device__ __forceinline__ void softmax8(f32x16& p0, f32x16& p1, float& M_run, float& alpha, i32x8& pf) {
  constexpr float CTHR = (56.f + 8.f * (5.f * 1.4426950408889634f)) * CSC;
  float a0 = mx3(p0[0], p0[1], p0[2]), a1 = mx3(p0[8], p0[9], p0[10]), a2 = mx3(p1[0], p1[1], p1[2]), a3 = mx3(p1[8], p1[9], p1[10]);
  a0 = mx3(a0, p0[3], p0[4]); a1 = mx3(a1, p0[11], p0[12]); a2 = mx3(a2, p1[3], p1[4]); a3 = mx3(a3, p1[11], p1[12]);
  a0 = mx3(a0, p0[5], p0[6]); a1 = mx3(a1, p0[13], p0[14]); a2 = mx3(a2, p1[5], p1[6]); a3 = mx3(a3, p1[13], p1[14]);
  a0 = mx3(a0, p0[7], a1); a2 = mx3(a2, p1[7], a3);
  float cmax = mx3(a0, p0[15], a2); cmax = mx3(cmax, p1[15], cmax);
  { auto rr = __builtin_amdgcn_permlane32_swap(__float_as_uint(cmax), __float_as_uint(cmax), false, false); cmax = mx3(__uint_as_float(rr[0]), __uint_as_float(rr[1]), __uint_as_float(rr[1])); }
  alpha = 1.f;
  if (FIRST || !__builtin_expect(__all(cmax <= CTHR), 1)) {
    const float tmax = (cmax * 65536.f - 56.f) * 0.125f, d = FIRST ? tmax : fmaxf(tmax, 0.f), d8 = 8.f * d * CSC;
    alpha = __builtin_amdgcn_exp2f(-d); M_run += d;
#pragma unroll
    for (int r = 0; r < 16; ++r) { p0[r] -= d8; p1[r] -= d8; }
  }
  typedef unsigned short us2 __attribute__((ext_vector_type(2)));
#pragma unroll
  for (int w = 0; w < 4; ++w) { const unsigned A = __builtin_bit_cast(unsigned, __builtin_amdgcn_cvt_pknorm_u16(p0[4 * w], p0[4 * w + 1])), B = __builtin_bit_cast(unsigned, __builtin_amdgcn_cvt_pknorm_u16(p0[4 * w + 2], p0[4 * w + 3]));
    pf[w] = (int)__builtin_amdgcn_perm(B, A, 0x06040200u); }
#pragma unroll
  for (int w = 0; w < 4; ++w) { const unsigned A = __builtin_bit_cast(unsigned, __builtin_amdgcn_cvt_pknorm_u16(p1[4 * w], p1[4 * w + 1])), B = __builtin_bit_cast(unsigned, __builtin_amdgcn_cvt_pknorm_u16(p1[4 * w + 2], p1[4 * w + 3]));
    pf[4 + w] = (int)__builtin_amdgcn_perm(B, A, 0x06040200u); }
}

template <int DQK, int LDQ, int LDK, int LDO, bool DIFF, int PROBE = 0>
__device__ __forceinline__ void attn_body8(const unsigned char* __restrict__ Qb, const unsigned char* __restrict__ Kh, const unsigned char* __restrict__ VT, unsigned char* __restrict__ Ob, int seq, char* lds,
                                           int dmode, float lam, const float* __restrict__ subg) {
  constexpr int SHM_V = 128 * 64, SHM_K = 64 * DQK, SLOT = SHM_V + SHM_K, NS = DQK / 64;
  int tid_ = threadIdx.x; asm volatile("" : "+v"(tid_));
  const int tid = tid_, wid = __builtin_amdgcn_readfirstlane(tid >> 6), lane = tid & 63, r32 = lane & 31, hi = lane >> 5, half = wid >> 2;
  constexpr int RD = 4;
  float* ws = (float*)(lds + RD * SLOT) + wid * 64; float* al_l = ws + 32;
  int sc1 = 0x7f7f7f7f; asm volatile("" : "+v"(sc1));
  int scq = 0x6f6f6f6f; asm volatile("" : "+v"(scq));
  float M_run = 0.f; asm volatile("" : "+v"(M_run));
  f32x16 o[4] = {};
  typedef float f32x4_ __attribute__((ext_vector_type(4)));
  f32x4_ osum = {0.f, 0.f, 0.f, 0.f};
  i32x8 sel8;
  { const int onv = (((lane & 15) == 0 && ((lane >> 4) & 1) == 0) || ((lane & 15) == 1 && ((lane >> 4) & 1) == 1)) ? 0x38383838 : 0;
#pragma unroll
    for (int i = 0; i < 8; ++i) { int t_; asm volatile("v_mov_b32 %0, %1" : "=v"(t_) : "v"(onv)); sel8[i] = t_; } }
#define MFMA16S(acc4, a8, b8) asm volatile("v_mfma_scale_f32_16x16x128_f8f6f4 %0, %1, %2, %0, %3, %3 op_sel_hi:[0,0,0]" : "+v"(acc4) : "v"(a8), "v"(b8), "v"(sc1))
  i32x8 qf[NS];
  { const unsigned char* Qw = Qb + (long)(wid * QBLK + r32) * LDQ + hi * 32;
#pragma unroll
    for (int s = 0; s < NS; ++s) qf[s] = cat8(*reinterpret_cast<const i32x4*>(Qw + s * 64), *reinterpret_cast<const i32x4*>(Qw + s * 64 + 16)); }
  const int vrow = 16 * wid + (lane >> 2), vpc = lane & 3;
  const int krow = 8 * wid + ((DQK == 128) ? (lane >> 3) : ((lane >> 2) & 7)), kpc = (DQK == 128) ? (lane & 7) : (lane & 3);
  const unsigned char* vsrc = VT + (long)vrow * SB + ((vpc ^ ((vrow >> 2) & 3)) << 4);
  const unsigned char* ksrc = Kh + (long)krow * LDK + ((DQK == 128) ? ((kpc ^ ((krow >> 1) & 7)) << 4) : ((kpc ^ ((krow >> 2) & 3)) << 4));
  const bool kact = (DQK == 128) || (lane < 32);
  const unsigned ldv = (unsigned)__builtin_amdgcn_readfirstlane((int)(uintptr_t)lds + wid * 1024), ldk = (unsigned)__builtin_amdgcn_readfirstlane((int)(uintptr_t)lds + SHM_V + wid * (DQK == 128 ? 1024 : 512));
#define GLDS16(gsrc, ldst) do { unsigned keep_; asm volatile("s_mov_b32 %0, m0\n\ts_mov_b32 m0, %2\n\ts_nop 0\n\tglobal_load_lds_dwordx4 %1, off\n\ts_mov_b32 m0, %0" : "=&s"(keep_) : "v"(gsrc), "s"(ldst) : "memory"); } while (0)
#define SDMA8(t_, sl_) do { GLDS16(vsrc + (t_) * KVBLK, ldv + (unsigned)((sl_) * SLOT)); if (kact) GLDS16(ksrc + (long)((t_) * KVBLK) * LDK, ldk + (unsigned)((sl_) * SLOT)); } while (0)
#define VMWAIT8(n) asm volatile("s_waitcnt vmcnt(" #n ")" ::: "memory")
#define BARL8() do { SBAR(); asm volatile("s_waitcnt lgkmcnt(0)\n\ts_barrier" ::: "memory"); SBAR(); } while (0)
#define LWAIT8(n) do { asm volatile("s_waitcnt lgkmcnt(" #n ")" ::: "memory"); SBAR(); } while (0)
#define RESC8(a) do { if (__any((a) < 1.f)) { if (hi == 0) al_l[r32] = (a); asm volatile("s_waitcnt lgkmcnt(0)" ::: "memory"); \
    _Pragma("unroll") for (int g = 0; g < 4; ++g) { const f32x4 a4_ = *(const f32x4*)(al_l + 8 * g + 4 * hi);      \
      _Pragma("unroll") for (int i = 0; i < 4; ++i) { _Pragma("unroll") for (int d = 0; d < 4; ++d) o[d][4 * g + i] *= a4_[i]; } SBAR(); } \
    { const f32x4 a4_ = *(const f32x4*)(al_l + (lane & 1) * 16 + 4 * (lane >> 4)); _Pragma("unroll") for (int i = 0; i < 4; ++i) osum[i] *= a4_[i]; }     \
    CIN_SET8(); } } while (0)
#define MFMA8(acc, a8, b8) asm volatile("v_mfma_scale_f32_32x32x64_f8f6f4 %0, %1, %2, %0, %3, %3 op_sel_hi:[0,0,0]" : "+v"(acc) : "v"(a8), "v"(b8), "v"(sc1))
#define MFMA8QC(acc, a8, b8, cin_) asm volatile("v_mfma_scale_f32_32x32x64_f8f6f4 %0, %1, %2, %3, %4, %5 op_sel_hi:[0,0,0]" : "=&v"(acc) : "v"(a8), "v"(b8), "v"(cin_), "v"(scq), "v"(sc1))
#define MFMA8Q(acc, a8, b8) asm volatile("v_mfma_scale_f32_32x32x64_f8f6f4 %0, %1, %2, %0, %3, %4 op_sel_hi:[0,0,0]" : "+v"(acc) : "v"(a8), "v"(b8), "v"(scq), "v"(sc1))
  const int lb = (int)(uintptr_t)lds;
  const int va0 = lb + r32 * 64 + (((2 * hi) ^ ((r32 >> 2) & 3)) << 4), va1 = lb + r32 * 64 + (((2 * hi + 1) ^ ((r32 >> 2) & 3)) << 4);
  const int kz = (DQK == 128) ? ((r32 >> 1) & 7) : ((r32 >> 2) & 3), krb = lb + SHM_V + r32 * DQK;
  const int ka00 = krb + (((2 * hi) ^ kz) << 4), ka01 = krb + (((2 * hi + 1) ^ kz) << 4), ka10 = krb + (((4 + 2 * hi) ^ kz) << 4), ka11 = krb + (((5 + 2 * hi) ^ kz) << 4);
#define KREAD8(so) do { k00 = rd128<0>(ka00 + (so)); k01 = rd128<0>(ka01 + (so)); k10 = rd128<32 * DQK>(ka00 + (so)); k11 = rd128<32 * DQK>(ka01 + (so)); \
    if constexpr (NS == 2) { k20 = rd128<0>(ka10 + (so)); k21 = rd128<0>(ka11 + (so)); k30 = rd128<32 * DQK>(ka10 + (so)); k31 = rd128<32 * DQK>(ka11 + (so)); } } while (0)
#define KREAD8C(SO) do { k00 = rd128<(SO)>(ka00); k01 = rd128<(SO)>(ka01); k10 = rd128<(SO) + 32 * DQK>(ka00); k11 = rd128<(SO) + 32 * DQK>(ka01); \
    if constexpr (NS == 2) { k20 = rd128<(SO)>(ka10); k21 = rd128<(SO)>(ka11); k30 = rd128<(SO) + 32 * DQK>(ka10); k31 = rd128<(SO) + 32 * DQK>(ka11); } } while (0)
#define VREAD8AC(SO) do { v00 = rd128<(SO)>(va0); v01 = rd128<(SO)>(va1); v10 = rd128<(SO) + 2048>(va0); v11 = rd128<(SO) + 2048>(va1); } while (0)
#define VREAD8BC(SO) do { if constexpr (NS == 2) { k00 = rd128<(SO) + 4096>(va0); k01 = rd128<(SO) + 4096>(va1); k10 = rd128<(SO) + 6144>(va0); k11 = rd128<(SO) + 6144>(va1); } \
    else { k20 = rd128<(SO) + 4096>(va0); k21 = rd128<(SO) + 4096>(va1); k30 = rd128<(SO) + 6144>(va0); k31 = rd128<(SO) + 6144>(va1); } } while (0)
#define VREAD8A(so) do { v00 = rd128<0>(va0 + (so)); v01 = rd128<0>(va1 + (so)); v10 = rd128<2048>(va0 + (so)); v11 = rd128<2048>(va1 + (so)); } while (0)
#define VREAD8B(so) do { if constexpr (NS == 2) { k00 = rd128<4096>(va0 + (so)); k01 = rd128<4096>(va1 + (so)); k10 = rd128<6144>(va0 + (so)); k11 = rd128<6144>(va1 + (so)); } \
    else { k20 = rd128<4096>(va0 + (so)); k21 = rd128<4096>(va1 + (so)); k30 = rd128<6144>(va0 + (so)); k31 = rd128<6144>(va1 + (so)); } } while (0)
#define QK8(NV) do { if constexpr (NS == 2) { LWAIT8_(NV + 6); MFMA8QC(p0, cat8(k00, k01), qf[0], cin); LWAIT8_(NV + 4); MFMA8QC(p1, cat8(k10, k11), qf[0], cin); LWAIT8_(NV + 2); MFMA8Q(p0, cat8(k20, k21), qf[NS - 1]); LWAIT8_(NV); MFMA8Q(p1, cat8(k30, k31), qf[NS - 1]); } \
    else { LWAIT8_(NV + 2); MFMA8QC(p0, cat8(k00, k01), qf[0], cin); LWAIT8_(NV); MFMA8QC(p1, cat8(k10, k11), qf[0], cin); } } while (0)
#define LWAIT8_(n) do { asm volatile("s_waitcnt lgkmcnt(%0)" :: "n"(n) : "memory"); SBAR(); } while (0)
#define PV8() do { MFMA16S(osum, pf, sel8); LWAIT8(6); MFMA8(o[0], pf, cat8(v00, v01)); LWAIT8(4); MFMA8(o[1], pf, cat8(v10, v11)); \
    if constexpr (NS == 2) { LWAIT8(2); MFMA8(o[2], pf, cat8(k00, k01)); LWAIT8(0); MFMA8(o[3], pf, cat8(k10, k11)); } else { LWAIT8(2); MFMA8(o[2], pf, cat8(k20, k21)); LWAIT8(0); MFMA8(o[3], pf, cat8(k30, k31)); } } while (0)
  f32x16 p0, p1; float al; i32x8 pf; const int NT = seq / KVBLK;
  f32x16 cin;
#define CIN_SET8() do { const float nm_ = (56.f - 8.f * M_run) * CSC; _Pragma("unroll") for (int r = 0; r < 16; ++r) cin[r] = nm_; asm volatile("" : "+v"(cin)); SBAR(); } while (0)
  i32x4 k00, k01, k10, k11, k20, k21, k30, k31, v00, v01, v10, v11;
#define ACC_INIT8() do { const float nm = (56.f - 8.f * M_run) * CSC; typedef float f2_ __attribute__((ext_vector_type(2))); f2_ n2 = {nm, nm}; asm volatile("" : "+v"(n2)); \
      f2_ q_[16]; _Pragma("unroll") for (int i = 0; i < 16; ++i) asm volatile("v_mov_b64 %0, %1" : "=v"(q_[i]) : "v"(n2)); \
      typedef float f4_ __attribute__((ext_vector_type(4))); typedef float f8_ __attribute__((ext_vector_type(8))); \
      { const f4_ a = __builtin_shufflevector(q_[0], q_[1], 0, 1, 2, 3), b = __builtin_shufflevector(q_[2], q_[3], 0, 1, 2, 3), c = __builtin_shufflevector(q_[4], q_[5], 0, 1, 2, 3), d = __builtin_shufflevector(q_[6], q_[7], 0, 1, 2, 3); \
        const f8_ ab = __builtin_shufflevector(a, b, 0, 1, 2, 3, 4, 5, 6, 7), cd = __builtin_shufflevector(c, d, 0, 1, 2, 3, 4, 5, 6, 7); p0 = __builtin_shufflevector(ab, cd, 0, 1, 2, 3, 4, 5, 6, 7, 8, 9, 10, 11, 12, 13, 14, 15); } \
      { const f4_ a = __builtin_shufflevector(q_[8], q_[9], 0, 1, 2, 3), b = __builtin_shufflevector(q_[10], q_[11], 0, 1, 2, 3), c = __builtin_shufflevector(q_[12], q_[13], 0, 1, 2, 3), d = __builtin_shufflevector(q_[14], q_[15], 0, 1, 2, 3); \
        const f8_ ab = __builtin_shufflevector(a, b, 0, 1, 2, 3, 4, 5, 6, 7), cd = __builtin_shufflevector(c, d, 0, 1, 2, 3, 4, 5, 6, 7); p1 = __builtin_shufflevector(ab, cd, 0, 1, 2, 3, 4, 5, 6, 7, 8, 9, 10, 11, 12, 13, 14, 15); } \
      asm volatile("" : "+v"(p0), "+v"(p1)); SBAR(); } while (0)
  SDMA8(0, 0); SDMA8(1, 1); SDMA8(2, 2); if (half) SDMA8(3, 3);
  VMWAIT8(0); BARL8();
  CIN_SET8();
  KREAD8(0); QK8(0);
  SBAR(); asm volatile("s_nop 15\n\ts_nop 15\n\ts_nop 15\n\ts_nop 15\n\ts_nop 15\n\ts_nop 15" ::: "memory"); SBAR();
  softmax8<true>(p0, p1, M_run, al, pf);
  CIN_SET8();
  if (half) BARL8();
  int sw = (3 + half) & 3;
#define MSEG8(KO, VO) do { \
    if constexpr (NS == 2) { \
      k00 = rd128<(KO)>(ka00); k01 = rd128<(KO)>(ka01); k10 = rd128<(KO) + 32 * DQK>(ka00); k11 = rd128<(KO) + 32 * DQK>(ka01); k20 = rd128<(KO)>(ka10); k21 = rd128<(KO)>(ka11); \
      LWAIT8(4); MFMA8QC(p0, cat8(k00, k01), qf[0], cin); k30 = rd128<(KO) + 32 * DQK>(ka10); k31 = rd128<(KO) + 32 * DQK>(ka11); \
      LWAIT8(4); MFMA8QC(p1, cat8(k10, k11), qf[0], cin); v00 = rd128<(VO)>(va0); v01 = rd128<(VO)>(va1); \
      LWAIT8(4); MFMA8Q(p0, cat8(k20, k21), qf[NS - 1]); v10 = rd128<(VO) + 2048>(va0); v11 = rd128<(VO) + 2048>(va1); \
      LWAIT8(4); MFMA8Q(p1, cat8(k30, k31), qf[NS - 1]); k00 = rd128<(VO) + 4096>(va0); k01 = rd128<(VO) + 4096>(va1); \
      MFMA16S(osum, pf, sel8); k10 = rd128<(VO) + 6144>(va0); k11 = rd128<(VO) + 6144>(va1); \
      LWAIT8(6); MFMA8(o[0], pf, cat8(v00, v01)); LWAIT8(4); MFMA8(o[1], pf, cat8(v10, v11)); LWAIT8(2); MFMA8(o[2], pf, cat8(k00, k01)); LWAIT8(0); MFMA8(o[3], pf, cat8(k10, k11)); \
    } else { \
      k00 = rd128<(KO)>(ka00); k01 = rd128<(KO)>(ka01); k10 = rd128<(KO) + 32 * DQK>(ka00); k11 = rd128<(KO) + 32 * DQK>(ka01); v00 = rd128<(VO)>(va0); v01 = rd128<(VO)>(va1); \
      LWAIT8(4); MFMA8QC(p0, cat8(k00, k01), qf[0], cin); v10 = rd128<(VO) + 2048>(va0); v11 = rd128<(VO) + 2048>(va1); \
      LWAIT8(4); MFMA8QC(p1, cat8(k10, k11), qf[0], cin); k20 = rd128<(VO) + 4096>(va0); k21 = rd128<(VO) + 4096>(va1); \
      MFMA16S(osum, pf, sel8); k30 = rd128<(VO) + 6144>(va0); k31 = rd128<(VO) + 6144>(va1); \
      LWAIT8(6); MFMA8(o[0], pf, cat8(v00, v01)); LWAIT8(4); MFMA8(o[1], pf, cat8(v10, v11)); LWAIT8(2); MFMA8(o[2], pf, cat8(k20, k21)); LWAIT8(0); MFMA8(o[3], pf, cat8(k30, k31)); } } while (0)
#define STEP8(KS, VS, jj) do { \
    MSEG8((KS) * SLOT, (VS) * SLOT); \
    BARL8(); \
    softmax8<false>(p0, p1, M_run, al, pf); RESC8(al); \
    { const int t = (jj) + 3 + half; if (t < NT) { SDMA8(t, sw); VMWAIT8(2); } else VMWAIT8(0); } \
    BARL8(); \
    sw = (sw + 1) & 3; } while (0)
  int j = 0;
  for (; j + 4 < NT; j += 4) { STEP8(1, 0, j); STEP8(2, 1, j + 1); STEP8(3, 2, j + 2); STEP8(0, 3, j + 3); }
  if (j + 1 < NT) { STEP8(1, 0, j); ++j; }
  if (j + 1 < NT) { STEP8(2, 1, j); ++j; }
  if (j + 1 < NT) { STEP8(3, 2, j); ++j; }
  const int sv = j & 3;
#undef STEP8
#undef MSEG8
#undef ACC_INIT8
#undef CIN_SET8
  VREAD8A(sv * SLOT); VREAD8B(sv * SLOT); PV8();
  SBAR(); asm volatile("s_nop 15\n\ts_nop 15\n\ts_nop 15\n\ts_nop 15\n\ts_nop 15\n\ts_nop 15" ::: "memory"); SBAR();
  if (!half) BARL8();
  float rli[16];
  { if ((lane & 15) < 2) *(f32x4*)(al_l + (lane & 15) * 16 + 4 * (lane >> 4)) = (f32x4){osum[0], osum[1], osum[2], osum[3]};
    asm volatile("s_waitcnt lgkmcnt(0)" ::: "memory");
#pragma unroll
    for (int g = 0; g < 4; ++g) { const f32x4 a4 = *(const f32x4*)(al_l + 8 * g + 4 * hi);
#pragma unroll
      for (int i = 0; i < 4; ++i) rli[4 * g + i] = __builtin_amdgcn_rcpf(a4[i]); } }
  unsigned char* Ow = Ob + (long)(wid * QBLK) * LDO;
  if constexpr (!DIFF) {
#pragma unroll
    for (int r = 0; r < 16; ++r) { int orow = crow(r, hi);
#pragma unroll
      for (int d0 = 0; d0 < 4; ++d0) { const float v_ = o[d0][r] * (rli[r] * (OS_GQA / GS_GQA));     Ow[(long)orow * LDO + d0 * 32 + r32] = (unsigned char)__builtin_amdgcn_cvt_pk_fp8_f32(v_, v_, 0, false); } }
  } else {
    char* stash = lds + RD * SLOT + 2048 + wid * 8192 + lane * 16;
    if (dmode == 0) {
#pragma unroll
      for (int q = 0; q < 8; ++q) { const int d0 = q >> 1, r0 = (q & 1) * 8; i32x4 w;
#pragma unroll
        for (int i = 0; i < 4; ++i) w[i] = (int)att::cvtpk(o[d0][r0 + 2 * i] * rli[r0 + 2 * i], o[d0][r0 + 2 * i + 1] * rli[r0 + 2 * i + 1]);
        *(i32x4*)(stash + q * 1024) = w; }
    } else {
      float ss[16];
#pragma unroll
      for (int r = 0; r < 16; ++r) ss[r] = 0.f;
#pragma unroll
      for (int q = 0; q < 8; ++q) { const int d0 = q >> 1, r0 = (q & 1) * 8; const i32x4 w = *(const i32x4*)(stash + q * 1024);
#pragma unroll
        for (int i = 0; i < 4; ++i) { const int r = r0 + 2 * i;
          const float a = bflo((unsigned)w[i]) - lam * (o[d0][r] * rli[r]), b = bfhi((unsigned)w[i]) - lam * (o[d0][r + 1] * rli[r + 1]);
          o[d0][r] = a; o[d0][r + 1] = b; ss[r] += a * a; ss[r + 1] += b * b; } }
      float sg[4];
#pragma unroll
      for (int d0 = 0; d0 < 4; ++d0) sg[d0] = subg[d0 * 32 + r32] * ((1.f - LAM_INIT) * OS_DIFF);
#pragma unroll
      for (int r = 0; r < 16; ++r) { float s = ss[r];
#pragma unroll
        for (int x = 1; x < 32; x <<= 1) s += __shfl_xor(s, x);
        const float rs = rsqrtf(s * (1.f / 128.f) + RMS_EPS * (GS_DIFF * GS_DIFF)); const int orow = crow(r, hi);
#pragma unroll
        for (int d0 = 0; d0 < 4; ++d0) { const float v_ = o[d0][r] * rs * sg[d0]; Ow[(long)orow * LDO + d0 * 32 + r32] = (unsigned char)__builtin_amdgcn_cvt_pk_fp8_f32(v_, v_, 0, false); } }
    }
  }
  BARL8();
#undef GLDS16
#undef SDMA8
#undef VMWAIT8
#undef BARL8
#undef LWAIT8
#undef LWAIT8_
#undef RESC8
#undef MFMA8
#undef MFMA8Q
#undef MFMA16S
#undef KREAD8
#undef VREAD8A
#undef VREAD8B
#undef KREAD8C
#undef VREAD8AC
#undef VREAD8BC
#undef QK8
#undef PV8
}
#undef SBAR
}
#define XB_TMO      128
#define XB_XCNT(j)  (256  + 64 * (j))
#define XB_XSUB(j)  (1280 + 64 * (j))
#define XB_XGEN(j)  (2304 + 64 * (j))
#define XB_TOP      3328
#define XB_TOPGEN   3392
#define XCD_BAR_WORDS 3456
#define XB_SPIN_CAP (1u << 18)

__device__ __forceinline__ unsigned xb_ld(unsigned* p)              { return __hip_atomic_load(p, __ATOMIC_RELAXED, __HIP_MEMORY_SCOPE_AGENT); }
__device__ __forceinline__ unsigned xb_add(unsigned* p, unsigned v) { return __hip_atomic_fetch_add(p, v, __ATOMIC_RELAXED, __HIP_MEMORY_SCOPE_AGENT); }
__device__ __forceinline__ unsigned xb_xcc_id() { return (unsigned)__builtin_amdgcn_s_getreg((3 << 11) | 20) & 0xFu; }
#define XB_SPIN(cond, bar) do { unsigned _sp = 0; while (cond) { __builtin_amdgcn_s_sleep(1); \
    if ((++_sp & 255u) == 0u) { if (xb_ld(&(bar)[XB_TMO])) break; if (_sp > XB_SPIN_CAP) { atomicAdd(&(bar)[XB_TMO], 1u); break; } } } } while (0)

struct XcdBarrier {
    unsigned* bar; unsigned x;
    volatile LAS unsigned* st;
};

__device__ __forceinline__ XcdBarrier xcd_barrier_post(unsigned* bar, volatile LAS unsigned* st) {
    XcdBarrier b; b.bar = bar; b.x = xb_xcc_id(); b.st = st;
    if (threadIdx.x == 0) (void)xb_add(&bar[XB_XCNT(b.x)], 1u);
    return b;
}
__device__ __forceinline__ void xcd_barrier_complete(unsigned* bar, unsigned x, unsigned& nloc, unsigned& nx) {
    const unsigned G = gridDim.x * gridDim.y * gridDim.z;
    unsigned sum, cnt, mine, sp = 0u;
    for (;;) {
        sum = 0u; cnt = 0u; mine = 0u;
#pragma unroll
        for (unsigned j = 0; j < 16; ++j) { const unsigned c = xb_ld(&bar[XB_XCNT(j)]); sum += c; cnt += (c > 0u) ? 1u : 0u; mine = (j == x) ? c : mine; }
        if (sum == G) break;
        __builtin_amdgcn_s_sleep(1);
        if ((++sp & 255u) == 0u) { if (xb_ld(&bar[XB_TMO])) break; if (sp > XB_SPIN_CAP) { atomicAdd(&bar[XB_TMO], 1u); break; } }
    }
    nloc = mine > 0u ? mine : 1u; nx = cnt > 0u ? cnt : 1u;
}

__device__ __forceinline__ void xcd_barrier(const XcdBarrier& b) {
    asm volatile("s_waitcnt vmcnt(0)" ::: "memory");
    __syncthreads();
    if (threadIdx.x == 0) {
        unsigned* bar = b.bar;
        __builtin_amdgcn_s_waitcnt(0);
        unsigned nloc = b.st[0], nx = b.st[1];
        if (nloc == 0u) { xcd_barrier_complete(bar, b.x, nloc, nx); b.st[0] = nloc; b.st[1] = nx; }
        const unsigned old = xb_add(&bar[XB_XSUB(b.x)], 1u);
        const unsigned gen = old / nloc;
        if (old + 1u == (gen + 1u) * nloc) {
            __builtin_amdgcn_fence(__ATOMIC_RELEASE, "agent");
            asm volatile("s_waitcnt vmcnt(0)" ::: "memory");
            const unsigned og = xb_add(&bar[XB_TOP], 1u);
            const unsigned tg = og / nx;
            if (og + 1u == (tg + 1u) * nx) xb_add(&bar[XB_TOPGEN], 1u);
            else XB_SPIN(xb_ld(&bar[XB_TOPGEN]) == tg, bar);
            __builtin_amdgcn_fence(__ATOMIC_ACQUIRE, "agent");
            xb_add(&bar[XB_XGEN(b.x)], 1u);
            asm volatile("s_waitcnt vmcnt(0)" ::: "memory");
        } else {
            XB_SPIN(xb_ld(&bar[XB_XGEN(b.x)]) == gen, bar);
            __builtin_amdgcn_fence(__ATOMIC_ACQUIRE, "agent");
            asm volatile("s_waitcnt vmcnt(0)" ::: "memory");
        }
    }
    __syncthreads();
}

constexpr int NWAVES = 8;
constexpr int N_PHASES = 36;
#ifndef MK_STOP
#define MK_STOP N_PHASES
#endif
#ifndef ATT_SDEPTH
#define ATT_SDEPTH 1
#endif
#ifndef G1_PROBE
#define G1_PROBE 0
#endif
#ifndef ATT_PROBE
#define ATT_PROBE 0
#endif
#ifndef REP_MASK
#define REP_MASK 0
#endif
constexpr size_t WS_JUNK = WS_END - WS_GATE;
constexpr float W8_SCALE = 32.f;
constexpr float QSCALE128 = 8.f * 0.088388347648318440f * 1.4426950408889634f, QSCALE64 = 8.f * 0.125f * 1.4426950408889634f;
#ifndef SM_MASK
#define SM_MASK 127
#endif
#ifndef PRO_PARTS
#define PRO_PARTS 15
#endif
#ifndef MK_MULTI
#define MK_MULTI 0
#endif

struct Args { const float* in[N_IN]; float* out; unsigned char* ws; int ph_lo, ph_hi, dump, pad; };
static_assert(sizeof(Args) == N_IN * 8 + 8 + 8 + 16, "Args has no padding");
typedef const __attribute__((address_space(4))) Args* KArgs;
struct Frame {
    LAS unsigned char* lds;
    char* ldsg;
    int tid, lane, wave, vcu, G, gw, NGW;
    KArgs kp;
    __device__ __forceinline__ const float* in(int i) const { return kp->in[i]; }
    __device__ __forceinline__ float* out() const { return kp->out; }
    __device__ __forceinline__ unsigned char* ws() const { return kp->ws; }
    __device__ __forceinline__ unsigned* ctl() const { return (unsigned*)(kp->ws + WS_CTL); }
};
__device__ __forceinline__ bool refresh(Frame& F) { int t = threadIdx.x; asm volatile("" : "+v"(t)); F.tid = t; F.lane = t & 63; KArgs k = (KArgs)__builtin_amdgcn_kernarg_segment_ptr(); asm volatile("" : "+s"(k)); F.kp = k; return true; }
__device__ __forceinline__ const float* input_row(const Frame& F, int row) {
    const int b = row >= SB ? 1 : 0, w = row - b * SB;
    return (w < NCTX) ? F.in(I_CTX) + ((size_t)(b * NCTX + w)) * D : F.in(I_X) + ((size_t)(b * SEQ + (w - NCTX))) * D;
}
__device__ __forceinline__ int stream_of(int row) { const int b = row >= SB ? 1 : 0, w = row - b * SB; return (w < NCTX) ? 2 : b; }
__device__ __forceinline__ const float* modp(const Frame& F, int layer, int s, int chunk) { return (const float*)(F.ws() + WS_MOD) + ((size_t)(layer * 3 + s) * 6 + chunk) * D; }
__device__ __forceinline__ const float* normg(const Frame& F, int layer, int k) { return F.in(I_NORMG) + (size_t)(layer * 4 + k) * D; }

__device__ __forceinline__ void ld_row_f32(const float* p, int lane, f32x4 (&v)[4]) {
#pragma unroll
    for (int j = 0; j < 4; ++j) v[j] = *(const f32x4*)(p + 256 * j + 4 * lane);
}
__device__ __forceinline__ void st_row_f32(float* p, int lane, const f32x4 (&v)[4]) {
#pragma unroll
    for (int j = 0; j < 4; ++j) *(f32x4*)(p + 256 * j + 4 * lane) = v[j];
}
__device__ __forceinline__ void ld_row_bf16(const bf16_t* p, int lane, f32x4 (&v)[4]) {
#pragma unroll
    for (int j = 0; j < 4; ++j) { const u32x2 w = *(const u32x2*)(p + 256 * j + 4 * lane); v[j] = (f32x4){bflo(w.x), bfhi(w.x), bflo(w.y), bfhi(w.y)}; }
}
__device__ __forceinline__ void ld_row_fp8(const unsigned char* p, int lane, f32x4 (&v)[4]) {
#pragma unroll
    for (int j = 0; j < 4; ++j) { const int w = *(const int*)(p + 256 * j + 4 * lane);
        v[j] = (f32x4){__builtin_amdgcn_cvt_f32_fp8(w, 0), __builtin_amdgcn_cvt_f32_fp8(w, 1), __builtin_amdgcn_cvt_f32_fp8(w, 2), __builtin_amdgcn_cvt_f32_fp8(w, 3)}; }
}
__device__ __forceinline__ void st_row_bf16(bf16_t* p, int lane, const f32x4 (&v)[4]) {
#pragma unroll
    for (int j = 0; j < 4; ++j) { u32x2 w; w.x = pkbf(v[j].x, v[j].y); w.y = pkbf(v[j].z, v[j].w); *(u32x2*)(p + 256 * j + 4 * lane) = w; }
}
__device__ __forceinline__ float row_ss(const f32x4 (&v)[4]) {
    float s = 0.f;
#pragma unroll
    for (int j = 0; j < 4; ++j) s += (v[j].x * v[j].x + v[j].y * v[j].y) + (v[j].z * v[j].z + v[j].w * v[j].w);
    return wave_sum(s);
}
__device__ __forceinline__ void modnorm(const f32x4 (&v)[4], const float* g, const float* m1, const float* m0, int lane, f32x4 (&h)[4]) {
    const float r = rsqrtf(row_ss(v) * (1.f / D) + RMS_EPS);
#pragma unroll
    for (int j = 0; j < 4; ++j) { const f32x4 gv = *(const f32x4*)(g + 256 * j + 4 * lane), a = *(const f32x4*)(m1 + 256 * j + 4 * lane), b = *(const f32x4*)(m0 + 256 * j + 4 * lane);
        h[j] = (v[j] * r) * gv * (a + 1.f) + b; }
}

__device__ __forceinline__ void tr_item(const float* W, int K, int N, bf16_t* WT, int k0, int n0, int dst_row0, LAS float* scr, int lane, const float* colscale = nullptr) {
    float tmp[32]; const float csv = colscale ? colscale[lane & 31] : 1.f;
#pragma unroll
    for (int i = 0; i < 32; ++i) { const int kk = 2 * i + (lane >> 5); tmp[i] = W[(size_t)(k0 + kk) * N + n0 + (lane & 31)]; }
#pragma unroll
    for (int i = 0; i < 32; ++i) { const int kk = 2 * i + (lane >> 5); scr[kk * 33 + (lane & 31)] = tmp[i] * csv; }
    LDS_WAIT(); asm volatile("" ::: "memory");
    const int c = lane & 7;
#pragma unroll
    for (int j = 0; j < 4; ++j) { const int n = (lane >> 3) + 8 * j; const LAS float* s = scr + (8 * c) * 33 + n;
        u32x4 o; o.x = pkbf(s[0 * 33], s[1 * 33]); o.y = pkbf(s[2 * 33], s[3 * 33]); o.z = pkbf(s[4 * 33], s[5 * 33]); o.w = pkbf(s[6 * 33], s[7 * 33]);
        *(u32x4*)(WT + (size_t)(dst_row0 + n) * K + k0 + 8 * c) = o; }
    LDS_WAIT(); asm volatile("" ::: "memory");
}
__device__ __forceinline__ void tr_item8(const float* W, int K, int N, unsigned char* WT, int k0, int n0, int dst_row0, LAS float* scr, int lane, float wscale) {
    float tmp[32];
#pragma unroll
    for (int i = 0; i < 32; ++i) { const int kk = 2 * i + (lane >> 5); tmp[i] = W[(size_t)(k0 + kk) * N + n0 + (lane & 31)]; }
#pragma unroll
    for (int i = 0; i < 32; ++i) { const int kk = 2 * i + (lane >> 5); scr[kk * 33 + (lane & 31)] = tmp[i] * wscale; }
    LDS_WAIT(); asm volatile("" ::: "memory");
    const int c = lane & 7;
#pragma unroll
    for (int j = 0; j < 4; ++j) { const int n = (lane >> 3) + 8 * j; const LAS float* s = scr + (8 * c) * 33 + n;
        int w0 = 0, w1 = 0; w0 = __builtin_amdgcn_cvt_pk_fp8_f32(s[0 * 33], s[1 * 33], w0, false); w0 = __builtin_amdgcn_cvt_pk_fp8_f32(s[2 * 33], s[3 * 33], w0, true);
        w1 = __builtin_amdgcn_cvt_pk_fp8_f32(s[4 * 33], s[5 * 33], w1, false); w1 = __builtin_amdgcn_cvt_pk_fp8_f32(s[6 * 33], s[7 * 33], w1, true);
        *(u32x2*)(WT + (size_t)(dst_row0 + n) * K + k0 + 8 * c) = (u32x2){(unsigned)w0, (unsigned)w1}; }
    LDS_WAIT(); asm volatile("" ::: "memory");
}
__device__ __forceinline__ void tr_plain(const float* W, int K, int N, bf16_t* WT, int row_off, LAS float* scr, int item, int lane, const float* colscale = nullptr) {
    const int nblk = N / 32, kb = item / nblk, nb = item - kb * nblk;
    tr_item(W, K, N, WT, 64 * kb, 32 * nb, row_off + 32 * nb, scr, lane, colscale ? colscale + 32 * nb : nullptr);
}
__device__ __forceinline__ void tr_plain8(const float* W, int K, int N, unsigned char* WT, LAS float* scr, int item, int lane) {
    const int nblk = N / 32, kb = item / nblk, nb = item - kb * nblk;
    tr_item8(W, K, N, WT, 64 * kb, 32 * nb, 32 * nb, scr, lane, W8_SCALE);
}
__device__ __forceinline__ void p0_prologue(Frame& F) {
    {
        LAS float* sv = (LAS float*)(F.lds);
        LAS float* red = (LAS float*)(F.lds + 16384);
        if ((PRO_PARTS & 1) && F.vcu < 192) {
            for (int i = F.tid; i < 3 * D; i += 512) { const int s = i >> 10, k = i & 1023; const float c = (s < 2) ? F.in(I_C)[s * D + k] : F.in(I_CCTX)[k]; sv[i] = c / (1.f + __expf(-c)); }
            __syncthreads();
            for (int task = F.vcu; task < 192; task += F.G) {
                const int layer = task / 48, n0 = (task % 48) * 128;
                const int tx = F.tid & 31, ty = F.tid >> 5;
                const float* wp = F.in(I_MODW) + ((size_t)layer * D + ty * 64) * 6144 + n0 + 4 * tx;
                f32x4 a0 = {0, 0, 0, 0}, a1 = a0, a2 = a0;
#pragma unroll 8
                for (int k = 0; k < 64; ++k) { const f32x4 w = *(const f32x4*)(wp + (size_t)k * 6144); const int kk = ty * 64 + k;
                    a0 += w * sv[kk]; a1 += w * sv[D + kk]; a2 += w * sv[2 * D + kk]; }
                *(LAS f32x4*)(red + (ty * 3 + 0) * 128 + 4 * tx) = a0; *(LAS f32x4*)(red + (ty * 3 + 1) * 128 + 4 * tx) = a1; *(LAS f32x4*)(red + (ty * 3 + 2) * 128 + 4 * tx) = a2;
                __syncthreads();
                if (F.tid < 384) { const int s = F.tid >> 7, n = F.tid & 127; float acc = F.in(I_MODB)[layer * 6144 + n0 + n];
#pragma unroll
                    for (int y = 0; y < 16; ++y) acc += red[(y * 3 + s) * 128 + n];
                    ((float*)(F.ws() + WS_MOD))[((size_t)(layer * 3 + s)) * 6144 + n0 + n] = acc; }
                __syncthreads();
            }
        }
        __syncthreads();
    }
    { bf16_t* b1h = (bf16_t*)(F.ws() + WS_B1H); bf16_t* b2h = (bf16_t*)(F.ws() + WS_B2H); const float* b1 = F.in(I_B1); const float* b2 = F.in(I_B2);
      const int gt = F.vcu * (NWAVES * 64) + F.tid, ngt = F.G * NWAVES * 64;
      for (int i = gt; i < 4 * NE * 2048 / 2; i += ngt) ((unsigned*)b1h)[i] = pkbf(b1[2 * i], b1[2 * i + 1]);
      for (int i = gt; i < 4 * NE * 1024 / 2; i += ngt) ((unsigned*)b2h)[i] = pkbf(b2[2 * i], b2[2 * i + 1]); }
    LAS float* scr = (LAS float*)(F.lds + F.wave * 16384);
    if (PRO_PARTS & 2) {
        constexpr int I_POOL = 4 * (256 / 64) * (256 / 32);
        constexpr int I_GQ = 16 * 48, I_SQ = 16 * 32, I_W3 = 16 * 96;
        constexpr int NSMALL = I_POOL + I_GQ + I_SQ + I_W3 + I_SQ + I_W3 + I_SQ;
        for (int it = F.gw; it < NSMALL; it += F.NGW) {
            int r = it;
            if (r < I_POOL) { if (!(SM_MASK & 1)) continue; const int g = r >> 5; tr_plain(F.in(I_POOLW) + (size_t)g * 65536, 256, 256, (bf16_t*)(F.ws() + WS_POOLW), g * 256, scr, r & 31, F.lane, F.in(I_POOLS) + g * 256); continue; } r -= I_POOL;
            if (r < I_GQ) { if (!(SM_MASK & 2)) continue; tr_plain8(F.in(I_GQKV), D, 1536, F.ws() + WS_GQKV, scr, r, F.lane); continue; } r -= I_GQ;
            if (r < I_SQ) { if (!(SM_MASK & 4)) continue; tr_plain8(F.in(I_GO), D, D, F.ws() + WS_GO, scr, r, F.lane); continue; } r -= I_SQ;
            if (r < I_W3) { if (!(SM_MASK & 8)) continue; tr_plain8(F.in(I_CIN), D, 3072, F.ws() + WS_CIN, scr, r, F.lane); continue; } r -= I_W3;
            if (r < I_SQ) { if (!(SM_MASK & 16)) continue; tr_plain8(F.in(I_COUT), D, D, F.ws() + WS_COUT, scr, r, F.lane); continue; } r -= I_SQ;
            if (r < I_W3) { if (!(SM_MASK & 32)) continue; tr_plain8(F.in(I_DQKV), D, 3072, F.ws() + WS_DQKV, scr, r, F.lane); continue; } r -= I_W3;
            if (!(SM_MASK & 64)) continue; tr_plain8(F.in(I_DO), D, D, F.ws() + WS_DO, scr, r, F.lane);
        }
    }
    if (PRO_PARTS & 12) {
        constexpr int NI1 = 128 * 1024, NIT = NI1 + 128 * 512;
        float cur[32], nxt[32];
#define XW_DECODE(it_) const bool w1_ = (it_) < NI1; const int r2_ = w1_ ? (it_) : (it_) - NI1; const int mat_ = w1_ ? (r2_ >> 10) : (r2_ >> 9), rr_ = w1_ ? (r2_ & 1023) : (r2_ & 511), kb_ = w1_ ? (rr_ >> 7) : (rr_ >> 6), n0_ = 16 * (w1_ ? (rr_ & 127) : (rr_ & 63)), N_ = w1_ ? 2048 : 1024; \
        const float* W_ = w1_ ? F.in(I_W1) + (size_t)mat_ * D * 2048 : F.in(I_W2) + (size_t)mat_ * D * D;
#define XW_LOAD(it_, buf) do { XW_DECODE(it_) _Pragma("unroll") for (int i = 0; i < 32; ++i) { const int kk = 4 * i + (F.lane >> 4); buf[i] = W_[(size_t)(128 * kb_ + kk) * N_ + n0_ + (F.lane & 15)]; } } while (0)
        int it = F.gw;
        if (it < NIT) XW_LOAD(it, cur);
        for (; it < NIT; it += F.NGW) {
            const int itn = it + F.NGW;
            if (itn < NIT) XW_LOAD(itn, nxt);
            XW_DECODE(it)
            const int drow = w1_ ? (mat_ * 2048 + ((n0_ & 1023) >> 7) * 256 + (n0_ >> 10) * 128 + (n0_ & 127)) : (mat_ * 1024 + n0_);
            unsigned char* WT = F.ws() + (w1_ ? WS_W1T : WS_W2T);
#pragma unroll
            for (int i = 0; i < 32; ++i) { const int kk = 4 * i + (F.lane >> 4); scr[kk * 17 + (F.lane & 15)] = cur[i] * W8_SCALE; }
            LDS_WAIT(); asm volatile("" ::: "memory");
            { const int n = F.lane >> 2, c = F.lane & 3; const LAS float* s = scr + (32 * c) * 17 + n; unsigned o8[8];
#pragma unroll
              for (int q = 0; q < 8; ++q) { int w0 = 0; w0 = __builtin_amdgcn_cvt_pk_fp8_f32(s[(4 * q) * 17], s[(4 * q + 1) * 17], w0, false); w0 = __builtin_amdgcn_cvt_pk_fp8_f32(s[(4 * q + 2) * 17], s[(4 * q + 3) * 17], w0, true); o8[q] = (unsigned)w0; }
              unsigned char* d = WT + (size_t)(drow + n) * D + 128 * kb_ + 32 * c;
              *(u32x4*)d = (u32x4){o8[0], o8[1], o8[2], o8[3]}; *(u32x4*)(d + 16) = (u32x4){o8[4], o8[5], o8[6], o8[7]}; }
            LDS_WAIT(); asm volatile("" ::: "memory");
#pragma unroll
            for (int i = 0; i < 32; ++i) cur[i] = nxt[i];
        }
#undef XW_DECODE
#undef XW_LOAD
    }
    __syncthreads();
}

template <bool DRY> __device__ __forceinline__ void p_hpass0(Frame& F) {
    bf16_t* H = (bf16_t*)(F.ws() + WS_H + (DRY ? WS_JUNK : 0));
    int cs = -1; f32x4 pg[4], p0v[4];
    for (int rr = F.gw; rr < T; rr += 2 * F.NGW) {
        const int r0 = rr, r1 = min(rr + F.NGW, T - 1);
        f32x4 v0[4], v1[4], h[4]; ld_row_f32(input_row(F, r0), F.lane, v0); ld_row_f32(input_row(F, r1), F.lane, v1);
#define HP_ROW(v_, r_) do { const int s = stream_of(r_); if (s != cs) { cs = s; const float* gn = normg(F, 0, 0); const float* m1n = modp(F, 0, s, 1); const float* m0n = modp(F, 0, s, 0); \
            _Pragma("unroll") for (int j = 0; j < 4; ++j) { const int o = 256 * j + 4 * F.lane; pg[j] = *(const f32x4*)(gn + o) * (*(const f32x4*)(m1n + o) + 1.f); p0v[j] = *(const f32x4*)(m0n + o); } } \
          const float rx = rsqrtf(row_ss(v_) * (1.f / D) + RMS_EPS); _Pragma("unroll") for (int j = 0; j < 4; ++j) h[j] = (v_[j] * rx) * pg[j] + p0v[j]; st_row_bf16(H + (size_t)(r_) * D, F.lane, h); } while (0)
        HP_ROW(v0, r0); HP_ROW(v1, r1);
#undef HP_ROW
    }
}
template <bool DRY> __device__ __forceinline__ void p_poolprep(Frame& F) {
    const bf16_t* H = (const bf16_t*)(F.ws() + WS_H); bf16_t* Dp = (bf16_t*)(F.ws() + WS_O + (DRY ? WS_JUNK : 0));
    for (int row = F.gw; row < T; row += F.NGW) {
        const int b = row >= SB ? 1 : 0, w = row - b * SB;
        const int s0 = (w < NCTX) ? b * SB : b * SB + NCTX, s1 = (w < NCTX) ? b * SB + NCTX : (b + 1) * SB;
#pragma unroll
        for (int j = 0; j < 4; ++j) {
            constexpr int dummy = 0; (void)dummy;
            const int half = 1 << j;
            const int lo = max(row - half, s0), hi = min(row + half, s1);
            u32x2 q[16];
#pragma unroll
            for (int i = 0; i < 2 * half; ++i) { const int rr = row - half + i; const int rc = (rr >= lo && rr < hi) ? rr : row; q[i] = *(const u32x2*)(H + (size_t)rc * D + 256 * j + 4 * F.lane); }
            const u32x2 qs = *(const u32x2*)(H + (size_t)row * D + 256 * j + 4 * F.lane);
            f32x4 acc = {0, 0, 0, 0};
#pragma unroll
            for (int i = 0; i < 2 * half; ++i) { const int rr = row - half + i; const float wgt = (rr >= lo && rr < hi) ? 1.f : 0.f; acc += (f32x4){bflo(q[i].x), bfhi(q[i].x), bflo(q[i].y), bfhi(q[i].y)} * wgt; }
            const f32x4 self = {bflo(qs.x), bfhi(qs.x), bflo(qs.y), bfhi(qs.y)};
            const f32x4 d = acc * (1.f / (float)(hi - lo)) - self;
            u32x2 o; o.x = pkbf(d.x, d.y); o.y = pkbf(d.z, d.w);
            *(u32x2*)(Dp + ((size_t)j * T + row) * 256 + 4 * F.lane) = o;
        }
    }
}

template <int L>
__device__ __forceinline__ void p_moe_a(Frame& F, const bool DRY) {
    const bf16_t* Y = (const bf16_t*)(F.ws() + WS_Y); const bf16_t* X = (const bf16_t*)(F.ws() + WS_X); bf16_t* Xo = (bf16_t*)(F.ws() + WS_X + (DRY ? WS_JUNK : 0)); unsigned char* H8 = F.ws() + WS_H + (DRY ? WS_JUNK : 0);
    float* gate = (float*)(F.ws() + WS_GATE + (DRY ? WS_JUNK : 0)); int* list = (int*)(F.ws() + WS_LIST);
    LAS float* hbuf = (LAS float*)(F.lds);
    LAS float* part = (LAS float*)(F.lds + 65536);
    LAS int* sel = (LAS int*)(F.lds + 83968);
    LAS int* lcnt = (LAS int*)(F.lds + LC_LCNT); LAS int* gbase = (LAS int*)(F.lds + LC_GBASE);
    const float* g1 = normg(F, L, 1); const float* g2 = normg(F, L, 2);
    const float* rw = F.in(I_RW) + (size_t)L * D * NE; const float* rb = F.in(I_RB) + L * NE;
    const int e = F.lane & 31, kh = F.lane >> 5;
    typedef short rbf16x8 __attribute__((ext_vector_type(8)));
    rbf16x8 wh[4][2], wl[4][2];
#pragma unroll
    for (int s = 0; s < 4; ++s)
#pragma unroll
        for (int n = 0; n < 2; ++n) { unsigned hw[4], lw[4];
#pragma unroll
            for (int q = 0; q < 4; ++q) { const int k = 128 * F.wave + 32 * s + 8 * (F.lane >> 4) + 2 * q; const float w0 = rw[(size_t)k * NE + 16 * n + (F.lane & 15)], w1 = rw[(size_t)(k + 1) * NE + 16 * n + (F.lane & 15)];
                hw[q] = pkbf(w0, w1); lw[q] = pkbf(w0 - bflo(hw[q]), w1 - bfhi(hw[q])); }
            const u32x4 hv = {hw[0], hw[1], hw[2], hw[3]}, lv = {lw[0], lw[1], lw[2], lw[3]}; wh[s][n] = __builtin_bit_cast(rbf16x8, hv); wl[s][n] = __builtin_bit_cast(rbf16x8, lv); }
    const float bias = rb[e];
    if (F.tid < 32) lcnt[F.tid] = 0;
    __syncthreads();
    constexpr int NRA = (L == 3) ? NB * SEQ : T;
#define MA_ROW(n_) ((L == 3) ? (((n_) >> 14) * SB + NCTX + ((n_) & (SEQ - 1))) : (n_))
    const int chunk = (NRA + F.G - 1) / F.G, tok0 = min(NRA, (int)blockIdx.x * chunk), tok1 = min(NRA, tok0 + chunk);
    int cs = -1; f32x4 qm[4], qg[4], q0v[4];
    f32x4 y[2][4], x[2][4];
#define MA_LOAD(base_) do { _Pragma("unroll") for (int tt = 0; tt < 2; ++tt) { const int tok_ = (base_) + F.wave * 2 + tt; if (tok_ < tok1) { \
        const int row_ = MA_ROW(tok_); ld_row_bf16(Y + (size_t)row_ * D, F.lane, y[tt]); if constexpr (L == 0) ld_row_f32(input_row(F, row_), F.lane, x[tt]); else ld_row_bf16(X + (size_t)row_ * D, F.lane, x[tt]); } } } while (0)
    MA_LOAD(tok0);
    for (int base = tok0; base < tok1; base += 16) {
#pragma unroll
        for (int tt = 0; tt < 2; ++tt) {
            const int tl = F.wave * 2 + tt, tok = base + tl;
            if (tok < tok1) {
                const int row = MA_ROW(tok), s = stream_of(row);
                f32x4 h[4];
                if (s != cs) { cs = s; const float* m2 = modp(F, L, s, 2); const float* m4 = modp(F, L, s, 4); const float* m3 = modp(F, L, s, 3);
#pragma unroll
                    for (int j = 0; j < 4; ++j) { const int o = 256 * j + 4 * F.lane; qm[j] = *(const f32x4*)(m2 + o) * *(const f32x4*)(g1 + o); qg[j] = *(const f32x4*)(g2 + o) * (*(const f32x4*)(m4 + o) + 1.f); q0v[j] = *(const f32x4*)(m3 + o); } }
                const float ry = rsqrtf(row_ss(y[tt]) * (1.f / D) + RMS_EPS);
#pragma unroll
                for (int j = 0; j < 4; ++j) x[tt][j] = x[tt][j] + qm[j] * (y[tt][j] * ry);
                st_row_bf16(Xo + (size_t)row * D, F.lane, x[tt]);
                { const float rx = rsqrtf(row_ss(x[tt]) * (1.f / D) + RMS_EPS);
#pragma unroll
                  for (int j = 0; j < 4; ++j) h[j] = (x[tt][j] * rx) * qg[j] + q0v[j]; }
#pragma unroll
                for (int j = 0; j < 4; ++j) { int w = 0; w = __builtin_amdgcn_cvt_pk_fp8_f32(h[j].x, h[j].y, w, false); w = __builtin_amdgcn_cvt_pk_fp8_f32(h[j].z, h[j].w, w, true); *(int*)(H8 + (size_t)row * D + 256 * j + 4 * F.lane) = w; }
#pragma unroll
                for (int j = 0; j < 4; ++j) *(LAS f32x4*)(hbuf + tl * D + 256 * j + 4 * F.lane) = h[j];
            }
        }
        __syncthreads();
        if (base + 16 < tok1) MA_LOAD(base + 16);
        {
            f32x4 lg0 = {0.f, 0.f, 0.f, 0.f}, lg1 = {0.f, 0.f, 0.f, 0.f};
#pragma unroll
            for (int s = 0; s < 4; ++s) {
                const LAS float* hp = hbuf + (F.lane & 15) * D + 128 * F.wave + 32 * s + 8 * (F.lane >> 4);
                const f32x4 x0 = *(const LAS f32x4*)hp, x1 = *(const LAS f32x4*)(hp + 4);
                const unsigned h0 = pkbf(x0.x, x0.y), h1 = pkbf(x0.z, x0.w), h2 = pkbf(x1.x, x1.y), h3 = pkbf(x1.z, x1.w);
                const unsigned l0 = pkbf(x0.x - bflo(h0), x0.y - bfhi(h0)), l1 = pkbf(x0.z - bflo(h1), x0.w - bfhi(h1)), l2 = pkbf(x1.x - bflo(h2), x1.y - bfhi(h2)), l3 = pkbf(x1.z - bflo(h3), x1.w - bfhi(h3));
                const u32x4 hv = {h0, h1, h2, h3}, lv = {l0, l1, l2, l3};
                const rbf16x8 ah = __builtin_bit_cast(rbf16x8, hv), al = __builtin_bit_cast(rbf16x8, lv);
                lg0 = __builtin_amdgcn_mfma_f32_16x16x32_bf16(ah, wh[s][0], lg0, 0, 0, 0); lg1 = __builtin_amdgcn_mfma_f32_16x16x32_bf16(ah, wh[s][1], lg1, 0, 0, 0);
                lg0 = __builtin_amdgcn_mfma_f32_16x16x32_bf16(ah, wl[s][0], lg0, 0, 0, 0); lg1 = __builtin_amdgcn_mfma_f32_16x16x32_bf16(ah, wl[s][1], lg1, 0, 0, 0);
                lg0 = __builtin_amdgcn_mfma_f32_16x16x32_bf16(al, wh[s][0], lg0, 0, 0, 0); lg1 = __builtin_amdgcn_mfma_f32_16x16x32_bf16(al, wh[s][1], lg1, 0, 0, 0);
            }
#pragma unroll
            for (int r = 0; r < 4; ++r) { const int tl = 4 * (F.lane >> 4) + r; part[(F.wave * 16 + tl) * 32 + (F.lane & 15)] = lg0[r]; part[(F.wave * 16 + tl) * 32 + 16 + (F.lane & 15)] = lg1[r]; }
        }
        __syncthreads();
        {
            const int tl = F.wave * 2 + kh, tok = base + tl;
            float v = bias;
#pragma unroll
            for (int w = 0; w < 8; ++w) v += part[(w * 16 + tl) * 32 + e];
            float tv[4]; int ti[4];
#pragma unroll
            for (int k = 0; k < 4; ++k) {
                float cv = v; int ci = e;
#pragma unroll
                for (int o = 1; o < 32; o <<= 1) { const float ov = __shfl_xor(cv, o); const int oi = __shfl_xor(ci, o); if (ov > cv || (ov == cv && oi < ci)) { cv = ov; ci = oi; } }
                tv[k] = cv; ti[k] = ci; if (e == ci) v = -3.0e38f;
            }
            if (tok < tok1) {
                const float e1 = __expf(tv[1] - tv[0]), e2 = __expf(tv[2] - tv[0]), e3 = __expf(tv[3] - tv[0]); const float inv = 1.f / (1.f + e1 + e2 + e3);
                if (e == 0) *(f32x4*)(gate + (size_t)MA_ROW(tok) * 4) = (f32x4){inv, e1 * inv, e2 * inv, e3 * inv};
                if (!DRY && e < 4) { const int ex = (e == 0) ? ti[0] : (e == 1) ? ti[1] : (e == 2) ? ti[2] : ti[3];
                    const int rank = __hip_atomic_fetch_add(lcnt + ex, 1, __ATOMIC_RELAXED, __HIP_MEMORY_SCOPE_WORKGROUP); sel[(tok - tok0) * 4 + e] = ex | (rank << 8); }
            }
        }
    }
#undef MA_LOAD
    __syncthreads();
    if (DRY) return;
    if (F.tid < 32) gbase[F.tid] = (int)__hip_atomic_fetch_add(F.ctl() + CW_CNT + L * 32 + F.tid, (unsigned)lcnt[F.tid], __ATOMIC_RELAXED, __HIP_MEMORY_SCOPE_AGENT);
    __syncthreads();
    for (int i = F.tid; i < (tok1 - tok0) * 4; i += 512) { const int v = sel[i], ee = v & 255, rank = v >> 8; list[(size_t)ee * T + gbase[ee] + rank] = MA_ROW(tok0 + (i >> 2)) * 4 + (i & 3); }
    __syncthreads();
#undef MA_ROW
}
template <int L>
__device__ __forceinline__ int moe_setup(Frame& F) {
    LAS int* cnt = (LAS int*)(F.lds + LC_CNT); LAS int* tbase = (LAS int*)(F.lds + LC_TBASE); LAS int* tile_e = (LAS int*)(F.lds + LC_TILEE);
    __syncthreads();
    if (F.tid < 64) {
        const int c = (F.lane < 32) ? (int)__hip_atomic_load(F.ctl() + CW_CNT + L * 32 + F.lane, __ATOMIC_RELAXED, __HIP_MEMORY_SCOPE_AGENT) : 0;
        const int nt = (c + 255) >> 8;
        int incl = nt;
#pragma unroll
        for (int o = 1; o < 32; o <<= 1) { const int t = __shfl_up(incl, o); if (F.lane >= o) incl += t; }
        const int excl = incl - nt;
        if (F.lane < 32) { cnt[F.lane] = c; tbase[F.lane] = excl; for (int t = 0; t < nt; ++t) tile_e[excl + t] = F.lane; }
        if (F.lane == 31) tbase[32] = incl;
    }
    __syncthreads();
    return tbase[32];
}
template <int L, bool DRY>
__device__ __forceinline__ void p_moe_b(Frame& F) {
    const unsigned char* SLOT = F.ws() + WS_SLOT; const bf16_t* X = (const bf16_t*)(F.ws() + WS_X); bf16_t* Xo = (bf16_t*)(F.ws() + WS_X + (DRY ? WS_JUNK : 0)); unsigned char* H8 = F.ws() + WS_H + (DRY ? WS_JUNK : 0); const float* gate = (const float*)(F.ws() + WS_GATE);
    const float* g3 = normg(F, L, 3);
    constexpr int NR = (L == 3) ? NB * SEQ : T;
    int sl[4][4], sn[4][4]; f32x4 xc[4], xn[4], gc, gn;
#define MB_ROW(n_) ((L == 3) ? (((n_) >> 14) * SB + NCTX + ((n_) & (SEQ - 1))) : (n_))
#define MB_LOAD(n_, S_, X_, G_) do { const int r_ = MB_ROW(n_); G_ = *(const f32x4*)(gate + (size_t)r_ * 4); \
        _Pragma("unroll") for (int k = 0; k < 4; ++k) _Pragma("unroll") for (int j = 0; j < 4; ++j) S_[k][j] = *(const int*)(SLOT + ((size_t)r_ * 4 + k) * D + 256 * j + 4 * F.lane); \
        ld_row_bf16(X + (size_t)r_ * D, F.lane, X_); } while (0)
    int cs = -1; f32x4 pm[4], pg[4], p0v[4];
    int n = F.gw;
    if (n < NR) MB_LOAD(n, sl, xc, gc);
    for (; n < NR; n += F.NGW) {
        const int nn = n + F.NGW;
        if (nn < NR) MB_LOAD(nn, sn, xn, gn);
        const int row = MB_ROW(n), b = row >= SB ? 1 : 0, w = row - b * SB, s = (w < NCTX) ? 2 : b;
        f32x4 y[4], x[4];
#pragma unroll
        for (int j = 0; j < 4; ++j) { y[j] = (f32x4){0, 0, 0, 0}; x[j] = xc[j];
#pragma unroll
            for (int k = 0; k < 4; ++k) { const int q = sl[k][j]; y[j] += (f32x4){__builtin_amdgcn_cvt_f32_fp8(q, 0), __builtin_amdgcn_cvt_f32_fp8(q, 1), __builtin_amdgcn_cvt_f32_fp8(q, 2), __builtin_amdgcn_cvt_f32_fp8(q, 3)} * gc[k]; } }
        if (s != cs) { cs = s; constexpr int LN_ = (L < 3) ? L + 1 : 3; const float* m5 = modp(F, L, s, 5); const float* gn = normg(F, LN_, 0); const float* m1n = modp(F, LN_, s, 1); const float* m0n = modp(F, LN_, s, 0);
#pragma unroll
            for (int j = 0; j < 4; ++j) { const int o = 256 * j + 4 * F.lane; pm[j] = *(const f32x4*)(m5 + o) * *(const f32x4*)(g3 + o); pg[j] = *(const f32x4*)(gn + o) * (*(const f32x4*)(m1n + o) + 1.f); p0v[j] = *(const f32x4*)(m0n + o); } }
        const float ry = rsqrtf(row_ss(y) * (1.f / D) + RMS_EPS);
#pragma unroll
        for (int j = 0; j < 4; ++j) x[j] = x[j] + pm[j] * (y[j] * ry);
        if (L == 3) { st_row_f32((DRY ? (float*)Xo : F.out()) + ((size_t)(b * SEQ + (w - NCTX))) * D, F.lane, x); }
        else {
            st_row_bf16(Xo + (size_t)row * D, F.lane, x);
            f32x4 h[4]; const float rx = rsqrtf(row_ss(x) * (1.f / D) + RMS_EPS);
#pragma unroll
            for (int j = 0; j < 4; ++j) h[j] = (x[j] * rx) * pg[j] + p0v[j];
#pragma unroll
            for (int j = 0; j < 4; ++j) { int w8 = 0; w8 = __builtin_amdgcn_cvt_pk_fp8_f32(h[j].x, h[j].y, w8, false); w8 = __builtin_amdgcn_cvt_pk_fp8_f32(h[j].z, h[j].w, w8, true); *(int*)(H8 + (size_t)row * D + 256 * j + 4 * F.lane) = w8; }
        }
#pragma unroll
        for (int k = 0; k < 4; ++k)
#pragma unroll
            for (int j = 0; j < 4; ++j) sl[k][j] = sn[k][j];
#pragma unroll
        for (int j = 0; j < 4; ++j) xc[j] = xn[j];
        gc = gn;
    }
#undef MB_ROW
#undef MB_LOAD
}
template <int LDG, int VCOL0, int NH>
__device__ __forceinline__ void vt_prep(Frame& F, const bf16_t* G, unsigned char* VT8) {
    LAS unsigned char* scr = F.lds + F.wave * 4096;
    constexpr int NTI = SB / 64;
    const int dvl = F.lane >> 1, hf = F.lane & 1;
    for (int it = F.gw; it < NB * NH * NTI; it += F.NGW) {
        const int tile = it % NTI, bh = it / NTI, b = bh / NH, hd = bh - b * NH;
        const bf16_t* src = G + (size_t)(b * SB + tile * 64 + F.lane) * LDG + VCOL0 + hd * 128;
        unsigned char* dst = VT8 + (size_t)(bh * 128) * SB + tile * 64 + hf * 32;
#pragma unroll 1
        for (int c = 0; c < 4; ++c) {
            u32x4 a[4];
#pragma unroll
            for (int i = 0; i < 4; ++i) a[i] = *(const u32x4*)(src + c * 32 + i * 8);
#pragma unroll
            for (int i = 0; i < 4; ++i) {
                int w0 = 0, w1 = 0;
                w0 = __builtin_amdgcn_cvt_pk_fp8_f32(bflo(a[i].x), bfhi(a[i].x), w0, false); w0 = __builtin_amdgcn_cvt_pk_fp8_f32(bflo(a[i].y), bfhi(a[i].y), w0, true);
                w1 = __builtin_amdgcn_cvt_pk_fp8_f32(bflo(a[i].z), bfhi(a[i].z), w1, false); w1 = __builtin_amdgcn_cvt_pk_fp8_f32(bflo(a[i].w), bfhi(a[i].w), w1, true);
                *(LAS int*)(scr + F.lane * 36 + 8 * i) = w0; *(LAS int*)(scr + F.lane * 36 + 8 * i + 4) = w1;
            }
            LDS_WAIT(); asm volatile("" ::: "memory");
            unsigned o8[8];
#pragma unroll
            for (int q = 0; q < 8; ++q) { const int kb = 32 * (q >> 2) + 8 * (q & 3) + 4 * hf; const LAS unsigned char* p = scr + kb * 36 + dvl;
                o8[q] = (unsigned)p[0] | ((unsigned)p[36] << 8) | ((unsigned)p[72] << 16) | ((unsigned)p[108] << 24); }
            unsigned char* d = dst + (size_t)(c * 32 + dvl) * SB;
            *(u32x4*)d = (u32x4){o8[0], o8[1], o8[2], o8[3]}; *(u32x4*)(d + 16) = (u32x4){o8[4], o8[5], o8[6], o8[7]};
            LDS_WAIT(); asm volatile("" ::: "memory");
        }
    }
}
template <int LDG, int VCOL0, int NH>
__device__ __forceinline__ void vt_prep8(Frame& F, const unsigned char* G, unsigned char* VT8) {
    LAS unsigned char* scr = F.lds + F.wave * 4096;
    constexpr int NTI = SB / 64;
    const int dvl = F.lane >> 1, hf = F.lane & 1;
    for (int it = F.gw; it < NB * NH * NTI; it += F.NGW) {
        const int tile = it % NTI, bh = it / NTI, b = bh / NH, hd = bh - b * NH;
        const unsigned char* src = G + (size_t)(b * SB + tile * 64 + F.lane) * LDG + VCOL0 + hd * 128;
        unsigned char* dst = VT8 + (size_t)(bh * 128) * SB + tile * 64 + hf * 32;
#pragma unroll 1
        for (int c = 0; c < 4; ++c) {
            const u32x4 a0 = *(const u32x4*)(src + c * 32), a1 = *(const u32x4*)(src + c * 32 + 16);
#pragma unroll
            for (int i = 0; i < 4; ++i) { *(LAS unsigned*)(scr + F.lane * 36 + 4 * i) = a0[i]; *(LAS unsigned*)(scr + F.lane * 36 + 16 + 4 * i) = a1[i]; }
            LDS_WAIT(); asm volatile("" ::: "memory");
            unsigned o8[8];
#pragma unroll
            for (int q = 0; q < 8; ++q) { const int kb = 32 * (q >> 2) + 8 * (q & 3) + 4 * hf; const LAS unsigned char* p = scr + kb * 36 + dvl;
                o8[q] = (unsigned)p[0] | ((unsigned)p[36] << 8) | ((unsigned)p[72] << 16) | ((unsigned)p[108] << 24); }
            unsigned char* d = dst + (size_t)(c * 32 + dvl) * SB;
            *(u32x4*)d = (u32x4){o8[0], o8[1], o8[2], o8[3]}; *(u32x4*)(d + 16) = (u32x4){o8[4], o8[5], o8[6], o8[7]};
            LDS_WAIT(); asm volatile("" ::: "memory");
        }
    }
}
template <bool DRY> __device__ __forceinline__ void p_gqa_prep(Frame& F) {
    const unsigned char* G = F.ws() + WS_G; unsigned char* Q8 = F.ws() + WS_Q8; unsigned char* K8 = F.ws() + WS_K8; const float* qg = F.in(I_GQG); const float* kg = F.in(I_GKG);
    const int hi = F.lane >> 5, jl = (F.lane & 31) * 2, c0 = hi * 64 + jl;
    const float f0 = __builtin_amdgcn_exp2f(-(float)(jl & 31) * (LOG2_THETA / 32.f)), f1 = __builtin_amdgcn_exp2f(-(float)((jl + 1) & 31) * (LOG2_THETA / 32.f));
    const float qg0 = qg[c0], qg1 = qg[c0 + 1], kg0 = kg[c0], kg1 = kg[c0 + 1];
    for (int rr = F.gw; rr < T; rr += 2 * F.NGW) {
        unsigned qw[2][10];
#pragma unroll
        for (int u = 0; u < 2; ++u) { const int row = min(rr + u * F.NGW, T - 1); const unsigned char* gr = G + (size_t)row * 1536 + c0;
#pragma unroll
            for (int h = 0; h < 10; ++h) qw[u][h] = *(const unsigned short*)(gr + h * 128); }
#pragma unroll
        for (int u = 0; u < 2; ++u) {
            const int row = min(rr + u * F.NGW, T - 1);
            const int b = row >= SB ? 1 : 0, w = row - b * SB; const bool lat = w >= NCTX; const int t = w - NCTX;
            const float pos = lat ? ((jl < 32) ? (float)(t >> 6) : (float)(t & 63)) : 0.f; const float a0 = pos * f0, a1 = pos * f1;
            const float cs0 = __cosf(a0), sn0 = __sinf(a0), cs1 = __cosf(a1), sn1 = __sinf(a1);
#pragma unroll
            for (int h = 0; h < 10; ++h) {
                const unsigned q = qw[u][h];
                const float x0 = __builtin_amdgcn_cvt_f32_fp8((int)q, 0), x1 = __builtin_amdgcn_cvt_f32_fp8((int)q, 1);
                const float r = rsqrtf(wave_sum(x0 * x0 + x1 * x1) * (1.f / 128.f) + RMS_EPS * (GS_GQA * GS_GQA));
                const float n0 = x0 * r * (h < 8 ? qg0 : kg0), n1 = x1 * r * (h < 8 ? qg1 : kg1);
                const float p0 = __shfl_xor(n0, 32), p1 = __shfl_xor(n1, 32);
                const float o0 = hi ? (n0 * cs0 + p0 * sn0) : (n0 * cs0 - p0 * sn0), o1 = hi ? (n1 * cs1 + p1 * sn1) : (n1 * cs1 - p1 * sn1);
                const float qs = (h < 8) ? QSCALE128 : 1.f;
                const unsigned short w8 = (unsigned short)__builtin_amdgcn_cvt_pk_fp8_f32(o0 * qs, o1 * qs, 0, false);
                if (h < 8) *(unsigned short*)(Q8 + (size_t)row * 1024 + h * 128 + c0) = w8; else *(unsigned short*)(K8 + (size_t)row * 256 + (h - 8) * 128 + c0) = w8;
            }
        }
    }
    vt_prep8<1536, 1280, 2>(F, G, F.ws() + WS_VT8);
}
template <bool DRY> __device__ __forceinline__ void p_diff_prep(Frame& F) {
    const unsigned char* G = F.ws() + WS_G; unsigned char* Q8 = F.ws() + WS_Q8; unsigned char* K8 = F.ws() + WS_K8;
    const int l31 = F.lane & 31, j0 = 2 * l31; const bool first = l31 < 16; const int jj = j0 & 31;
    const float f0 = __builtin_amdgcn_exp2f(-(float)(jj & 15) * (LOG2_THETA / 16.f)), f1 = __builtin_amdgcn_exp2f(-(float)((jj + 1) & 15) * (LOG2_THETA / 16.f));
    for (int rr = F.gw; rr < T; rr += 2 * F.NGW) {
        unsigned qw[2][16];
#pragma unroll
        for (int u = 0; u < 2; ++u) { const int row = min(rr + u * F.NGW, T - 1); const unsigned char* gr = G + (size_t)row * 3072 + 2 * F.lane;
#pragma unroll
            for (int ch = 0; ch < 16; ++ch) qw[u][ch] = *(const unsigned short*)(gr + ch * 128); }
#pragma unroll
        for (int u = 0; u < 2; ++u) {
            const int row = min(rr + u * F.NGW, T - 1);
            const int b = row >= SB ? 1 : 0, w = row - b * SB; const int t = w - NCTX;
            const float pos = (w >= NCTX) ? ((jj < 16) ? (float)(t >> 6) : (float)(t & 63)) : 0.f; const float a0 = pos * f0, a1 = pos * f1;
            const float cs0 = __cosf(a0), sn0 = __sinf(a0), cs1 = __cosf(a1), sn1 = __sinf(a1);
#pragma unroll
            for (int ch = 0; ch < 16; ++ch) {
                const unsigned q = qw[u][ch];
                const float x0 = __builtin_amdgcn_cvt_f32_fp8((int)q, 0), x1 = __builtin_amdgcn_cvt_f32_fp8((int)q, 1);
                const float p0 = __shfl_xor(x0, 16), p1 = __shfl_xor(x1, 16);
                const float o0 = first ? (x0 * cs0 - p0 * sn0) : (x0 * cs0 + p0 * sn0), o1 = first ? (x1 * cs1 - p1 * sn1) : (x1 * cs1 + p1 * sn1);
                const float qs = (ch < 8) ? QSCALE64 / GS_DIFF : 1.f / GS_DIFF;
                const unsigned short w8 = (unsigned short)__builtin_amdgcn_cvt_pk_fp8_f32(o0 * qs, o1 * qs, 0, false);
                if (ch < 8) *(unsigned short*)(Q8 + (size_t)row * 1024 + ch * 128 + 2 * F.lane) = w8; else *(unsigned short*)(K8 + (size_t)row * 1024 + (ch - 8) * 128 + 2 * F.lane) = w8;
            }
        }
    }
    vt_prep8<3072, 2048, 8>(F, G, F.ws() + WS_VT8);
}
template <bool DRY> __device__ __forceinline__ void p_conv_prep(Frame& F) {
    const unsigned char* G = F.ws() + WS_G; unsigned char* Z = F.ws() + WS_O + (DRY ? WS_JUNK : 0); const float* wd = F.in(I_CDW);
    for (int rr = F.gw; rr < T; rr += 2 * F.NGW) {
        int qc[2][3][4], qx[2][3][4], qb[2][4]; float wm[2][3];
#pragma unroll
        for (int u = 0; u < 2; ++u) {
            const int row = min(rr + u * F.NGW, T - 1); const int b = row >= SB ? 1 : 0, w = row - b * SB;
            const int s0 = (w < NCTX) ? b * SB : b * SB + NCTX, s1 = (w < NCTX) ? b * SB + NCTX : (b + 1) * SB;
            const bool hasp = row - 1 >= s0, hasn = row + 1 < s1;
            const int rws[3] = {hasp ? row - 1 : row, row, hasn ? row + 1 : row}; wm[u][0] = hasp ? 1.f : 0.f; wm[u][1] = 1.f; wm[u][2] = hasn ? 1.f : 0.f;
#pragma unroll
            for (int j = 0; j < 4; ++j) { const int c = 256 * j + 4 * F.lane; qb[u][j] = *(const int*)(G + (size_t)row * 3072 + c);
#pragma unroll
                for (int d = 0; d < 3; ++d) { const unsigned char* gp = G + (size_t)rws[d] * 3072 + c; qc[u][d][j] = *(const int*)(gp + 1024); qx[u][d][j] = *(const int*)(gp + 2048); } }
        }
#pragma unroll
        for (int u = 0; u < 2; ++u) {
            const int row = min(rr + u * F.NGW, T - 1);
#pragma unroll
            for (int j = 0; j < 4; ++j) { const int c = 256 * j + 4 * F.lane; f32x4 acc = {0, 0, 0, 0};
#pragma unroll
                for (int d = 0; d < 3; ++d) { const int a = qc[u][d][j], x = qx[u][d][j];
                    const f32x4 uu = (f32x4){__builtin_amdgcn_cvt_f32_fp8(a, 0), __builtin_amdgcn_cvt_f32_fp8(a, 1), __builtin_amdgcn_cvt_f32_fp8(a, 2), __builtin_amdgcn_cvt_f32_fp8(a, 3)}
                                   * (f32x4){__builtin_amdgcn_cvt_f32_fp8(x, 0), __builtin_amdgcn_cvt_f32_fp8(x, 1), __builtin_amdgcn_cvt_f32_fp8(x, 2), __builtin_amdgcn_cvt_f32_fp8(x, 3)};
                    acc += uu * (*(const f32x4*)(wd + d * D + c) * wm[u][d]); }
                const int g = qb[u][j]; constexpr float ZS = OS_CONV / (GS_CONV * GS_CONV * GS_CONV);
                const f32x4 z = acc * (f32x4){__builtin_amdgcn_cvt_f32_fp8(g, 0), __builtin_amdgcn_cvt_f32_fp8(g, 1), __builtin_amdgcn_cvt_f32_fp8(g, 2), __builtin_amdgcn_cvt_f32_fp8(g, 3)};
                int w8 = 0; w8 = __builtin_amdgcn_cvt_pk_fp8_f32(z.x * ZS, z.y * ZS, w8, false); w8 = __builtin_amdgcn_cvt_pk_fp8_f32(z.z * ZS, z.w * ZS, w8, true);
                *(int*)(Z + (size_t)row * D + c) = w8; }
        }
    }
}
template <int PV> __device__ __forceinline__ void p_gqa_attn(Frame& F) {
    const unsigned char* Q8 = F.ws() + WS_Q8; const unsigned char* K8 = F.ws() + WS_K8; const unsigned char* VT8 = F.ws() + WS_VT8; unsigned char* O = F.ws() + WS_O + (PV ? WS_JUNK : 0);
    for (int idx = F.vcu; idx < 1024 + 16; idx += F.G) {
        int b, hq, qrow, seq;
        if (idx < 1024) { const int r = idx >> 8, wi = idx & 255; b = r >> 1; hq = (r & 1) * 4 + (wi >> 6); qrow = b * SB + NCTX + (wi & 63) * 256; seq = SB; }
        else { const int j = idx - 1024; b = j >> 3; hq = j & 7; qrow = b * SB; seq = NCTX; }
        const int kvh = hq >> 2;
        att8::attn_body8<128, 1024, 256, 1024, false, (PV > 0 ? PV - 1 : 0)>(Q8 + (size_t)qrow * 1024 + hq * 128, K8 + (size_t)(b * SB) * 256 + kvh * 128, VT8 + (size_t)((b * 2 + kvh) * 128) * SB,
                                                      O + (size_t)qrow * D + hq * 128, seq, F.ldsg, 0, 0.f, nullptr);
    }
}
__device__ __forceinline__ void p_diff_attn(Frame& F) {
    const unsigned char* Q8 = F.ws() + WS_Q8; const unsigned char* K8 = F.ws() + WS_K8; const unsigned char* VT8 = F.ws() + WS_VT8; unsigned char* O = F.ws() + WS_O;
    const float* lv = F.in(I_DLAM);
    const float lam = __expf(wave_sum(lv[F.lane] * lv[64 + F.lane])) - __expf(wave_sum(lv[128 + F.lane] * lv[192 + F.lane])) + LAM_INIT;
    for (int idx = F.vcu; idx < 1024; idx += F.G) {
#pragma unroll 1
        for (int s = 0; s < 2; ++s) {
            int ix = idx; asm volatile("" : "+s"(ix));
            const int r = ix >> 6, b = r >> 3, h = r & 7, qrow = b * SB + NCTX + (ix & 63) * 256;
            att8::attn_body8<64, 1024, 1024, 1024, true>(Q8 + (size_t)qrow * 1024 + h * 128 + s * 64, K8 + (size_t)(b * SB) * 1024 + h * 128 + s * 64, VT8 + (size_t)((b * 8 + h) * 128) * SB,
                                                         O + (size_t)qrow * D + h * 128, SB, F.ldsg, s, lam, F.in(I_DSUB));
        }
    }
}


#define PG8_ALIGN true
#define PG8_SP2 true

template <int L, int P0> __device__ __forceinline__ void moe_layer(Frame& F, const XcdBarrier& bar, int lo, int hi, int rep_mask);

__global__ void __launch_bounds__(NWAVES * 64, 2) mk_fwd(Args args) {
    extern __shared__ __attribute__((aligned(16))) unsigned char lds[];
    Frame F;
    F.lds = (LAS unsigned char*)lds; F.ldsg = (char*)lds;
    F.tid = threadIdx.x; F.lane = F.tid & 63; F.wave = __builtin_amdgcn_readfirstlane(F.tid >> 6);
    F.G = gridDim.x; { const int bx = blockIdx.x; F.vcu = (F.G % 8 == 0) ? (bx % 8) * (F.G / 8) + bx / 8 : bx; }
    F.gw = F.vcu * NWAVES + F.wave; F.NGW = F.G * NWAVES;
    refresh(F);
    for (int u = F.tid; u < (LDS_BYTES - RING_BYTES) / 4; u += NWAVES * 64) ((LAS unsigned*)(F.lds + RING_BYTES))[u] = 0u;
    __syncthreads();
    XcdBarrier bar; bar.bar = F.ctl() + CW_BAR; bar.x = 0; bar.st = nullptr;
    if (!MK_MULTI) bar = xcd_barrier_post(F.ctl() + CW_BAR, (volatile LAS unsigned*)(F.lds + LC_MISC));
    const int lo = args.ph_lo, hi = args.ph_hi; const int rep_mask = args.pad;
#define IN(k) (lo <= (k) && (k) < hi && refresh(F))
#define NREP(bit) (REP_MASK ? 1 + ((rep_mask & (bit)) ? 1 : 0) : 1)
#define PHM(k) asm volatile("; === PHASE %0" :: "i"(k))
#define SEAM(k) do { if (IN(k) && IN((k) + 1)) { xcd_barrier(bar); if constexpr ((REP_MASK & 256) != 0) xcd_barrier(bar); } } while (0)
    bf16_t* const Hb = (bf16_t*)(F.ws() + WS_H); bf16_t* const Gb = (bf16_t*)(F.ws() + WS_G); bf16_t* const Ob = (bf16_t*)(F.ws() + WS_O); bf16_t* const Yb = (bf16_t*)(F.ws() + WS_Y);

    if (IN(0)) { PHM(0); for (int rep = 0; rep < NREP(16); ++rep) p0_prologue(F); } SEAM(0);
    if (IN(1)) { PHM(1); if constexpr ((REP_MASK & 128) != 0) p_hpass0<true>(F); p_hpass0<false>(F); } SEAM(1);
    if (IN(2)) { PHM(2); if constexpr ((REP_MASK & 128) != 0) p_poolprep<true>(F); p_poolprep<false>(F); } SEAM(2);
    if (IN(3)) { PHM(3);
        int kpool = 256; asm volatile("" : "+s"(kpool));
        pg8::Gemm g{Ob, (const bf16_t*)(F.ws() + WS_POOLW), 4 * T, 256, kpool}; pg8::PoolOrder S{F.G, F.vcu};
        pg8::EpiPool E{Yb, D};
        for (int rep = 0; rep < NREP(32); ++rep) pg8::gemm_phase<pg8::EpiPool, pg8::PoolOrder, PG8_ALIGN, PG8_SP2>(F.lds, g, S, E);
    } SEAM(3);
    moe_layer<0, 4>(F, bar, lo, hi, rep_mask);
    if (IN(9)) { PHM(9);
        int kop = D; asm volatile("" : "+s"(kop));
        pg8::Gemm g{Hb, (const bf16_t*)(F.ws() + WS_GQKV), T, 1536, kop}; pg8::StaticOrder S; S.init(T, 1536, F.G, (int)blockIdx.x);
        pg8::EpiRows8 E{F.ws() + WS_G, 1536, GS_GQA / W8_SCALE};
        pg8::gemm_phase<pg8::EpiRows8, pg8::StaticOrder, PG8_ALIGN, PG8_SP2, 1>(F.lds, g, S, E);
    } SEAM(9);
    if (IN(10)) { PHM(10); if constexpr ((REP_MASK & 128) != 0) p_gqa_prep<true>(F); p_gqa_prep<false>(F); } SEAM(10);
    if (IN(11)) { PHM(11); if constexpr ((REP_MASK & 1) != 0) { p_gqa_attn<ATT_PROBE + 1>(F); refresh(F); } p_gqa_attn<0>(F); } SEAM(11);
    if (IN(12)) { PHM(12);
        int kop = D; asm volatile("" : "+s"(kop));
        pg8::Gemm g{Ob, (const bf16_t*)(F.ws() + WS_GO), T, D, kop}; pg8::StaticOrder S; S.init(T, D, F.G, (int)blockIdx.x);
        pg8::EpiScaled E{Yb, D, 1.f / (W8_SCALE * OS_GQA)};
        for (int rep = 0; rep < NREP(32); ++rep) pg8::gemm_phase<pg8::EpiScaled, pg8::StaticOrder, PG8_ALIGN, PG8_SP2, 1>(F.lds, g, S, E);
    } SEAM(12);
    moe_layer<1, 13>(F, bar, lo, hi, rep_mask);
    if (IN(18)) { PHM(18);
        int kop = D; asm volatile("" : "+s"(kop));
        pg8::Gemm g{Hb, (const bf16_t*)(F.ws() + WS_CIN), T, 3072, kop}; pg8::StaticOrder S; S.init(T, 3072, F.G, (int)blockIdx.x);
        pg8::EpiRows8 E{F.ws() + WS_G, 3072, GS_CONV / W8_SCALE};
        pg8::gemm_phase<pg8::EpiRows8, pg8::StaticOrder, PG8_ALIGN, PG8_SP2, 1>(F.lds, g, S, E);
    } SEAM(18);
    if (IN(19)) { PHM(19); if constexpr ((REP_MASK & 128) != 0) p_conv_prep<true>(F); p_conv_prep<false>(F); } SEAM(19);
    if (IN(20)) { PHM(20);
        int kop = D; asm volatile("" : "+s"(kop));
        pg8::Gemm g{Ob, (const bf16_t*)(F.ws() + WS_COUT), T, D, kop}; pg8::StaticOrder S; S.init(T, D, F.G, (int)blockIdx.x);
        pg8::EpiScaled E{Yb, D, 1.f / (W8_SCALE * OS_CONV)};
        for (int rep = 0; rep < NREP(32); ++rep) pg8::gemm_phase<pg8::EpiScaled, pg8::StaticOrder, PG8_ALIGN, PG8_SP2, 1>(F.lds, g, S, E);
    } SEAM(20);
    moe_layer<2, 21>(F, bar, lo, hi, rep_mask);
    if (IN(26)) { PHM(26);
        int kop = D; asm volatile("" : "+s"(kop));
        pg8::Gemm g{Hb, (const bf16_t*)(F.ws() + WS_DQKV), T, 3072, kop}; pg8::StaticOrder S; S.init(T, 3072, F.G, (int)blockIdx.x);
        pg8::EpiRows8 E{F.ws() + WS_G, 3072, GS_DIFF / W8_SCALE};
        pg8::gemm_phase<pg8::EpiRows8, pg8::StaticOrder, PG8_ALIGN, PG8_SP2, 1>(F.lds, g, S, E);
    } SEAM(26);
    if (IN(27)) { PHM(27); if constexpr ((REP_MASK & 128) != 0) p_diff_prep<true>(F); p_diff_prep<false>(F); } SEAM(27);
    if (IN(28)) { PHM(28); for (int rep = 0; rep < NREP(2); ++rep) p_diff_attn(F); } if (IN(28) && IN(30)) xcd_barrier(bar);
    if (IN(30)) { PHM(30);
        int kop = D; asm volatile("" : "+s"(kop));
        pg8::Gemm g{Ob, (const bf16_t*)(F.ws() + WS_DO), T, D, kop}; pg8::LatentOrder S; S.init(D, F.G, (int)blockIdx.x);
        pg8::EpiScaled E{Yb, D, 1.f / (W8_SCALE * OS_DIFF)};
        for (int rep = 0; rep < NREP(32); ++rep) pg8::gemm_phase<pg8::EpiScaled, pg8::LatentOrder, PG8_ALIGN, PG8_SP2, 1>(F.lds, g, S, E);
    } SEAM(30);
    moe_layer<3, 31>(F, bar, lo, hi, rep_mask);
    if (args.dump) {
        if (!MK_MULTI) xcd_barrier(bar);
        const bf16_t* X = (const bf16_t*)(F.ws() + WS_X);
        for (int row = F.gw; row < T; row += F.NGW) { const int b = row >= SB ? 1 : 0, w = row - b * SB; if (w < NCTX) continue;
            f32x4 v[4]; ld_row_bf16(X + (size_t)row * D, F.lane, v); st_row_f32(F.out() + ((size_t)(b * SEQ + (w - NCTX))) * D, F.lane, v); }
    }
}
struct MoeDeal { int base, stride, limit, nun; };
__device__ __forceinline__ MoeDeal moe_deal(const Frame& F, int U) {
    MoeDeal d;
    if (F.G % 8 == 0) { const int per = F.G / 8, x = F.vcu / per, cl = F.vcu - x * per; d.base = (int)(((long)U * x) / 8) + cl; d.stride = per; d.limit = (int)(((long)U * (x + 1)) / 8); }
    else { d.base = F.vcu; d.stride = F.G; d.limit = U; }
    d.nun = (d.base < d.limit) ? (d.limit - d.base + d.stride - 1) / d.stride : 0;
    return d;
}
template <int L, int P0> __device__ __forceinline__ void moe_layer(Frame& F, const XcdBarrier& bar, int lo, int hi, int rep_mask) {
    if (IN(P0)) { PHM(P0); if constexpr ((REP_MASK & 512) != 0) { p_moe_a<L>(F, true); refresh(F); } p_moe_a<L>(F, false); } if (IN(P0) && IN(P0 + 2)) xcd_barrier(bar);
    if (IN(P0 + 2)) { PHM(P0 + 2);
        const int ntiles = moe_setup<L>(F); const MoeDeal dl = moe_deal(F, ntiles * 8);
        int kop = D; asm volatile("" : "+s"(kop));
        { LAS unsigned short* tk = (LAS unsigned short*)(F.lds + LC_TOK16); const LAS int* cnt = (const LAS int*)(F.lds + LC_CNT); const LAS int* tbase = (const LAS int*)(F.lds + LC_TBASE); const LAS int* tile_e = (const LAS int*)(F.lds + LC_TILEE);
          const int* list = (const int*)(F.ws() + WS_LIST); int nun = dl.nun; if (nun > MAXU) nun = MAXU;
          const int nent = nun * 256;
          for (int idx0 = F.tid; idx0 < nent; idx0 += 5 * NWAVES * 64) { int val[5]; bool ok[5];
#pragma unroll
              for (int k = 0; k < 5; ++k) { const int idx = min(idx0 + k * NWAVES * 64, nent - 1), i = idx >> 8, r = idx & 255, pm = (dl.base + i * dl.stride) >> 3, ee = tile_e[pm], pos = (pm - tbase[ee]) * 256 + r, c = cnt[ee];
                  ok[k] = pos < c; val[k] = list[(size_t)ee * T + min(pos, c - 1)]; }
#pragma unroll
              for (int k = 0; k < 5; ++k) { const int idx = idx0 + k * NWAVES * 64; if (idx < nent) tk[idx] = (unsigned short)(ok[k] ? (val[k] >> 2) : 0); } }
          __syncthreads(); }
        pg8::Gemm g{(const bf16_t*)(F.ws() + WS_H), (const bf16_t*)(F.ws() + WS_W1T + (size_t)L * NE * 2048 * D), T, 2048, kop};
        pg8::MoeOrder S{(const LAS int*)(F.lds + LC_TILEE), dl.limit, 8, dl.stride, dl.base};
        pg8::EpiSwiGLU E{F.ws() + WS_ACT, (const bf16_t*)(F.ws() + WS_B1H) + (size_t)L * NE * 2048, 1.f / W8_SCALE};
        if constexpr ((REP_MASK & 4) != 0) { pg8::EpiSwiGLUT<(G1_PROBE & 3)> E2{F.ws() + WS_HS, (const bf16_t*)(F.ws() + WS_B1H) + (size_t)L * NE * 2048, 1.f / W8_SCALE};
            pg8::gemm_phase<pg8::EpiSwiGLUT<(G1_PROBE & 3)>, pg8::MoeOrder, PG8_ALIGN, PG8_SP2, 1, true, (G1_PROBE >> 2)>(F.lds, g, S, E2, (const LAS unsigned short*)(F.lds + LC_TOK16)); }
        pg8::gemm_phase<pg8::EpiSwiGLU, pg8::MoeOrder, PG8_ALIGN, PG8_SP2, 1, true>(F.lds, g, S, E, (const LAS unsigned short*)(F.lds + LC_TOK16));
    } SEAM(P0 + 2);
    if (IN(P0 + 3)) { PHM(P0 + 3);
        const int ntiles = moe_setup<L>(F); const MoeDeal dl = moe_deal(F, ntiles * 4);
        int kop = D; asm volatile("" : "+s"(kop));
        pg8::Gemm g{(const bf16_t*)(F.ws() + WS_ACT), (const bf16_t*)(F.ws() + WS_W2T + (size_t)L * NE * D * D), CROWS, D, kop};
        pg8::MoeOrder S{(const LAS int*)(F.lds + LC_TILEE), dl.limit, 4, dl.stride, dl.base};
        { LAS int* st = (LAS int*)(F.lds + LC_TOK16); const LAS int* cnt = (const LAS int*)(F.lds + LC_CNT); const LAS int* tbase = (const LAS int*)(F.lds + LC_TBASE); const LAS int* tile_e = (const LAS int*)(F.lds + LC_TILEE);
          const int* list = (const int*)(F.ws() + WS_LIST); int nun = dl.nun; if (nun > MAXU / 2) nun = MAXU / 2;
          const int nent = nun * 256;
          for (int idx0 = F.tid; idx0 < nent; idx0 += 5 * NWAVES * 64) { int val[5]; bool ok[5];
#pragma unroll
              for (int k = 0; k < 5; ++k) { const int idx = min(idx0 + k * NWAVES * 64, nent - 1), i = idx >> 8, r = idx & 255, pm = (dl.base + i * dl.stride) >> 2, ee = tile_e[pm], pos = (pm - tbase[ee]) * 256 + r, c = cnt[ee];
                  ok[k] = pos < c; val[k] = list[(size_t)ee * T + min(pos, c - 1)]; }
#pragma unroll
              for (int k = 0; k < 5; ++k) { const int idx = idx0 + k * NWAVES * 64; if (idx < nent) st[idx] = ok[k] ? val[k] : -1; } }
          __syncthreads(); }
        pg8::EpiScatter E{F.ws() + WS_SLOT, (const LAS int*)(F.lds + LC_TOK16), dl.stride, dl.base, (const bf16_t*)(F.ws() + WS_B2H) + (size_t)L * NE * D, 1.f / W8_SCALE, 0, T * 4};
        pg8::gemm_phase<pg8::EpiScatter, pg8::MoeOrder, PG8_ALIGN, PG8_SP2, 1>(F.lds, g, S, E);
        if constexpr ((REP_MASK & 8) != 0) { pg8::EpiScatter E2{F.ws() + WS_HS, (const LAS int*)(F.lds + LC_TOK16), dl.stride, dl.base, (const bf16_t*)(F.ws() + WS_B2H) + (size_t)L * NE * D, 1.f / W8_SCALE, ((REP_MASK & 4096) ? 1 : 0), CROWS};
            pg8::gemm_phase<pg8::EpiScatter, pg8::MoeOrder, PG8_ALIGN, PG8_SP2, 1>(F.lds, g, S, E2); }
    } SEAM(P0 + 3);
    if (IN(P0 + 4)) { PHM(P0 + 4); if constexpr ((REP_MASK & 1024) != 0) p_moe_b<L, true>(F); p_moe_b<L, false>(F); } SEAM(P0 + 4);
}
#undef IN
#undef SEAM

extern "C" void kernel_launch(void* const* d_in, const int* in_sizes, int n_in, void* d_out, int out_size, void* d_ws, size_t ws_size, hipStream_t stream) {
    static int grid = 0;
    if (grid == 0) {
        if (n_in != N_IN || in_sizes[0] != NB * SEQ * D || out_size != NB * SEQ * D || ws_size < WS_END) {
            fprintf(stderr, "kernel_launch: shape mismatch (n_in %d, in0 %d, out %d, ws %zu, need %zu); nothing launched\n", n_in, n_in > 0 ? in_sizes[0] : -1, out_size, ws_size, (size_t)WS_END); grid = -1; return; }
        { const long long exp_sz[N_IN] = {(long long)NB * SEQ * D, NB * D, NB * NCTX * D, D, 4LL * D * 6 * D, 4 * 6 * D, 4 * 4 * D, 4 * 256 * 256, D, D * 1536, D * D, 128, 128, D * 3072, 3 * D, D * D, D * 3072, D * D, 4 * 64, 128,
                                             4 * D * NE, 4 * NE, 4LL * NE * D * 2048, 4 * NE * 2048, 4LL * NE * D * D, 4 * NE * D};
          for (int i = 0; i < N_IN; ++i) if ((long long)in_sizes[i] != exp_sz[i]) { fprintf(stderr, "kernel_launch: input %d has %d elements, expected %lld; nothing launched\n", i, in_sizes[i], exp_sz[i]); grid = -1; return; } }
        int dev = 0, cus = 0, per_cu = 0;
        if (hipGetDevice(&dev) != hipSuccess || hipDeviceGetAttribute(&cus, hipDeviceAttributeMultiprocessorCount, dev) != hipSuccess) { fprintf(stderr, "kernel_launch: device query failed\n"); grid = -1; return; }
        if (hipFuncSetAttribute((const void*)mk_fwd, hipFuncAttributeMaxDynamicSharedMemorySize, LDS_BYTES) != hipSuccess) { fprintf(stderr, "kernel_launch: hipFuncSetAttribute failed\n"); grid = -1; return; }
        if (hipOccupancyMaxActiveBlocksPerMultiprocessor(&per_cu, (const void*)mk_fwd, NWAVES * 64, LDS_BYTES) != hipSuccess || per_cu < 1)
            fprintf(stderr, "kernel_launch: note: occupancy query reports %d workgroups per CU\n", per_cu);
        (void)hipGetLastError();
        grid = cus;
    }
    if (grid < 0) return;
    if (hipMemsetAsync((char*)d_ws + WS_CTL, 0, CTL_ZERO_BYTES, stream) != hipSuccess) { fprintf(stderr, "kernel_launch: memset failed\n"); return; }
    Args a{};
    for (int i = 0; i < N_IN; ++i) a.in[i] = (const float*)d_in[i];
    a.out = (float*)d_out; a.ws = (unsigned char*)d_ws; a.pad = REP_MASK;
    constexpr int STOP = MK_STOP;
#if MK_MULTI
    for (int p = 0; p < STOP; ++p) { a.ph_lo = p; a.ph_hi = p + 1; a.dump = 0; hipLaunchKernelGGL(mk_fwd, dim3(grid), dim3(NWAVES * 64), LDS_BYTES, stream, a); }
    if (STOP < N_PHASES) { a.ph_lo = 0; a.ph_hi = 0; a.dump = 1; hipLaunchKernelGGL(mk_fwd, dim3(grid), dim3(NWAVES * 64), LDS_BYTES, stream, a); }
#else
    a.ph_lo = 0; a.ph_hi = STOP; a.dump = (STOP < N_PHASES) ? 1 : 0;
    hipLaunchKernelGGL(mk_fwd, dim3(grid), dim3(NWAVES * 64), LDS_BYTES, stream, a);
#endif
    const hipError_t le = hipPeekAtLastError();
    if (le != hipSuccess) fprintf(stderr, "kernel_launch: launch failed: %s\n", hipGetErrorName(le));
}
```
